# Optimizing an MI355X kernel written in HIP

```python
import jax
import jax.numpy as jnp
from jax import lax
import numpy as np

D_MODEL = 1024
BATCH = 2
SEQ = 16384
DEPTH = 2

HEAD_DIM = 64
N_GROUPS = 4
MIX_W = N_GROUPS * HEAD_DIM
N_BRANCH = 4
CONV_W = 3
Q_LORA = 256
KV_LORA = 128
QK_NOPE = 64
QK_ROPE = 32
QK_HEAD = QK_NOPE + QK_ROPE
V_HEAD = 64
Q_BLOCK = 128
SG_CHUNK = 128
RET_CHUNK = 128
D_FF = 2816
N_EXPERTS = 8
TOP_K = 2
D_FF_EXPERT = 3584
N_DENSE = (DEPTH + 1) // 2
N_MOE = DEPTH // 2
ROPE_THETA = 10000.0
EPS = 1e-6
IN_SIZES = (MIX_W, MIX_W, MIX_W, Q_LORA, KV_LORA, QK_ROPE, MIX_W, MIX_W, MIX_W, MIX_W, MIX_W, MIX_W, N_BRANCH * D_MODEL)
D_IN = 9 * MIX_W + Q_LORA + KV_LORA + QK_ROPE + N_BRANCH * D_MODEL

kernel_name = 'hybrid_gated_mixers_moe_trunk'


def rms_norm(x, g):
    xf = x.astype(jnp.float32)
    y = xf * lax.rsqrt(jnp.mean(xf * xf, axis=-1, keepdims=True) + EPS)
    return (y * g.astype(jnp.float32)).astype(x.dtype)


def head_layer_norm(x, g):
    xf = x.astype(jnp.float32)
    xc = xf - jnp.mean(xf, axis=-1, keepdims=True)
    var = jnp.mean(xc * xc, axis=-1, keepdims=True)
    return (xc * lax.rsqrt(var + EPS) * g.astype(jnp.float32)).astype(x.dtype)


def rotary(x, positions):
    half = x.shape[-1] // 2
    inv_freq = ROPE_THETA ** (-jnp.arange(half, dtype=jnp.float32) / half)
    ang = positions.astype(jnp.float32)[:, :, None] * inv_freq
    cos = jnp.cos(ang)[:, :, None, :]
    sin = jnp.sin(ang)[:, :, None, :]
    xf = x.astype(jnp.float32)
    x1, x2 = xf[..., :half], xf[..., half:]
    return jnp.concatenate([x1 * cos - x2 * sin, x2 * cos + x1 * sin], axis=-1).astype(x.dtype)


def modulate(h, shift, scale):
    return h * (1.0 + scale) + shift


def short_conv_mixer(b_gate, c_gate, z, conv_w):
    u = c_gate * z
    y = lax.conv_general_dilated(u, conv_w[:, None, :].astype(u.dtype), window_strides=(1,),
                                 padding=[(CONV_W - 1, 0)], dimension_numbers=('NWC', 'WIO', 'NWC'),
                                 feature_group_count=MIX_W)
    return b_gate * y


def blocked_causal_attention(q, k, v):
    B, S, H, Dq = q.shape
    nb = S // Q_BLOCK
    qb = q.reshape(B, nb, Q_BLOCK, H, Dq).transpose(1, 0, 2, 3, 4)
    k_idx = jnp.arange(S)
    scale = Dq ** -0.5

    def one_block(args):
        q_blk, i = args
        s = jnp.einsum('bqhd,bkhd->bhqk', q_blk, k).astype(jnp.float32) * scale
        q_idx = i * Q_BLOCK + jnp.arange(Q_BLOCK)
        s = jnp.where(k_idx[None, :] <= q_idx[:, None], s, -jnp.inf)
        p = jax.nn.softmax(s, axis=-1).astype(v.dtype)
        return jnp.einsum('bhqk,bkhd->bqhd', p, v)

    out = lax.map(one_block, (qb, jnp.arange(nb)))
    return out.transpose(1, 0, 2, 3, 4).reshape(B, S, H, v.shape[-1])


def mla_mixer(c_q, c_kv, k_rope, positions, cq_g, w_uq, ckv_g, w_ukv, qn_g, kn_g):
    B, S, _ = c_q.shape
    q = (rms_norm(c_q, cq_g) @ w_uq).reshape(B, S, N_GROUPS, QK_HEAD)
    kv = (rms_norm(c_kv, ckv_g) @ w_ukv).reshape(B, S, N_GROUPS, QK_NOPE + V_HEAD)
    k_nope, v = kv[..., :QK_NOPE], kv[..., QK_NOPE:]
    k_pe = jnp.broadcast_to(k_rope[:, :, None, :], (B, S, N_GROUPS, QK_ROPE))
    k = jnp.concatenate([k_nope, k_pe], axis=-1)
    q = rms_norm(q, qn_g)
    k = rms_norm(k, kn_g)
    q = jnp.concatenate([q[..., :QK_NOPE], rotary(q[..., QK_NOPE:], positions)], axis=-1)
    k = jnp.concatenate([k[..., :QK_NOPE], rotary(k[..., QK_NOPE:], positions)], axis=-1)
    return blocked_causal_attention(q, k, v).reshape(B, S, N_GROUPS * V_HEAD)


def spatial_gating_mixer(u, v, gv_g, w_s, b_s):
    B, S, _ = u.shape
    nc = S // SG_CHUNK
    u = jax.nn.gelu(u).reshape(B, nc, SG_CHUNK, N_GROUPS, HEAD_DIM)
    v = rms_norm(jax.nn.gelu(v).reshape(B, S, N_GROUPS, HEAD_DIM), gv_g)
    v = v.reshape(B, nc, SG_CHUNK, N_GROUPS, HEAD_DIM)
    ws = jnp.tril(w_s)
    mixed = jnp.einsum('gts,bnsgc->bntgc', ws, v) + b_s.T[:, :, None]
    return (u * mixed).reshape(B, S, MIX_W)


def retention_mixer(q, k, v, g, positions, ret_g):
    B, S, _ = q.shape
    H, dk, C = N_GROUPS, HEAD_DIM, RET_CHUNK
    nc = S // C
    f32 = jnp.float32
    q = rotary(q.reshape(B, S, H, dk), positions).astype(f32)
    k = rotary(k.reshape(B, S, H, dk), positions).astype(f32) * dk ** -0.5
    v = v.reshape(B, S, H, dk).astype(f32)
    log_gamma = jnp.log1p(-(2.0 ** (-5.0 - jnp.arange(H, dtype=f32))))
    qc = q.reshape(B, nc, C, H, dk)
    kc = k.reshape(B, nc, C, H, dk)
    vc = v.reshape(B, nc, C, H, dk)
    pos = jnp.arange(C, dtype=f32)
    rel = pos[:, None] - pos[None, :]
    decay = jnp.where(rel >= 0, jnp.exp(log_gamma[:, None, None] * jnp.maximum(rel, 0.0)), 0.0)
    scores = jnp.einsum('bnihd,bnjhd->bnhij', qc, kc) * decay
    o_inner = jnp.einsum('bnhij,bnjhd->bnihd', scores, vc)
    k_decay = jnp.exp(log_gamma[None, :] * (C - 1.0 - pos)[:, None])
    kv_chunk = jnp.einsum('bnjhd,bnjhe->bnhde', kc * k_decay[:, :, None], vc)
    chunk_decay = jnp.exp(log_gamma * C)[None, :, None, None]

    def step(state, kv_n):
        return state * chunk_decay + kv_n, state

    init = jnp.zeros((B, H, dk, dk), f32)
    _, prev = lax.scan(step, init, kv_chunk.transpose(1, 0, 2, 3, 4))
    prev = prev.transpose(1, 0, 2, 3, 4)
    q_decay = jnp.exp(log_gamma[None, :] * (pos + 1.0)[:, None])
    o_cross = jnp.einsum('bnihd,bnhde->bnihe', qc * q_decay[:, :, None], prev)
    o = head_layer_norm((o_inner + o_cross).reshape(B, S, H, dk), ret_g).reshape(B, S, MIX_W)
    return (jax.nn.silu(g.astype(f32)) * o).astype(g.dtype)


def mixer_sublayer(h, positions, w_in, conv_w, cq_g, w_uq, ckv_g, w_ukv, qn_g, kn_g,
                   gv_g, w_s, b_s, ret_g, w_branch, w_o):
    B, S, _ = h.shape
    points = np.cumsum(IN_SIZES)[:-1].tolist()
    (a_b, a_c, a_x, m_cq, m_ckv, m_kr, s_u, s_v, r_q, r_k, r_v, r_g, gate_logits) = jnp.split(h @ w_in, points, axis=-1)
    ys = (
        short_conv_mixer(a_b, a_c, a_x, conv_w),
        mla_mixer(m_cq, m_ckv, m_kr, positions, cq_g, w_uq, ckv_g, w_ukv, qn_g, kn_g),
        spatial_gating_mixer(s_u, s_v, gv_g, w_s, b_s),
        retention_mixer(r_q, r_k, r_v, r_g, positions, ret_g),
    )
    merged = jnp.zeros((B, S, D_MODEL), h.dtype)
    for n in range(N_BRANCH):
        gate = jax.nn.sigmoid(gate_logits[..., n * D_MODEL:(n + 1) * D_MODEL])
        merged = merged + gate * (ys[n] @ w_branch[n])
    return merged @ w_o


def swiglu(h, w1, w3, w2):
    return (jax.nn.silu(h @ w1) * (h @ w3)) @ w2


def moe_swiglu(h, router_w, router_b, w1, w3, w2):
    B, S, D = h.shape
    t = h.reshape(B * S, D)
    n_tok = t.shape[0]
    probs = jax.nn.softmax((t @ router_w + router_b).astype(jnp.float32), axis=-1)
    top_p, top_i = lax.top_k(probs, TOP_K)
    top_p = top_p / jnp.sum(top_p, axis=-1, keepdims=True)
    flat_e = top_i.reshape(-1)
    order = jnp.argsort(flat_e)
    tok = order // TOP_K
    sizes = jnp.bincount(flat_e, length=N_EXPERTS).astype(jnp.int32)
    xs = t[tok]
    hid = jax.nn.silu(lax.ragged_dot(xs, w1, sizes)) * lax.ragged_dot(xs, w3, sizes)
    y = lax.ragged_dot(hid, w2, sizes) * top_p.reshape(-1)[order][:, None].astype(h.dtype)
    out = jnp.zeros((n_tok, D), h.dtype).at[tok].add(y)
    return out.reshape(B, S, D)


def setup_inputs(seed: int = 0) -> dict:
    key = jax.random.key(seed)
    ks = jax.random.split(key, 32)
    f32 = jnp.float32
    L = DEPTH

    def nrm(k, shape, scale):
        return jax.random.normal(k, shape, f32) * scale

    def gain(k, shape):
        return 1.0 + 0.02 * jax.random.normal(k, shape, f32)

    start = jax.random.randint(ks[2], (BATCH, 1), 0, 4096, dtype=jnp.int32)
    return {
        'x': nrm(ks[0], (BATCH, SEQ, D_MODEL), 1.0),
        'c': nrm(ks[1], (BATCH, D_MODEL), 1.0),
        'positions': start + jnp.arange(SEQ, dtype=jnp.int32)[None, :],
        'norm1_g': gain(ks[3], (L, D_MODEL)),
        'norm2_g': gain(ks[4], (L, D_MODEL)),
        'ada_w': nrm(ks[5], (L, D_MODEL, 6 * D_MODEL), D_MODEL ** -0.5),
        'ada_b': nrm(ks[6], (L, 6 * D_MODEL), 0.02),
        'w_in': nrm(ks[7], (L, D_MODEL, D_IN), D_MODEL ** -0.5),
        'conv_w': nrm(ks[8], (L, CONV_W, MIX_W), CONV_W ** -0.5),
        'cq_g': gain(ks[9], (L, Q_LORA)),
        'w_uq': nrm(ks[10], (L, Q_LORA, N_GROUPS * QK_HEAD), Q_LORA ** -0.5),
        'ckv_g': gain(ks[11], (L, KV_LORA)),
        'w_ukv': nrm(ks[12], (L, KV_LORA, N_GROUPS * (QK_NOPE + V_HEAD)), KV_LORA ** -0.5),
        'qn_g': gain(ks[13], (L, QK_HEAD)),
        'kn_g': gain(ks[14], (L, QK_HEAD)),
        'gv_g': gain(ks[15], (L, N_GROUPS, HEAD_DIM)),
        'w_s': nrm(ks[16], (L, N_GROUPS, SG_CHUNK, SG_CHUNK), SG_CHUNK ** -0.5),
        'b_s': gain(ks[17], (L, N_GROUPS, SG_CHUNK)),
        'ret_g': gain(ks[18], (L, N_GROUPS, HEAD_DIM)),
        'w_branch': nrm(ks[19], (L, N_BRANCH, MIX_W, D_MODEL), MIX_W ** -0.5),
        'w_o': nrm(ks[20], (L, D_MODEL, D_MODEL), D_MODEL ** -0.5),
        'ffn_w1': nrm(ks[21], (N_DENSE, D_MODEL, D_FF), D_MODEL ** -0.5),
        'ffn_w3': nrm(ks[22], (N_DENSE, D_MODEL, D_FF), D_MODEL ** -0.5),
        'ffn_w2': nrm(ks[23], (N_DENSE, D_FF, D_MODEL), D_FF ** -0.5),
        'router_w': nrm(ks[24], (N_MOE, D_MODEL, N_EXPERTS), D_MODEL ** -0.5),
        'router_b': nrm(ks[25], (N_MOE, N_EXPERTS), 0.01),
        'moe_w1': nrm(ks[26], (N_MOE, N_EXPERTS, D_MODEL, D_FF_EXPERT), D_MODEL ** -0.5),
        'moe_w3': nrm(ks[27], (N_MOE, N_EXPERTS, D_MODEL, D_FF_EXPERT), D_MODEL ** -0.5),
        'moe_w2': nrm(ks[28], (N_MOE, N_EXPERTS, D_FF_EXPERT, D_MODEL), D_FF_EXPERT ** -0.5),
    }


def reference(x, c, positions, norm1_g, norm2_g, ada_w, ada_b, w_in, conv_w, cq_g, w_uq, ckv_g, w_ukv,
              qn_g, kn_g, gv_g, w_s, b_s, ret_g, w_branch, w_o, ffn_w1, ffn_w3, ffn_w2,
              router_w, router_b, moe_w1, moe_w3, moe_w2):
    cond = jax.nn.silu(c)
    for l in range(DEPTH):
        ada = (cond @ ada_w[l] + ada_b[l])[:, None, :]
        sh1, sc1, g1, sh2, sc2, g2 = jnp.split(ada, 6, axis=-1)
        h = modulate(rms_norm(x, norm1_g[l]), sh1, sc1)
        x = x + g1 * mixer_sublayer(h, positions, w_in[l], conv_w[l], cq_g[l], w_uq[l], ckv_g[l], w_ukv[l],
                                    qn_g[l], kn_g[l], gv_g[l], w_s[l], b_s[l], ret_g[l], w_branch[l], w_o[l])
        h = modulate(rms_norm(x, norm2_g[l]), sh2, sc2)
        if l % 2 == 0:
            f = swiglu(h, ffn_w1[l // 2], ffn_w3[l // 2], ffn_w2[l // 2])
        else:
            f = moe_swiglu(h, router_w[l // 2], router_b[l // 2], moe_w1[l // 2], moe_w3[l // 2], moe_w2[l // 2])
        x = x + g2 * f
    return x
```

```cpp
#include <hip/hip_runtime.h>
#include <cstdio>
#include <cstdint>
#include <cmath>

constexpr int DM = 1024, NBATCH = 2, SEQ = 16384, NTOK = NBATCH * SEQ, DEPTH = 2;
constexpr int MIXW = 256, D_IN = 6816, PROJW = 2816, GATEW = 4096, NPROJ_SRC = 2720;
constexpr int QKH = 96, NHEAD = 4, QW = NHEAD * QKH  , DFF = 2816, NEXP = 8, DFFE = 3584;
constexpr int CHUNK = 128, NCHUNK = SEQ / CHUNK  ;
constexpr float EPS = 1e-6f;
constexpr int C_AB = 0, C_AC = 256, C_AX = 512, C_CQ = 768, C_CKV = 1024, C_KR = 1152, C_SU = 1280, C_SV = 1536, C_RQ = 1792, C_RK = 2048, C_RV = 2304, C_RG = 2560;
constexpr int A_SH1 = 0, A_SC1 = 1024, A_G1 = 2048, A_SH2 = 3072, A_SC2 = 4096, A_G2 = 5120;
constexpr float ATT_C2 = 0.10206207261596575f * 1.4426950408889634f;

constexpr size_t MiB = 1u << 20;
constexpr size_t WS_CTL = 0, CTL_ZERO_BYTES = 1 * MiB;
constexpr size_t WS_ADA = 1 * MiB;
constexpr size_t WS_PSLOT = 1 * MiB + 256 * 1024;
constexpr size_t WS_PEXP = 1 * MiB + 768 * 1024;
constexpr size_t WS_BND = 1 * MiB + 800 * 1024;
constexpr size_t WS_ROUTE = 2 * MiB;
constexpr size_t WS_CNT = 2 * MiB + 512 * 1024;
constexpr size_t WS_SLOT = 2 * MiB + 768 * 1024;
constexpr size_t WS_WUQ_T = 3 * MiB;
constexpr size_t WS_WUKV_T = 3 * MiB + 512 * 1024;
constexpr size_t WS_WS_T = 3 * MiB + 768 * 1024;
constexpr size_t WS_WIN_T = 4 * MiB;
constexpr size_t WS_WBR_T = 31 * MiB;
constexpr size_t WS_WO_T = 35 * MiB;
constexpr size_t WS_F13_T = 39 * MiB;
constexpr size_t WS_F2_T = 50 * MiB;
constexpr size_t WS_H = 56 * MiB;
constexpr size_t WS_YB = 120 * MiB;
constexpr size_t WS_PROJ = 184 * MiB;
constexpr size_t WS_Q = 360 * MiB, WS_K = 384 * MiB, WS_VT = 408 * MiB;
constexpr size_t WS_RET = 424 * MiB;
constexpr size_t WS_G = 184 * MiB;
constexpr size_t WS_MIX_END = 440 * MiB;
constexpr int MAXPANEL = 264, MAXSLOT = MAXPANEL * 256, NCH = 2, CH_PANELS = MAXPANEL / NCH;
constexpr size_t WS_HID = 56 * MiB;
constexpr size_t WS_MW13_T = 288 * MiB;
constexpr size_t WS_MW2_T = 400 * MiB;
constexpr size_t WS_XS = 456 * MiB;
constexpr size_t WS_END = 588 * MiB;
static_assert(WS_HID + (size_t)CH_PANELS * 256 * DFFE * 2 <= WS_MW13_T, "hid");
static_assert(WS_XS + (size_t)MAXSLOT * DM * 2 <= WS_END, "xs");

typedef unsigned short bf16;
__device__ __forceinline__ float bf2f(bf16 v) { return __uint_as_float(((unsigned)v) << 16); }
__device__ __forceinline__ bf16 f2bf(float f) { unsigned u = __float_as_uint(f); return (bf16)((u + 0x7fffu + ((u >> 16) & 1u)) >> 16); }
__device__ __forceinline__ float bfr(float f) { return bf2f(f2bf(f)); }
__device__ __forceinline__ float silu_f(float x) { return x / (1.f + __expf(-x)); }
__device__ __forceinline__ float sigmoid_f(float x) { return 1.f / (1.f + __expf(-x)); }
__device__ __forceinline__ float gelu_tanh(float x) { const float u = 0.7978845608028654f * (x + 0.044715f * x * x * x); return 0.5f * x * (1.f + tanhf(u)); }
namespace nv {

__global__ void __launch_bounds__(256) k_ada(const float* c, const float* ada_w, const float* ada_b, float* ADA) {
    const int idx = blockIdx.x * 256 + threadIdx.x;
    if (idx >= DEPTH * 6 * DM) return;
    const int l = idx / (6 * DM), j = idx % (6 * DM);
    const float* w = ada_w + (size_t)l * DM * 6 * DM + j;
    float s0 = 0.f, s1 = 0.f;
    for (int k = 0; k < DM; ++k) { const float wv = w[(size_t)k * 6 * DM]; s0 += silu_f(c[k]) * wv; s1 += silu_f(c[DM + k]) * wv; }
    const float bb = ada_b[idx];
    ADA[(size_t)(l * 2 + 0) * 6 * DM + j] = s0 + bb;
    ADA[(size_t)(l * 2 + 1) * 6 * DM + j] = s1 + bb;
}

__global__ void k_bnd(const float* qn_g, const float* kn_g, float* BND) {
    const int l = threadIdx.x; if (l >= DEPTH) return;
    float a = 0.f, b = 0.f;
    for (int i = 0; i < QKH; ++i) { a = fmaxf(a, fabsf(qn_g[l * QKH + i])); b = fmaxf(b, fabsf(kn_g[l * QKH + i])); }
    BND[l] = 9.797958971132712f * 1.4426950408889634f * a * b * 1.001f;
}

struct Route { int e0, e1; float p0, p1; };
__global__ void __launch_bounds__(256) k_norm(const float* X, bf16* H, const float* gain, const float* ada_l  , int off_sh, int off_sc,
                                              const float* router_w, const float* router_b, Route* route) {
    const int lane = threadIdx.x & 63, gw = blockIdx.x * 4 + (threadIdx.x >> 6), ngw = gridDim.x * 4;
    for (int m = gw; m < NTOK; m += ngw) {
        const int b = m / SEQ;
        const float4* xr = (const float4*)(X + (size_t)m * DM);
        float4 v[4]; float ss = 0.f;
#pragma unroll
        for (int j = 0; j < 4; ++j) { v[j] = xr[lane + 64 * j]; ss += v[j].x * v[j].x + v[j].y * v[j].y + v[j].z * v[j].z + v[j].w * v[j].w; }
#pragma unroll
        for (int o = 1; o < 64; o <<= 1) ss += __shfl_xor(ss, o);
        const float rstd = rsqrtf(ss * (1.f / DM) + EPS);
        float lg[NEXP];
#pragma unroll
        for (int e = 0; e < NEXP; ++e) lg[e] = 0.f;
#pragma unroll
        for (int j = 0; j < 4; ++j) {
            const int col = 4 * (lane + 64 * j);
            const float4 g = *(const float4*)(gain + col);
            const float4 sc = *(const float4*)(ada_l + (size_t)b * 6 * DM + off_sc + col);
            const float4 sh = *(const float4*)(ada_l + (size_t)b * 6 * DM + off_sh + col);
            float h0 = v[j].x * rstd * g.x * (1.f + sc.x) + sh.x, h1 = v[j].y * rstd * g.y * (1.f + sc.y) + sh.y;
            float h2 = v[j].z * rstd * g.z * (1.f + sc.z) + sh.z, h3 = v[j].w * rstd * g.w * (1.f + sc.w) + sh.w;
            uint2 o; o.x = (unsigned)f2bf(h0) | ((unsigned)f2bf(h1) << 16); o.y = (unsigned)f2bf(h2) | ((unsigned)f2bf(h3) << 16);
            *(uint2*)(H + (size_t)m * DM + col) = o;
            if (router_w) {
#pragma unroll
                for (int e = 0; e < NEXP; ++e) lg[e] += h0 * router_w[(col + 0) * NEXP + e] + h1 * router_w[(col + 1) * NEXP + e] + h2 * router_w[(col + 2) * NEXP + e] + h3 * router_w[(col + 3) * NEXP + e];
            }
        }
        if (router_w) {
#pragma unroll
            for (int e = 0; e < NEXP; ++e) {
#pragma unroll
                for (int o = 1; o < 64; o <<= 1) lg[e] += __shfl_xor(lg[e], o);
                lg[e] += router_b[e];
            }
            if (lane == 0) {
                int e0 = 0; float l0 = lg[0];
#pragma unroll
                for (int e = 1; e < NEXP; ++e) if (lg[e] > l0) { l0 = lg[e]; e0 = e; }
                int e1 = -1; float l1 = -INFINITY;
#pragma unroll
                for (int e = 0; e < NEXP; ++e) if (e != e0 && lg[e] > l1) { l1 = lg[e]; e1 = e; }
                const float p0 = 1.f / (1.f + __expf(l1 - l0));
                Route r; r.e0 = e0; r.e1 = e1; r.p0 = p0; r.p1 = 1.f - p0; route[m] = r;
            }
        }
    }
}

template <class Epi, bool DUAL, int SEGK>
__global__ void __launch_bounds__(256) k_gemm(const bf16* A, int lda, const float* W, const float* W2, int ldw, int M, int N, int K, const int* pexp, size_t estride, int m_base, int a_sub, Epi E) {
    __shared__ float As[16][68], Bs[16][68], Bs2[DUAL ? 16 : 1][68];
    const int tid = threadIdx.x, tx = tid & 15, ty = tid >> 4;
    const int n0 = blockIdx.x * 64, m0 = m_base + blockIdx.y * 64;
    if (pexp) { const int e = pexp[m0 >> 8]; if (e < 0) return; W += (size_t)e * estride; if (DUAL) W2 += (size_t)e * estride; }
    float acc[4][4], acc2[4][4], macc[4][4];
#pragma unroll
    for (int i = 0; i < 4; ++i)
#pragma unroll
        for (int j = 0; j < 4; ++j) { acc[i][j] = 0.f; acc2[i][j] = 0.f; macc[i][j] = 0.f; }
    const int am = tid >> 2, ak = (tid & 3) * 4;
    const int bk = tid >> 4, bn = (tid & 15) * 4;
    for (int k0 = 0; k0 < K; k0 += 16) {
        {
            const uint2 a = *(const uint2*)(A + (size_t)(m0 - a_sub + am) * lda + k0 + ak);
            As[ak + 0][am] = bf2f((bf16)(a.x & 0xffff)); As[ak + 1][am] = bf2f((bf16)(a.x >> 16));
            As[ak + 2][am] = bf2f((bf16)(a.y & 0xffff)); As[ak + 3][am] = bf2f((bf16)(a.y >> 16));
            float4 w = make_float4(0.f, 0.f, 0.f, 0.f), w2 = w;
            if (n0 + bn < N) { w = *(const float4*)(W + (size_t)(k0 + bk) * ldw + n0 + bn); if (DUAL) w2 = *(const float4*)(W2 + (size_t)(k0 + bk) * ldw + n0 + bn); }
            Bs[bk][bn + 0] = bfr(w.x); Bs[bk][bn + 1] = bfr(w.y); Bs[bk][bn + 2] = bfr(w.z); Bs[bk][bn + 3] = bfr(w.w);
            if (DUAL) { Bs2[bk][bn + 0] = bfr(w2.x); Bs2[bk][bn + 1] = bfr(w2.y); Bs2[bk][bn + 2] = bfr(w2.z); Bs2[bk][bn + 3] = bfr(w2.w); }
        }
        __syncthreads();
#pragma unroll
        for (int kk = 0; kk < 16; ++kk) {
            float a[4], b[4], b2[4];
#pragma unroll
            for (int i = 0; i < 4; ++i) a[i] = As[kk][ty * 4 + i];
#pragma unroll
            for (int j = 0; j < 4; ++j) { b[j] = Bs[kk][tx * 4 + j]; if (DUAL) b2[j] = Bs2[kk][tx * 4 + j]; }
#pragma unroll
            for (int i = 0; i < 4; ++i)
#pragma unroll
                for (int j = 0; j < 4; ++j) { acc[i][j] += a[i] * b[j]; if (DUAL) acc2[i][j] += a[i] * b2[j]; }
        }
        __syncthreads();
        if (SEGK > 0 && ((k0 + 16) % (SEGK > 0 ? SEGK : 1)) == 0) {
            const int s = k0 / (SEGK > 0 ? SEGK : 1);
#pragma unroll
            for (int i = 0; i < 4; ++i)
#pragma unroll
                for (int j = 0; j < 4; ++j) { const int n = n0 + tx * 4 + j; if (n < N) macc[i][j] += E.seg(m0 + ty * 4 + i, n, s, acc[i][j]); acc[i][j] = 0.f; }
        }
    }
#pragma unroll
    for (int i = 0; i < 4; ++i)
#pragma unroll
        for (int j = 0; j < 4; ++j) { const int n = n0 + tx * 4 + j; if (n < N) E(m0 + ty * 4 + i, n, SEGK > 0 ? macc[i][j] : acc[i][j], acc2[i][j]); }
}

struct EpiProj { bf16* P; __device__ void operator()(int m, int n, float a, float) const { P[(size_t)m * PROJW + (n < 1184 ? n : n + 96)] = f2bf(a); } __device__ float seg(int, int, int, float) const { return 0.f; } };
struct EpiGate { bf16* G; __device__ void operator()(int m, int n, float a, float) const { G[(size_t)m * GATEW + n] = f2bf(sigmoid_f(a)); } __device__ float seg(int, int, int, float) const { return 0.f; } };
struct EpiMerge { const bf16* G; bf16* Mg; __device__ void operator()(int m, int n, float a, float) const { Mg[(size_t)m * DM + n] = f2bf(a); }
                  __device__ float seg(int m, int n, int s, float a) const { return bf2f(G[(size_t)m * GATEW + s * DM + n]) * a; } };
struct EpiResid { const float* Xin; float* Xout; const float* gate  ; __device__ void operator()(int m, int n, float a, float) const {
                      const int b = m / SEQ; Xout[(size_t)m * DM + n] = Xin[(size_t)m * DM + n] + gate[(size_t)b * 6 * DM + n] * a; } __device__ float seg(int, int, int, float) const { return 0.f; } };
struct EpiSwiglu { bf16* U; int ldu; int m_sub; __device__ void operator()(int m, int n, float a, float b) const { U[(size_t)(m - m_sub) * ldu + n] = f2bf(silu_f(a) * b); } __device__ float seg(int, int, int, float) const { return 0.f; } };
struct EpiMoeDown { bf16* Y; const float* ps; int m_add, pad; __device__ void operator()(int m, int n, float a, float) const { Y[(size_t)(m + m_add) * DM + n] = f2bf(a * ps[m + m_add]); } __device__ float seg(int, int, int, float) const { return 0.f; } };

__global__ void __launch_bounds__(256) k_conv(const bf16* P, const float* cw  , bf16* YB) {
    const size_t idx = (size_t)blockIdx.x * 256 + threadIdx.x; const int t = (int)(idx >> 8), c = (int)(idx & 255);
    if (t >= NTOK) return; const int s = t % SEQ;
    const bf16* r = P + (size_t)t * PROJW;
    float u0 = bf2f(r[C_AC + c]) * bf2f(r[C_AX + c]), u1 = 0.f, u2 = 0.f;
    if (s >= 1) u1 = bf2f(r[C_AC + c - PROJW]) * bf2f(r[C_AX + c - PROJW]);
    if (s >= 2) u2 = bf2f(r[C_AC + c - 2 * PROJW]) * bf2f(r[C_AX + c - 2 * PROJW]);
    YB[(size_t)t * DM + c] = f2bf(bf2f(r[C_AB + c]) * (cw[c] * u2 + cw[256 + c] * u1 + cw[512 + c] * u0));
}

__global__ void __launch_bounds__(256) k_mla_pre(const bf16* P, const int* pos, const float* cq_g, const float* w_uq, const float* ckv_g, const float* w_ukv, const float* qn_g, const float* kn_g,
                                                 bf16* Q, bf16* Kb, bf16* VT) {
    __shared__ float cq[256], ckv[128], kr[32], qraw[384], kvraw[512], red[8], hs[8];
    const int t = blockIdx.x, tid = threadIdx.x, b = t / SEQ, s = t % SEQ;
    const bf16* r = P + (size_t)t * PROJW;
    cq[tid] = bf2f(r[C_CQ + tid]); if (tid < 128) ckv[tid] = bf2f(r[C_CKV + tid]); if (tid < 32) kr[tid] = bf2f(r[C_KR + tid]);
    __syncthreads();
    float a = cq[tid] * cq[tid], c2 = tid < 128 ? ckv[tid] * ckv[tid] : 0.f;
#pragma unroll
    for (int o = 1; o < 64; o <<= 1) { a += __shfl_xor(a, o); c2 += __shfl_xor(c2, o); }
    if ((tid & 63) == 0) { red[tid >> 6] = a; red[4 + (tid >> 6)] = c2; }
    __syncthreads();
    const float rq = rsqrtf((red[0] + red[1] + red[2] + red[3]) * (1.f / 256) + EPS), rkv = rsqrtf((red[4] + red[5] + red[6] + red[7]) * (1.f / 128) + EPS);
    __syncthreads();
    for (int n = tid; n < 384; n += 256) { float acc = 0.f; for (int k = 0; k < 256; ++k) acc += cq[k] * cq_g[k] * w_uq[k * 384 + n]; qraw[n] = acc * rq; }
    for (int n = tid; n < 512; n += 256) { float acc = 0.f; for (int k = 0; k < 128; ++k) acc += ckv[k] * ckv_g[k] * w_ukv[k * 512 + n]; kvraw[n] = acc * rkv; }
    __syncthreads();
    if (tid < 8) { const int h = tid & 3; float ss = 0.f;
        if (tid < 4) { for (int c = 0; c < 96; ++c) ss += qraw[h * 96 + c] * qraw[h * 96 + c]; }
        else { for (int c = 0; c < 64; ++c) ss += kvraw[h * 128 + c] * kvraw[h * 128 + c]; for (int c = 0; c < 32; ++c) ss += kr[c] * kr[c]; }
        hs[tid] = rsqrtf(ss * (1.f / 96) + EPS); }
    __syncthreads();
    const float fpos = (float)pos[t];
    for (int n = tid; n < 384; n += 256) { const int h = n / 96, c = n % 96; float v;
        if (c < 64) v = qraw[n] * hs[h] * qn_g[c];
        else { const int i = (c - 64) & 15; const float x1 = qraw[h * 96 + 64 + i] * hs[h] * qn_g[64 + i], x2 = qraw[h * 96 + 80 + i] * hs[h] * qn_g[80 + i];
               const float ang = fpos * powf(10000.f, -(float)i / 16.f); float sn, cs; sincosf(ang, &sn, &cs); v = (c < 80) ? x1 * cs - x2 * sn : x2 * cs + x1 * sn; }
        Q[(size_t)t * QW + n] = f2bf(v * ATT_C2); }
    for (int n = tid; n < 384; n += 256) { const int h = n / 96, c = n % 96; float v;
        if (c < 64) v = kvraw[h * 128 + c] * hs[4 + h] * kn_g[c];
        else { const int i = (c - 64) & 15; const float x1 = kr[i] * hs[4 + h] * kn_g[64 + i], x2 = kr[16 + i] * hs[4 + h] * kn_g[80 + i];
               const float ang = fpos * powf(10000.f, -(float)i / 16.f); float sn, cs; sincosf(ang, &sn, &cs); v = (c < 80) ? x1 * cs - x2 * sn : x2 * cs + x1 * sn; }
        Kb[(size_t)t * QW + n] = f2bf(v); }
    { const int h = tid >> 6, dv = tid & 63; VT[((size_t)(b * NHEAD + h) * 64 + dv) * SEQ + s] = f2bf(kvraw[h * 128 + 64 + dv]); }
}

__global__ void __launch_bounds__(256) k_attn(const bf16* Q, const bf16* Kb, const bf16* VT, const float* BND, bf16* YB) {
    __shared__ float Ks[64][96], Vs[64][64];
    const int qb = blockIdx.x, bh = blockIdx.y, b = bh / NHEAD, h = bh % NHEAD, tid = threadIdx.x;
    const int qs = qb * 256 + tid; const size_t t = (size_t)b * SEQ + qs;
    float q[96], o[64], l = 0.f; const float nb = -BND[0];
#pragma unroll
    for (int d = 0; d < 96; ++d) q[d] = bf2f(Q[t * QW + h * 96 + d]);
#pragma unroll
    for (int d = 0; d < 64; ++d) o[d] = 0.f;
    const int ntile = (qb * 256 + 256) / 64;
    for (int kt = 0; kt < ntile; ++kt) {
        __syncthreads();
        for (int i = tid; i < 64 * 96; i += 256) { const int kk = i / 96, d = i % 96; Ks[kk][d] = bf2f(Kb[((size_t)b * SEQ + kt * 64 + kk) * QW + h * 96 + d]); }
        for (int i = tid; i < 64 * 64; i += 256) { const int dv = i / 64, kk = i % 64; Vs[kk][dv] = bf2f(VT[((size_t)bh * 64 + dv) * SEQ + kt * 64 + kk]); }
        __syncthreads();
        const int kmax = qs - kt * 64;
        for (int kk = 0; kk < 64; ++kk) {
            if (kk > kmax) break;
            float sc = nb;
#pragma unroll
            for (int d = 0; d < 96; ++d) sc += q[d] * Ks[kk][d];
            const float p = bfr(exp2f(sc)); l += p;
#pragma unroll
            for (int d = 0; d < 64; ++d) o[d] += p * Vs[kk][d];
        }
    }
    const float il = 1.f / l;
#pragma unroll
    for (int d = 0; d < 64; ++d) YB[t * DM + 256 + h * 64 + d] = f2bf(o[d] * il);
}

__global__ void __launch_bounds__(256) k_sgu(const bf16* P, const float* gv_g  , const float* w_s  , const float* b_s  , bf16* YB) {
    __shared__ float vn[128][65];
    const int ch = blockIdx.x, g = blockIdx.y, tid = threadIdx.x; const size_t t0 = (size_t)ch * CHUNK;
    { const int s = tid >> 1, hf = tid & 1; const bf16* r = P + (t0 + s) * PROJW + C_SV + g * 64 + hf * 32; float v[32], ss = 0.f;
#pragma unroll
      for (int c = 0; c < 32; ++c) { v[c] = gelu_tanh(bf2f(r[c])); ss += v[c] * v[c]; }
      ss += __shfl_xor(ss, 1); const float rs = rsqrtf(ss * (1.f / 64) + EPS);
#pragma unroll
      for (int c = 0; c < 32; ++c) vn[s][hf * 32 + c] = bfr(v[c] * rs * gv_g[g * 64 + hf * 32 + c]); }
    __syncthreads();
    { const int tt = tid >> 1, hf = tid & 1; float acc[32];
#pragma unroll
      for (int c = 0; c < 32; ++c) acc[c] = 0.f;
      for (int s = 0; s <= tt; ++s) { const float w = bfr(w_s[((size_t)g * 128 + tt) * 128 + s]);
#pragma unroll
          for (int c = 0; c < 32; ++c) acc[c] += w * vn[s][hf * 32 + c]; }
      const float bb = b_s[g * 128 + tt]; const bf16* r = P + (t0 + tt) * PROJW + C_SU + g * 64 + hf * 32;
#pragma unroll
      for (int c = 0; c < 32; ++c) YB[(t0 + tt) * DM + 512 + g * 64 + hf * 32 + c] = f2bf(gelu_tanh(bf2f(r[c])) * (acc[c] + bb)); }
}

__device__ __forceinline__ float ret_loggamma(int h) { return log1pf(-exp2f(-5.f - (float)h)); }
__global__ void __launch_bounds__(256) k_ret_kv(bf16* P, const int* pos, float* RET) {
    extern __shared__ float sm[];
    float (*kt)[65] = (float (*)[65])sm; float (*vv)[65] = (float (*)[65])(sm + 128 * 65);
    const int ch = blockIdx.x, h = blockIdx.y, tid = threadIdx.x; const size_t t0 = (size_t)ch * CHUNK; const float lg = ret_loggamma(h);
    for (int it = tid; it < 128 * 32; it += 256) { const int j = it >> 5, i = it & 31; bf16* r = P + (t0 + j) * PROJW;
        const float ang = (float)pos[t0 + j] * powf(10000.f, -(float)i / 32.f); float sn, cs; sincosf(ang, &sn, &cs);
        const float q1 = bf2f(r[C_RQ + h * 64 + i]), q2 = bf2f(r[C_RQ + h * 64 + 32 + i]), k1 = bf2f(r[C_RK + h * 64 + i]), k2 = bf2f(r[C_RK + h * 64 + 32 + i]);
        const float dq = __expf(lg * (float)j), dk = 0.125f * __expf(-lg * (float)j);
        const bf16 qa = f2bf((q1 * cs - q2 * sn) * dq), qb = f2bf((q2 * cs + q1 * sn) * dq), ka = f2bf((k1 * cs - k2 * sn) * dk), kb = f2bf((k2 * cs + k1 * sn) * dk);
        r[C_RQ + h * 64 + i] = qa; r[C_RQ + h * 64 + 32 + i] = qb; r[C_RK + h * 64 + i] = ka; r[C_RK + h * 64 + 32 + i] = kb;
        kt[j][i] = bf2f(ka); kt[j][32 + i] = bf2f(kb); }
    for (int it = tid; it < 128 * 64; it += 256) { const int j = it >> 6, e = it & 63; vv[j][e] = bf2f(P[(t0 + j) * PROJW + C_RV + h * 64 + e]); }
    __syncthreads();
    const float g127 = __expf(lg * 127.f);
    { const int e = tid & 63, dq = tid >> 6; float acc[16];
#pragma unroll
      for (int d = 0; d < 16; ++d) acc[d] = 0.f;
      for (int j = 0; j < 128; ++j) { const float v = vv[j][e];
#pragma unroll
          for (int d = 0; d < 16; ++d) acc[d] += kt[j][dq * 16 + d] * v; }
      float* o = RET + ((size_t)ch * NHEAD + h) * 4096 + e * 64 + dq * 16;
#pragma unroll
      for (int d = 0; d < 16; ++d) o[d] = acc[d] * g127; }
}
__global__ void __launch_bounds__(256) k_ret_scan(float* RET) {
    const int idx = blockIdx.x * 256 + threadIdx.x;
    const int b = idx / (NHEAD * 4096), h = (idx / 4096) % NHEAD, ed = idx % 4096;
    const float cd = __expf(ret_loggamma(h) * 128.f); float st = 0.f;
    float* p = RET + ((size_t)b * NCHUNK * NHEAD + h) * 4096 + ed;
    for (int n = 0; n < NCHUNK; ++n) { const float kv = p[(size_t)n * NHEAD * 4096]; p[(size_t)n * NHEAD * 4096] = st; st = st * cd + kv; }
}
__global__ void __launch_bounds__(256) k_ret_out(const bf16* P, const float* RET, const float* ret_g, bf16* YB) {
    extern __shared__ float sm[];
    float (*qt)[65] = (float (*)[65])sm; float (*kt)[65] = (float (*)[65])(sm + 128 * 65); float (*vv)[65] = (float (*)[65])(sm + 2 * 128 * 65); float (*pv)[65] = (float (*)[65])(sm + 3 * 128 * 65);
    const int ch = blockIdx.x, h = blockIdx.y, tid = threadIdx.x; const size_t t0 = (size_t)ch * CHUNK; const float gam = __expf(ret_loggamma(h));
    for (int it = tid; it < 128 * 64; it += 256) { const int j = it >> 6, d = it & 63; const bf16* r = P + (t0 + j) * PROJW;
        qt[j][d] = bf2f(r[C_RQ + h * 64 + d]); kt[j][d] = bf2f(r[C_RK + h * 64 + d]); vv[j][d] = bf2f(r[C_RV + h * 64 + d]); }
    for (int it = tid; it < 4096; it += 256) pv[it >> 6][it & 63] = bfr(RET[((size_t)ch * NHEAD + h) * 4096 + it] * gam);
    __syncthreads();
    const int i = tid >> 1, hf = tid & 1; float o[32];
#pragma unroll
    for (int e = 0; e < 32; ++e) o[e] = 0.f;
    for (int j = 0; j <= i; ++j) { float s = 0.f;
#pragma unroll
        for (int d = 0; d < 64; ++d) s += qt[i][d] * kt[j][d];
        s = bfr(s);
#pragma unroll
        for (int e = 0; e < 32; ++e) o[e] += s * vv[j][hf * 32 + e]; }
#pragma unroll
    for (int e = 0; e < 32; ++e) { float s = 0.f;
        for (int d = 0; d < 64; ++d) s += qt[i][d] * pv[hf * 32 + e][d];
        o[e] += s; }
    float mu = 0.f;
#pragma unroll
    for (int e = 0; e < 32; ++e) mu += o[e];
    mu += __shfl_xor(mu, 1); mu *= (1.f / 64); float var = 0.f;
#pragma unroll
    for (int e = 0; e < 32; ++e) { o[e] -= mu; var += o[e] * o[e]; }
    var += __shfl_xor(var, 1); const float rs = rsqrtf(var * (1.f / 64) + EPS);
    const bf16* r = P + (t0 + i) * PROJW + C_RG + h * 64 + hf * 32;
#pragma unroll
    for (int e = 0; e < 32; ++e) YB[(t0 + i) * DM + 768 + h * 64 + hf * 32 + e] = f2bf(silu_f(bf2f(r[e])) * (o[e] * rs * ret_g[h * 64 + hf * 32 + e]));
}

__global__ void __launch_bounds__(128) k_moe_count(const Route* route, int* CNT) {
    __shared__ int c[NEXP]; const int tid = threadIdx.x; if (tid < NEXP) c[tid] = 0; __syncthreads();
    const Route r = route[blockIdx.x * 128 + tid]; atomicAdd(&c[r.e0], 1); atomicAdd(&c[r.e1], 1); __syncthreads();
    if (tid < NEXP) CNT[blockIdx.x * NEXP + tid] = c[tid];
}
__global__ void __launch_bounds__(128) k_moe_assign(const Route* route, const int* CNT, const bf16* H2, bf16* XS, int* SLOT, float* PSLOT, int* PEXP) {
    __shared__ int tot[NEXP], pre[NEXP], base[NEXP + 1], wcnt[2][NEXP];
    const int tid = threadIdx.x, blk = blockIdx.x, lane = tid & 63, w = tid >> 6;
    if (tid < NEXP) { int t = 0, p = 0; for (int i = 0; i < 256; ++i) { const int v = CNT[i * NEXP + tid]; if (i < blk) p += v; t += v; } tot[tid] = t; pre[tid] = p; }
    __syncthreads();
    if (tid == 0) { int bsum = 0; for (int e = 0; e < NEXP; ++e) { base[e] = bsum; bsum += (tot[e] + 255) & ~255; } base[NEXP] = bsum; }
    __syncthreads();
    if (blk == 0) {
        for (int p = tid; p < MAXPANEL + 8; p += 128) { int e = -1; for (int x = 0; x < NEXP; ++x) if (p * 256 >= base[x] && p * 256 < base[x + 1]) e = x; if (p == MAXPANEL) e = base[NEXP] >> 8; PEXP[p] = e; }
    }
    if (blk < NEXP) { const int e = blk; for (int s = base[e] + tot[e] + tid; s < base[e + 1]; s += 128) PSLOT[s] = 0.f; }
    const int t = blk * 128 + tid; const Route r = route[t];
    int rank0 = 0, rank1 = 0;
    for (int e = 0; e < NEXP; ++e) { const bool in = (r.e0 == e) || (r.e1 == e); const unsigned long long m = __ballot(in); if (lane == 0) wcnt[w][e] = __popcll(m);
        const int rk = __popcll(m & ((1ull << lane) - 1ull)); if (r.e0 == e) rank0 = rk; if (r.e1 == e) rank1 = rk; }
    __syncthreads();
    if (w == 1) { rank0 += wcnt[0][r.e0]; rank1 += wcnt[0][r.e1]; }
    const int s0 = base[r.e0] + pre[r.e0] + rank0, s1 = base[r.e1] + pre[r.e1] + rank1;
    SLOT[2 * t] = s0; SLOT[2 * t + 1] = s1; PSLOT[s0] = r.p0; PSLOT[s1] = r.p1;
    __syncthreads();
    __shared__ int ss0[128], ss1[128]; ss0[tid] = s0; ss1[tid] = s1; __syncthreads();
    for (int i = 0; i < 128; ++i) { const uint4 v = *(const uint4*)(H2 + (size_t)(blk * 128 + i) * DM + tid * 8);
        *(uint4*)(XS + (size_t)ss0[i] * DM + tid * 8) = v; *(uint4*)(XS + (size_t)ss1[i] * DM + tid * 8) = v; }
}
__global__ void __launch_bounds__(256) k_moe_combine(float* X, const bf16* Y, const int* SLOT, const float* g2  ) {
    const size_t idx = (size_t)blockIdx.x * 256 + threadIdx.x; const int t = (int)(idx >> 8), c4 = (int)(idx & 255) * 4; if (t >= NTOK) return;
    const int b = t / SEQ, s0 = SLOT[2 * t], s1 = SLOT[2 * t + 1];
    const uint2 a = *(const uint2*)(Y + (size_t)s0 * DM + c4), bq = *(const uint2*)(Y + (size_t)s1 * DM + c4);
    float4 x = *(float4*)(X + (size_t)t * DM + c4); const float4 g = *(const float4*)(g2 + (size_t)b * 6 * DM + c4);
    x.x += g.x * (bf2f((bf16)(a.x & 0xffff)) + bf2f((bf16)(bq.x & 0xffff))); x.y += g.y * (bf2f((bf16)(a.x >> 16)) + bf2f((bf16)(bq.x >> 16)));
    x.z += g.z * (bf2f((bf16)(a.y & 0xffff)) + bf2f((bf16)(bq.y & 0xffff))); x.w += g.w * (bf2f((bf16)(a.y >> 16)) + bf2f((bf16)(bq.y >> 16)));
    *(float4*)(X + (size_t)t * DM + c4) = x;
}
}
struct Inputs {
    const float *x, *c; const int* pos; const float *norm1_g, *norm2_g, *ada_w, *ada_b, *w_in, *conv_w, *cq_g, *w_uq, *ckv_g, *w_ukv, *qn_g, *kn_g, *gv_g, *w_s, *b_s, *ret_g, *w_branch, *w_o,
        *ffn_w1, *ffn_w3, *ffn_w2, *router_w, *router_b, *moe_w1, *moe_w3, *moe_w2;
};
static Inputs get_inputs(void* const* d_in) {
    Inputs I; int i = 0;
    I.x = (const float*)d_in[i++]; I.c = (const float*)d_in[i++]; I.pos = (const int*)d_in[i++]; I.norm1_g = (const float*)d_in[i++]; I.norm2_g = (const float*)d_in[i++];
    I.ada_w = (const float*)d_in[i++]; I.ada_b = (const float*)d_in[i++]; I.w_in = (const float*)d_in[i++]; I.conv_w = (const float*)d_in[i++]; I.cq_g = (const float*)d_in[i++];
    I.w_uq = (const float*)d_in[i++]; I.ckv_g = (const float*)d_in[i++]; I.w_ukv = (const float*)d_in[i++]; I.qn_g = (const float*)d_in[i++]; I.kn_g = (const float*)d_in[i++];
    I.gv_g = (const float*)d_in[i++]; I.w_s = (const float*)d_in[i++]; I.b_s = (const float*)d_in[i++]; I.ret_g = (const float*)d_in[i++]; I.w_branch = (const float*)d_in[i++];
    I.w_o = (const float*)d_in[i++]; I.ffn_w1 = (const float*)d_in[i++]; I.ffn_w3 = (const float*)d_in[i++]; I.ffn_w2 = (const float*)d_in[i++]; I.router_w = (const float*)d_in[i++];
    I.router_b = (const float*)d_in[i++]; I.moe_w1 = (const float*)d_in[i++]; I.moe_w3 = (const float*)d_in[i++]; I.moe_w2 = (const float*)d_in[i++];
    return I;
}

static void naive_forward(const Inputs& I, float* X  , unsigned char* ws, hipStream_t st) {
    using namespace nv;
    float* ADA = (float*)(ws + WS_ADA); float* BND = (float*)(ws + WS_BND);
    bf16* H = (bf16*)(ws + WS_H); bf16* YB = (bf16*)(ws + WS_YB); bf16* P = (bf16*)(ws + WS_PROJ); bf16* Q = (bf16*)(ws + WS_Q); bf16* Kb = (bf16*)(ws + WS_K); bf16* VT = (bf16*)(ws + WS_VT);
    float* RET = (float*)(ws + WS_RET); bf16* G = (bf16*)(ws + WS_G); bf16* MG = H; bf16* U = P;
    Route* route = (Route*)(ws + WS_ROUTE); int* CNT = (int*)(ws + WS_CNT); int* SLOT = (int*)(ws + WS_SLOT); float* PSLOT = (float*)(ws + WS_PSLOT); int* PEXP = (int*)(ws + WS_PEXP);
    bf16* XS = (bf16*)(ws + WS_XS); bf16* HID = (bf16*)(ws + WS_HID);
    static bool attr = false;
    if (!attr) { attr = true;
        (void)hipFuncSetAttribute((const void*)k_ret_kv, hipFuncAttributeMaxDynamicSharedMemorySize, 2 * 128 * 65 * 4);
        (void)hipFuncSetAttribute((const void*)k_ret_out, hipFuncAttributeMaxDynamicSharedMemorySize, (3 * 128 + 64) * 65 * 4); }
    k_ada<<<(DEPTH * 6 * DM) / 256, 256, 0, st>>>(I.c, I.ada_w, I.ada_b, ADA);
    k_bnd<<<1, 64, 0, st>>>(I.qn_g, I.kn_g, BND);
    for (int l = 0; l < DEPTH; ++l) {
        const float* ada_l = ADA + (size_t)l * 2 * 6 * DM;
        const float* Xin = (l == 0) ? I.x : X;
        k_norm<<<1024, 256, 0, st>>>(Xin, H, I.norm1_g + l * DM, ada_l, A_SH1, A_SC1, nullptr, nullptr, nullptr);
        const float* w_in = I.w_in + (size_t)l * DM * D_IN;
        k_gemm<EpiProj, false, 0><<<dim3((NPROJ_SRC + 63) / 64, NTOK / 64), 256, 0, st>>>(H, DM, w_in, nullptr, D_IN, NTOK, NPROJ_SRC, DM, nullptr, 0, 0, 0, EpiProj{P});
        k_conv<<<NTOK, 256, 0, st>>>(P, I.conv_w + l * 3 * MIXW, YB);
        k_mla_pre<<<NTOK, 256, 0, st>>>(P, I.pos, I.cq_g + l * 256, I.w_uq + (size_t)l * 256 * QW, I.ckv_g + l * 128, I.w_ukv + (size_t)l * 128 * 512, I.qn_g + l * QKH, I.kn_g + l * QKH, Q, Kb, VT);
        k_sgu<<<dim3(NTOK / CHUNK, 4), 256, 0, st>>>(P, I.gv_g + l * 256, I.w_s + (size_t)l * 4 * 128 * 128, I.b_s + l * 4 * 128, YB);
        k_ret_kv<<<dim3(NTOK / CHUNK, 4), 256, 2 * 128 * 65 * 4, st>>>(P, I.pos, RET);
        k_ret_scan<<<(NBATCH * NHEAD * 4096) / 256, 256, 0, st>>>(RET);
        k_attn<<<dim3(SEQ / 256, NBATCH * NHEAD), 256, 0, st>>>(Q, Kb, VT, BND + l, YB);
        k_ret_out<<<dim3(NTOK / CHUNK, 4), 256, (3 * 128 + 64) * 65 * 4, st>>>(P, RET, I.ret_g + l * 256, YB);
        k_gemm<EpiGate, false, 0><<<dim3(GATEW / 64, NTOK / 64), 256, 0, st>>>(H, DM, w_in + NPROJ_SRC, nullptr, D_IN, NTOK, GATEW, DM, nullptr, 0, 0, 0, EpiGate{G});
        k_gemm<EpiMerge, false, 256><<<dim3(DM / 64, NTOK / 64), 256, 0, st>>>(YB, DM, I.w_branch + (size_t)l * 4 * MIXW * DM, nullptr, DM, NTOK, DM, DM, nullptr, 0, 0, 0, EpiMerge{G, MG});
        k_gemm<EpiResid, false, 0><<<dim3(DM / 64, NTOK / 64), 256, 0, st>>>(MG, DM, I.w_o + (size_t)l * DM * DM, nullptr, DM, NTOK, DM, DM, nullptr, 0, 0, 0, EpiResid{Xin, X, ada_l + A_G1});
        if (l % 2 == 0) {
            k_norm<<<1024, 256, 0, st>>>(X, H, I.norm2_g + l * DM, ada_l, A_SH2, A_SC2, nullptr, nullptr, nullptr);
            const int f = l / 2;
            k_gemm<EpiSwiglu, true, 0><<<dim3(DFF / 64, NTOK / 64), 256, 0, st>>>(H, DM, I.ffn_w1 + (size_t)f * DM * DFF, I.ffn_w3 + (size_t)f * DM * DFF, DFF, NTOK, DFF, DM, nullptr, 0, 0, 0, EpiSwiglu{U, DFF, 0});
            k_gemm<EpiResid, false, 0><<<dim3(DM / 64, NTOK / 64), 256, 0, st>>>(U, DFF, I.ffn_w2 + (size_t)f * DFF * DM, nullptr, DM, NTOK, DM, DFF, nullptr, 0, 0, 0, EpiResid{X, X, ada_l + A_G2});
        } else {
            const int f = l / 2;
            k_norm<<<1024, 256, 0, st>>>(X, H, I.norm2_g + l * DM, ada_l, A_SH2, A_SC2, I.router_w + (size_t)f * DM * NEXP, I.router_b + f * NEXP, route);
            k_moe_count<<<NTOK / 128, 128, 0, st>>>(route, CNT);
            k_moe_assign<<<NTOK / 128, 128, 0, st>>>(route, CNT, H, XS, SLOT, PSLOT, PEXP);
            for (int c = 0; c < NCH; ++c) {
                const int r0 = c * CH_PANELS * 256;
                k_gemm<EpiSwiglu, true, 0><<<dim3(DFFE / 64, CH_PANELS * 4), 256, 0, st>>>(XS, DM, I.moe_w1 + (size_t)f * NEXP * DM * DFFE, I.moe_w3 + (size_t)f * NEXP * DM * DFFE, DFFE, 0, DFFE, DM, PEXP, (size_t)DM * DFFE, r0, 0, EpiSwiglu{HID, DFFE, r0});
                k_gemm<EpiMoeDown, false, 0><<<dim3(DM / 64, CH_PANELS * 4), 256, 0, st>>>(HID, DFFE, I.moe_w2 + (size_t)f * NEXP * DFFE * DM, nullptr, DM, 0, DM, DFFE, PEXP, (size_t)DFFE * DM, r0, r0, EpiMoeDown{XS, PSLOT, 0, 0});
            }
            k_moe_combine<<<NTOK, 256, 0, st>>>(X, XS, SLOT, ada_l + A_G2);
        }
    }
}
extern "C" void kernel_launch(void* const* d_in, const int* in_sizes, int n_in, void* d_out, int out_size, void* d_ws, size_t ws_size, hipStream_t stream) {
    if (n_in != 29 || out_size != NTOK * DM || ws_size < WS_END) { fprintf(stderr, "kernel_launch: unexpected sizes n_in %d out %d ws %zu\n", n_in, out_size, ws_size); return; }
    const Inputs I = get_inputs(d_in);
    naive_forward(I, (float*)d_out, (unsigned char*)d_ws, stream);
}
```

```cpp
#define MEGA_THIN 3
#include <hip/hip_runtime.h>
#include <cstdio>
#include <cstdint>
#include <cmath>

constexpr int DM = 1024, NBATCH = 2, SEQ = 16384, NTOK = NBATCH * SEQ, DEPTH = 2;
constexpr int MIXW = 256, D_IN = 6816, PROJW = 2816, GATEW = 4096, NPROJ_SRC = 2720;
constexpr int QKH = 96, NHEAD = 4, QW = NHEAD * QKH  , DFF = 2816, NEXP = 8, DFFE = 3584;
constexpr int CHUNK = 128, NCHUNK = SEQ / CHUNK  ;
constexpr float EPS = 1e-6f;
constexpr int C_AB = 0, C_AC = 256, C_AX = 512, C_CQ = 768, C_CKV = 1024, C_KR = 1152, C_SU = 1280, C_SV = 1536, C_RQ = 1792, C_RK = 2048, C_RV = 2304, C_RG = 2560;
constexpr int A_SH1 = 0, A_SC1 = 1024, A_G1 = 2048, A_SH2 = 3072, A_SC2 = 4096, A_G2 = 5120;
constexpr float ATT_C2 = 0.10206207261596575f * 1.4426950408889634f;

constexpr size_t MiB = 1u << 20;
constexpr size_t WS_CTL = 0, CTL_ZERO_BYTES = 1 * MiB;
constexpr size_t WS_ADA = 1 * MiB;
constexpr size_t WS_PSLOT = 1 * MiB + 256 * 1024;
constexpr size_t WS_PEXP = 1 * MiB + 768 * 1024;
constexpr size_t WS_BND = 1 * MiB + 800 * 1024;
constexpr size_t WS_ROUTE = 2 * MiB;
constexpr size_t WS_CNT = 2 * MiB + 512 * 1024;
constexpr size_t WS_SLOT = 2 * MiB + 768 * 1024;
constexpr size_t WS_WUQ_T = 3 * MiB;
constexpr size_t WS_WUKV_T = 3 * MiB + 512 * 1024;
constexpr size_t WS_WS_T = 3 * MiB + 768 * 1024;
constexpr size_t WS_WIN_T = 4 * MiB;
constexpr size_t WS_WBR_T = 31 * MiB;
constexpr size_t WS_WO_T = 35 * MiB;
constexpr size_t WS_F13_T = 39 * MiB;
constexpr size_t WS_F2_T = 50 * MiB;
constexpr size_t WS_H = 56 * MiB;
constexpr size_t WS_YB = 120 * MiB;
constexpr size_t WS_PROJ = 184 * MiB;
constexpr size_t WS_Q = 360 * MiB, WS_K = 384 * MiB, WS_VT = 408 * MiB;
constexpr size_t WS_RET = 424 * MiB;
constexpr size_t WS_G = 184 * MiB;
constexpr size_t WS_MIX_END = 440 * MiB;
constexpr int MAXPANEL = 264, MAXSLOT = MAXPANEL * 256, NCH = 2, CH_PANELS = MAXPANEL / NCH;
constexpr size_t WS_HID = 56 * MiB;
constexpr size_t WS_MW13_T = 288 * MiB;
constexpr size_t WS_MW2_T = 400 * MiB;
constexpr size_t WS_XS = 456 * MiB;
constexpr size_t WS_END = 588 * MiB;
static_assert(WS_HID + (size_t)CH_PANELS * 256 * DFFE * 2 <= WS_MW13_T, "hid");
static_assert(WS_XS + (size_t)MAXSLOT * DM * 2 <= WS_END, "xs");

typedef unsigned short bf16;
__device__ __forceinline__ float bf2f(bf16 v) { return __uint_as_float(((unsigned)v) << 16); }
__device__ __forceinline__ bf16 f2bf(float f) { unsigned u = __float_as_uint(f); return (bf16)((u + 0x7fffu + ((u >> 16) & 1u)) >> 16); }
__device__ __forceinline__ float bfr(float f) { return bf2f(f2bf(f)); }
__device__ __forceinline__ float silu_f(float x) { return x / (1.f + __expf(-x)); }
__device__ __forceinline__ float sigmoid_f(float x) { return 1.f / (1.f + __expf(-x)); }
__device__ __forceinline__ float gelu_tanh(float x) { const float u = 0.7978845608028654f * (x + 0.044715f * x * x * x); return 0.5f * x * (1.f + tanhf(u)); }

namespace nv {
struct Route { int e0, e1; float p0, p1; };
__device__ __forceinline__ float ret_loggamma(int h) { return log1pf(-exp2f(-5.f - (float)h)); }
}
namespace pg8 {
#define PG8_LAS __attribute__((address_space(3)))
typedef short bf16x8 __attribute__((ext_vector_type(8)));
typedef float f32x4 __attribute__((ext_vector_type(4)));
typedef float f32x2 __attribute__((ext_vector_type(2)));
typedef unsigned u32x4 __attribute__((ext_vector_type(4)));
constexpr int BM = 256, BK = 64, HALF = 128, HTB = HALF * BK * 2  , STAGE_BYTES = 8 * HTB, NXCD = 8, WGM = 8;

__host__ __device__ __forceinline__ int lds_byte(int r, int c) { const int st = (r >> 4) * 2 + (c >> 5), rr = r & 15, cc = c & 31, ob = rr * 64 + cc * 2; return st * 1024 + (ob ^ (((ob >> 9) & 1) << 5)); }
__host__ __device__ __forceinline__ void stage_rc(int b, int& R, int& C) { const int st = b / 1024, sb = b % 1024, swz = sb ^ (((sb >> 9) & 1) << 5); R = (st >> 1) * 16 + swz / 64; C = (st & 1) * 32 + (swz % 64) / 2; }
__host__ __device__ __forceinline__ int perm32(int rho) { const int n = rho >> 4, i = rho & 15; return 8 * (i >> 2) + 4 * n + (i & 3); }

struct Unit { const char* A; const char* B; int pm, pn, aux, pad; };

__device__ __forceinline__ bool static_tile(int i, int G, int c, int nM, int nN, int& pm, int& pn) {
    const int nwg = nM * nN; const long L = (long)i * G + c; if (L >= nwg) return false;
    int wgid = (int)L; { const int q = nwg / NXCD, r = nwg % NXCD, xcd = wgid % NXCD, off = wgid / NXCD; wgid = (xcd < r ? xcd * (q + 1) : r * (q + 1) + (xcd - r) * q) + off; }
    const int nig = WGM * nN, gid = wgid / nig, fm = gid * WGM, gsz = (nM - fm) < WGM ? (nM - fm) : WGM;
    pm = fm + ((wgid % nig) % gsz); pn = (wgid % nig) / gsz; return true;
}
struct DenseOrder {
    const char* A; const char* B; size_t tA, tB; int nM, nN, G, c;
    __device__ __forceinline__ bool next(int i, Unit& u) const { int pm, pn; if (!static_tile(i, G, c, nM, nN, pm, pn)) return false; u.pm = pm; u.pn = pn; u.aux = 0; u.A = A + (size_t)pm * tA; u.B = B + (size_t)pn * tB; return true; }
};
struct MergeOrder {
    const char* A; const char* B; int nM, nN, G, c;
    __device__ __forceinline__ bool next(int i, Unit& u) const { int pm, pn; if (!static_tile(i >> 2, G, c, nM, nN, pm, pn)) return false; const int n = i & 3; u.pm = pm; u.pn = pn; u.aux = n;
        u.A = A + (size_t)pm * (256 * 1024 * 2) + n * 512; u.B = B + (size_t)n * (1024 * 256 * 2) + (size_t)pn * (256 * 256 * 2); return true; }
};
struct MoeOrder {
    const char* A; const char* B; size_t tA, tB; const int* pexp; int p0, nM, nN, G, c;
    __device__ __forceinline__ bool next(int i, Unit& u) const { int pm, pn; if (nM <= 0 || !static_tile(i, G, c, nM, nN, pm, pn)) return false; const int e = pexp[p0 + pm]; u.pm = pm; u.pn = pn; u.aux = e;
        u.A = A + (size_t)pm * tA; u.B = B + ((size_t)e * nN + pn) * tB; return true; }
};

typedef __bf16 bf16x2_t __attribute__((ext_vector_type(2)));
__device__ __forceinline__ unsigned cvt_pk_bf16(float lo, float hi) { const f32x2 v = {lo, hi}; return __builtin_bit_cast(unsigned, __builtin_convertvector(v, bf16x2_t)); }
__device__ __forceinline__ float fast_sigmoid(float x) { return __builtin_amdgcn_rcpf(1.f + __builtin_amdgcn_exp2f(-1.4426950408889634f * x)); }
__device__ __forceinline__ float bflo(unsigned w) { return __uint_as_float(w << 16); }
__device__ __forceinline__ float bfhi(unsigned w) { return __uint_as_float(w & 0xffff0000u); }

template <int ACT  > struct EpiBf16 {
    static constexpr bool PERM = true;
    bf16* O; int ldc;
    __device__ __forceinline__ void operator()(const f32x4 (&acc)[2][2][4][2], const Unit& u, int wr, int wc, int fr, int fq) const {
        const int row0 = u.pm * BM + wr * 64 + fr, col0 = u.pn * BM + wc * 32 + 8 * fq;
#pragma unroll
        for (int ai = 0; ai < 2; ++ai)
#pragma unroll
            for (int m = 0; m < 4; ++m) { bf16* rowp = O + (size_t)(row0 + ai * HALF + m * 16) * ldc + col0;
#pragma unroll
                for (int bj = 0; bj < 2; ++bj) { f32x4 v0 = acc[ai][bj][m][0], v1 = acc[ai][bj][m][1];
                    if (ACT == 2) {
#pragma unroll
                        for (int i = 0; i < 4; ++i) { v0[i] = fast_sigmoid(v0[i]); v1[i] = fast_sigmoid(v1[i]); } }
                    u32x4 w; w.x = cvt_pk_bf16(v0[0], v0[1]); w.y = cvt_pk_bf16(v0[2], v0[3]); w.z = cvt_pk_bf16(v1[0], v1[1]); w.w = cvt_pk_bf16(v1[2], v1[3]);
                    *(u32x4*)(rowp + bj * HALF) = w; } }
    }
};
struct EpiSwiglu {
    static constexpr bool PERM = true;
    bf16* O; int ldc;
    __device__ __forceinline__ void operator()(const f32x4 (&acc)[2][2][4][2], const Unit& u, int wr, int wc, int fr, int fq) const {
        const int row0 = u.pm * BM + wr * 64 + fr, col0 = u.pn * HALF + wc * 32 + 8 * fq;
#pragma unroll
        for (int ai = 0; ai < 2; ++ai)
#pragma unroll
            for (int m = 0; m < 4; ++m) { bf16* rowp = O + (size_t)(row0 + ai * HALF + m * 16) * ldc + col0; float r[8];
#pragma unroll
                for (int n = 0; n < 2; ++n)
#pragma unroll
                    for (int i = 0; i < 4; ++i) { const float a = acc[ai][0][m][n][i], b = acc[ai][1][m][n][i]; r[n * 4 + i] = a * fast_sigmoid(a) * b; }
                u32x4 w; w.x = cvt_pk_bf16(r[0], r[1]); w.y = cvt_pk_bf16(r[2], r[3]); w.z = cvt_pk_bf16(r[4], r[5]); w.w = cvt_pk_bf16(r[6], r[7]);
                *(u32x4*)rowp = w; }
    }
};
struct EpiResid {
    static constexpr bool PERM = false;
    const float* Xin; float* Xout; const float* gate;
    __device__ __forceinline__ void operator()(const f32x4 (&acc)[2][2][4][2], const Unit& u, int wr, int wc, int fr, int fq) const {
        const int row0 = u.pm * BM + wr * 64 + fr, col0 = u.pn * BM + wc * 32 + 4 * fq; const float* gp = gate + (size_t)(u.pm >> 6) * (6 * DM) + col0;
        f32x4 gv[2][2];
#pragma unroll
        for (int bj = 0; bj < 2; ++bj)
#pragma unroll
            for (int n = 0; n < 2; ++n) gv[bj][n] = *(const f32x4*)(gp + bj * HALF + n * 16);
#pragma unroll
        for (int ai = 0; ai < 2; ++ai)
#pragma unroll
            for (int m = 0; m < 4; ++m) { const size_t off = (size_t)(row0 + ai * HALF + m * 16) * DM + col0;
#pragma unroll
                for (int bj = 0; bj < 2; ++bj)
#pragma unroll
                    for (int n = 0; n < 2; ++n) { const f32x4 xi = *(const f32x4*)(Xin + off + bj * HALF + n * 16); *(f32x4*)(Xout + off + bj * HALF + n * 16) = xi + gv[bj][n] * acc[ai][bj][m][n]; } }
    }
};
struct EpiMerge {
    static constexpr bool PERM = true;
    const bf16* G; bf16* Mg;
    __device__ __forceinline__ void operator()(const f32x4 (&acc)[2][2][4][2], const Unit& u, int wr, int wc, int fr, int fq) const {
        const int row0 = u.pm * BM + wr * 64 + fr, col0 = u.pn * BM + wc * 32 + 8 * fq, n_br = u.aux;
#pragma unroll
        for (int ai = 0; ai < 2; ++ai)
#pragma unroll
            for (int m = 0; m < 4; ++m) { const size_t row = (size_t)(row0 + ai * HALF + m * 16);
#pragma unroll
                for (int bj = 0; bj < 2; ++bj) { const u32x4 g = *(const u32x4*)(G + row * GATEW + n_br * DM + col0 + bj * HALF); bf16* mp = Mg + row * DM + col0 + bj * HALF;
                    const f32x4 a0 = acc[ai][bj][m][0], a1 = acc[ai][bj][m][1]; float r[8];
                    r[0] = bflo(g.x) * a0[0]; r[1] = bfhi(g.x) * a0[1]; r[2] = bflo(g.y) * a0[2]; r[3] = bfhi(g.y) * a0[3];
                    r[4] = bflo(g.z) * a1[0]; r[5] = bfhi(g.z) * a1[1]; r[6] = bflo(g.w) * a1[2]; r[7] = bfhi(g.w) * a1[3];
                    if (n_br != 0) { const u32x4 o = *(const u32x4*)mp; r[0] += bflo(o.x); r[1] += bfhi(o.x); r[2] += bflo(o.y); r[3] += bfhi(o.y); r[4] += bflo(o.z); r[5] += bfhi(o.z); r[6] += bflo(o.w); r[7] += bfhi(o.w); }
                    u32x4 w; w.x = cvt_pk_bf16(r[0], r[1]); w.y = cvt_pk_bf16(r[2], r[3]); w.z = cvt_pk_bf16(r[4], r[5]); w.w = cvt_pk_bf16(r[6], r[7]);
                    *(u32x4*)mp = w; } }
    }
};
struct EpiMoeDown {
    static constexpr bool PERM = true;
    bf16* Y; const float* ps;
    __device__ __forceinline__ void operator()(const f32x4 (&acc)[2][2][4][2], const Unit& u, int wr, int wc, int fr, int fq) const {
        const int row0 = u.pm * BM + wr * 64 + fr, col0 = u.pn * BM + wc * 32 + 8 * fq;
#pragma unroll
        for (int ai = 0; ai < 2; ++ai)
#pragma unroll
            for (int m = 0; m < 4; ++m) { const int row = row0 + ai * HALF + m * 16; const float s = ps[row]; bf16* rowp = Y + (size_t)row * DM + col0;
#pragma unroll
                for (int bj = 0; bj < 2; ++bj) { const f32x4 v0 = acc[ai][bj][m][0] * s, v1 = acc[ai][bj][m][1] * s;
                    u32x4 w; w.x = cvt_pk_bf16(v0[0], v0[1]); w.y = cvt_pk_bf16(v0[2], v0[3]); w.z = cvt_pk_bf16(v1[0], v1[1]); w.w = cvt_pk_bf16(v1[2], v1[3]);
                    *(u32x4*)(rowp + bj * HALF) = w; } }
    }
};

template <class Epi, class Sched>
__device__ __forceinline__ void gemm_phase(PG8_LAS unsigned char* lds, const int lda, const int ldb, const int K, const Sched& S, const Epi& E) {
    int tid_ = threadIdx.x; asm volatile("" : "+v"(tid_));
    const int tid = tid_, wid = __builtin_amdgcn_readfirstlane(tid >> 6), lane = tid & 63, wr = wid >> 2, wc = wid & 3, fr = lane & 15, fq = lane >> 4;
    const int nt = K / BK;
    unsigned voffA[2], voffB[2];
#pragma unroll
    for (int i = 0; i < 2; ++i) { int R, C; stage_rc(tid * 16 + i * 8192, R, C); const int Rb = Epi::PERM ? ((R & ~31) + perm32(R & 31)) : R;
        voffA[i] = (unsigned)(R * lda + C) * 2u; voffB[i] = (unsigned)(Rb * ldb + C) * 2u; }
    const size_t kstep = (size_t)(BK * 2);
    const size_t hstepA = (size_t)HALF * lda * 2, hstepB = (size_t)HALF * ldb * 2;
    const unsigned ldsw = (unsigned)wid * 1024u;
    const int aoff = lds_byte(wr * 64 + fr, fq * 8), boff = lds_byte(wc * 32 + fr, fq * 8);
#define PG8_SA(b, h) (((b) * 2 + (h)) * HTB)
#define PG8_SB(b, h) ((4 + (b) * 2 + (h)) * HTB)
#define PG8_STAGE(bufoff, gbase, voff) do { _Pragma("unroll") for (int _i = 0; _i < 2; ++_i) \
        __builtin_amdgcn_global_load_lds((const unsigned*)((const char*)(gbase) + (voff)[_i]), (PG8_LAS unsigned*)(lds + (bufoff) + ldsw + _i * 8192), 16, 0, 0); } while (0)
#define PG8_LDA(dst, b, h) do { _Pragma("unroll") for (int m = 0; m < 4; ++m) _Pragma("unroll") for (int k = 0; k < 2; ++k) dst[m][k] = *(const PG8_LAS bf16x8*)(lds + PG8_SA(b, h) + aoff + m * 2048 + k * 1024); } while (0)
#define PG8_LDB(dst, b, h) do { _Pragma("unroll") for (int n = 0; n < 2; ++n) _Pragma("unroll") for (int k = 0; k < 2; ++k) dst[n][k] = *(const PG8_LAS bf16x8*)(lds + PG8_SB(b, h) + boff + n * 2048 + k * 1024); } while (0)
#define PG8_MMA(ai, bj, At, Bt) do { __builtin_amdgcn_s_setprio(1); _Pragma("unroll") for (int m = 0; m < 4; ++m) _Pragma("unroll") for (int n = 0; n < 2; ++n) _Pragma("unroll") for (int k = 0; k < 2; ++k) \
        acc[ai][bj][m][n] = __builtin_amdgcn_mfma_f32_16x16x32_bf16(Bt[n][k], At[m][k], acc[ai][bj][m][n], 0, 0, 0); __builtin_amdgcn_s_setprio(0); } while (0)
#define PG8_WAIT_V(n) asm volatile("s_waitcnt vmcnt(" #n ")" ::: "memory")
#define PG8_WAIT_L(n) asm volatile("s_waitcnt lgkmcnt(" #n ")" ::: "memory")
#define PG8_BAR __builtin_amdgcn_s_barrier()
#define PG8_SCHED __builtin_amdgcn_sched_barrier(0)
    Unit cur, nxt; int ui = 0;
    if (!S.next(0, cur)) return;
    f32x4 acc[2][2][4][2];
#pragma unroll
    for (int a = 0; a < 2; ++a)
#pragma unroll
        for (int b = 0; b < 2; ++b)
#pragma unroll
            for (int m = 0; m < 4; ++m)
#pragma unroll
                for (int n = 0; n < 2; ++n) acc[a][b][m][n] = (f32x4){0.f, 0.f, 0.f, 0.f};
    bf16x8 At[4][2], B0[2][2], B1[2][2];
    const char* cA = cur.A; const char* cB = cur.B;
    PG8_STAGE(PG8_SB(0, 0), cB, voffB); PG8_STAGE(PG8_SB(0, 1), cB + hstepB, voffB); PG8_STAGE(PG8_SA(0, 0), cA, voffA); PG8_STAGE(PG8_SA(0, 1), cA + hstepA, voffA);
    if (wr == 1) PG8_BAR;
    PG8_WAIT_V(2); PG8_BAR;
    PG8_STAGE(PG8_SB(1, 0), cB + kstep, voffB); PG8_STAGE(PG8_SA(1, 0), cA + kstep, voffA); PG8_STAGE(PG8_SB(1, 1), cB + hstepB + kstep, voffB);
    PG8_WAIT_V(6); PG8_BAR;
    for (;;) {
        const bool has_next = S.next(ui + 1, nxt);
        const char* nA = has_next ? nxt.A : cA; const char* nB = has_next ? nxt.B : cB;
        for (int t = 0; t < nt; t += 2) {
            const bool last = (t == nt - 2);
            const char* a1 = cA + (size_t)(t + 1) * kstep;
            const char* a2 = last ? nA : cA + (size_t)(t + 2) * kstep; const char* b2 = last ? nB : cB + (size_t)(t + 2) * kstep;
            const char* a3 = a2 + kstep; const char* b3 = b2 + kstep;
            PG8_LDB(B0, 0, 0); PG8_LDB(B1, 0, 1); PG8_SCHED; PG8_LDA(At, 0, 0); PG8_STAGE(PG8_SA(1, 1), a1 + hstepA, voffA);
            PG8_WAIT_V(8); PG8_WAIT_L(0); PG8_BAR; PG8_MMA(0, 0, At, B0); PG8_MMA(0, 1, At, B1); PG8_BAR; PG8_SCHED;
            PG8_LDA(At, 0, 1); PG8_STAGE(PG8_SB(0, 0), b2, voffB); PG8_STAGE(PG8_SB(0, 1), b2 + hstepB, voffB); PG8_STAGE(PG8_SA(0, 0), a2, voffA);
            PG8_WAIT_V(8); PG8_WAIT_L(0); PG8_BAR; PG8_MMA(1, 0, At, B0); PG8_MMA(1, 1, At, B1); PG8_BAR; PG8_SCHED;
            PG8_LDB(B0, 1, 0); PG8_LDB(B1, 1, 1); PG8_SCHED; PG8_LDA(At, 1, 0); PG8_STAGE(PG8_SA(0, 1), a2 + hstepA, voffA);
            PG8_WAIT_V(8); PG8_WAIT_L(0); PG8_BAR; PG8_MMA(0, 0, At, B0); PG8_MMA(0, 1, At, B1); PG8_BAR; PG8_SCHED;
            PG8_LDA(At, 1, 1); PG8_STAGE(PG8_SB(1, 0), b3, voffB); PG8_STAGE(PG8_SB(1, 1), b3 + hstepB, voffB); PG8_STAGE(PG8_SA(1, 0), a3, voffA);
            PG8_WAIT_V(8); PG8_WAIT_L(0); PG8_BAR; PG8_MMA(1, 0, At, B0); PG8_MMA(1, 1, At, B1); PG8_BAR; PG8_SCHED;
        }
        if (wr == 0) PG8_BAR;
        E(acc, cur, wr, wc, fr, fq);
        if (!has_next) break;
#pragma unroll
        for (int a = 0; a < 2; ++a)
#pragma unroll
            for (int b = 0; b < 2; ++b)
#pragma unroll
                for (int m = 0; m < 4; ++m)
#pragma unroll
                    for (int n = 0; n < 2; ++n) acc[a][b][m][n] = (f32x4){0.f, 0.f, 0.f, 0.f};
        cur = nxt; cA = nA; cB = nB; ++ui;
        if (wr == 1) PG8_BAR;
    }
    PG8_WAIT_V(0);
    PG8_BAR;
#undef PG8_SA
#undef PG8_SB
#undef PG8_STAGE
#undef PG8_LDA
#undef PG8_LDB
#undef PG8_MMA
#undef PG8_WAIT_V
#undef PG8_WAIT_L
#undef PG8_BAR
#undef PG8_SCHED
}
}
constexpr int NWAVES = 8;
constexpr int RING_OFF = 0, RING_BYTES = 131072;
constexpr int LDSCTL_OFF = RING_BYTES, MISC_OFF = LDSCTL_OFF + 320;
constexpr int LDS_BYTES = 147456;
constexpr int CW_TMO = 0, CW_CODE = 1, CW_BAR = 4096;

#define GAS __attribute__((address_space(1)))
#define LAS __attribute__((address_space(3)))
typedef unsigned v4u __attribute__((ext_vector_type(4)));
typedef unsigned v2u __attribute__((ext_vector_type(2)));
typedef GAS unsigned gu32;
#define RLX_AGENT __ATOMIC_RELAXED, __HIP_MEMORY_SCOPE_AGENT
#define LDS_WAIT() asm volatile("s_waitcnt lgkmcnt(0)" ::: "memory")
#define VM_WAIT() asm volatile("s_waitcnt vmcnt(0)" ::: "memory")
__device__ __forceinline__ unsigned pk2(float lo, float hi) { return (unsigned)f2bf(lo) | ((unsigned)f2bf(hi) << 16); }

#define XB_TMO      128
#define XB_XCNT(j)  (256  + 64 * (j))
#define XB_XSUB(j)  (1280 + 64 * (j))
#define XB_XGEN(j)  (2304 + 64 * (j))
#define XB_TOP      3328
#define XB_TOPGEN   3392
#define XCD_BAR_WORDS 3456
#define XB_SPIN_CAP (1u << 18)
__device__ __forceinline__ unsigned xb_ld(unsigned* p)              { return __hip_atomic_load(p, __ATOMIC_RELAXED, __HIP_MEMORY_SCOPE_AGENT); }
__device__ __forceinline__ unsigned xb_add(unsigned* p, unsigned v) { return __hip_atomic_fetch_add(p, v, __ATOMIC_RELAXED, __HIP_MEMORY_SCOPE_AGENT); }
__device__ __forceinline__ unsigned xb_xcc_id() { return (unsigned)__builtin_amdgcn_s_getreg((3 << 11) | 20) & 0xFu; }
#define XB_SPIN(cond, bar) do { unsigned _sp = 0; while (cond) { __builtin_amdgcn_s_sleep(1); \
    if ((++_sp & 255u) == 0u) { if (xb_ld(&(bar)[XB_TMO])) break; if (_sp > XB_SPIN_CAP) { atomicAdd(&(bar)[XB_TMO], 1u); break; } } } } while (0)
struct XcdBarrier { unsigned* bar; unsigned x; volatile LAS unsigned* st; };
__device__ __forceinline__ XcdBarrier xcd_barrier_post(unsigned* bar, volatile LAS unsigned* st) {
    XcdBarrier b; b.bar = bar; b.x = xb_xcc_id(); b.st = st;
    if (threadIdx.x == 0) (void)xb_add(&bar[XB_XCNT(b.x)], 1u);
    return b;
}
__device__ __forceinline__ void xcd_barrier_complete(unsigned* bar, unsigned x, unsigned& nloc, unsigned& nx) {
    const unsigned G = gridDim.x * gridDim.y * gridDim.z;
    unsigned sum, cnt, mine, sp = 0u;
    for (;;) {
        sum = 0u; cnt = 0u; mine = 0u;
#pragma unroll
        for (unsigned j = 0; j < 16; ++j) { const unsigned c = xb_ld(&bar[XB_XCNT(j)]); sum += c; cnt += (c > 0u) ? 1u : 0u; mine = (j == x) ? c : mine; }
        if (sum == G) break;
        __builtin_amdgcn_s_sleep(1);
        if ((++sp & 255u) == 0u) { if (xb_ld(&bar[XB_TMO])) break; if (sp > XB_SPIN_CAP) { atomicAdd(&bar[XB_TMO], 1u); break; } }
    }
    nloc = mine > 0u ? mine : 1u; nx = cnt > 0u ? cnt : 1u;
}
__device__ __forceinline__ void xcd_barrier(const XcdBarrier& b) {
    asm volatile("s_waitcnt vmcnt(0)" ::: "memory");
    __syncthreads();
    if (threadIdx.x == 0) {
        unsigned* bar = b.bar;
        __builtin_amdgcn_s_waitcnt(0);
        unsigned nloc = b.st[0], nx = b.st[1];
        if (nloc == 0u) { xcd_barrier_complete(bar, b.x, nloc, nx); b.st[0] = nloc; b.st[1] = nx; }
        const unsigned old = xb_add(&bar[XB_XSUB(b.x)], 1u);
        const unsigned gen = old / nloc;
        if (old + 1u == (gen + 1u) * nloc) {
            __builtin_amdgcn_fence(__ATOMIC_RELEASE, "agent");
            asm volatile("s_waitcnt vmcnt(0)" ::: "memory");
            const unsigned og = xb_add(&bar[XB_TOP], 1u);
            const unsigned tg = og / nx;
            if (og + 1u == (tg + 1u) * nx) xb_add(&bar[XB_TOPGEN], 1u);
            else XB_SPIN(xb_ld(&bar[XB_TOPGEN]) == tg, bar);
            __builtin_amdgcn_fence(__ATOMIC_ACQUIRE, "agent");
            xb_add(&bar[XB_XGEN(b.x)], 1u);
            asm volatile("s_waitcnt vmcnt(0)" ::: "memory");
        } else {
            XB_SPIN(xb_ld(&bar[XB_XGEN(b.x)]) == gen, bar);
            __builtin_amdgcn_fence(__ATOMIC_ACQUIRE, "agent");
            asm volatile("s_waitcnt vmcnt(0)" ::: "memory");
        }
    }
    __syncthreads();
}

struct Frame {
    LAS unsigned char* lds; volatile LAS unsigned* MISC; unsigned* ctl;
    int tid, lane, wave, vcu, G;
};
__device__ __forceinline__ float wave_sum(float v) {
#pragma unroll
    for (int o = 1; o < 64; o <<= 1) v += __shfl_xor(v, o);
    return v;
}

__device__ __forceinline__ void transpose_item(const float* W, int ldw, bf16* WT, int ldt, int drow0, int k0, int n0, const float* scale, LAS float* scr, int lane) {
#pragma unroll 8
    for (int i = 0; i < 32; ++i) { const int kk = 2 * i + (lane >> 5); float v = W[(size_t)(k0 + kk) * ldw + n0 + (lane & 31)]; if (scale) v *= scale[k0 + kk]; scr[kk * 33 + (lane & 31)] = v; }
    LDS_WAIT(); asm volatile("" ::: "memory");
    const int c = lane & 7;
#pragma unroll
    for (int j = 0; j < 4; ++j) { const int n = (lane >> 3) + 8 * j; const LAS float* s = scr + (8 * c) * 33 + n;
        v4u o; o.x = pk2(s[0 * 33], s[1 * 33]); o.y = pk2(s[2 * 33], s[3 * 33]); o.z = pk2(s[4 * 33], s[5 * 33]); o.w = pk2(s[6 * 33], s[7 * 33]);
        *(v4u*)(WT + (size_t)(drow0 + n) * ldt + k0 + 8 * c) = o; }
    LDS_WAIT(); asm volatile("" ::: "memory");
}
__device__ __forceinline__ void convert_job(Frame& F, const float* src, size_t sstride, int K, int N, bf16* dst, size_t dstride, int ldt, int mode, const float* scale, int nmat, int rot) {
    LAS float* scr = (LAS float*)(F.lds + RING_OFF + F.wave * 16384);
    const int NGW = F.G * NWAVES, gw = (F.vcu * NWAVES + F.wave + rot) % NGW;
    const int nkb = K / 64, nnb = N / 32, per = nkb * nnb, total = per * nmat;
    for (int it = gw; it < total; it += NGW) {
        const int mi = it / per, r = it % per, kb = r / nnb, nb = r % nnb, n0 = nb * 32;
        int drow = n0;
        if (mode == 1) drow = n0 + (n0 >= 1184 ? 96 : 0);
        else if (mode == 2) drow = (n0 >> 7) * 256 + (n0 & 127);
        else if (mode == 3) drow = (n0 >> 7) * 256 + 128 + (n0 & 127);
        transpose_item(src + (size_t)mi * sstride, N, dst + (size_t)mi * dstride, ldt, drow, kb * 64, n0, scale, scr, F.lane);
    }
}
enum { IN_X = 0, IN_C, IN_POS, IN_N1G, IN_N2G, IN_ADAW, IN_ADAB, IN_WIN, IN_CONVW, IN_CQG, IN_WUQ, IN_CKVG, IN_WUKV, IN_QNG, IN_KNG, IN_GVG, IN_WS, IN_BS, IN_RETG, IN_WBR, IN_WO,
       IN_F1, IN_F3, IN_F2, IN_RW, IN_RB, IN_M1, IN_M3, IN_M2, N_IN };
enum { PH_PRO = 0, PL_NORM1 = 0, PL_INPROJ, PL_PRE, PL_SCAN, PL_ATTN, PL_GATE, PL_MERGE, PL_WO, PL_NORM2, PL_F0, PL_F1, PL_F2, PL_F3, PL_F4, PL_F5, PL_PER_LAYER = 16, N_PHASES = 1 + 2 * PL_PER_LAYER };
__host__ __device__ constexpr int PHL(int l, int k) { return 1 + l * PL_PER_LAYER + k; }

struct Args { const void* in[N_IN]; float* out; unsigned char* ws; int ph_lo, ph_hi, li, pad; };

__device__ __forceinline__ void norm_phase(Frame& F, const float* X, bf16* H, const float* gain, const float* ada_l, const int off_sh, const int off_sc,
                                           const float* router_w, const float* router_b, nv::Route* route, int* CNT) {
    int lane_ = F.lane; asm volatile("" : "+v"(lane_)); const int lane = lane_;
    LAS int* cnt = (LAS int*)(F.lds + RING_OFF);
    for (int blk = F.vcu; blk < NTOK / 128; blk += F.G) {
        if (router_w) { if (F.tid < NEXP) cnt[F.tid] = 0; __syncthreads(); }
        const int b = (blk * 128) / SEQ;
        float4 gm[4], sh[4];
#pragma unroll
        for (int j = 0; j < 4; ++j) { const int col = 4 * (lane + 64 * j);
            const float4 g = *(const float4*)(gain + col), sc = *(const float4*)(ada_l + (size_t)b * 6 * DM + off_sc + col);
            gm[j] = make_float4(g.x * (1.f + sc.x), g.y * (1.f + sc.y), g.z * (1.f + sc.z), g.w * (1.f + sc.w));
            sh[j] = *(const float4*)(ada_l + (size_t)b * 6 * DM + off_sh + col); }
        for (int rr = 0; rr < 16; ++rr) {
            const int m = blk * 128 + F.wave * 16 + rr;
            const float4* xr = (const float4*)(X + (size_t)m * DM);
            float4 v[4]; float ss = 0.f;
#pragma unroll
            for (int j = 0; j < 4; ++j) { v[j] = xr[lane + 64 * j]; ss += v[j].x * v[j].x + v[j].y * v[j].y + v[j].z * v[j].z + v[j].w * v[j].w; }
            ss = wave_sum(ss);
            const float rstd = rsqrtf(ss * (1.f / DM) + EPS);
            float lg[NEXP];
#pragma unroll
            for (int e = 0; e < NEXP; ++e) lg[e] = 0.f;
#pragma unroll
            for (int j = 0; j < 4; ++j) {
                const int col = 4 * (lane + 64 * j);
                const float h0 = v[j].x * rstd * gm[j].x + sh[j].x, h1 = v[j].y * rstd * gm[j].y + sh[j].y, h2 = v[j].z * rstd * gm[j].z + sh[j].z, h3 = v[j].w * rstd * gm[j].w + sh[j].w;
                uint2 o; o.x = pk2(h0, h1); o.y = pk2(h2, h3);
                *(uint2*)(H + (size_t)m * DM + col) = o;
                if (router_w) {
                    const float4* rw = (const float4*)(router_w + (size_t)col * NEXP);
#pragma unroll
                    for (int q = 0; q < 2; ++q) { const float4 w0 = rw[q], w1 = rw[2 + q], w2 = rw[4 + q], w3 = rw[6 + q];
                        lg[4 * q + 0] += h0 * w0.x + h1 * w1.x + h2 * w2.x + h3 * w3.x; lg[4 * q + 1] += h0 * w0.y + h1 * w1.y + h2 * w2.y + h3 * w3.y;
                        lg[4 * q + 2] += h0 * w0.z + h1 * w1.z + h2 * w2.z + h3 * w3.z; lg[4 * q + 3] += h0 * w0.w + h1 * w1.w + h2 * w2.w + h3 * w3.w; }
                }
            }
            if (router_w) {
#pragma unroll
                for (int e = 0; e < NEXP; ++e) lg[e] = wave_sum(lg[e]) + router_b[e];
                if (lane == 0) {
                    int e0 = 0; float l0 = lg[0];
#pragma unroll
                    for (int e = 1; e < NEXP; ++e) if (lg[e] > l0) { l0 = lg[e]; e0 = e; }
                    int e1 = -1; float l1 = -INFINITY;
#pragma unroll
                    for (int e = 0; e < NEXP; ++e) if (e != e0 && lg[e] > l1) { l1 = lg[e]; e1 = e; }
                    const float p0 = 1.f / (1.f + __expf(l1 - l0));
                    nv::Route r; r.e0 = e0; r.e1 = e1; r.p0 = p0; r.p1 = 1.f - p0; route[m] = r;
                    atomicAdd((int*)&cnt[e0], 1); atomicAdd((int*)&cnt[e1], 1);
                }
            }
        }
        if (router_w) { __syncthreads(); if (F.tid < NEXP) CNT[blk * NEXP + F.tid] = cnt[F.tid]; __syncthreads(); }
    }
}

__device__ __forceinline__ void moe_assign_phase(Frame& F, const Args& args) {
    unsigned char* ws = args.ws;
    const nv::Route* route = (const nv::Route*)(ws + WS_ROUTE); const int* CNT = (const int*)(ws + WS_CNT); const bf16* H2 = (const bf16*)(ws + WS_H); bf16* XS = (bf16*)(ws + WS_XS);
    int* SLOT = (int*)(ws + WS_SLOT); float* PSLOT = (float*)(ws + WS_PSLOT); int* PEXP = (int*)(ws + WS_PEXP);
    LAS int* sm = (LAS int*)(F.lds + RING_OFF);
    LAS int* tot = sm; LAS int* pre = sm + 8; LAS int* base = sm + 16; LAS int* wcnt = sm + 32; LAS int* ss0 = sm + 64; LAS int* ss1 = sm + 192;
    const int tid = F.tid, lane = F.lane, w = F.wave;
    for (int blk = F.vcu; blk < NTOK / 128; blk += F.G) {
        if (tid < 16) sm[tid] = 0;
        __syncthreads();
        if (tid < 256) { const int4 c0 = *(const int4*)(CNT + tid * NEXP), c1 = *(const int4*)(CNT + tid * NEXP + 4); const int cc[8] = {c0.x, c0.y, c0.z, c0.w, c1.x, c1.y, c1.z, c1.w};
#pragma unroll
            for (int e = 0; e < NEXP; ++e) { atomicAdd((int*)&tot[e], cc[e]); if (tid < blk) atomicAdd((int*)&pre[e], cc[e]); } }
        __syncthreads();
        if (tid == 0) { int bsum = 0; for (int e = 0; e < NEXP; ++e) { base[e] = bsum; bsum += (tot[e] + 255) & ~255; } base[NEXP] = bsum; }
        __syncthreads();
        if (blk == 0) { for (int p = tid; p < MAXPANEL + 8; p += NWAVES * 64) { int e = -1;
#pragma unroll
                for (int x = 0; x < NEXP; ++x) if (p * 256 >= base[x] && p * 256 < base[x + 1]) e = x;
                if (p == MAXPANEL) e = base[NEXP] >> 8; PEXP[p] = e; } }
        if (blk < NEXP) { const int e = blk; for (int s = base[e] + tot[e] + tid; s < base[e + 1]; s += NWAVES * 64) PSLOT[s] = 0.f; }
        if (tid < 128) {
            const int t = blk * 128 + tid; const nv::Route r = route[t]; int rank0 = 0, rank1 = 0;
#pragma unroll
            for (int e = 0; e < NEXP; ++e) { const bool in = (r.e0 == e) || (r.e1 == e); const unsigned long long m = __ballot(in); if (lane == 0) wcnt[w * 8 + e] = __popcll(m);
                const int rk = __popcll(m & ((1ull << lane) - 1ull)); if (r.e0 == e) rank0 = rk; if (r.e1 == e) rank1 = rk; }
            ss0[tid] = rank0; ss1[tid] = rank1;
        }
        __syncthreads();
        if (tid < 128) {
            const int t = blk * 128 + tid; const nv::Route r = route[t]; int rank0 = ss0[tid], rank1 = ss1[tid];
            if (w == 1) { rank0 += wcnt[r.e0]; rank1 += wcnt[r.e1]; }
            const int s0 = base[r.e0] + pre[r.e0] + rank0, s1 = base[r.e1] + pre[r.e1] + rank1;
            SLOT[2 * t] = s0; SLOT[2 * t + 1] = s1; PSLOT[s0] = r.p0; PSLOT[s1] = r.p1;
            ss0[tid] = s0; ss1[tid] = s1;
        }
        __syncthreads();
        { const int rsub = tid >> 7, c8 = (tid & 127) * 8;
          for (int i = 0; i < 128; i += 4) { const int row = i + rsub; const uint4 v = *(const uint4*)(H2 + (size_t)(blk * 128 + row) * DM + c8);
              *(uint4*)(XS + (size_t)ss0[row] * DM + c8) = v; *(uint4*)(XS + (size_t)ss1[row] * DM + c8) = v; } }
        __syncthreads();
    }
}

__device__ __forceinline__ void moe_combine_phase(Frame& F, float* X, const bf16* Y, const int* SLOT, const float* g2) {
    const int gw = F.vcu * NWAVES + F.wave, NGW = F.G * NWAVES;
    for (int t = gw; t < NTOK; t += NGW) {
        const int b = t / SEQ, s0 = SLOT[2 * t], s1 = SLOT[2 * t + 1];
#pragma unroll
        for (int j = 0; j < 4; ++j) { const int c4 = 4 * (F.lane + 64 * j);
            const uint2 a = *(const uint2*)(Y + (size_t)s0 * DM + c4), bq = *(const uint2*)(Y + (size_t)s1 * DM + c4);
            float4 x = *(float4*)(X + (size_t)t * DM + c4); const float4 g = *(const float4*)(g2 + (size_t)b * 6 * DM + c4);
            x.x += g.x * (bf2f((bf16)(a.x & 0xffff)) + bf2f((bf16)(bq.x & 0xffff))); x.y += g.y * (bf2f((bf16)(a.x >> 16)) + bf2f((bf16)(bq.x >> 16)));
            x.z += g.z * (bf2f((bf16)(a.y & 0xffff)) + bf2f((bf16)(bq.y & 0xffff))); x.w += g.w * (bf2f((bf16)(a.y >> 16)) + bf2f((bf16)(bq.y >> 16)));
            *(float4*)(X + (size_t)t * DM + c4) = x; }
    }
}

__device__ __forceinline__ void scan_phase(Frame& F, float* RET) {
    for (int idx = F.vcu * NWAVES * 64 + F.tid; idx < NBATCH * NHEAD * 4096; idx += F.G * NWAVES * 64) {
        const int b = idx / (NHEAD * 4096), h = (idx / 4096) % NHEAD, ed = idx % 4096;
        const float cd = __expf(nv::ret_loggamma(h) * 128.f); float st = 0.f;
        float* p = RET + ((size_t)b * NCHUNK * NHEAD + h) * 4096 + ed; const size_t stp = (size_t)NHEAD * 4096;
        for (int n0 = 0; n0 < NCHUNK; n0 += 8) { float kv[8];
#pragma unroll
            for (int i = 0; i < 8; ++i) kv[i] = p[(size_t)(n0 + i) * stp];
#pragma unroll
            for (int i = 0; i < 8; ++i) { p[(size_t)(n0 + i) * stp] = st; st = st * cd + kv[i]; } }
    }
}
typedef short bf16x8 __attribute__((ext_vector_type(8)));
typedef float f32x4 __attribute__((ext_vector_type(4)));
typedef float f32x16 __attribute__((ext_vector_type(16)));
#define MFMA16(a, b, c) __builtin_amdgcn_mfma_f32_16x16x32_bf16((a), (b), (c), 0, 0, 0)
__device__ __forceinline__ float bflo_(unsigned w) { return __uint_as_float(w << 16); }
__device__ __forceinline__ float bfhi_(unsigned w) { return __uint_as_float(w & 0xffff0000u); }
__device__ __forceinline__ float sumsq8(bf16x8 v) { float s = 0.f;
#pragma unroll
    for (int i = 0; i < 8; ++i) { const float f = bf2f((bf16)v[i]); s += f * f; } return s; }
__device__ __forceinline__ int tofs(int row, int j) { return row * 256 + ((((j >> 3) ^ (row & 15)) << 4) | ((j & 7) << 1)); }
__device__ __forceinline__ float fast_gelu_tanh(float x) { const float u = 0.7978845608028654f * (x + 0.044715f * x * x * x);
    return x * __builtin_amdgcn_rcpf(1.f + __builtin_amdgcn_exp2f(-2.885390081777927f * u)); }

template <int l> __device__ __forceinline__ void pre_conv(Frame& F, const Args& args, const int t0) {
    const bf16* P = (const bf16*)(args.ws + WS_PROJ); bf16* YB = (bf16*)(args.ws + WS_YB); const float* cw = (const float*)args.in[IN_CONVW] + l * 3 * MIXW;
    int tid_ = F.tid; asm volatile("" : "+v"(tid_)); const int cg = tid_ & 31, tl = tid_ >> 5, c0 = cg * 8, tb = t0 + tl * 8, sb = tb % SEQ;
    float w0[8], w1[8], w2[8], u1[8], u2[8];
#pragma unroll
    for (int i = 0; i < 8; ++i) { w0[i] = cw[c0 + i]; w1[i] = cw[256 + c0 + i]; w2[i] = cw[512 + c0 + i]; u1[i] = 0.f; u2[i] = 0.f; }
    auto ldu = [&](int t, float* u) { const v4u a = *(const v4u*)(P + (size_t)t * PROJW + C_AC + c0), x = *(const v4u*)(P + (size_t)t * PROJW + C_AX + c0);
        u[0] = bflo_(a.x) * bflo_(x.x); u[1] = bfhi_(a.x) * bfhi_(x.x); u[2] = bflo_(a.y) * bflo_(x.y); u[3] = bfhi_(a.y) * bfhi_(x.y);
        u[4] = bflo_(a.z) * bflo_(x.z); u[5] = bfhi_(a.z) * bfhi_(x.z); u[6] = bflo_(a.w) * bflo_(x.w); u[7] = bfhi_(a.w) * bfhi_(x.w); };
    if (sb >= 1) ldu(tb - 1, u1);
    if (sb >= 2) ldu(tb - 2, u2);
#pragma unroll
    for (int i = 0; i < 8; ++i) { const int t = tb + i; float u0[8]; ldu(t, u0);
        const v4u ab = *(const v4u*)(P + (size_t)t * PROJW + C_AB + c0); const float bb[8] = {bflo_(ab.x), bfhi_(ab.x), bflo_(ab.y), bfhi_(ab.y), bflo_(ab.z), bfhi_(ab.z), bflo_(ab.w), bfhi_(ab.w)};
        float y[8];
#pragma unroll
        for (int c = 0; c < 8; ++c) { y[c] = bb[c] * (w0[c] * u2[c] + w1[c] * u1[c] + w2[c] * u0[c]); u2[c] = u1[c]; u1[c] = u0[c]; }
        v4u o; o.x = pk2(y[0], y[1]); o.y = pk2(y[2], y[3]); o.z = pk2(y[4], y[5]); o.w = pk2(y[6], y[7]);
        *(v4u*)(YB + (size_t)t * DM + c0) = o; }
}

template <int l> __device__ __forceinline__ void pre_mla(Frame& F, const Args& args, const int t0) {
    unsigned char* ws = args.ws;
    const bf16* P = (const bf16*)(ws + WS_PROJ); bf16* Q = (bf16*)(ws + WS_Q); bf16* Kb = (bf16*)(ws + WS_K); bf16* VT = (bf16*)(ws + WS_VT);
    const bf16* WUQ = (const bf16*)(ws + WS_WUQ_T) + (size_t)l * QW * 256; const bf16* WUKV = (const bf16*)(ws + WS_WUKV_T) + (size_t)l * 512 * 128;
    const float* qn_g = (const float*)args.in[IN_QNG] + l * QKH; const float* kn_g = (const float*)args.in[IN_KNG] + l * QKH; const int* pos = (const int*)args.in[IN_POS];
    int lane_ = F.lane; asm volatile("" : "+v"(lane_)); const int lr = lane_ & 15, lq = lane_ >> 4;
    const int tw = t0 + F.wave * 16 + lr, b = t0 / SEQ, sw = (t0 % SEQ) + F.wave * 16;
    const bf16* prow = P + (size_t)tw * PROJW;
    bf16x8 xq[8], xkv[4]; float ssq = 0.f, sskv = 0.f;
#pragma unroll
    for (int s = 0; s < 8; ++s) { xq[s] = *(const bf16x8*)(prow + C_CQ + 32 * s + 8 * lq); ssq += sumsq8(xq[s]); }
#pragma unroll
    for (int s = 0; s < 4; ++s) { xkv[s] = *(const bf16x8*)(prow + C_CKV + 32 * s + 8 * lq); sskv += sumsq8(xkv[s]); }
    ssq += __shfl_xor(ssq, 16); ssq += __shfl_xor(ssq, 32); sskv += __shfl_xor(sskv, 16); sskv += __shfl_xor(sskv, 32);
    const float rq = rsqrtf(ssq * (1.f / 256) + EPS), rkv = rsqrtf(sskv * (1.f / 128) + EPS);
    float cs[4], sn[4]; { const float fpos = (float)pos[tw];
#pragma unroll
        for (int r = 0; r < 4; ++r) { const float ang = fpos * powf(10000.f, -(float)(4 * lq + r) / 16.f); sincosf(ang, &sn[r], &cs[r]); } }
#pragma unroll 1
    for (int h = 0; h < NHEAD; ++h) {
        f32x4 acc[6];
#pragma unroll
        for (int nt = 0; nt < 6; ++nt) acc[nt] = (f32x4){0.f, 0.f, 0.f, 0.f};
#pragma unroll
        for (int s = 0; s < 8; ++s)
#pragma unroll
            for (int nt = 0; nt < 6; ++nt) { const bf16x8 wf = *(const bf16x8*)(WUQ + (size_t)(h * 96 + nt * 16 + lr) * 256 + 32 * s + 8 * lq); acc[nt] = MFMA16(wf, xq[s], acc[nt]); }
        float ss = 0.f;
#pragma unroll
        for (int nt = 0; nt < 6; ++nt) { acc[nt] = acc[nt] * rq; ss += acc[nt][0] * acc[nt][0] + acc[nt][1] * acc[nt][1] + acc[nt][2] * acc[nt][2] + acc[nt][3] * acc[nt][3]; }
        ss += __shfl_xor(ss, 16); ss += __shfl_xor(ss, 32);
        const float rh = rsqrtf(ss * (1.f / 96) + EPS);
#pragma unroll
        for (int nt = 0; nt < 6; ++nt) { const f32x4 g = *(const f32x4*)(qn_g + nt * 16 + 4 * lq); acc[nt] = acc[nt] * rh * g; }
#pragma unroll
        for (int r = 0; r < 4; ++r) { const float x1 = acc[4][r], x2 = acc[5][r]; acc[4][r] = x1 * cs[r] - x2 * sn[r]; acc[5][r] = x2 * cs[r] + x1 * sn[r]; }
#pragma unroll
        for (int nt = 0; nt < 6; ++nt) { v2u o; o.x = pk2(acc[nt][0] * ATT_C2, acc[nt][1] * ATT_C2); o.y = pk2(acc[nt][2] * ATT_C2, acc[nt][3] * ATT_C2);
            *(v2u*)(Q + (size_t)tw * QW + h * 96 + nt * 16 + 4 * lq) = o; }
    }
    float kr1[4], kr2[4]; { const v2u a = *(const v2u*)(prow + C_KR + 4 * lq), c = *(const v2u*)(prow + C_KR + 16 + 4 * lq);
        kr1[0] = bflo_(a.x); kr1[1] = bfhi_(a.x); kr1[2] = bflo_(a.y); kr1[3] = bfhi_(a.y); kr2[0] = bflo_(c.x); kr2[1] = bfhi_(c.x); kr2[2] = bflo_(c.y); kr2[3] = bfhi_(c.y); }
    float sskr = 0.f;
#pragma unroll
    for (int r = 0; r < 4; ++r) sskr += kr1[r] * kr1[r] + kr2[r] * kr2[r];
    float rkv_r[4];
#pragma unroll
    for (int r = 0; r < 4; ++r) rkv_r[r] = __shfl(rkv, 4 * lq + r);
#pragma unroll 1
    for (int h = 0; h < NHEAD; ++h) {
        f32x4 ak[4], av[4];
#pragma unroll
        for (int nt = 0; nt < 4; ++nt) { ak[nt] = (f32x4){0.f, 0.f, 0.f, 0.f}; av[nt] = (f32x4){0.f, 0.f, 0.f, 0.f}; }
#pragma unroll
        for (int s = 0; s < 4; ++s)
#pragma unroll
            for (int nt = 0; nt < 4; ++nt) {
                const bf16x8 wk = *(const bf16x8*)(WUKV + (size_t)(h * 128 + nt * 16 + lr) * 128 + 32 * s + 8 * lq); ak[nt] = MFMA16(wk, xkv[s], ak[nt]);
                const bf16x8 wv = *(const bf16x8*)(WUKV + (size_t)(h * 128 + 64 + nt * 16 + lr) * 128 + 32 * s + 8 * lq); av[nt] = MFMA16(xkv[s], wv, av[nt]);
            }
        float ss = sskr;
#pragma unroll
        for (int nt = 0; nt < 4; ++nt) { ak[nt] = ak[nt] * rkv; ss += ak[nt][0] * ak[nt][0] + ak[nt][1] * ak[nt][1] + ak[nt][2] * ak[nt][2] + ak[nt][3] * ak[nt][3]; }
        ss += __shfl_xor(ss, 16); ss += __shfl_xor(ss, 32);
        const float rk = rsqrtf(ss * (1.f / 96) + EPS);
#pragma unroll
        for (int nt = 0; nt < 4; ++nt) { const f32x4 g = *(const f32x4*)(kn_g + nt * 16 + 4 * lq); const f32x4 v = ak[nt] * rk * g; v2u o; o.x = pk2(v[0], v[1]); o.y = pk2(v[2], v[3]);
            *(v2u*)(Kb + (size_t)tw * QW + h * 96 + nt * 16 + 4 * lq) = o; }
        { const f32x4 g1 = *(const f32x4*)(kn_g + 64 + 4 * lq), g2 = *(const f32x4*)(kn_g + 80 + 4 * lq); float o1[4], o2[4];
#pragma unroll
          for (int r = 0; r < 4; ++r) { const float x1 = kr1[r] * rk * g1[r], x2 = kr2[r] * rk * g2[r]; o1[r] = x1 * cs[r] - x2 * sn[r]; o2[r] = x2 * cs[r] + x1 * sn[r]; }
          v2u a; a.x = pk2(o1[0], o1[1]); a.y = pk2(o1[2], o1[3]); *(v2u*)(Kb + (size_t)tw * QW + h * 96 + 64 + 4 * lq) = a;
          v2u c; c.x = pk2(o2[0], o2[1]); c.y = pk2(o2[2], o2[3]); *(v2u*)(Kb + (size_t)tw * QW + h * 96 + 80 + 4 * lq) = c; }
#pragma unroll
        for (int nt = 0; nt < 4; ++nt) { v2u o; o.x = pk2(av[nt][0] * rkv_r[0], av[nt][1] * rkv_r[1]); o.y = pk2(av[nt][2] * rkv_r[2], av[nt][3] * rkv_r[3]);
            *(v2u*)(VT + ((size_t)(b * NHEAD + h) * 64 + nt * 16 + lr) * SEQ + sw + 4 * lq) = o; }
    }
}

template <int l> __device__ __forceinline__ void pre_sgu(Frame& F, const Args& args, const int t0) {
    unsigned char* ws = args.ws;
    const bf16* P = (const bf16*)(ws + WS_PROJ); bf16* YB = (bf16*)(ws + WS_YB); const bf16* WST = (const bf16*)(ws + WS_WS_T) + (size_t)l * 4 * 128 * 128;
    const float* gv_g = (const float*)args.in[IN_GVG] + l * 256; const float* b_s = (const float*)args.in[IN_BS] + l * 4 * 128;
    LAS unsigned char* vT = F.lds + RING_OFF;
    int lane_ = F.lane; asm volatile("" : "+v"(lane_)); const int lane = lane_, lr = lane & 15, lq = lane >> 4, w = F.wave;
    { const f32x4 gg = *(const f32x4*)(gv_g + 4 * lane);
      for (int j = 0; j < 16; ++j) { const int s = 16 * w + j; const v2u a = *(const v2u*)(P + (size_t)(t0 + s) * PROJW + C_SV + 4 * lane);
          float v[4] = {fast_gelu_tanh(bflo_(a.x)), fast_gelu_tanh(bfhi_(a.x)), fast_gelu_tanh(bflo_(a.y)), fast_gelu_tanh(bfhi_(a.y))};
          float ss = v[0] * v[0] + v[1] * v[1] + v[2] * v[2] + v[3] * v[3];
          ss += __shfl_xor(ss, 1); ss += __shfl_xor(ss, 2); ss += __shfl_xor(ss, 4); ss += __shfl_xor(ss, 8);
          const float rs = rsqrtf(ss * (1.f / 64) + EPS);
#pragma unroll
          for (int i = 0; i < 4; ++i) *(LAS bf16*)(vT + tofs(4 * lane + i, s)) = f2bf(v[i] * rs * gg[i]); } }
    __syncthreads();
    const int tw = t0 + 16 * w + lr, nks = (16 * w + 15) / 32 + 1;
#pragma unroll 1
    for (int g = 0; g < 4; ++g) {
        f32x4 acc[4];
#pragma unroll
        for (int ct = 0; ct < 4; ++ct) acc[ct] = (f32x4){0.f, 0.f, 0.f, 0.f};
        for (int ks = 0; ks < nks; ++ks) { const bf16x8 wf = *(const bf16x8*)(WST + ((size_t)g * 128 + 16 * w + lr) * 128 + 32 * ks + 8 * lq);
#pragma unroll
            for (int ct = 0; ct < 4; ++ct) { const bf16x8 vf = *(const LAS bf16x8*)(vT + tofs(g * 64 + ct * 16 + lr, 32 * ks + 8 * lq)); acc[ct] = MFMA16(vf, wf, acc[ct]); } }
        const float bb = b_s[g * 128 + 16 * w + lr];
#pragma unroll
        for (int ct = 0; ct < 4; ++ct) { const v2u a = *(const v2u*)(P + (size_t)tw * PROJW + C_SU + g * 64 + ct * 16 + 4 * lq);
            v2u o; o.x = pk2(fast_gelu_tanh(bflo_(a.x)) * (acc[ct][0] + bb), fast_gelu_tanh(bfhi_(a.x)) * (acc[ct][1] + bb)); o.y = pk2(fast_gelu_tanh(bflo_(a.y)) * (acc[ct][2] + bb), fast_gelu_tanh(bfhi_(a.y)) * (acc[ct][3] + bb));
            *(v2u*)(YB + (size_t)tw * DM + 512 + g * 64 + ct * 16 + 4 * lq) = o; }
    }
    __syncthreads();
}

__device__ __forceinline__ void pre_retkv(Frame& F, const Args& args, const int t0, const int ch) {
    unsigned char* ws = args.ws;
    bf16* P = (bf16*)(ws + WS_PROJ); float* RET = (float*)(ws + WS_RET); const int* pos = (const int*)args.in[IN_POS];
    LAS unsigned char* kT = F.lds + RING_OFF; LAS unsigned char* vT = F.lds + RING_OFF + 65536;
    int lane_ = F.lane; asm volatile("" : "+v"(lane_)); const int lane = lane_, lr = lane & 15, lq = lane >> 4, w = F.wave;
    { const int h = lane >> 4, i0 = (lane & 15) * 2; const float lg = nv::ret_loggamma(h);
      const float f0 = powf(10000.f, -(float)i0 / 32.f), f1 = powf(10000.f, -(float)(i0 + 1) / 32.f);
      for (int j = 0; j < 16; ++j) { const int s = 16 * w + j; bf16* r = P + (size_t)(t0 + s) * PROJW; const float fpos = (float)pos[t0 + s];
          const unsigned q1 = *(const unsigned*)(r + C_RQ + h * 64 + i0), q2 = *(const unsigned*)(r + C_RQ + h * 64 + 32 + i0), k1 = *(const unsigned*)(r + C_RK + h * 64 + i0), k2 = *(const unsigned*)(r + C_RK + h * 64 + 32 + i0);
          const v2u vv = *(const v2u*)(r + C_RV + 4 * lane);
          float s0, c0, s1, c1; sincosf(fpos * f0, &s0, &c0); sincosf(fpos * f1, &s1, &c1);
          const float dq = __expf(lg * (float)s), dk = 0.125f * __expf(-lg * (float)s);
          const unsigned qa = pk2((bflo_(q1) * c0 - bflo_(q2) * s0) * dq, (bfhi_(q1) * c1 - bfhi_(q2) * s1) * dq), qb = pk2((bflo_(q2) * c0 + bflo_(q1) * s0) * dq, (bfhi_(q2) * c1 + bfhi_(q1) * s1) * dq);
          const unsigned ka = pk2((bflo_(k1) * c0 - bflo_(k2) * s0) * dk, (bfhi_(k1) * c1 - bfhi_(k2) * s1) * dk), kb = pk2((bflo_(k2) * c0 + bflo_(k1) * s0) * dk, (bfhi_(k2) * c1 + bfhi_(k1) * s1) * dk);
          *(unsigned*)(r + C_RQ + h * 64 + i0) = qa; *(unsigned*)(r + C_RQ + h * 64 + 32 + i0) = qb; *(unsigned*)(r + C_RK + h * 64 + i0) = ka; *(unsigned*)(r + C_RK + h * 64 + 32 + i0) = kb;
          *(LAS bf16*)(kT + tofs(h * 64 + i0, s)) = (bf16)(ka & 0xffff); *(LAS bf16*)(kT + tofs(h * 64 + i0 + 1, s)) = (bf16)(ka >> 16);
          *(LAS bf16*)(kT + tofs(h * 64 + 32 + i0, s)) = (bf16)(kb & 0xffff); *(LAS bf16*)(kT + tofs(h * 64 + 32 + i0 + 1, s)) = (bf16)(kb >> 16);
          *(LAS bf16*)(vT + tofs(4 * lane + 0, s)) = (bf16)(vv.x & 0xffff); *(LAS bf16*)(vT + tofs(4 * lane + 1, s)) = (bf16)(vv.x >> 16);
          *(LAS bf16*)(vT + tofs(4 * lane + 2, s)) = (bf16)(vv.y & 0xffff); *(LAS bf16*)(vT + tofs(4 * lane + 3, s)) = (bf16)(vv.y >> 16); } }
    __syncthreads();
    { const int h = w >> 1; const float g127 = __expf(nv::ret_loggamma(h) * 127.f);
      f32x4 acc[4][2];
#pragma unroll
      for (int dt = 0; dt < 4; ++dt)
#pragma unroll
          for (int ei = 0; ei < 2; ++ei) acc[dt][ei] = (f32x4){0.f, 0.f, 0.f, 0.f};
#pragma unroll
      for (int ks = 0; ks < 4; ++ks) { bf16x8 vf[2];
#pragma unroll
          for (int ei = 0; ei < 2; ++ei) vf[ei] = *(const LAS bf16x8*)(vT + tofs(h * 64 + ((w & 1) * 2 + ei) * 16 + lr, 32 * ks + 8 * lq));
#pragma unroll
          for (int dt = 0; dt < 4; ++dt) { const bf16x8 kf = *(const LAS bf16x8*)(kT + tofs(h * 64 + dt * 16 + lr, 32 * ks + 8 * lq));
#pragma unroll
              for (int ei = 0; ei < 2; ++ei) acc[dt][ei] = MFMA16(kf, vf[ei], acc[dt][ei]); } }
#pragma unroll
      for (int dt = 0; dt < 4; ++dt)
#pragma unroll
          for (int ei = 0; ei < 2; ++ei) *(f32x4*)(RET + (((size_t)ch * NHEAD + h) * 64 + ((w & 1) * 2 + ei) * 16 + lr) * 64 + dt * 16 + 4 * lq) = acc[dt][ei] * g127; }
    __syncthreads();
}

template <int l> __device__ __forceinline__ void pre_phase(Frame& F, const Args& args) {
    for (int ch = F.vcu; ch < NTOK / CHUNK; ch += F.G) {
        const int t0 = ch * CHUNK;
        pre_conv<l>(F, args, t0);
        pre_mla<l>(F, args, t0);
        pre_sgu<l>(F, args, t0);
        pre_retkv(F, args, t0, ch);
    }
}
#define MFMA32(a, b, c) __builtin_amdgcn_mfma_f32_32x32x16_bf16((a), (b), (c), 0, 0, 0)
typedef short s16x4 __attribute__((ext_vector_type(4)));
constexpr int AT_KROW = 208, AT_VROW = 136, AT_KBYTES = 64 * AT_KROW, AT_STAGE = 22528;
__device__ __forceinline__ int crow32(int r, int hi) { return (r & 3) + 8 * (r >> 2) + 4 * hi; }

__device__ __forceinline__ void attn_unit(Frame& F, const bf16* Q, const bf16* Kb, const bf16* VT, bf16* YB, const float nbnd, const int b, const int h, const int qb) {
    int tid_ = F.tid; asm volatile("" : "+v"(tid_)); const int tid = tid_, lane = tid & 63, r32 = lane & 31, hi = lane >> 5, w = F.wave;
    LAS unsigned char* lds = F.lds + RING_OFF;
    const int bh = b * NHEAD + h, qw0 = qb * 256 + w * 32;
    const size_t tq = (size_t)b * SEQ + qw0 + r32;
    bf16x8 qf[6];
#pragma unroll
    for (int s = 0; s < 6; ++s) qf[s] = *(const bf16x8*)(Q + tq * QW + h * 96 + 16 * s + 8 * hi);
    f32x16 o0, o1; float lsum = 0.f;
#pragma unroll
    for (int r = 0; r < 16; ++r) { o0[r] = 0.f; o1[r] = 0.f; }
    const int ntile = 4 * qb + 4;
    const int kr0 = tid / 12, kc0 = tid % 12, kr1 = (tid + 512) / 12, kc1 = (tid + 512) % 12, vd = tid >> 3, vc = tid & 7;
    const bf16* kg0 = Kb + ((size_t)b * SEQ + kr0) * QW + h * 96 + kc0 * 8; const bf16* kg1 = Kb + ((size_t)b * SEQ + kr1) * QW + h * 96 + kc1 * 8;
    const bf16* vg = VT + ((size_t)bh * 64 + vd) * SEQ + vc * 8;
    const int kl0 = kr0 * AT_KROW + kc0 * 16, kl1 = kr1 * AT_KROW + kc1 * 16, vl = AT_KBYTES + vd * AT_VROW + vc * 16;
    v4u rk0, rk1, rv; rk1 = (v4u){0u, 0u, 0u, 0u};
    rk0 = *(const v4u*)kg0; if (tid < 256) rk1 = *(const v4u*)kg1; rv = *(const v4u*)vg;
    *(LAS v4u*)(lds + kl0) = rk0; if (tid < 256) *(LAS v4u*)(lds + kl1) = rk1;
    *(LAS v2u*)(lds + vl) = (v2u){rv.x, rv.y}; *(LAS v2u*)(lds + vl + 8) = (v2u){rv.z, rv.w};
    __syncthreads();
    const int ka = r32 * AT_KROW + hi * 16;
    const int va = AT_KBYTES + r32 * AT_VROW + hi * 8;
    for (int t = 0; t < ntile; ++t) {
        LAS unsigned char* cur = lds + (t & 1) * AT_STAGE; LAS unsigned char* nxt = lds + ((t + 1) & 1) * AT_STAGE;
        const bool more = (t + 1 < ntile);
        if (more) { const size_t ko = (size_t)(t + 1) * 64 * QW; rk0 = *(const v4u*)(kg0 + ko); if (tid < 256) rk1 = *(const v4u*)(kg1 + ko); rv = *(const v4u*)(vg + (t + 1) * 64); }
        if (64 * t <= qw0 + 31) {
            f32x16 p0, p1;
#pragma unroll
            for (int r = 0; r < 16; ++r) { p0[r] = nbnd; p1[r] = nbnd; }
#pragma unroll
            for (int s = 0; s < 6; ++s) { const bf16x8 k0 = *(const LAS bf16x8*)(cur + ka + s * 32), k1 = *(const LAS bf16x8*)(cur + ka + 32 * AT_KROW + s * 32);
                p0 = MFMA32(k0, qf[s], p0); p1 = MFMA32(k1, qf[s], p1); }
#pragma unroll
            for (int r = 0; r < 16; ++r) { p0[r] = __builtin_amdgcn_exp2f(p0[r]); p1[r] = __builtin_amdgcn_exp2f(p1[r]); }
            if (64 * t + 63 > qw0) {
                const int qrel = qw0 + r32 - 64 * t;
#pragma unroll
                for (int r = 0; r < 16; ++r) { const int kk = crow32(r, hi); if (kk > qrel) p0[r] = 0.f; if (kk + 32 > qrel) p1[r] = 0.f; }
            }
            float sacc = 0.f;
#pragma unroll
            for (int r = 0; r < 16; ++r) sacc += p0[r] + p1[r];
            lsum += sacc;
            bf16x8 pb[2][2];
#pragma unroll
            for (int s2 = 0; s2 < 2; ++s2) {
                const v4u a = {pg8::cvt_pk_bf16(p0[8 * s2 + 0], p0[8 * s2 + 1]), pg8::cvt_pk_bf16(p0[8 * s2 + 2], p0[8 * s2 + 3]), pg8::cvt_pk_bf16(p0[8 * s2 + 4], p0[8 * s2 + 5]), pg8::cvt_pk_bf16(p0[8 * s2 + 6], p0[8 * s2 + 7])};
                const v4u c = {pg8::cvt_pk_bf16(p1[8 * s2 + 0], p1[8 * s2 + 1]), pg8::cvt_pk_bf16(p1[8 * s2 + 2], p1[8 * s2 + 3]), pg8::cvt_pk_bf16(p1[8 * s2 + 4], p1[8 * s2 + 5]), pg8::cvt_pk_bf16(p1[8 * s2 + 6], p1[8 * s2 + 7])};
                pb[0][s2] = __builtin_bit_cast(bf16x8, a); pb[1][s2] = __builtin_bit_cast(bf16x8, c); }
#pragma unroll
            for (int kh = 0; kh < 2; ++kh)
#pragma unroll
                for (int s2 = 0; s2 < 2; ++s2) {
                    const int ko = (kh * 32 + 16 * s2) * 2;
                    const s16x4 a0 = *(const LAS s16x4*)(cur + va + ko), a1 = *(const LAS s16x4*)(cur + va + ko + 16);
                    const s16x4 c0 = *(const LAS s16x4*)(cur + va + 32 * AT_VROW + ko), c1 = *(const LAS s16x4*)(cur + va + 32 * AT_VROW + ko + 16);
                    const bf16x8 vf0 = {a0[0], a0[1], a0[2], a0[3], a1[0], a1[1], a1[2], a1[3]}, vf1 = {c0[0], c0[1], c0[2], c0[3], c1[0], c1[1], c1[2], c1[3]};
                    o0 = MFMA32(vf0, pb[kh][s2], o0); o1 = MFMA32(vf1, pb[kh][s2], o1); }
        }
        if (more) { *(LAS v4u*)(nxt + kl0) = rk0; if (tid < 256) *(LAS v4u*)(nxt + kl1) = rk1; *(LAS v2u*)(nxt + vl) = (v2u){rv.x, rv.y}; *(LAS v2u*)(nxt + vl + 8) = (v2u){rv.z, rv.w}; }
        __syncthreads();
    }
    lsum += __shfl_xor(lsum, 32);
    const float il = 1.f / lsum;
    bf16* orow = YB + tq * DM + 256 + h * 64;
#pragma unroll
    for (int g = 0; g < 4; ++g) {
        v2u a; a.x = pg8::cvt_pk_bf16(o0[4 * g] * il, o0[4 * g + 1] * il); a.y = pg8::cvt_pk_bf16(o0[4 * g + 2] * il, o0[4 * g + 3] * il); *(v2u*)(orow + 8 * g + 4 * hi) = a;
        v2u c; c.x = pg8::cvt_pk_bf16(o1[4 * g] * il, o1[4 * g + 1] * il); c.y = pg8::cvt_pk_bf16(o1[4 * g + 2] * il, o1[4 * g + 3] * il); *(v2u*)(orow + 32 + 8 * g + 4 * hi) = c; }
}

template <int l> __device__ __forceinline__ void ret_out_chunk(Frame& F, const Args& args, const int ch) {
    unsigned char* ws = args.ws;
    const bf16* P = (const bf16*)(ws + WS_PROJ); const float* RET = (const float*)(ws + WS_RET); bf16* YB = (bf16*)(ws + WS_YB); const float* ret_g = (const float*)args.in[IN_RETG] + l * 256;
    LAS unsigned char* vT = F.lds + RING_OFF;
    int lane_ = F.lane; asm volatile("" : "+v"(lane_)); const int lane = lane_, lr = lane & 15, lq = lane >> 4, w = F.wave;
    const int t0 = ch * CHUNK;
    for (int j = 0; j < 16; ++j) { const int s = 16 * w + j; const v2u vv = *(const v2u*)(P + (size_t)(t0 + s) * PROJW + C_RV + 4 * lane);
        *(LAS bf16*)(vT + tofs(4 * lane + 0, s)) = (bf16)(vv.x & 0xffff); *(LAS bf16*)(vT + tofs(4 * lane + 1, s)) = (bf16)(vv.x >> 16);
        *(LAS bf16*)(vT + tofs(4 * lane + 2, s)) = (bf16)(vv.y & 0xffff); *(LAS bf16*)(vT + tofs(4 * lane + 3, s)) = (bf16)(vv.y >> 16); }
    __syncthreads();
    const size_t ti = (size_t)t0 + 16 * w + lr;
#pragma unroll 1
    for (int h = 0; h < NHEAD; ++h) {
        const float gam = __expf(nv::ret_loggamma(h));
        bf16x8 qf[2];
#pragma unroll
        for (int ks = 0; ks < 2; ++ks) qf[ks] = *(const bf16x8*)(P + ti * PROJW + C_RQ + h * 64 + 32 * ks + 8 * lq);
        f32x4 acc[4];
#pragma unroll
        for (int et = 0; et < 4; ++et) acc[et] = (f32x4){0.f, 0.f, 0.f, 0.f};
        for (int kk = 0; kk <= (w >> 1); ++kk) {
            const int jt0 = 2 * kk, jt1 = 2 * kk + 1;
            f32x4 s0 = {0.f, 0.f, 0.f, 0.f}, s1 = {0.f, 0.f, 0.f, 0.f};
#pragma unroll
            for (int ks = 0; ks < 2; ++ks) { const bf16x8 kf = *(const bf16x8*)(P + (size_t)(t0 + jt0 * 16 + lr) * PROJW + C_RK + h * 64 + 32 * ks + 8 * lq); s0 = MFMA16(kf, qf[ks], s0); }
            if (jt1 <= w) {
#pragma unroll
                for (int ks = 0; ks < 2; ++ks) { const bf16x8 kf = *(const bf16x8*)(P + (size_t)(t0 + jt1 * 16 + lr) * PROJW + C_RK + h * 64 + 32 * ks + 8 * lq); s1 = MFMA16(kf, qf[ks], s1); } }
            if (jt0 == w) {
#pragma unroll
                for (int r = 0; r < 4; ++r) if (4 * lq + r > lr) s0[r] = 0.f; }
            if (jt1 == w) {
#pragma unroll
                for (int r = 0; r < 4; ++r) if (4 * lq + r > lr) s1[r] = 0.f; }
            const v4u pw = {pk2(s0[0], s0[1]), pk2(s0[2], s0[3]), pk2(s1[0], s1[1]), pk2(s1[2], s1[3])};
            const bf16x8 pb = __builtin_bit_cast(bf16x8, pw);
#pragma unroll
            for (int et = 0; et < 4; ++et) { const int row = h * 64 + et * 16 + lr;
                const s16x4 a0 = *(const LAS s16x4*)(vT + tofs(row, jt0 * 16 + 4 * lq)), a1 = *(const LAS s16x4*)(vT + tofs(row, (jt1 & 7) * 16 + 4 * lq));
                const bf16x8 vf = {a0[0], a0[1], a0[2], a0[3], a1[0], a1[1], a1[2], a1[3]};
                acc[et] = MFMA16(vf, pb, acc[et]); }
        }
#pragma unroll
        for (int ks = 0; ks < 2; ++ks)
#pragma unroll
            for (int et = 0; et < 4; ++et) { const float* pr = RET + (((size_t)ch * NHEAD + h) * 64 + et * 16 + lr) * 64 + 32 * ks + 8 * lq; const f32x4 x0 = *(const f32x4*)pr, x1 = *(const f32x4*)(pr + 4);
                const v4u pw = {pk2(x0[0] * gam, x0[1] * gam), pk2(x0[2] * gam, x0[3] * gam), pk2(x1[0] * gam, x1[1] * gam), pk2(x1[2] * gam, x1[3] * gam)};
                acc[et] = MFMA16(__builtin_bit_cast(bf16x8, pw), qf[ks], acc[et]); }
        float mu = 0.f;
#pragma unroll
        for (int et = 0; et < 4; ++et) mu += acc[et][0] + acc[et][1] + acc[et][2] + acc[et][3];
        mu += __shfl_xor(mu, 16); mu += __shfl_xor(mu, 32); mu *= (1.f / 64);
        float var = 0.f;
#pragma unroll
        for (int et = 0; et < 4; ++et) { acc[et] = acc[et] - mu; var += acc[et][0] * acc[et][0] + acc[et][1] * acc[et][1] + acc[et][2] * acc[et][2] + acc[et][3] * acc[et][3]; }
        var += __shfl_xor(var, 16); var += __shfl_xor(var, 32);
        const float rs = rsqrtf(var * (1.f / 64) + EPS);
#pragma unroll
        for (int et = 0; et < 4; ++et) { const int c = h * 64 + et * 16 + 4 * lq; const v2u rg = *(const v2u*)(P + ti * PROJW + C_RG + c); const f32x4 g = *(const f32x4*)(ret_g + c);
            const float r0 = bflo_(rg.x), r1 = bfhi_(rg.x), r2 = bflo_(rg.y), r3 = bfhi_(rg.y);
            v2u o; o.x = pk2(r0 * pg8::fast_sigmoid(r0) * acc[et][0] * rs * g[0], r1 * pg8::fast_sigmoid(r1) * acc[et][1] * rs * g[1]);
            o.y = pk2(r2 * pg8::fast_sigmoid(r2) * acc[et][2] * rs * g[2], r3 * pg8::fast_sigmoid(r3) * acc[et][3] * rs * g[3]);
            *(v2u*)(YB + ti * DM + 768 + c) = o; }
    }
    __syncthreads();
}

template <int l> __device__ __forceinline__ void attn_phase(Frame& F, const Args& args) {
    unsigned char* ws = args.ws;
    const bf16* Q = (const bf16*)(ws + WS_Q); const bf16* Kb = (const bf16*)(ws + WS_K); const bf16* VT = (const bf16*)(ws + WS_VT); bf16* YB = (bf16*)(ws + WS_YB);
    const float nbnd = -((const float*)(ws + WS_BND))[l];
    for (int p = F.vcu; p < NBATCH * NHEAD * 32; p += F.G) {
        const int bh = p >> 5, s = p & 31;
        attn_unit(F, Q, Kb, VT, YB, nbnd, bh / NHEAD, bh % NHEAD, 63 - s);
        attn_unit(F, Q, Kb, VT, YB, nbnd, bh / NHEAD, bh % NHEAD, s);
    }
    for (int ch = F.vcu; ch < NTOK / CHUNK; ch += F.G) ret_out_chunk<l>(F, args, ch);
}
#ifndef MEGA_THIN
#define MEGA_THIN 0
#endif

#define IN(k) (lo <= (k) && (k) < hi)
#define SEAM(k) do { if (IN(k) && IN((k) + 1)) xcd_barrier(bar); } while (0)
#define INF(i) ((const float*)args.in[i])
template <int l> __device__ __forceinline__ void layer_phases(Frame& F, const Args& args, const XcdBarrier& bar, const int lo, const int hi) {
    unsigned char* ws = args.ws;
    float* ADA = (float*)(ws + WS_ADA);
    bf16* H = (bf16*)(ws + WS_H); bf16* YB = (bf16*)(ws + WS_YB); bf16* P = (bf16*)(ws + WS_PROJ);
    bf16* G = (bf16*)(ws + WS_G); bf16* MG = H; bf16* U = P;
    float* X = args.out;
    LAS unsigned char* ring = F.lds + RING_OFF;
        const float* ada_l = ADA + (size_t)l * 2 * 6 * DM;
        const float* Xin = (l == 0) ? INF(IN_X) : X;
        const bf16* WIN_T = (const bf16*)(ws + WS_WIN_T) + (size_t)l * 6912 * DM;

        if (IN(PHL(l, PL_NORM1))) {
#if MEGA_THIN >= 1
            norm_phase(F, Xin, H, INF(IN_N1G) + l * DM, ada_l, A_SH1, A_SC1, nullptr, nullptr, nullptr, nullptr);
#endif
        }
        SEAM(PHL(l, PL_NORM1));
        if (IN(PHL(l, PL_INPROJ))) {
            pg8::DenseOrder S{(const char*)H, (const char*)WIN_T, (size_t)256 * DM * 2, (size_t)256 * DM * 2, NTOK / 256, PROJW / 256, F.G, (int)blockIdx.x};
            pg8::EpiBf16<0> E{P, PROJW};
            pg8::gemm_phase(ring, DM, DM, DM, S, E);
        }
        SEAM(PHL(l, PL_INPROJ));
        if (IN(PHL(l, PL_PRE))) {
#if MEGA_THIN >= 2
            pre_phase<l>(F, args);
#endif
        }
        SEAM(PHL(l, PL_PRE));
        if (IN(PHL(l, PL_SCAN))) {
#if MEGA_THIN >= 1
            scan_phase(F, (float*)(ws + WS_RET));
#endif
        }
        SEAM(PHL(l, PL_SCAN));
        if (IN(PHL(l, PL_ATTN))) {
#if MEGA_THIN >= 3
            attn_phase<l>(F, args);
#endif
        }
        SEAM(PHL(l, PL_ATTN));
        if (IN(PHL(l, PL_GATE))) {
            pg8::DenseOrder S{(const char*)H, (const char*)(WIN_T + (size_t)PROJW * DM), (size_t)256 * DM * 2, (size_t)256 * DM * 2, NTOK / 256, GATEW / 256, F.G, (int)blockIdx.x};
            pg8::EpiBf16<2> E{G, GATEW};
            pg8::gemm_phase(ring, DM, DM, DM, S, E);
        }
        SEAM(PHL(l, PL_GATE));
        if (IN(PHL(l, PL_MERGE))) {
            pg8::MergeOrder S{(const char*)YB, (const char*)((const bf16*)(ws + WS_WBR_T) + (size_t)l * 4 * DM * MIXW), NTOK / 256, DM / 256, F.G, (int)blockIdx.x};
            pg8::EpiMerge E{G, MG};
            pg8::gemm_phase(ring, DM, MIXW, MIXW, S, E);
        }
        SEAM(PHL(l, PL_MERGE));
        if (IN(PHL(l, PL_WO))) {
            pg8::DenseOrder S{(const char*)MG, (const char*)((const bf16*)(ws + WS_WO_T) + (size_t)l * DM * DM), (size_t)256 * DM * 2, (size_t)256 * DM * 2, NTOK / 256, DM / 256, F.G, (int)blockIdx.x};
            pg8::EpiResid E{Xin, X, ada_l + A_G1};
            pg8::gemm_phase(ring, DM, DM, DM, S, E);
        }
        SEAM(PHL(l, PL_WO));
        if (IN(PHL(l, PL_NORM2))) {
#if MEGA_THIN >= 1
            if (l == 0) norm_phase(F, X, H, INF(IN_N2G) + l * DM, ada_l, A_SH2, A_SC2, nullptr, nullptr, nullptr, nullptr);
            else norm_phase(F, X, H, INF(IN_N2G) + l * DM, ada_l, A_SH2, A_SC2, INF(IN_RW), INF(IN_RB), (nv::Route*)(ws + WS_ROUTE), (int*)(ws + WS_CNT));
#endif
        }
        SEAM(PHL(l, PL_NORM2));
        if constexpr (l == 0) {
            if (IN(PHL(l, PL_F0))) {
                pg8::DenseOrder S{(const char*)H, (const char*)(ws + WS_F13_T), (size_t)256 * DM * 2, (size_t)256 * DM * 2, NTOK / 256, 2 * DFF / 256, F.G, (int)blockIdx.x};
                pg8::EpiSwiglu E{U, DFF};
                pg8::gemm_phase(ring, DM, DM, DM, S, E);
            }
            SEAM(PHL(l, PL_F0));
            if (IN(PHL(l, PL_F1))) {
                pg8::DenseOrder S{(const char*)U, (const char*)(ws + WS_F2_T), (size_t)256 * DFF * 2, (size_t)256 * DFF * 2, NTOK / 256, DM / 256, F.G, (int)blockIdx.x};
                pg8::EpiResid E{X, X, ada_l + A_G2};
                pg8::gemm_phase(ring, DFF, DFF, DFF, S, E);
            }
            SEAM(PHL(l, PL_F1));
        } else {
            bf16* XS = (bf16*)(ws + WS_XS); bf16* HID = (bf16*)(ws + WS_HID); const int* PEXP = (const int*)(ws + WS_PEXP); const float* PSLOT = (const float*)(ws + WS_PSLOT);
            if (IN(PHL(l, PL_F0))) {
#if MEGA_THIN >= 1
                moe_assign_phase(F, args);
#endif
                convert_job(F, INF(IN_M1), (size_t)DM * DFFE, DM, DFFE, (bf16*)(ws + WS_MW13_T), (size_t)2 * DFFE * DM, DM, 2, nullptr, NEXP, 0);
                convert_job(F, INF(IN_M3), (size_t)DM * DFFE, DM, DFFE, (bf16*)(ws + WS_MW13_T), (size_t)2 * DFFE * DM, DM, 3, nullptr, NEXP, 0);
                convert_job(F, INF(IN_M2), (size_t)DFFE * DM, DFFE, DM, (bf16*)(ws + WS_MW2_T), (size_t)DM * DFFE, DFFE, 0, nullptr, NEXP, 0);
            }
            SEAM(PHL(l, PL_F0));
            for (int c = 0; c < NCH; ++c) {
                const int p0 = c * CH_PANELS; int npan = PEXP[MAXPANEL] - p0; npan = npan > CH_PANELS ? CH_PANELS : npan;
                if (IN(PHL(l, PL_F1 + 2 * c))) {
                    pg8::MoeOrder S{(const char*)(XS + (size_t)p0 * 256 * DM), (const char*)(ws + WS_MW13_T), (size_t)256 * DM * 2, (size_t)256 * DM * 2, PEXP, p0, npan, 2 * DFFE / 256, F.G, (int)blockIdx.x};
                    pg8::EpiSwiglu E{HID, DFFE};
                    pg8::gemm_phase(ring, DM, DM, DM, S, E);
                }
                SEAM(PHL(l, PL_F1 + 2 * c));
                if (IN(PHL(l, PL_F2 + 2 * c))) {
                    pg8::MoeOrder S{(const char*)HID, (const char*)(ws + WS_MW2_T), (size_t)256 * DFFE * 2, (size_t)256 * DFFE * 2, PEXP, p0, npan, DM / 256, F.G, (int)blockIdx.x};
                    pg8::EpiMoeDown E{XS + (size_t)p0 * 256 * DM, PSLOT + p0 * 256};
                    pg8::gemm_phase(ring, DFFE, DFFE, DFFE, S, E);
                }
                SEAM(PHL(l, PL_F2 + 2 * c));
            }
            if (IN(PHL(l, PL_F5))) {
#if MEGA_THIN >= 1
                moe_combine_phase(F, X, XS, (const int*)(ws + WS_SLOT), ada_l + A_G2);
#endif
            }
        }
}

__global__ void __launch_bounds__(NWAVES * 64, 2) mega(Args args) {
    extern __shared__ __attribute__((aligned(16))) unsigned char lds_raw[];
    Frame F;
    F.lds = (LAS unsigned char*)lds_raw;
    F.MISC = (volatile LAS unsigned*)(F.lds + MISC_OFF);
    F.tid = threadIdx.x; F.lane = F.tid & 63; F.wave = __builtin_amdgcn_readfirstlane(F.tid >> 6);
    F.G = gridDim.x; { const int bx = blockIdx.x; F.vcu = (F.G % 8 == 0) ? (bx % 8) * (F.G / 8) + bx / 8 : bx; }
    unsigned char* ws = args.ws;
    F.ctl = (unsigned*)(ws + WS_CTL);
    for (int u = F.tid; u < (LDS_BYTES - LDSCTL_OFF) / 4; u += NWAVES * 64) ((LAS unsigned*)(F.lds + LDSCTL_OFF))[u] = 0u;
    __syncthreads();
    XcdBarrier bar = xcd_barrier_post(F.ctl + CW_BAR + args.li * XCD_BAR_WORDS, F.MISC + 8);
    const int lo = args.ph_lo, hi = args.ph_hi;
    float* ADA = (float*)(ws + WS_ADA); float* BND = (float*)(ws + WS_BND);
    LAS unsigned char* ring = F.lds + RING_OFF;

    if (IN(PH_PRO)) {
        for (int it = F.vcu; it < DEPTH * 24; it += F.G) {
            const int l = it / 24, j0 = (it % 24) * 256; const float* c = INF(IN_C);
            const float* w = INF(IN_ADAW) + (size_t)l * DM * 6 * DM + j0 + 4 * F.lane;
            float a0[4] = {0.f, 0.f, 0.f, 0.f}, a1[4] = {0.f, 0.f, 0.f, 0.f};
#pragma unroll 8
            for (int kk = 0; kk < 128; ++kk) { const int k = F.wave * 128 + kk; const float4 wv = *(const float4*)(w + (size_t)k * 6 * DM); const float s0 = silu_f(c[k]), s1 = silu_f(c[DM + k]);
                a0[0] += s0 * wv.x; a0[1] += s0 * wv.y; a0[2] += s0 * wv.z; a0[3] += s0 * wv.w; a1[0] += s1 * wv.x; a1[1] += s1 * wv.y; a1[2] += s1 * wv.z; a1[3] += s1 * wv.w; }
            LAS float* red = (LAS float*)ring;
#pragma unroll
            for (int i = 0; i < 4; ++i) { red[(F.wave * 2 + 0) * 256 + 4 * F.lane + i] = a0[i]; red[(F.wave * 2 + 1) * 256 + 4 * F.lane + i] = a1[i]; }
            __syncthreads();
            { const int b = F.tid >> 8, col = F.tid & 255; float s = INF(IN_ADAB)[l * 6 * DM + j0 + col];
#pragma unroll
              for (int w8 = 0; w8 < 8; ++w8) s += red[(w8 * 2 + b) * 256 + col];
              ADA[(size_t)(l * 2 + b) * 6 * DM + j0 + col] = s; }
            __syncthreads();
        }
        if (blockIdx.x == 0 && F.tid < DEPTH) { const int l = F.tid; float a = 0.f, b = 0.f;
            for (int i = 0; i < QKH; ++i) { a = fmaxf(a, fabsf(INF(IN_QNG)[l * QKH + i])); b = fmaxf(b, fabsf(INF(IN_KNG)[l * QKH + i])); }
            BND[l] = 9.797958971132712f * 1.4426950408889634f * a * b * 1.001f; }
        { bf16* WST = (bf16*)(ws + WS_WS_T); const float* wsrc = INF(IN_WS);
          for (int i = (F.vcu * NWAVES * 64 + F.tid); i < DEPTH * 4 * 128 * 128; i += F.G * NWAVES * 64) { const int t = (i >> 7) & 127, s = i & 127; WST[i] = (s <= t) ? f2bf(wsrc[i]) : (bf16)0; } }
        int rot = 0;
        convert_job(F, INF(IN_WIN), (size_t)DM * D_IN, DM, D_IN, (bf16*)(ws + WS_WIN_T), (size_t)6912 * DM, DM, 1, nullptr, DEPTH, rot); rot += 331;
        convert_job(F, INF(IN_WBR), (size_t)MIXW * DM, MIXW, DM, (bf16*)(ws + WS_WBR_T), (size_t)DM * MIXW, MIXW, 0, nullptr, DEPTH * 4, rot); rot += 331;
        convert_job(F, INF(IN_WO), (size_t)DM * DM, DM, DM, (bf16*)(ws + WS_WO_T), (size_t)DM * DM, DM, 0, nullptr, DEPTH, rot); rot += 331;
        convert_job(F, INF(IN_F1), 0, DM, DFF, (bf16*)(ws + WS_F13_T), 0, DM, 2, nullptr, 1, rot); rot += 331;
        convert_job(F, INF(IN_F3), 0, DM, DFF, (bf16*)(ws + WS_F13_T), 0, DM, 3, nullptr, 1, rot); rot += 331;
        convert_job(F, INF(IN_F2), 0, DFF, DM, (bf16*)(ws + WS_F2_T), 0, DFF, 0, nullptr, 1, rot); rot += 331;
        for (int l = 0; l < DEPTH; ++l) {
            convert_job(F, INF(IN_WUQ) + (size_t)l * 256 * QW, 0, 256, QW, (bf16*)(ws + WS_WUQ_T) + (size_t)l * QW * 256, 0, 256, 0, INF(IN_CQG) + l * 256, 1, rot); rot += 331;
            convert_job(F, INF(IN_WUKV) + (size_t)l * 128 * 512, 0, 128, 512, (bf16*)(ws + WS_WUKV_T) + (size_t)l * 512 * 128, 0, 128, 0, INF(IN_CKVG) + l * 128, 1, rot); rot += 331;
        }
    }
    SEAM(PH_PRO);

    layer_phases<0>(F, args, bar, lo, hi);
    layer_phases<1>(F, args, bar, lo, hi);
}
#undef IN
#undef SEAM
#undef INF
static int g_grid = 0;
static bool mega_setup() {
    if (g_grid) return g_grid > 0;
    int dev = 0, cus = 0;
    if (hipGetDevice(&dev) != hipSuccess || hipDeviceGetAttribute(&cus, hipDeviceAttributeMultiprocessorCount, dev) != hipSuccess) { g_grid = -1; return false; }
    if (hipFuncSetAttribute((const void*)mega, hipFuncAttributeMaxDynamicSharedMemorySize, LDS_BYTES) != hipSuccess) { fprintf(stderr, "mega: hipFuncSetAttribute failed\n"); g_grid = -1; return false; }
    int per_cu = 0; (void)hipOccupancyMaxActiveBlocksPerMultiprocessor(&per_cu, (const void*)mega, NWAVES * 64, LDS_BYTES); (void)hipGetLastError();
    if (per_cu < 1) { fprintf(stderr, "mega: occupancy query reports %d workgroups per CU\n", per_cu); g_grid = -1; return false; }
    g_grid = cus; return true;
}
extern "C" void kernel_launch(void* const* d_in, const int* in_sizes, int n_in, void* d_out, int out_size, void* d_ws, size_t ws_size, hipStream_t stream) {
    if (n_in != 29 || out_size != NTOK * DM || ws_size < WS_END) { fprintf(stderr, "kernel_launch: unexpected sizes n_in %d out %d ws %zu\n", n_in, out_size, ws_size); return; }
    if (!mega_setup()) return;
    (void)hipMemsetAsync((char*)d_ws + WS_CTL, 0, CTL_ZERO_BYTES, stream);
    Args a{}; for (int i = 0; i < N_IN; ++i) a.in[i] = d_in[i];
    a.out = (float*)d_out; a.ws = (unsigned char*)d_ws; a.ph_lo = 0; a.ph_hi = N_PHASES; a.li = 0; a.pad = 0;
    hipLaunchKernelGGL(mega, dim3(g_grid), dim3(NWAVES * 64), LDS_BYTES, stream, a);
}
```

```cpp
#define MEGA_THIN 3
#include <hip/hip_runtime.h>
#include <cstdio>
#include <cstdint>
#include <cmath>

constexpr int DM = 1024, NBATCH = 2, SEQ = 16384, NTOK = NBATCH * SEQ, DEPTH = 2;
constexpr int MIXW = 256, D_IN = 6816, PROJW = 2816, GATEW = 4096, NPROJ_SRC = 2720;
constexpr int QKH = 96, NHEAD = 4, QW = NHEAD * QKH  , DFF = 2816, NEXP = 8, DFFE = 3584;
constexpr int CHUNK = 128, NCHUNK = SEQ / CHUNK  ;
constexpr float EPS = 1e-6f;
constexpr int C_AB = 0, C_AC = 256, C_AX = 512, C_CQ = 768, C_CKV = 1024, C_KR = 1152, C_SU = 1280, C_SV = 1536, C_RQ = 1792, C_RK = 2048, C_RV = 2304, C_RG = 2560;
constexpr int A_SH1 = 0, A_SC1 = 1024, A_G1 = 2048, A_SH2 = 3072, A_SC2 = 4096, A_G2 = 5120;
constexpr float ATT_C2 = 0.10206207261596575f * 1.4426950408889634f;

constexpr size_t MiB = 1u << 20;
constexpr size_t WS_CTL = 0, CTL_ZERO_BYTES = 1 * MiB;
constexpr size_t WS_ADA = 1 * MiB;
constexpr size_t WS_PSLOT = 1 * MiB + 256 * 1024;
constexpr size_t WS_PEXP = 1 * MiB + 768 * 1024;
constexpr size_t WS_BND = 1 * MiB + 800 * 1024;
constexpr size_t WS_ROUTE = 2 * MiB;
constexpr size_t WS_CNT = 2 * MiB + 512 * 1024;
constexpr size_t WS_SLOT = 2 * MiB + 768 * 1024;
constexpr size_t WS_WUQ_T = 3 * MiB;
constexpr size_t WS_WUKV_T = 3 * MiB + 512 * 1024;
constexpr size_t WS_WS_T = 3 * MiB + 768 * 1024;
constexpr size_t WS_WIN_T = 4 * MiB;
constexpr size_t WS_WBR_T = 31 * MiB;
constexpr size_t WS_WO_T = 35 * MiB;
constexpr size_t WS_F13_T = 39 * MiB;
constexpr size_t WS_F2_T = 50 * MiB;
constexpr size_t WS_H = 56 * MiB;
constexpr size_t WS_YB = 120 * MiB;
constexpr size_t WS_PROJ = 184 * MiB;
constexpr size_t WS_Q = 360 * MiB, WS_K = 384 * MiB, WS_VT = 408 * MiB;
constexpr size_t WS_RET = 424 * MiB;
constexpr size_t WS_G = 184 * MiB;
constexpr size_t WS_MIX_END = 440 * MiB;
constexpr int MAXPANEL = 264, MAXSLOT = MAXPANEL * 256, NCH = 2, CH0_PANELS = 128, CH1_PANELS = MAXPANEL - CH0_PANELS;
constexpr size_t WS_HID = 56 * MiB;
constexpr size_t WS_MW13_T = 296 * MiB;
constexpr size_t WS_MW2_T = 408 * MiB;
constexpr size_t WS_XS = 464 * MiB;
constexpr size_t WS_END = 596 * MiB;
static_assert(WS_HID + (size_t)CH1_PANELS * 256 * DFFE * 2 <= WS_MW13_T, "hid");
static_assert(WS_XS + (size_t)MAXSLOT * DM * 2 <= WS_END, "xs");
static_assert(WS_MW13_T >= WS_MIX_END - 256 * MiB, "moe weights may overlay dead mixer buffers only");

typedef unsigned short bf16;
__device__ __forceinline__ float bf2f(bf16 v) { return __uint_as_float(((unsigned)v) << 16); }
__device__ __forceinline__ bf16 f2bf(float f) { unsigned u = __float_as_uint(f); return (bf16)((u + 0x7fffu + ((u >> 16) & 1u)) >> 16); }
__device__ __forceinline__ float bfr(float f) { return bf2f(f2bf(f)); }
__device__ __forceinline__ float silu_f(float x) { return x / (1.f + __expf(-x)); }
__device__ __forceinline__ float sigmoid_f(float x) { return 1.f / (1.f + __expf(-x)); }
__device__ __forceinline__ float gelu_tanh(float x) { const float u = 0.7978845608028654f * (x + 0.044715f * x * x * x); return 0.5f * x * (1.f + tanhf(u)); }

__device__ __forceinline__ int lane_id() { unsigned z = 0u; asm volatile("" : "+s"(z)); return (int)__builtin_amdgcn_mbcnt_hi(~0u, __builtin_amdgcn_mbcnt_lo(~0u, z)); }

namespace nv {
struct Route { int e0, e1; float p0, p1; };
__device__ __forceinline__ float ret_loggamma(int h) { return log1pf(-exp2f(-5.f - (float)h)); }
}
namespace pg8 {
#define PG8_LAS __attribute__((address_space(3)))
typedef short bf16x8 __attribute__((ext_vector_type(8)));
typedef float f32x4 __attribute__((ext_vector_type(4)));
typedef float f32x2 __attribute__((ext_vector_type(2)));
typedef unsigned u32x4 __attribute__((ext_vector_type(4)));
constexpr int BM = 256, BK = 64, HALF = 128, HTB = HALF * BK * 2  , STAGE_BYTES = 8 * HTB, NXCD = 8, WGM = 8;

__host__ __device__ __forceinline__ int lds_byte(int r, int c) { const int st = (r >> 4) * 2 + (c >> 5), rr = r & 15, cc = c & 31, ob = rr * 64 + cc * 2; return st * 1024 + (ob ^ (((ob >> 9) & 1) << 5)); }
__host__ __device__ __forceinline__ void stage_rc(int b, int& R, int& C) { const int st = b / 1024, sb = b % 1024, swz = sb ^ (((sb >> 9) & 1) << 5); R = (st >> 1) * 16 + swz / 64; C = (st & 1) * 32 + (swz % 64) / 2; }
__host__ __device__ __forceinline__ int perm32(int rho) { const int n = rho >> 4, i = rho & 15; return 8 * (i >> 2) + 4 * n + (i & 3); }

struct Unit { const char* A; const char* B; int pm, pn, aux, pad; };

__device__ __forceinline__ bool static_tile(int i, int G, int c, int nM, int nN, int& pm, int& pn) {
    const int nwg = nM * nN; const long L = (long)i * G + c; if (L >= nwg) return false;
    int wgid = (int)L; { const int q = nwg / NXCD, r = nwg % NXCD, xcd = wgid % NXCD, off = wgid / NXCD; wgid = (xcd < r ? xcd * (q + 1) : r * (q + 1) + (xcd - r) * q) + off; }
    const int nig = WGM * nN, gid = wgid / nig, fm = gid * WGM, gsz = (nM - fm) < WGM ? (nM - fm) : WGM;
    pm = fm + ((wgid % nig) % gsz); pn = (wgid % nig) / gsz; return true;
}
struct DenseOrder {
    const char* A; const char* B; size_t tA, tB; int nM, nN, G, c;
    __device__ __forceinline__ bool next(int i, Unit& u) const { int pm, pn; if (!static_tile(i, G, c, nM, nN, pm, pn)) return false; u.pm = pm; u.pn = pn; u.aux = 0; u.A = A + (size_t)pm * tA; u.B = B + (size_t)pn * tB; return true; }
};
struct ZOrder {
    const char* A; const char* B; int nM, G, c;
    __device__ __forceinline__ bool next(int i, Unit& u) const { int pm, pn; if (!static_tile(i, G, c, nM, 16, pm, pn)) return false; const int n = pn >> 2; u.pm = pm; u.pn = pn; u.aux = n;
        u.A = A + (size_t)pm * (256 * 1024 * 2) + n * 512; u.B = B + (size_t)n * (1024 * 256 * 2) + (size_t)(pn & 3) * (256 * 256 * 2); return true; }
};
struct MergeOrder {
    const char* A; const char* B; int nM, nN, G, c;
    __device__ __forceinline__ bool next(int i, Unit& u) const { int pm, pn; if (!static_tile(i >> 2, G, c, nM, nN, pm, pn)) return false; const int n = i & 3; u.pm = pm; u.pn = pn; u.aux = n;
        u.A = A + (size_t)pm * (256 * 1024 * 2) + n * 512; u.B = B + (size_t)n * (1024 * 256 * 2) + (size_t)pn * (256 * 256 * 2); return true; }
};
struct MoeOrder {
    const char* A; const char* B; size_t tA, tB; const int* pexp; int p0, nM, nN, G, c;
    __device__ __forceinline__ bool next(int i, Unit& u) const { int pm, pn; if (nM <= 0 || !static_tile(i, G, c, nM, nN, pm, pn)) return false; const int e = pexp[p0 + pm]; u.pm = pm; u.pn = pn; u.aux = e;
        u.A = A + (size_t)pm * tA; u.B = B + ((size_t)e * nN + pn) * tB; return true; }
};

typedef __bf16 bf16x2_t __attribute__((ext_vector_type(2)));
__device__ __forceinline__ unsigned cvt_pk_bf16(float lo, float hi) { const f32x2 v = {lo, hi}; return __builtin_bit_cast(unsigned, __builtin_convertvector(v, bf16x2_t)); }
__device__ __forceinline__ float fast_sigmoid(float x) { return __builtin_amdgcn_rcpf(1.f + __builtin_amdgcn_exp2f(-1.4426950408889634f * x)); }
__device__ __forceinline__ float bflo(unsigned w) { return __uint_as_float(w << 16); }
__device__ __forceinline__ float bfhi(unsigned w) { return __uint_as_float(w & 0xffff0000u); }

template <int ACT  > struct EpiBf16 {
    static constexpr bool PERM = true;
    bf16* O; int ldc, aux_cols;
    __device__ __forceinline__ void operator()(const f32x4 (&acc)[2][2][4][2], const Unit& u, int wr, int wc, int fr, int fq) const {
        const int row0 = u.pm * BM + wr * 64 + fr, col0 = u.aux * aux_cols + u.pn * BM + wc * 32 + 8 * fq;
#pragma unroll
        for (int ai = 0; ai < 2; ++ai)
#pragma unroll
            for (int m = 0; m < 4; ++m) { bf16* rowp = O + (size_t)(row0 + ai * HALF + m * 16) * ldc + col0;
#pragma unroll
                for (int bj = 0; bj < 2; ++bj) { f32x4 v0 = acc[ai][bj][m][0], v1 = acc[ai][bj][m][1];
                    if (ACT == 2) {
#pragma unroll
                        for (int i = 0; i < 4; ++i) { v0[i] = fast_sigmoid(v0[i]); v1[i] = fast_sigmoid(v1[i]); } }
                    u32x4 w; w.x = cvt_pk_bf16(v0[0], v0[1]); w.y = cvt_pk_bf16(v0[2], v0[3]); w.z = cvt_pk_bf16(v1[0], v1[1]); w.w = cvt_pk_bf16(v1[2], v1[3]);
                    *(u32x4*)(rowp + bj * HALF) = w; } }
    }
};
struct EpiSwiglu {
    static constexpr bool PERM = true;
    bf16* O; int ldc;
    __device__ __forceinline__ void operator()(const f32x4 (&acc)[2][2][4][2], const Unit& u, int wr, int wc, int fr, int fq) const {
        const int row0 = u.pm * BM + wr * 64 + fr, col0 = u.pn * HALF + wc * 32 + 8 * fq;
#pragma unroll
        for (int ai = 0; ai < 2; ++ai)
#pragma unroll
            for (int m = 0; m < 4; ++m) { bf16* rowp = O + (size_t)(row0 + ai * HALF + m * 16) * ldc + col0; float r[8];
#pragma unroll
                for (int n = 0; n < 2; ++n)
#pragma unroll
                    for (int i = 0; i < 4; ++i) { const float a = acc[ai][0][m][n][i], b = acc[ai][1][m][n][i]; r[n * 4 + i] = a * fast_sigmoid(a) * b; }
                u32x4 w; w.x = cvt_pk_bf16(r[0], r[1]); w.y = cvt_pk_bf16(r[2], r[3]); w.z = cvt_pk_bf16(r[4], r[5]); w.w = cvt_pk_bf16(r[6], r[7]);
                *(u32x4*)rowp = w; }
    }
};
struct EpiResid {
    static constexpr bool PERM = false;
    const float* Xin; float* Xout; const float* gate;
    __device__ __forceinline__ void operator()(const f32x4 (&acc)[2][2][4][2], const Unit& u, int wr, int wc, int fr, int fq) const {
        const int row0 = u.pm * BM + wr * 64 + fr, col0 = u.pn * BM + wc * 32 + 4 * fq; const float* gp = gate + (size_t)(u.pm >> 6) * (6 * DM) + col0;
        f32x4 gv[2][2];
#pragma unroll
        for (int bj = 0; bj < 2; ++bj)
#pragma unroll
            for (int n = 0; n < 2; ++n) gv[bj][n] = *(const f32x4*)(gp + bj * HALF + n * 16);
#pragma unroll
        for (int ai = 0; ai < 2; ++ai)
#pragma unroll
        for (int mp = 0; mp < 4; mp += 2) {
            f32x4 xi[2][2][2];
#pragma unroll
            for (int m = 0; m < 2; ++m) { const size_t off = (size_t)(row0 + ai * HALF + (mp + m) * 16) * DM + col0;
#pragma unroll
                for (int bj = 0; bj < 2; ++bj)
#pragma unroll
                    for (int n = 0; n < 2; ++n) xi[m][bj][n] = *(const f32x4*)(Xin + off + bj * HALF + n * 16); }
            asm volatile("" ::: "memory");
#pragma unroll
            for (int m = 0; m < 2; ++m) { const size_t off = (size_t)(row0 + ai * HALF + (mp + m) * 16) * DM + col0;
#pragma unroll
                for (int bj = 0; bj < 2; ++bj)
#pragma unroll
                    for (int n = 0; n < 2; ++n) *(f32x4*)(Xout + off + bj * HALF + n * 16) = xi[m][bj][n] + gv[bj][n] * acc[ai][bj][mp + m][n]; }
            asm volatile("" ::: "memory");
        }
    }
};
struct EpiMerge {
    static constexpr bool PERM = true;
    const bf16* G; bf16* Mg;
    __device__ __forceinline__ void operator()(const f32x4 (&acc)[2][2][4][2], const Unit& u, int wr, int wc, int fr, int fq) const {
        const int row0 = u.pm * BM + wr * 64 + fr, col0 = u.pn * BM + wc * 32 + 8 * fq, n_br = u.aux;
#pragma unroll
        for (int ai = 0; ai < 2; ++ai)
#pragma unroll
        for (int mp = 0; mp < 4; mp += 2) {
            u32x4 g[2][2], o[2][2];
#pragma unroll
            for (int m = 0; m < 2; ++m) { const size_t row = (size_t)(row0 + ai * HALF + (mp + m) * 16);
#pragma unroll
                for (int bj = 0; bj < 2; ++bj) { g[m][bj] = *(const u32x4*)(G + row * GATEW + n_br * DM + col0 + bj * HALF);
                    o[m][bj] = (n_br != 0) ? *(const u32x4*)(Mg + row * DM + col0 + bj * HALF) : (u32x4){0u, 0u, 0u, 0u}; } }
            asm volatile("" ::: "memory");
#pragma unroll
            for (int m = 0; m < 2; ++m) { const size_t row = (size_t)(row0 + ai * HALF + (mp + m) * 16);
#pragma unroll
                for (int bj = 0; bj < 2; ++bj) { const u32x4 gg = g[m][bj], oo = o[m][bj]; const f32x4 a0 = acc[ai][bj][mp + m][0], a1 = acc[ai][bj][mp + m][1]; float r[8];
                    r[0] = bflo(gg.x) * a0[0] + bflo(oo.x); r[1] = bfhi(gg.x) * a0[1] + bfhi(oo.x); r[2] = bflo(gg.y) * a0[2] + bflo(oo.y); r[3] = bfhi(gg.y) * a0[3] + bfhi(oo.y);
                    r[4] = bflo(gg.z) * a1[0] + bflo(oo.z); r[5] = bfhi(gg.z) * a1[1] + bfhi(oo.z); r[6] = bflo(gg.w) * a1[2] + bflo(oo.w); r[7] = bfhi(gg.w) * a1[3] + bfhi(oo.w);
                    u32x4 w; w.x = cvt_pk_bf16(r[0], r[1]); w.y = cvt_pk_bf16(r[2], r[3]); w.z = cvt_pk_bf16(r[4], r[5]); w.w = cvt_pk_bf16(r[6], r[7]);
                    *(u32x4*)(Mg + row * DM + col0 + bj * HALF) = w; } }
            asm volatile("" ::: "memory");
        }
    }
};
struct EpiGM {
    static constexpr bool PERM = false;
    const bf16* Z; bf16* Mg;
    __device__ __forceinline__ void operator()(const f32x4 (&acc)[2][2][4][2], const Unit& u, int wr, int wc, int fr, int fq) const {
        const int row0 = u.pm * BM + wr * 64 + fr, col0 = u.pn * 64 + wc * 16 + 4 * fq;
        const bf16* zb = Z + (size_t)row0 * GATEW + col0; bf16* mb = Mg + (size_t)row0 * DM + col0;
#pragma unroll
        for (int ai = 0; ai < 2; ++ai) {
            f32x2 zz[4][4];
#pragma unroll
            for (int m = 0; m < 4; ++m)
#pragma unroll
                for (int br = 0; br < 4; ++br) zz[m][br] = *(const f32x2*)(zb + (size_t)(ai * HALF + m * 16) * GATEW + br * DM);
            asm volatile("" ::: "memory");
#pragma unroll
            for (int m = 0; m < 4; ++m) { f32x4 r = {0.f, 0.f, 0.f, 0.f};
#pragma unroll
                for (int br = 0; br < 4; ++br) { const f32x4 a = acc[ai][br >> 1][m][br & 1]; const unsigned z0 = __float_as_uint(zz[m][br][0]), z1 = __float_as_uint(zz[m][br][1]);
                    r[0] += fast_sigmoid(a[0]) * bflo(z0); r[1] += fast_sigmoid(a[1]) * bfhi(z0); r[2] += fast_sigmoid(a[2]) * bflo(z1); r[3] += fast_sigmoid(a[3]) * bfhi(z1); }
                f32x2 w; w[0] = __uint_as_float(cvt_pk_bf16(r[0], r[1])); w[1] = __uint_as_float(cvt_pk_bf16(r[2], r[3]));
                *(f32x2*)(mb + (size_t)(ai * HALF + m * 16) * DM) = w;
                __builtin_amdgcn_sched_barrier(0); }
            asm volatile("" ::: "memory");
        }
    }
};
struct EpiMoeDown {
    static constexpr bool PERM = true;
    bf16* Y; const float* ps;
    __device__ __forceinline__ void operator()(const f32x4 (&acc)[2][2][4][2], const Unit& u, int wr, int wc, int fr, int fq) const {
        const int row0 = u.pm * BM + wr * 64 + fr, col0 = u.pn * BM + wc * 32 + 8 * fq;
#pragma unroll
        for (int ai = 0; ai < 2; ++ai)
#pragma unroll
            for (int m = 0; m < 4; ++m) { const int row = row0 + ai * HALF + m * 16; const float s = ps[row]; bf16* rowp = Y + (size_t)row * DM + col0;
#pragma unroll
                for (int bj = 0; bj < 2; ++bj) { const f32x4 v0 = acc[ai][bj][m][0] * s, v1 = acc[ai][bj][m][1] * s;
                    u32x4 w; w.x = cvt_pk_bf16(v0[0], v0[1]); w.y = cvt_pk_bf16(v0[2], v0[3]); w.z = cvt_pk_bf16(v1[0], v1[1]); w.w = cvt_pk_bf16(v1[2], v1[3]);
                    *(u32x4*)(rowp + bj * HALF) = w; } }
    }
};

template <class Epi, class Sched>
__device__ __forceinline__ void gemm_phase(PG8_LAS unsigned char* lds, const int wave_, const int lda, const int ldb, const int K, const Sched& S, const Epi& E) {
    int tid_ = wave_ * 64 + lane_id(); asm volatile("" : "+v"(tid_));
    const int tid = tid_, wid = __builtin_amdgcn_readfirstlane(tid >> 6), lane = tid & 63, wr = wid >> 2, wc = wid & 3, fr = lane & 15, fq = lane >> 4;
    const int nt = K / BK;
    unsigned voffA[2], voffB[2];
#pragma unroll
    for (int i = 0; i < 2; ++i) { int R, C; stage_rc(tid * 16 + i * 8192, R, C); const int Rb = Epi::PERM ? ((R & ~31) + perm32(R & 31)) : R;
        voffA[i] = (unsigned)(R * lda + C) * 2u; voffB[i] = (unsigned)(Rb * ldb + C) * 2u; }
    const size_t kstep = (size_t)(BK * 2);
    const size_t hstepA = (size_t)HALF * lda * 2, hstepB = (size_t)HALF * ldb * 2;
    const unsigned ldsw = (unsigned)wid * 1024u;
    const int aoff = lds_byte(wr * 64 + fr, fq * 8), boff = lds_byte(wc * 32 + fr, fq * 8);
#define PG8_SA(b, h) (((b) * 2 + (h)) * HTB)
#define PG8_SB(b, h) ((4 + (b) * 2 + (h)) * HTB)
#define PG8_STAGE(bufoff, gbase, voff) do { _Pragma("unroll") for (int _i = 0; _i < 2; ++_i) \
        __builtin_amdgcn_global_load_lds((const unsigned*)((const char*)(gbase) + (voff)[_i]), (PG8_LAS unsigned*)(lds + (bufoff) + ldsw + _i * 8192), 16, 0, 0); } while (0)
#define PG8_LDA(dst, b, h) do { _Pragma("unroll") for (int m = 0; m < 4; ++m) _Pragma("unroll") for (int k = 0; k < 2; ++k) dst[m][k] = *(const PG8_LAS bf16x8*)(lds + PG8_SA(b, h) + aoff + m * 2048 + k * 1024); } while (0)
#define PG8_LDB(dst, b, h) do { _Pragma("unroll") for (int n = 0; n < 2; ++n) _Pragma("unroll") for (int k = 0; k < 2; ++k) dst[n][k] = *(const PG8_LAS bf16x8*)(lds + PG8_SB(b, h) + boff + n * 2048 + k * 1024); } while (0)
#define PG8_MMA(ai, bj, At, Bt) do { __builtin_amdgcn_s_setprio(1); _Pragma("unroll") for (int m = 0; m < 4; ++m) _Pragma("unroll") for (int n = 0; n < 2; ++n) _Pragma("unroll") for (int k = 0; k < 2; ++k) \
        acc[ai][bj][m][n] = __builtin_amdgcn_mfma_f32_16x16x32_bf16(Bt[n][k], At[m][k], acc[ai][bj][m][n], 0, 0, 0); __builtin_amdgcn_s_setprio(0); } while (0)
#define PG8_WAIT_V(n) asm volatile("s_waitcnt vmcnt(" #n ")" ::: "memory")
#define PG8_WAIT_L(n) asm volatile("s_waitcnt lgkmcnt(" #n ")" ::: "memory")
#define PG8_BAR __builtin_amdgcn_s_barrier()
#define PG8_SCHED __builtin_amdgcn_sched_barrier(0)
    Unit cur, nxt; int ui = 0;
    if (!S.next(0, cur)) return;
    f32x4 acc[2][2][4][2];
#pragma unroll
    for (int a = 0; a < 2; ++a)
#pragma unroll
        for (int b = 0; b < 2; ++b)
#pragma unroll
            for (int m = 0; m < 4; ++m)
#pragma unroll
                for (int n = 0; n < 2; ++n) acc[a][b][m][n] = (f32x4){0.f, 0.f, 0.f, 0.f};
    bf16x8 At[4][2], B0[2][2], B1[2][2];
    const char* cA = cur.A; const char* cB = cur.B;
    PG8_STAGE(PG8_SB(0, 0), cB, voffB); PG8_STAGE(PG8_SB(0, 1), cB + hstepB, voffB); PG8_STAGE(PG8_SA(0, 0), cA, voffA); PG8_STAGE(PG8_SA(0, 1), cA + hstepA, voffA);
    if (wr == 1) PG8_BAR;
    PG8_WAIT_V(2); PG8_BAR;
    PG8_STAGE(PG8_SB(1, 0), cB + kstep, voffB); PG8_STAGE(PG8_SA(1, 0), cA + kstep, voffA); PG8_STAGE(PG8_SB(1, 1), cB + hstepB + kstep, voffB);
    PG8_WAIT_V(6); PG8_BAR;
    for (;;) {
        const bool has_next = S.next(ui + 1, nxt);
        const char* nA = has_next ? nxt.A : cA; const char* nB = has_next ? nxt.B : cB;
        for (int t = 0; t < nt; t += 2) {
            const bool last = (t == nt - 2);
            const char* a1 = cA + (size_t)(t + 1) * kstep;
            const char* a2 = last ? nA : cA + (size_t)(t + 2) * kstep; const char* b2 = last ? nB : cB + (size_t)(t + 2) * kstep;
            const char* a3 = a2 + kstep; const char* b3 = b2 + kstep;
            PG8_LDB(B0, 0, 0); PG8_LDB(B1, 0, 1); PG8_SCHED; PG8_LDA(At, 0, 0); PG8_STAGE(PG8_SA(1, 1), a1 + hstepA, voffA);
            PG8_WAIT_V(8); PG8_WAIT_L(0); PG8_BAR; PG8_MMA(0, 0, At, B0); PG8_MMA(0, 1, At, B1); PG8_BAR; PG8_SCHED;
            PG8_LDA(At, 0, 1); PG8_STAGE(PG8_SB(0, 0), b2, voffB); PG8_STAGE(PG8_SB(0, 1), b2 + hstepB, voffB); PG8_STAGE(PG8_SA(0, 0), a2, voffA);
            PG8_WAIT_V(8); PG8_WAIT_L(0); PG8_BAR; PG8_MMA(1, 0, At, B0); PG8_MMA(1, 1, At, B1); PG8_BAR; PG8_SCHED;
            PG8_LDB(B0, 1, 0); PG8_LDB(B1, 1, 1); PG8_SCHED; PG8_LDA(At, 1, 0); PG8_STAGE(PG8_SA(0, 1), a2 + hstepA, voffA);
            PG8_WAIT_V(8); PG8_WAIT_L(0); PG8_BAR; PG8_MMA(0, 0, At, B0); PG8_MMA(0, 1, At, B1); PG8_BAR; PG8_SCHED;
            PG8_LDA(At, 1, 1); PG8_STAGE(PG8_SB(1, 0), b3, voffB); PG8_STAGE(PG8_SB(1, 1), b3 + hstepB, voffB); PG8_STAGE(PG8_SA(1, 0), a3, voffA);
            PG8_WAIT_V(8); PG8_WAIT_L(0); PG8_BAR; PG8_MMA(1, 0, At, B0); PG8_MMA(1, 1, At, B1); PG8_BAR; PG8_SCHED;
        }
        if (wr == 0) PG8_BAR;
        E(acc, cur, wr, wc, fr, fq);
        if (!has_next) break;
#pragma unroll
        for (int a = 0; a < 2; ++a)
#pragma unroll
            for (int b = 0; b < 2; ++b)
#pragma unroll
                for (int m = 0; m < 4; ++m)
#pragma unroll
                    for (int n = 0; n < 2; ++n) acc[a][b][m][n] = (f32x4){0.f, 0.f, 0.f, 0.f};
        cur = nxt; cA = nA; cB = nB; ++ui;
        if (wr == 1) PG8_BAR;
    }
    PG8_WAIT_V(0);
    PG8_BAR;
#undef PG8_SA
#undef PG8_SB
#undef PG8_STAGE
#undef PG8_LDA
#undef PG8_LDB
#undef PG8_MMA
#undef PG8_WAIT_V
#undef PG8_WAIT_L
#undef PG8_BAR
#undef PG8_SCHED
}
}
constexpr int NWAVES = 8;
constexpr int RING_OFF = 0, RING_BYTES = 131072;
constexpr int LDSCTL_OFF = RING_BYTES, MISC_OFF = LDSCTL_OFF + 320;
constexpr int LDS_BYTES = 147456;
constexpr int CW_TMO = 0, CW_CODE = 1, CW_BAR = 4096;

#define GAS __attribute__((address_space(1)))
#define LAS __attribute__((address_space(3)))
typedef unsigned v4u __attribute__((ext_vector_type(4)));
typedef unsigned v2u __attribute__((ext_vector_type(2)));
typedef GAS unsigned gu32;
#define RLX_AGENT __ATOMIC_RELAXED, __HIP_MEMORY_SCOPE_AGENT
#define LDS_WAIT() asm volatile("s_waitcnt lgkmcnt(0)" ::: "memory")
#define VM_WAIT() asm volatile("s_waitcnt vmcnt(0)" ::: "memory")
__device__ __forceinline__ unsigned pk2(float lo, float hi) { return (unsigned)f2bf(lo) | ((unsigned)f2bf(hi) << 16); }


#define XB_TMO      128
#define XB_XCNT(j)  (256  + 64 * (j))
#define XB_XSUB(j)  (1280 + 64 * (j))
#define XB_XGEN(j)  (2304 + 64 * (j))
#define XB_TOP      3328
#define XB_TOPGEN   3392
#define XCD_BAR_WORDS 3456
#define XB_SPIN_CAP (1u << 18)
__device__ __forceinline__ unsigned xb_ld(unsigned* p)              { return __hip_atomic_load(p, __ATOMIC_RELAXED, __HIP_MEMORY_SCOPE_AGENT); }
__device__ __forceinline__ unsigned xb_add(unsigned* p, unsigned v) { return __hip_atomic_fetch_add(p, v, __ATOMIC_RELAXED, __HIP_MEMORY_SCOPE_AGENT); }
__device__ __forceinline__ unsigned xb_xcc_id() { return (unsigned)__builtin_amdgcn_s_getreg((3 << 11) | 20) & 0xFu; }
#define XB_SPIN(cond, bar) do { unsigned _sp = 0; while (cond) { __builtin_amdgcn_s_sleep(1); \
    if ((++_sp & 255u) == 0u) { if (xb_ld(&(bar)[XB_TMO])) break; if (_sp > XB_SPIN_CAP) { atomicAdd(&(bar)[XB_TMO], 1u); break; } } } } while (0)
struct XcdBarrier { unsigned* bar; unsigned x; volatile LAS unsigned* st; };
__device__ __forceinline__ XcdBarrier xcd_barrier_post(unsigned* bar, volatile LAS unsigned* st) {
    XcdBarrier b; b.bar = bar; b.x = xb_xcc_id(); b.st = st;
    if (threadIdx.x == 0) (void)xb_add(&bar[XB_XCNT(b.x)], 1u);
    return b;
}
__device__ __forceinline__ void xcd_barrier_complete(unsigned* bar, unsigned x, unsigned& nloc, unsigned& nx) {
    const unsigned G = gridDim.x * gridDim.y * gridDim.z;
    unsigned sum, cnt, mine, sp = 0u;
    for (;;) {
        sum = 0u; cnt = 0u; mine = 0u;
#pragma unroll
        for (unsigned j = 0; j < 16; ++j) { const unsigned c = xb_ld(&bar[XB_XCNT(j)]); sum += c; cnt += (c > 0u) ? 1u : 0u; mine = (j == x) ? c : mine; }
        if (sum == G) break;
        __builtin_amdgcn_s_sleep(1);
        if ((++sp & 255u) == 0u) { if (xb_ld(&bar[XB_TMO])) break; if (sp > XB_SPIN_CAP) { atomicAdd(&bar[XB_TMO], 1u); break; } }
    }
    nloc = mine > 0u ? mine : 1u; nx = cnt > 0u ? cnt : 1u;
}
__device__ __forceinline__ void xcd_barrier(const XcdBarrier& b, const int wave) {
    asm volatile("s_waitcnt vmcnt(0)" ::: "memory");
    __syncthreads();
    if (wave == 0 && lane_id() == 0) {
        unsigned* bar = b.bar;
        __builtin_amdgcn_s_waitcnt(0);
        unsigned nloc = b.st[0], nx = b.st[1];
        if (nloc == 0u) { xcd_barrier_complete(bar, b.x, nloc, nx); b.st[0] = nloc; b.st[1] = nx; }
        const unsigned old = xb_add(&bar[XB_XSUB(b.x)], 1u);
        const unsigned gen = old / nloc;
        if (old + 1u == (gen + 1u) * nloc) {
            __builtin_amdgcn_fence(__ATOMIC_RELEASE, "agent");
            asm volatile("s_waitcnt vmcnt(0)" ::: "memory");
            const unsigned og = xb_add(&bar[XB_TOP], 1u);
            const unsigned tg = og / nx;
            if (og + 1u == (tg + 1u) * nx) xb_add(&bar[XB_TOPGEN], 1u);
            else XB_SPIN(xb_ld(&bar[XB_TOPGEN]) == tg, bar);
            __builtin_amdgcn_fence(__ATOMIC_ACQUIRE, "agent");
            xb_add(&bar[XB_XGEN(b.x)], 1u);
            asm volatile("s_waitcnt vmcnt(0)" ::: "memory");
        } else {
            XB_SPIN(xb_ld(&bar[XB_XGEN(b.x)]) == gen, bar);
            __builtin_amdgcn_fence(__ATOMIC_ACQUIRE, "agent");
            asm volatile("s_waitcnt vmcnt(0)" ::: "memory");
        }
    }
    __syncthreads();
}

struct Frame {
    LAS unsigned char* lds; volatile LAS unsigned* MISC; unsigned* ctl;
    int wave, vcu, G;
};
#define F_LANE (lane_id())
#define F_TID (F.wave * 64 + lane_id())
__device__ __forceinline__ float wave_sum(float v) {
#pragma unroll
    for (int o = 1; o < 64; o <<= 1) v += __shfl_xor(v, o);
    return v;
}

__host__ __device__ __forceinline__ int win_row(int sc) { if (sc < NPROJ_SRC) return sc + (sc >= 1184 ? 96 : 0); const int g = sc - NPROJ_SRC, br = g >> 10, oc = g & 1023, p = oc >> 6, j = oc & 63;
    return PROJW + p * 256 + 128 * (br >> 1) + 32 * (j >> 4) + 16 * (br & 1) + (j & 15); }
__device__ __forceinline__ void transpose_item(const float* W, int ldw, bf16* WT, int ldt, int drow0, int k0, int n0, const float* scale, LAS float* scr, int lane, const bool winmap = false) {
#pragma unroll 8
    for (int i = 0; i < 32; ++i) { const int kk = 2 * i + (lane >> 5); float v = W[(size_t)(k0 + kk) * ldw + n0 + (lane & 31)]; if (scale) v *= scale[k0 + kk]; scr[kk * 33 + (lane & 31)] = v; }
    LDS_WAIT(); asm volatile("" ::: "memory");
    const int c = lane & 7;
#pragma unroll
    for (int j = 0; j < 4; ++j) { const int n = (lane >> 3) + 8 * j; const LAS float* s = scr + (8 * c) * 33 + n;
        v4u o; o.x = pk2(s[0 * 33], s[1 * 33]); o.y = pk2(s[2 * 33], s[3 * 33]); o.z = pk2(s[4 * 33], s[5 * 33]); o.w = pk2(s[6 * 33], s[7 * 33]);
        *(v4u*)(WT + (size_t)(winmap ? win_row(n0 + n) : drow0 + n) * ldt + k0 + 8 * c) = o; }
    LDS_WAIT(); asm volatile("" ::: "memory");
}
__device__ __forceinline__ void convert_job(Frame& F, const float* src, size_t sstride, int K, int N, bf16* dst, size_t dstride, int ldt, int mode, const float* scale, int nmat, int rot) {
    LAS float* scr = (LAS float*)(F.lds + RING_OFF + F.wave * 16384);
    const int NGW = F.G * NWAVES, gw = (F.vcu * NWAVES + F.wave + rot) % NGW, lane = F_LANE;
    const int nkb = K / 64, nnb = N / 32, per = nkb * nnb, total = per * nmat;
    for (int it = gw; it < total; it += NGW) {
        const int mi = it / per, r = it % per, kb = r / nnb, nb = r % nnb, n0 = nb * 32;
        int drow = n0;
        if (mode == 2) drow = (n0 >> 7) * 256 + (n0 & 127);
        else if (mode == 3) drow = (n0 >> 7) * 256 + 128 + (n0 & 127);
        transpose_item(src + (size_t)mi * sstride, N, dst + (size_t)mi * dstride, ldt, drow, kb * 64, n0, scale, scr, lane, mode == 1);
    }
}
enum { IN_X = 0, IN_C, IN_POS, IN_N1G, IN_N2G, IN_ADAW, IN_ADAB, IN_WIN, IN_CONVW, IN_CQG, IN_WUQ, IN_CKVG, IN_WUKV, IN_QNG, IN_KNG, IN_GVG, IN_WS, IN_BS, IN_RETG, IN_WBR, IN_WO,
       IN_F1, IN_F3, IN_F2, IN_RW, IN_RB, IN_M1, IN_M3, IN_M2, N_IN };
enum { PH_PRO = 0, PL_NORM1 = 0, PL_INPROJ, PL_PRE, PL_SCAN, PL_ATTN, PL_GATE, PL_MERGE, PL_WO, PL_NORM2, PL_F0, PL_F1, PL_F2, PL_F3, PL_F4, PL_F5, PL_PER_LAYER = 16, N_PHASES = 1 + 2 * PL_PER_LAYER };
__host__ __device__ constexpr int PHL(int l, int k) { return 1 + l * PL_PER_LAYER + k; }

struct Args { const void* in[N_IN]; float* out; unsigned char* ws; int ph_lo, ph_hi, li, pad; };


typedef const __attribute__((address_space(4))) unsigned long long* karg_t;
__device__ __forceinline__ const void* karg_ptr(int idx) { karg_t k = (karg_t)__builtin_amdgcn_kernarg_segment_ptr(); asm volatile("" : "+s"(k)); return (const void*)(const __attribute__((address_space(1))) char*)k[idx]; }
#define K_IN(i) (karg_ptr(i))
#define K_OUT ((float*)karg_ptr(N_IN))
#define K_WS ((unsigned char*)karg_ptr(N_IN + 1))
__device__ __forceinline__ void norm_phase(Frame& F, const float* X, bf16* H, const float* gain, const float* ada_l, const int off_sh, const int off_sc,
                                           const float* router_w, const float* router_b, nv::Route* route, int* CNT) {
    int lane_ = F_LANE; asm volatile("" : "+v"(lane_)); const int lane = lane_;
    LAS int* cnt = (LAS int*)(F.lds + RING_OFF);
    for (int blk = F.vcu; blk < NTOK / 128; blk += F.G) {
        if (router_w) { if (F_TID < NEXP) cnt[F_TID] = 0; __syncthreads(); }
        const int b = (blk * 128) / SEQ;
        float4 gm[4], sh[4];
#pragma unroll
        for (int j = 0; j < 4; ++j) { const int col = 4 * (lane + 64 * j);
            const float4 g = *(const float4*)(gain + col), sc = *(const float4*)(ada_l + (size_t)b * 6 * DM + off_sc + col);
            gm[j] = make_float4(g.x * (1.f + sc.x), g.y * (1.f + sc.y), g.z * (1.f + sc.z), g.w * (1.f + sc.w));
            sh[j] = *(const float4*)(ada_l + (size_t)b * 6 * DM + off_sh + col); }
        for (int rr = 0; rr < 16; ++rr) {
            const int m = blk * 128 + F.wave * 16 + rr;
            const float4* xr = (const float4*)(X + (size_t)m * DM);
            float4 v[4]; float ss = 0.f;
#pragma unroll
            for (int j = 0; j < 4; ++j) { v[j] = xr[lane + 64 * j]; ss += v[j].x * v[j].x + v[j].y * v[j].y + v[j].z * v[j].z + v[j].w * v[j].w; }
            ss = wave_sum(ss);
            const float rstd = rsqrtf(ss * (1.f / DM) + EPS);
            float lg[NEXP];
#pragma unroll
            for (int e = 0; e < NEXP; ++e) lg[e] = 0.f;
#pragma unroll
            for (int j = 0; j < 4; ++j) {
                const int col = 4 * (lane + 64 * j);
                const float h0 = v[j].x * rstd * gm[j].x + sh[j].x, h1 = v[j].y * rstd * gm[j].y + sh[j].y, h2 = v[j].z * rstd * gm[j].z + sh[j].z, h3 = v[j].w * rstd * gm[j].w + sh[j].w;
                uint2 o; o.x = pk2(h0, h1); o.y = pk2(h2, h3);
                *(uint2*)(H + (size_t)m * DM + col) = o;
                if (router_w) {
                    const float4* rw = (const float4*)(router_w + (size_t)col * NEXP);
#pragma unroll
                    for (int q = 0; q < 2; ++q) { const float4 w0 = rw[q], w1 = rw[2 + q], w2 = rw[4 + q], w3 = rw[6 + q];
                        lg[4 * q + 0] += h0 * w0.x + h1 * w1.x + h2 * w2.x + h3 * w3.x; lg[4 * q + 1] += h0 * w0.y + h1 * w1.y + h2 * w2.y + h3 * w3.y;
                        lg[4 * q + 2] += h0 * w0.z + h1 * w1.z + h2 * w2.z + h3 * w3.z; lg[4 * q + 3] += h0 * w0.w + h1 * w1.w + h2 * w2.w + h3 * w3.w; }
                }
            }
            if (router_w) {
#pragma unroll
                for (int e = 0; e < NEXP; ++e) lg[e] = wave_sum(lg[e]) + router_b[e];
                if (lane == 0) {
                    int e0 = 0; float l0 = lg[0];
#pragma unroll
                    for (int e = 1; e < NEXP; ++e) if (lg[e] > l0) { l0 = lg[e]; e0 = e; }
                    int e1 = -1; float l1 = -INFINITY;
#pragma unroll
                    for (int e = 0; e < NEXP; ++e) if (e != e0 && lg[e] > l1) { l1 = lg[e]; e1 = e; }
                    const float p0 = 1.f / (1.f + __expf(l1 - l0));
                    nv::Route r; r.e0 = e0; r.e1 = e1; r.p0 = p0; r.p1 = 1.f - p0; route[m] = r;
                    atomicAdd((int*)&cnt[e0], 1); atomicAdd((int*)&cnt[e1], 1);
                }
            }
        }
        if (router_w) { __syncthreads(); if (F_TID < NEXP) CNT[blk * NEXP + F_TID] = cnt[F_TID]; __syncthreads(); }
    }
}

__device__ __forceinline__ void moe_assign_phase(Frame& F, const Args& args) {
    unsigned char* ws = K_WS;
    const nv::Route* route = (const nv::Route*)(ws + WS_ROUTE); const int* CNT = (const int*)(ws + WS_CNT); const bf16* H2 = (const bf16*)(ws + WS_H); bf16* XS = (bf16*)(ws + WS_XS);
    int* SLOT = (int*)(ws + WS_SLOT); float* PSLOT = (float*)(ws + WS_PSLOT); int* PEXP = (int*)(ws + WS_PEXP);
    LAS int* sm = (LAS int*)(F.lds + RING_OFF);
    LAS int* tot = sm; LAS int* pre = sm + 8; LAS int* base = sm + 16; LAS int* wcnt = sm + 32; LAS int* ss0 = sm + 64; LAS int* ss1 = sm + 192;
    const int tid = F_TID, lane = F_LANE, w = F.wave;
    for (int blk = F.vcu; blk < NTOK / 128; blk += F.G) {
        if (tid < 16) sm[tid] = 0;
        __syncthreads();
        if (tid < 256) { const int4 c0 = *(const int4*)(CNT + tid * NEXP), c1 = *(const int4*)(CNT + tid * NEXP + 4); const int cc[8] = {c0.x, c0.y, c0.z, c0.w, c1.x, c1.y, c1.z, c1.w};
#pragma unroll
            for (int e = 0; e < NEXP; ++e) { atomicAdd((int*)&tot[e], cc[e]); if (tid < blk) atomicAdd((int*)&pre[e], cc[e]); } }
        __syncthreads();
        if (tid == 0) { int bsum = 0; for (int e = 0; e < NEXP; ++e) { base[e] = bsum; bsum += (tot[e] + 255) & ~255; } base[NEXP] = bsum; }
        __syncthreads();
        if (blk == 0) { for (int p = tid; p < MAXPANEL + 8; p += NWAVES * 64) { int e = -1;
#pragma unroll
                for (int x = 0; x < NEXP; ++x) if (p * 256 >= base[x] && p * 256 < base[x + 1]) e = x;
                if (p == MAXPANEL) e = base[NEXP] >> 8; PEXP[p] = e; } }
        if (blk < NEXP) { const int e = blk; for (int s = base[e] + tot[e] + tid; s < base[e + 1]; s += NWAVES * 64) PSLOT[s] = 0.f; }
        if (tid < 128) {
            const int t = blk * 128 + tid; const nv::Route r = route[t]; int rank0 = 0, rank1 = 0;
#pragma unroll
            for (int e = 0; e < NEXP; ++e) { const bool in = (r.e0 == e) || (r.e1 == e); const unsigned long long m = __ballot(in); if (lane == 0) wcnt[w * 8 + e] = __popcll(m);
                const int rk = __popcll(m & ((1ull << lane) - 1ull)); if (r.e0 == e) rank0 = rk; if (r.e1 == e) rank1 = rk; }
            ss0[tid] = rank0; ss1[tid] = rank1;
        }
        __syncthreads();
        if (tid < 128) {
            const int t = blk * 128 + tid; const nv::Route r = route[t]; int rank0 = ss0[tid], rank1 = ss1[tid];
            if (w == 1) { rank0 += wcnt[r.e0]; rank1 += wcnt[r.e1]; }
            const int s0 = base[r.e0] + pre[r.e0] + rank0, s1 = base[r.e1] + pre[r.e1] + rank1;
            SLOT[2 * t] = s0; SLOT[2 * t + 1] = s1; PSLOT[s0] = r.p0; PSLOT[s1] = r.p1;
            ss0[tid] = s0; ss1[tid] = s1;
        }
        __syncthreads();
        { const int rsub = tid >> 7, c8 = (tid & 127) * 8;
          for (int i = 0; i < 128; i += 4) { const int row = i + rsub; const uint4 v = *(const uint4*)(H2 + (size_t)(blk * 128 + row) * DM + c8);
              *(uint4*)(XS + (size_t)ss0[row] * DM + c8) = v; *(uint4*)(XS + (size_t)ss1[row] * DM + c8) = v; } }
        __syncthreads();
    }
}

__device__ __forceinline__ void moe_combine_phase(Frame& F, float* X, const bf16* Y, const int* SLOT, const float* g2) {
    const int gw = F.vcu * NWAVES + F.wave, NGW = F.G * NWAVES;
    for (int t = gw; t < NTOK; t += NGW) {
        const int b = t / SEQ, s0 = SLOT[2 * t], s1 = SLOT[2 * t + 1];
#pragma unroll
        for (int j = 0; j < 4; ++j) { const int c4 = 4 * (F_LANE + 64 * j);
            const uint2 a = *(const uint2*)(Y + (size_t)s0 * DM + c4), bq = *(const uint2*)(Y + (size_t)s1 * DM + c4);
            float4 x = *(float4*)(X + (size_t)t * DM + c4); const float4 g = *(const float4*)(g2 + (size_t)b * 6 * DM + c4);
            x.x += g.x * (bf2f((bf16)(a.x & 0xffff)) + bf2f((bf16)(bq.x & 0xffff))); x.y += g.y * (bf2f((bf16)(a.x >> 16)) + bf2f((bf16)(bq.x >> 16)));
            x.z += g.z * (bf2f((bf16)(a.y & 0xffff)) + bf2f((bf16)(bq.y & 0xffff))); x.w += g.w * (bf2f((bf16)(a.y >> 16)) + bf2f((bf16)(bq.y >> 16)));
            *(float4*)(X + (size_t)t * DM + c4) = x; }
    }
}

__device__ __forceinline__ void scan_phase(Frame& F, float* RET) {
    for (int idx = F.vcu * NWAVES * 64 + F_TID; idx < NBATCH * NHEAD * 4096; idx += F.G * NWAVES * 64) {
        const int b = idx / (NHEAD * 4096), h = (idx / 4096) % NHEAD, ed = idx % 4096;
        const float cd = __expf(nv::ret_loggamma(h) * 128.f); float st = 0.f;
        float* p = RET + ((size_t)b * NCHUNK * NHEAD + h) * 4096 + ed; const size_t stp = (size_t)NHEAD * 4096;
        for (int n0 = 0; n0 < NCHUNK; n0 += 8) { float kv[8];
#pragma unroll
            for (int i = 0; i < 8; ++i) kv[i] = p[(size_t)(n0 + i) * stp];
#pragma unroll
            for (int i = 0; i < 8; ++i) { p[(size_t)(n0 + i) * stp] = st; st = st * cd + kv[i]; } }
    }
}
typedef short bf16x8 __attribute__((ext_vector_type(8)));
typedef float f32x4 __attribute__((ext_vector_type(4)));
typedef float f32x16 __attribute__((ext_vector_type(16)));
#define MFMA16(a, b, c) __builtin_amdgcn_mfma_f32_16x16x32_bf16((a), (b), (c), 0, 0, 0)
__device__ __forceinline__ float bflo_(unsigned w) { return __uint_as_float(w << 16); }
__device__ __forceinline__ float bfhi_(unsigned w) { return __uint_as_float(w & 0xffff0000u); }
__device__ __forceinline__ float sumsq8(bf16x8 v) { float s = 0.f;
#pragma unroll
    for (int i = 0; i < 8; ++i) { const float f = bf2f((bf16)v[i]); s += f * f; } return s; }
__device__ __forceinline__ int tofs(int row, int j) { return row * 256 + ((((j >> 3) ^ (row & 15)) << 4) | ((j & 7) << 1)); }
__device__ __forceinline__ float fast_gelu_tanh(float x) { const float u = 0.7978845608028654f * (x + 0.044715f * x * x * x);
    return x * __builtin_amdgcn_rcpf(1.f + __builtin_amdgcn_exp2f(-2.885390081777927f * u)); }

template <int l> __device__ __forceinline__ void pre_conv(Frame& F, const Args& args, const int t0) {
    const bf16* P = (const bf16*)(K_WS + WS_PROJ); bf16* YB = (bf16*)(K_WS + WS_YB); const float* cw = (const float*)K_IN(IN_CONVW) + l * 3 * MIXW;
    int tid_ = F_TID; asm volatile("" : "+v"(tid_)); const int cg = tid_ & 31, tl = tid_ >> 5, c0 = cg * 8, tb = t0 + tl * 8, sb = tb % SEQ;
    float w0[8], w1[8], w2[8], u1[8], u2[8];
#pragma unroll
    for (int i = 0; i < 8; ++i) { w0[i] = cw[c0 + i]; w1[i] = cw[256 + c0 + i]; w2[i] = cw[512 + c0 + i]; u1[i] = 0.f; u2[i] = 0.f; }
    auto ldu = [&](int t, float* u) { const v4u a = *(const v4u*)(P + (size_t)t * PROJW + C_AC + c0), x = *(const v4u*)(P + (size_t)t * PROJW + C_AX + c0);
        u[0] = bflo_(a.x) * bflo_(x.x); u[1] = bfhi_(a.x) * bfhi_(x.x); u[2] = bflo_(a.y) * bflo_(x.y); u[3] = bfhi_(a.y) * bfhi_(x.y);
        u[4] = bflo_(a.z) * bflo_(x.z); u[5] = bfhi_(a.z) * bfhi_(x.z); u[6] = bflo_(a.w) * bflo_(x.w); u[7] = bfhi_(a.w) * bfhi_(x.w); };
    if (sb >= 1) ldu(tb - 1, u1);
    if (sb >= 2) ldu(tb - 2, u2);
#pragma unroll
    for (int i = 0; i < 8; ++i) { const int t = tb + i; float u0[8]; ldu(t, u0);
        const v4u ab = *(const v4u*)(P + (size_t)t * PROJW + C_AB + c0); const float bb[8] = {bflo_(ab.x), bfhi_(ab.x), bflo_(ab.y), bfhi_(ab.y), bflo_(ab.z), bfhi_(ab.z), bflo_(ab.w), bfhi_(ab.w)};
        float y[8];
#pragma unroll
        for (int c = 0; c < 8; ++c) { y[c] = bb[c] * (w0[c] * u2[c] + w1[c] * u1[c] + w2[c] * u0[c]); u2[c] = u1[c]; u1[c] = u0[c]; }
        v4u o; o.x = pk2(y[0], y[1]); o.y = pk2(y[2], y[3]); o.z = pk2(y[4], y[5]); o.w = pk2(y[6], y[7]);
        *(v4u*)(YB + (size_t)t * DM + c0) = o; }
}

template <int l> __device__ __forceinline__ void pre_mla(Frame& F, const Args& args, const int t0) {
    unsigned char* ws = K_WS;
    const bf16* P = (const bf16*)(ws + WS_PROJ); bf16* Q = (bf16*)(ws + WS_Q); bf16* Kb = (bf16*)(ws + WS_K); bf16* VT = (bf16*)(ws + WS_VT);
    const bf16* WUQ = (const bf16*)(ws + WS_WUQ_T) + (size_t)l * QW * 256; const bf16* WUKV = (const bf16*)(ws + WS_WUKV_T) + (size_t)l * 512 * 128;
    const float* qn_g = (const float*)K_IN(IN_QNG) + l * QKH; const float* kn_g = (const float*)K_IN(IN_KNG) + l * QKH; const int* pos = (const int*)K_IN(IN_POS);
    int lane_ = F_LANE; asm volatile("" : "+v"(lane_)); const int lr = lane_ & 15, lq = lane_ >> 4;
    const int tw = t0 + F.wave * 16 + lr, b = t0 / SEQ, sw = (t0 % SEQ) + F.wave * 16;
    const bf16* prow = P + (size_t)tw * PROJW;
    bf16x8 xq[8], xkv[4]; float ssq = 0.f, sskv = 0.f;
#pragma unroll
    for (int s = 0; s < 8; ++s) { xq[s] = *(const bf16x8*)(prow + C_CQ + 32 * s + 8 * lq); ssq += sumsq8(xq[s]); }
#pragma unroll
    for (int s = 0; s < 4; ++s) { xkv[s] = *(const bf16x8*)(prow + C_CKV + 32 * s + 8 * lq); sskv += sumsq8(xkv[s]); }
    ssq += __shfl_xor(ssq, 16); ssq += __shfl_xor(ssq, 32); sskv += __shfl_xor(sskv, 16); sskv += __shfl_xor(sskv, 32);
    const float rq = rsqrtf(ssq * (1.f / 256) + EPS), rkv = rsqrtf(sskv * (1.f / 128) + EPS);
    float cs[4], sn[4]; { const float fpos = (float)pos[tw];
#pragma unroll
        for (int r = 0; r < 4; ++r) { const float ang = fpos * powf(10000.f, -(float)(4 * lq + r) / 16.f); sincosf(ang, &sn[r], &cs[r]); } }
#pragma unroll 1
    for (int h = 0; h < NHEAD; ++h) {
        f32x4 acc[6];
#pragma unroll
        for (int nt = 0; nt < 6; ++nt) acc[nt] = (f32x4){0.f, 0.f, 0.f, 0.f};
#pragma unroll
        for (int s = 0; s < 8; ++s)
#pragma unroll
            for (int nt = 0; nt < 6; ++nt) { const bf16x8 wf = *(const bf16x8*)(WUQ + (size_t)(h * 96 + nt * 16 + lr) * 256 + 32 * s + 8 * lq); acc[nt] = MFMA16(wf, xq[s], acc[nt]); }
        float ss = 0.f;
#pragma unroll
        for (int nt = 0; nt < 6; ++nt) { acc[nt] = acc[nt] * rq; ss += acc[nt][0] * acc[nt][0] + acc[nt][1] * acc[nt][1] + acc[nt][2] * acc[nt][2] + acc[nt][3] * acc[nt][3]; }
        ss += __shfl_xor(ss, 16); ss += __shfl_xor(ss, 32);
        const float rh = rsqrtf(ss * (1.f / 96) + EPS);
#pragma unroll
        for (int nt = 0; nt < 6; ++nt) { const f32x4 g = *(const f32x4*)(qn_g + nt * 16 + 4 * lq); acc[nt] = acc[nt] * rh * g; }
#pragma unroll
        for (int r = 0; r < 4; ++r) { const float x1 = acc[4][r], x2 = acc[5][r]; acc[4][r] = x1 * cs[r] - x2 * sn[r]; acc[5][r] = x2 * cs[r] + x1 * sn[r]; }
#pragma unroll
        for (int nt = 0; nt < 6; ++nt) { v2u o; o.x = pk2(acc[nt][0] * ATT_C2, acc[nt][1] * ATT_C2); o.y = pk2(acc[nt][2] * ATT_C2, acc[nt][3] * ATT_C2);
            *(v2u*)(Q + (size_t)tw * QW + h * 96 + nt * 16 + 4 * lq) = o; }
    }
    float kr1[4], kr2[4]; { const v2u a = *(const v2u*)(prow + C_KR + 4 * lq), c = *(const v2u*)(prow + C_KR + 16 + 4 * lq);
        kr1[0] = bflo_(a.x); kr1[1] = bfhi_(a.x); kr1[2] = bflo_(a.y); kr1[3] = bfhi_(a.y); kr2[0] = bflo_(c.x); kr2[1] = bfhi_(c.x); kr2[2] = bflo_(c.y); kr2[3] = bfhi_(c.y); }
    float sskr = 0.f;
#pragma unroll
    for (int r = 0; r < 4; ++r) sskr += kr1[r] * kr1[r] + kr2[r] * kr2[r];
    float rkv_r[4];
#pragma unroll
    for (int r = 0; r < 4; ++r) rkv_r[r] = __shfl(rkv, 4 * lq + r);
#pragma unroll 1
    for (int h = 0; h < NHEAD; ++h) {
        f32x4 ak[4], av[4];
#pragma unroll
        for (int nt = 0; nt < 4; ++nt) { ak[nt] = (f32x4){0.f, 0.f, 0.f, 0.f}; av[nt] = (f32x4){0.f, 0.f, 0.f, 0.f}; }
#pragma unroll
        for (int s = 0; s < 4; ++s)
#pragma unroll
            for (int nt = 0; nt < 4; ++nt) {
                const bf16x8 wk = *(const bf16x8*)(WUKV + (size_t)(h * 128 + nt * 16 + lr) * 128 + 32 * s + 8 * lq); ak[nt] = MFMA16(wk, xkv[s], ak[nt]);
                const bf16x8 wv = *(const bf16x8*)(WUKV + (size_t)(h * 128 + 64 + nt * 16 + lr) * 128 + 32 * s + 8 * lq); av[nt] = MFMA16(xkv[s], wv, av[nt]);
            }
        float ss = sskr;
#pragma unroll
        for (int nt = 0; nt < 4; ++nt) { ak[nt] = ak[nt] * rkv; ss += ak[nt][0] * ak[nt][0] + ak[nt][1] * ak[nt][1] + ak[nt][2] * ak[nt][2] + ak[nt][3] * ak[nt][3]; }
        ss += __shfl_xor(ss, 16); ss += __shfl_xor(ss, 32);
        const float rk = rsqrtf(ss * (1.f / 96) + EPS);
#pragma unroll
        for (int nt = 0; nt < 4; ++nt) { const f32x4 g = *(const f32x4*)(kn_g + nt * 16 + 4 * lq); const f32x4 v = ak[nt] * rk * g; v2u o; o.x = pk2(v[0], v[1]); o.y = pk2(v[2], v[3]);
            *(v2u*)(Kb + (size_t)tw * QW + h * 96 + nt * 16 + 4 * lq) = o; }
        { const f32x4 g1 = *(const f32x4*)(kn_g + 64 + 4 * lq), g2 = *(const f32x4*)(kn_g + 80 + 4 * lq); float o1[4], o2[4];
#pragma unroll
          for (int r = 0; r < 4; ++r) { const float x1 = kr1[r] * rk * g1[r], x2 = kr2[r] * rk * g2[r]; o1[r] = x1 * cs[r] - x2 * sn[r]; o2[r] = x2 * cs[r] + x1 * sn[r]; }
          v2u a; a.x = pk2(o1[0], o1[1]); a.y = pk2(o1[2], o1[3]); *(v2u*)(Kb + (size_t)tw * QW + h * 96 + 64 + 4 * lq) = a;
          v2u c; c.x = pk2(o2[0], o2[1]); c.y = pk2(o2[2], o2[3]); *(v2u*)(Kb + (size_t)tw * QW + h * 96 + 80 + 4 * lq) = c; }
#pragma unroll
        for (int nt = 0; nt < 4; ++nt) { v2u o; o.x = pk2(av[nt][0] * rkv_r[0], av[nt][1] * rkv_r[1]); o.y = pk2(av[nt][2] * rkv_r[2], av[nt][3] * rkv_r[3]);
            *(v2u*)(VT + ((size_t)(b * NHEAD + h) * 64 + nt * 16 + lr) * SEQ + sw + 4 * lq) = o; }
    }
}

template <int l> __device__ __forceinline__ void pre_sgu(Frame& F, const Args& args, const int t0) {
    unsigned char* ws = K_WS;
    const bf16* P = (const bf16*)(ws + WS_PROJ); bf16* YB = (bf16*)(ws + WS_YB); const bf16* WST = (const bf16*)(ws + WS_WS_T) + (size_t)l * 4 * 128 * 128;
    const float* gv_g = (const float*)K_IN(IN_GVG) + l * 256; const float* b_s = (const float*)K_IN(IN_BS) + l * 4 * 128;
    LAS unsigned char* vT = F.lds + RING_OFF;
    int lane_ = F_LANE; asm volatile("" : "+v"(lane_)); const int lane = lane_, lr = lane & 15, lq = lane >> 4, w = F.wave;
    { const f32x4 gg = *(const f32x4*)(gv_g + 4 * lane);
      for (int j = 0; j < 16; ++j) { const int s = 16 * w + j; const v2u a = *(const v2u*)(P + (size_t)(t0 + s) * PROJW + C_SV + 4 * lane);
          float v[4] = {fast_gelu_tanh(bflo_(a.x)), fast_gelu_tanh(bfhi_(a.x)), fast_gelu_tanh(bflo_(a.y)), fast_gelu_tanh(bfhi_(a.y))};
          float ss = v[0] * v[0] + v[1] * v[1] + v[2] * v[2] + v[3] * v[3];
          ss += __shfl_xor(ss, 1); ss += __shfl_xor(ss, 2); ss += __shfl_xor(ss, 4); ss += __shfl_xor(ss, 8);
          const float rs = rsqrtf(ss * (1.f / 64) + EPS);
#pragma unroll
          for (int i = 0; i < 4; ++i) *(LAS bf16*)(vT + tofs(4 * lane + i, s)) = f2bf(v[i] * rs * gg[i]); } }
    __syncthreads();
    const int tw = t0 + 16 * w + lr, nks = (16 * w + 15) / 32 + 1;
#pragma unroll 1
    for (int g = 0; g < 4; ++g) {
        f32x4 acc[4];
#pragma unroll
        for (int ct = 0; ct < 4; ++ct) acc[ct] = (f32x4){0.f, 0.f, 0.f, 0.f};
        for (int ks = 0; ks < nks; ++ks) { const bf16x8 wf = *(const bf16x8*)(WST + ((size_t)g * 128 + 16 * w + lr) * 128 + 32 * ks + 8 * lq);
#pragma unroll
            for (int ct = 0; ct < 4; ++ct) { const bf16x8 vf = *(const LAS bf16x8*)(vT + tofs(g * 64 + ct * 16 + lr, 32 * ks + 8 * lq)); acc[ct] = MFMA16(vf, wf, acc[ct]); } }
        const float bb = b_s[g * 128 + 16 * w + lr];
#pragma unroll
        for (int ct = 0; ct < 4; ++ct) { const v2u a = *(const v2u*)(P + (size_t)tw * PROJW + C_SU + g * 64 + ct * 16 + 4 * lq);
            v2u o; o.x = pk2(fast_gelu_tanh(bflo_(a.x)) * (acc[ct][0] + bb), fast_gelu_tanh(bfhi_(a.x)) * (acc[ct][1] + bb)); o.y = pk2(fast_gelu_tanh(bflo_(a.y)) * (acc[ct][2] + bb), fast_gelu_tanh(bfhi_(a.y)) * (acc[ct][3] + bb));
            *(v2u*)(YB + (size_t)tw * DM + 512 + g * 64 + ct * 16 + 4 * lq) = o; }
    }
    __syncthreads();
}

__device__ __forceinline__ void pre_retkv(Frame& F, const Args& args, const int t0, const int ch) {
    unsigned char* ws = K_WS;
    bf16* P = (bf16*)(ws + WS_PROJ); float* RET = (float*)(ws + WS_RET); const int* pos = (const int*)K_IN(IN_POS);
    LAS unsigned char* kT = F.lds + RING_OFF; LAS unsigned char* vT = F.lds + RING_OFF + 65536;
    int lane_ = F_LANE; asm volatile("" : "+v"(lane_)); const int lane = lane_, lr = lane & 15, lq = lane >> 4, w = F.wave;
    { const int h = lane >> 4, i0 = (lane & 15) * 2; const float lg = nv::ret_loggamma(h);
      const float f0 = powf(10000.f, -(float)i0 / 32.f), f1 = powf(10000.f, -(float)(i0 + 1) / 32.f);
      for (int j = 0; j < 16; ++j) { const int s = 16 * w + j; bf16* r = P + (size_t)(t0 + s) * PROJW; const float fpos = (float)pos[t0 + s];
          const unsigned q1 = *(const unsigned*)(r + C_RQ + h * 64 + i0), q2 = *(const unsigned*)(r + C_RQ + h * 64 + 32 + i0), k1 = *(const unsigned*)(r + C_RK + h * 64 + i0), k2 = *(const unsigned*)(r + C_RK + h * 64 + 32 + i0);
          const v2u vv = *(const v2u*)(r + C_RV + 4 * lane);
          float s0, c0, s1, c1; sincosf(fpos * f0, &s0, &c0); sincosf(fpos * f1, &s1, &c1);
          const float dq = __expf(lg * (float)s), dk = 0.125f * __expf(-lg * (float)s);
          const unsigned qa = pk2((bflo_(q1) * c0 - bflo_(q2) * s0) * dq, (bfhi_(q1) * c1 - bfhi_(q2) * s1) * dq), qb = pk2((bflo_(q2) * c0 + bflo_(q1) * s0) * dq, (bfhi_(q2) * c1 + bfhi_(q1) * s1) * dq);
          const unsigned ka = pk2((bflo_(k1) * c0 - bflo_(k2) * s0) * dk, (bfhi_(k1) * c1 - bfhi_(k2) * s1) * dk), kb = pk2((bflo_(k2) * c0 + bflo_(k1) * s0) * dk, (bfhi_(k2) * c1 + bfhi_(k1) * s1) * dk);
          *(unsigned*)(r + C_RQ + h * 64 + i0) = qa; *(unsigned*)(r + C_RQ + h * 64 + 32 + i0) = qb; *(unsigned*)(r + C_RK + h * 64 + i0) = ka; *(unsigned*)(r + C_RK + h * 64 + 32 + i0) = kb;
          *(LAS bf16*)(kT + tofs(h * 64 + i0, s)) = (bf16)(ka & 0xffff); *(LAS bf16*)(kT + tofs(h * 64 + i0 + 1, s)) = (bf16)(ka >> 16);
          *(LAS bf16*)(kT + tofs(h * 64 + 32 + i0, s)) = (bf16)(kb & 0xffff); *(LAS bf16*)(kT + tofs(h * 64 + 32 + i0 + 1, s)) = (bf16)(kb >> 16);
          *(LAS bf16*)(vT + tofs(4 * lane + 0, s)) = (bf16)(vv.x & 0xffff); *(LAS bf16*)(vT + tofs(4 * lane + 1, s)) = (bf16)(vv.x >> 16);
          *(LAS bf16*)(vT + tofs(4 * lane + 2, s)) = (bf16)(vv.y & 0xffff); *(LAS bf16*)(vT + tofs(4 * lane + 3, s)) = (bf16)(vv.y >> 16); } }
    __syncthreads();
    { const int h = w >> 1; const float g127 = __expf(nv::ret_loggamma(h) * 127.f);
      f32x4 acc[4][2];
#pragma unroll
      for (int dt = 0; dt < 4; ++dt)
#pragma unroll
          for (int ei = 0; ei < 2; ++ei) acc[dt][ei] = (f32x4){0.f, 0.f, 0.f, 0.f};
#pragma unroll
      for (int ks = 0; ks < 4; ++ks) { bf16x8 vf[2];
#pragma unroll
          for (int ei = 0; ei < 2; ++ei) vf[ei] = *(const LAS bf16x8*)(vT + tofs(h * 64 + ((w & 1) * 2 + ei) * 16 + lr, 32 * ks + 8 * lq));
#pragma unroll
          for (int dt = 0; dt < 4; ++dt) { const bf16x8 kf = *(const LAS bf16x8*)(kT + tofs(h * 64 + dt * 16 + lr, 32 * ks + 8 * lq));
#pragma unroll
              for (int ei = 0; ei < 2; ++ei) acc[dt][ei] = MFMA16(kf, vf[ei], acc[dt][ei]); } }
#pragma unroll
      for (int dt = 0; dt < 4; ++dt)
#pragma unroll
          for (int ei = 0; ei < 2; ++ei) *(f32x4*)(RET + (((size_t)ch * NHEAD + h) * 64 + ((w & 1) * 2 + ei) * 16 + lr) * 64 + dt * 16 + 4 * lq) = acc[dt][ei] * g127; }
    __syncthreads();
}

template <int l> __device__ __forceinline__ void pre_phase(Frame& F, const Args& args) {
    for (int ch = F.vcu; ch < NTOK / CHUNK; ch += F.G) {
        const int t0 = ch * CHUNK;
        pre_conv<l>(F, args, t0);
        pre_mla<l>(F, args, t0);
        pre_sgu<l>(F, args, t0);
        pre_retkv(F, args, t0, ch);
    }
}
#define MFMA32(a, b, c) __builtin_amdgcn_mfma_f32_32x32x16_bf16((a), (b), (c), 0, 0, 0)
typedef short s16x4 __attribute__((ext_vector_type(4)));
constexpr int AT_KROW = 208, AT_VROW = 136, AT_KBYTES = 64 * AT_KROW, AT_STAGE = 22528;
__device__ __forceinline__ int crow32(int r, int hi) { return (r & 3) + 8 * (r >> 2) + 4 * hi; }

__device__ __forceinline__ void attn_unit(Frame& F, const bf16* Q, const bf16* Kb, const bf16* VT, bf16* YB, const float nbnd, const int b, const int h, const int qb) {
    int tid_ = F_TID; asm volatile("" : "+v"(tid_)); const int tid = tid_, lane = tid & 63, r32 = lane & 31, hi = lane >> 5, w = F.wave;
    LAS unsigned char* lds = F.lds + RING_OFF;
    const int bh = b * NHEAD + h, qw0 = qb * 256 + w * 32;
    const size_t tq = (size_t)b * SEQ + qw0 + r32;
    bf16x8 qf[6];
#pragma unroll
    for (int s = 0; s < 6; ++s) qf[s] = *(const bf16x8*)(Q + tq * QW + h * 96 + 16 * s + 8 * hi);
    f32x16 o0, o1; float lsum = 0.f;
#pragma unroll
    for (int r = 0; r < 16; ++r) { o0[r] = 0.f; o1[r] = 0.f; }
    const int ntile = 4 * qb + 4;
    const int kr0 = tid / 12, kc0 = tid % 12, kr1 = (tid + 512) / 12, kc1 = (tid + 512) % 12, vd = tid >> 3, vc = tid & 7;
    const bf16* kg0 = Kb + ((size_t)b * SEQ + kr0) * QW + h * 96 + kc0 * 8; const bf16* kg1 = Kb + ((size_t)b * SEQ + kr1) * QW + h * 96 + kc1 * 8;
    const bf16* vg = VT + ((size_t)bh * 64 + vd) * SEQ + vc * 8;
    const int kl0 = kr0 * AT_KROW + kc0 * 16, kl1 = kr1 * AT_KROW + kc1 * 16, vl = AT_KBYTES + vd * AT_VROW + vc * 16;
    v4u rk0, rk1, rv; rk1 = (v4u){0u, 0u, 0u, 0u};
    rk0 = *(const v4u*)kg0; if (tid < 256) rk1 = *(const v4u*)kg1; rv = *(const v4u*)vg;
    *(LAS v4u*)(lds + kl0) = rk0; if (tid < 256) *(LAS v4u*)(lds + kl1) = rk1;
    *(LAS v2u*)(lds + vl) = (v2u){rv.x, rv.y}; *(LAS v2u*)(lds + vl + 8) = (v2u){rv.z, rv.w};
    __syncthreads();
    const int ka = r32 * AT_KROW + hi * 16;
    const int va = AT_KBYTES + r32 * AT_VROW + hi * 8;
    for (int t = 0; t < ntile; ++t) {
        LAS unsigned char* cur = lds + (t & 1) * AT_STAGE; LAS unsigned char* nxt = lds + ((t + 1) & 1) * AT_STAGE;
        const bool more = (t + 1 < ntile);
        if (more) { const size_t ko = (size_t)(t + 1) * 64 * QW; rk0 = *(const v4u*)(kg0 + ko); if (tid < 256) rk1 = *(const v4u*)(kg1 + ko); rv = *(const v4u*)(vg + (t + 1) * 64); }
        if (64 * t <= qw0 + 31) {
            f32x16 p0, p1;
#pragma unroll
            for (int r = 0; r < 16; ++r) { p0[r] = nbnd; p1[r] = nbnd; }
#pragma unroll
            for (int s = 0; s < 6; ++s) { const bf16x8 k0 = *(const LAS bf16x8*)(cur + ka + s * 32), k1 = *(const LAS bf16x8*)(cur + ka + 32 * AT_KROW + s * 32);
                p0 = MFMA32(k0, qf[s], p0); p1 = MFMA32(k1, qf[s], p1); }
#pragma unroll
            for (int r = 0; r < 16; ++r) { p0[r] = __builtin_amdgcn_exp2f(p0[r]); p1[r] = __builtin_amdgcn_exp2f(p1[r]); }
            if (64 * t + 63 > qw0) {
                const int qrel = qw0 + r32 - 64 * t;
#pragma unroll
                for (int r = 0; r < 16; ++r) { const int kk = crow32(r, hi); if (kk > qrel) p0[r] = 0.f; if (kk + 32 > qrel) p1[r] = 0.f; }
            }
            float sacc = 0.f;
#pragma unroll
            for (int r = 0; r < 16; ++r) sacc += p0[r] + p1[r];
            lsum += sacc;
            bf16x8 pb[2][2];
#pragma unroll
            for (int s2 = 0; s2 < 2; ++s2) {
                const v4u a = {pg8::cvt_pk_bf16(p0[8 * s2 + 0], p0[8 * s2 + 1]), pg8::cvt_pk_bf16(p0[8 * s2 + 2], p0[8 * s2 + 3]), pg8::cvt_pk_bf16(p0[8 * s2 + 4], p0[8 * s2 + 5]), pg8::cvt_pk_bf16(p0[8 * s2 + 6], p0[8 * s2 + 7])};
                const v4u c = {pg8::cvt_pk_bf16(p1[8 * s2 + 0], p1[8 * s2 + 1]), pg8::cvt_pk_bf16(p1[8 * s2 + 2], p1[8 * s2 + 3]), pg8::cvt_pk_bf16(p1[8 * s2 + 4], p1[8 * s2 + 5]), pg8::cvt_pk_bf16(p1[8 * s2 + 6], p1[8 * s2 + 7])};
                pb[0][s2] = __builtin_bit_cast(bf16x8, a); pb[1][s2] = __builtin_bit_cast(bf16x8, c); }
#pragma unroll
            for (int kh = 0; kh < 2; ++kh)
#pragma unroll
                for (int s2 = 0; s2 < 2; ++s2) {
                    const int ko = (kh * 32 + 16 * s2) * 2;
                    const s16x4 a0 = *(const LAS s16x4*)(cur + va + ko), a1 = *(const LAS s16x4*)(cur + va + ko + 16);
                    const s16x4 c0 = *(const LAS s16x4*)(cur + va + 32 * AT_VROW + ko), c1 = *(const LAS s16x4*)(cur + va + 32 * AT_VROW + ko + 16);
                    const bf16x8 vf0 = {a0[0], a0[1], a0[2], a0[3], a1[0], a1[1], a1[2], a1[3]}, vf1 = {c0[0], c0[1], c0[2], c0[3], c1[0], c1[1], c1[2], c1[3]};
                    o0 = MFMA32(vf0, pb[kh][s2], o0); o1 = MFMA32(vf1, pb[kh][s2], o1); }
        }
        if (more) { *(LAS v4u*)(nxt + kl0) = rk0; if (tid < 256) *(LAS v4u*)(nxt + kl1) = rk1; *(LAS v2u*)(nxt + vl) = (v2u){rv.x, rv.y}; *(LAS v2u*)(nxt + vl + 8) = (v2u){rv.z, rv.w}; }
        __syncthreads();
    }
    lsum += __shfl_xor(lsum, 32);
    const float il = 1.f / lsum;
    bf16* orow = YB + tq * DM + 256 + h * 64;
#pragma unroll
    for (int g = 0; g < 4; ++g) {
        v2u a; a.x = pg8::cvt_pk_bf16(o0[4 * g] * il, o0[4 * g + 1] * il); a.y = pg8::cvt_pk_bf16(o0[4 * g + 2] * il, o0[4 * g + 3] * il); *(v2u*)(orow + 8 * g + 4 * hi) = a;
        v2u c; c.x = pg8::cvt_pk_bf16(o1[4 * g] * il, o1[4 * g + 1] * il); c.y = pg8::cvt_pk_bf16(o1[4 * g + 2] * il, o1[4 * g + 3] * il); *(v2u*)(orow + 32 + 8 * g + 4 * hi) = c; }
}

template <int l> __device__ __forceinline__ void ret_out_chunk(Frame& F, const Args& args, const int ch) {
    unsigned char* ws = K_WS;
    const bf16* P = (const bf16*)(ws + WS_PROJ); const float* RET = (const float*)(ws + WS_RET); bf16* YB = (bf16*)(ws + WS_YB); const float* ret_g = (const float*)K_IN(IN_RETG) + l * 256;
    LAS unsigned char* vT = F.lds + RING_OFF;
    int lane_ = F_LANE; asm volatile("" : "+v"(lane_)); const int lane = lane_, lr = lane & 15, lq = lane >> 4, w = F.wave;
    const int t0 = ch * CHUNK;
    for (int j = 0; j < 16; ++j) { const int s = 16 * w + j; const v2u vv = *(const v2u*)(P + (size_t)(t0 + s) * PROJW + C_RV + 4 * lane);
        *(LAS bf16*)(vT + tofs(4 * lane + 0, s)) = (bf16)(vv.x & 0xffff); *(LAS bf16*)(vT + tofs(4 * lane + 1, s)) = (bf16)(vv.x >> 16);
        *(LAS bf16*)(vT + tofs(4 * lane + 2, s)) = (bf16)(vv.y & 0xffff); *(LAS bf16*)(vT + tofs(4 * lane + 3, s)) = (bf16)(vv.y >> 16); }
    __syncthreads();
    const size_t ti = (size_t)t0 + 16 * w + lr;
#pragma unroll 1
    for (int h = 0; h < NHEAD; ++h) {
        const float gam = __expf(nv::ret_loggamma(h));
        bf16x8 qf[2];
#pragma unroll
        for (int ks = 0; ks < 2; ++ks) qf[ks] = *(const bf16x8*)(P + ti * PROJW + C_RQ + h * 64 + 32 * ks + 8 * lq);
        f32x4 acc[4];
#pragma unroll
        for (int et = 0; et < 4; ++et) acc[et] = (f32x4){0.f, 0.f, 0.f, 0.f};
        for (int kk = 0; kk <= (w >> 1); ++kk) {
            const int jt0 = 2 * kk, jt1 = 2 * kk + 1;
            f32x4 s0 = {0.f, 0.f, 0.f, 0.f}, s1 = {0.f, 0.f, 0.f, 0.f};
#pragma unroll
            for (int ks = 0; ks < 2; ++ks) { const bf16x8 kf = *(const bf16x8*)(P + (size_t)(t0 + jt0 * 16 + lr) * PROJW + C_RK + h * 64 + 32 * ks + 8 * lq); s0 = MFMA16(kf, qf[ks], s0); }
            if (jt1 <= w) {
#pragma unroll
                for (int ks = 0; ks < 2; ++ks) { const bf16x8 kf = *(const bf16x8*)(P + (size_t)(t0 + jt1 * 16 + lr) * PROJW + C_RK + h * 64 + 32 * ks + 8 * lq); s1 = MFMA16(kf, qf[ks], s1); } }
            if (jt0 == w) {
#pragma unroll
                for (int r = 0; r < 4; ++r) if (4 * lq + r > lr) s0[r] = 0.f; }
            if (jt1 == w) {
#pragma unroll
                for (int r = 0; r < 4; ++r) if (4 * lq + r > lr) s1[r] = 0.f; }
            const v4u pw = {pk2(s0[0], s0[1]), pk2(s0[2], s0[3]), pk2(s1[0], s1[1]), pk2(s1[2], s1[3])};
            const bf16x8 pb = __builtin_bit_cast(bf16x8, pw);
#pragma unroll
            for (int et = 0; et < 4; ++et) { const int row = h * 64 + et * 16 + lr;
                const s16x4 a0 = *(const LAS s16x4*)(vT + tofs(row, jt0 * 16 + 4 * lq)), a1 = *(const LAS s16x4*)(vT + tofs(row, (jt1 & 7) * 16 + 4 * lq));
                const bf16x8 vf = {a0[0], a0[1], a0[2], a0[3], a1[0], a1[1], a1[2], a1[3]};
                acc[et] = MFMA16(vf, pb, acc[et]); }
        }
#pragma unroll
        for (int ks = 0; ks < 2; ++ks)
#pragma unroll
            for (int et = 0; et < 4; ++et) { const float* pr = RET + (((size_t)ch * NHEAD + h) * 64 + et * 16 + lr) * 64 + 32 * ks + 8 * lq; const f32x4 x0 = *(const f32x4*)pr, x1 = *(const f32x4*)(pr + 4);
                const v4u pw = {pk2(x0[0] * gam, x0[1] * gam), pk2(x0[2] * gam, x0[3] * gam), pk2(x1[0] * gam, x1[1] * gam), pk2(x1[2] * gam, x1[3] * gam)};
                acc[et] = MFMA16(__builtin_bit_cast(bf16x8, pw), qf[ks], acc[et]); }
        float mu = 0.f;
#pragma unroll
        for (int et = 0; et < 4; ++et) mu += acc[et][0] + acc[et][1] + acc[et][2] + acc[et][3];
        mu += __shfl_xor(mu, 16); mu += __shfl_xor(mu, 32); mu *= (1.f / 64);
        float var = 0.f;
#pragma unroll
        for (int et = 0; et < 4; ++et) { acc[et] = acc[et] - mu; var += acc[et][0] * acc[et][0] + acc[et][1] * acc[et][1] + acc[et][2] * acc[et][2] + acc[et][3] * acc[et][3]; }
        var += __shfl_xor(var, 16); var += __shfl_xor(var, 32);
        const float rs = rsqrtf(var * (1.f / 64) + EPS);
#pragma unroll
        for (int et = 0; et < 4; ++et) { const int c = h * 64 + et * 16 + 4 * lq; const v2u rg = *(const v2u*)(P + ti * PROJW + C_RG + c); const f32x4 g = *(const f32x4*)(ret_g + c);
            const float r0 = bflo_(rg.x), r1 = bfhi_(rg.x), r2 = bflo_(rg.y), r3 = bfhi_(rg.y);
            v2u o; o.x = pk2(r0 * pg8::fast_sigmoid(r0) * acc[et][0] * rs * g[0], r1 * pg8::fast_sigmoid(r1) * acc[et][1] * rs * g[1]);
            o.y = pk2(r2 * pg8::fast_sigmoid(r2) * acc[et][2] * rs * g[2], r3 * pg8::fast_sigmoid(r3) * acc[et][3] * rs * g[3]);
            *(v2u*)(YB + ti * DM + 768 + c) = o; }
    }
    __syncthreads();
}

template <int l> __device__ __forceinline__ void attn_phase(Frame& F, const Args& args) {
    for (int p = F.vcu; p < NBATCH * NHEAD * 32; p += F.G) {
        const int bh = p >> 5, s = p & 31; const float nbnd = -((const float*)(K_WS + WS_BND))[l];
        attn_unit(F, (const bf16*)(K_WS + WS_Q), (const bf16*)(K_WS + WS_K), (const bf16*)(K_WS + WS_VT), (bf16*)(K_WS + WS_YB), nbnd, bh / NHEAD, bh % NHEAD, 63 - s);
        attn_unit(F, (const bf16*)(K_WS + WS_Q), (const bf16*)(K_WS + WS_K), (const bf16*)(K_WS + WS_VT), (bf16*)(K_WS + WS_YB), nbnd, bh / NHEAD, bh % NHEAD, s);
    }
    for (int ch = F.vcu; ch < NTOK / CHUNK; ch += F.G) ret_out_chunk<l>(F, args, ch);
}
#ifndef MEGA_THIN
#define MEGA_THIN 0
#endif

#ifndef RPT_MASK
#define RPT_MASK 0
#endif
#define RPT(bit) _Pragma("unroll") for (int rep_ = 0; rep_ < 1 + ((RPT_MASK >> (bit)) & 1); ++rep_)
__device__ __forceinline__ bool in_range(int k, int lo, int hi) { asm volatile("" : "+s"(lo)); return lo <= k && k < hi; }
#define IN(k) (in_range((k), lo, hi))
#define SEAM(k) do { if (IN(k) && IN((k) + 1)) xcd_barrier(bar, F.wave); } while (0)
#define INF(i) ((const float*)K_IN(i))
template <int l> __device__ __forceinline__ void layer_phases(Frame& F, const Args& args, const XcdBarrier& bar, const int lo, const int hi) {
#define ws (K_WS)
#define ADA ((float*)(K_WS + WS_ADA))
#define bH ((bf16*)(K_WS + WS_H))
#define bYB ((bf16*)(K_WS + WS_YB))
#define bP ((bf16*)(K_WS + WS_PROJ))
#define bG ((bf16*)(K_WS + WS_G))
#define bMG bYB
#define bU bP
#define bX (K_OUT)
#define ring (F.lds + RING_OFF)
#define ada_l (ADA + (size_t)l * 2 * 6 * DM)
#define Xin ((l == 0) ? INF(IN_X) : (const float*)bX)
#define WIN_T ((const bf16*)(K_WS + WS_WIN_T) + (size_t)l * 6912 * DM)

        if (IN(PHL(l, PL_NORM1))) { RPT(8) {
#if MEGA_THIN >= 1
            norm_phase(F, Xin, bH, INF(IN_N1G) + l * DM, ada_l, A_SH1, A_SC1, nullptr, nullptr, nullptr, nullptr);
#endif
        } }
        SEAM(PHL(l, PL_NORM1));
        if (IN(PHL(l, PL_INPROJ))) { RPT(1) {
            pg8::DenseOrder S{(const char*)bH, (const char*)WIN_T, (size_t)256 * DM * 2, (size_t)256 * DM * 2, NTOK / 256, PROJW / 256, F.G, (int)blockIdx.x};
            pg8::EpiBf16<0> E{bP, PROJW, 0};
            pg8::gemm_phase(ring, F.wave, DM, DM, DM, S, E);
        } }
        SEAM(PHL(l, PL_INPROJ));
        if (IN(PHL(l, PL_PRE))) {
#if MEGA_THIN >= 2
            pre_phase<l>(F, args);
#endif
        }
        SEAM(PHL(l, PL_PRE));
        if (IN(PHL(l, PL_SCAN))) {
#if MEGA_THIN >= 1
            scan_phase(F, (float*)(ws + WS_RET));
#endif
        }
        SEAM(PHL(l, PL_SCAN));
        if (IN(PHL(l, PL_ATTN))) { RPT(2) {
#if MEGA_THIN >= 3
            attn_phase<l>(F, args);
#endif
        } }
        SEAM(PHL(l, PL_ATTN));
        if (IN(PHL(l, PL_GATE))) { RPT(3) {
            pg8::MergeOrder S{(const char*)bYB, (const char*)((const bf16*)(K_WS + WS_WBR_T) + (size_t)l * 4 * DM * MIXW), NTOK / 256, DM / 256, F.G, (int)blockIdx.x};
            pg8::EpiBf16<0> E{bG, GATEW, DM};
            int kz = MIXW; asm volatile("" : "+s"(kz));
            pg8::gemm_phase(ring, F.wave, DM, MIXW, kz, S, E);
        } }
        SEAM(PHL(l, PL_GATE));
        if (IN(PHL(l, PL_MERGE))) { RPT(4) {
            pg8::DenseOrder S{(const char*)bH, (const char*)(WIN_T + (size_t)PROJW * DM), (size_t)256 * DM * 2, (size_t)256 * DM * 2, NTOK / 256, GATEW / 256, F.G, (int)blockIdx.x};
            pg8::EpiGM E{bG, bMG};
            pg8::gemm_phase(ring, F.wave, DM, DM, DM, S, E);
        } }
        SEAM(PHL(l, PL_MERGE));
        if (IN(PHL(l, PL_WO))) {
            pg8::DenseOrder S{(const char*)bMG, (const char*)((const bf16*)(ws + WS_WO_T) + (size_t)l * DM * DM), (size_t)256 * DM * 2, (size_t)256 * DM * 2, NTOK / 256, DM / 256, F.G, (int)blockIdx.x};
            pg8::EpiResid E{Xin, bX, ada_l + A_G1};
            pg8::gemm_phase(ring, F.wave, DM, DM, DM, S, E);
        }
        SEAM(PHL(l, PL_WO));
        if (IN(PHL(l, PL_NORM2))) {
#if MEGA_THIN >= 1
            if (l == 0) norm_phase(F, bX, bH, INF(IN_N2G) + l * DM, ada_l, A_SH2, A_SC2, nullptr, nullptr, nullptr, nullptr);
            else norm_phase(F, bX, bH, INF(IN_N2G) + l * DM, ada_l, A_SH2, A_SC2, INF(IN_RW), INF(IN_RB), (nv::Route*)(ws + WS_ROUTE), (int*)(ws + WS_CNT));
#endif
        }
        SEAM(PHL(l, PL_NORM2));
        if constexpr (l == 0) {
            if (IN(PHL(l, PL_F0))) { RPT(5) {
                pg8::DenseOrder S{(const char*)bH, (const char*)(ws + WS_F13_T), (size_t)256 * DM * 2, (size_t)256 * DM * 2, NTOK / 256, 2 * DFF / 256, F.G, (int)blockIdx.x};
                pg8::EpiSwiglu E{bU, DFF};
                pg8::gemm_phase(ring, F.wave, DM, DM, DM, S, E);
            } }
            SEAM(PHL(l, PL_F0));
            if (IN(PHL(l, PL_F1))) {
                pg8::DenseOrder S{(const char*)bU, (const char*)(ws + WS_F2_T), (size_t)256 * DFF * 2, (size_t)256 * DFF * 2, NTOK / 256, DM / 256, F.G, (int)blockIdx.x};
                pg8::EpiResid E{bX, bX, ada_l + A_G2};
                pg8::gemm_phase(ring, F.wave, DFF, DFF, DFF, S, E);
            }
            SEAM(PHL(l, PL_F1));
        } else {
#define XS ((bf16*)(K_WS + WS_XS))
#define HID ((bf16*)(K_WS + WS_HID))
#define PEXP ((const int*)(K_WS + WS_PEXP))
#define PSLOT ((const float*)(K_WS + WS_PSLOT))
            if (IN(PHL(l, PL_F0))) {
#if MEGA_THIN >= 1
                moe_assign_phase(F, args);
#endif
                convert_job(F, INF(IN_M1), (size_t)DM * DFFE, DM, DFFE, (bf16*)(ws + WS_MW13_T), (size_t)2 * DFFE * DM, DM, 2, nullptr, NEXP, 0);
                convert_job(F, INF(IN_M3), (size_t)DM * DFFE, DM, DFFE, (bf16*)(ws + WS_MW13_T), (size_t)2 * DFFE * DM, DM, 3, nullptr, NEXP, 0);
                convert_job(F, INF(IN_M2), (size_t)DFFE * DM, DFFE, DM, (bf16*)(ws + WS_MW2_T), (size_t)DM * DFFE, DFFE, 0, nullptr, NEXP, 0);
            }
            SEAM(PHL(l, PL_F0));
            for (int c = 0; c < NCH; ++c) {
                const int p0 = c * CH0_PANELS; int npan = PEXP[MAXPANEL] - p0; { const int cap = (c == 0) ? CH0_PANELS : CH1_PANELS; npan = npan > cap ? cap : npan; }
                if (IN(PHL(l, PL_F1 + 2 * c))) { RPT(6) {
                    pg8::MoeOrder S{(const char*)(XS + (size_t)p0 * 256 * DM), (const char*)(ws + WS_MW13_T), (size_t)256 * DM * 2, (size_t)256 * DM * 2, PEXP, p0, npan, 2 * DFFE / 256, F.G, (int)blockIdx.x};
                    pg8::EpiSwiglu E{HID, DFFE};
                    pg8::gemm_phase(ring, F.wave, DM, DM, DM, S, E);
                } }
                SEAM(PHL(l, PL_F1 + 2 * c));
                if (IN(PHL(l, PL_F2 + 2 * c))) { RPT(7) {
                    pg8::MoeOrder S{(const char*)HID, (const char*)(ws + WS_MW2_T), (size_t)256 * DFFE * 2, (size_t)256 * DFFE * 2, PEXP, p0, npan, DM / 256, F.G, (int)blockIdx.x};
                    pg8::EpiMoeDown E{XS + (size_t)p0 * 256 * DM, PSLOT + p0 * 256};
                    pg8::gemm_phase(ring, F.wave, DFFE, DFFE, DFFE, S, E);
                } }
                SEAM(PHL(l, PL_F2 + 2 * c));
            }
            if (IN(PHL(l, PL_F5))) {
#if MEGA_THIN >= 1
                moe_combine_phase(F, bX, XS, (const int*)(ws + WS_SLOT), ada_l + A_G2);
#endif
            }
        }
#undef XS
#undef HID
#undef PEXP
#undef PSLOT
#undef ws
#undef ADA
#undef bH
#undef bYB
#undef bP
#undef bG
#undef bMG
#undef bU
#undef bX
#undef ring
#undef ada_l
#undef Xin
#undef WIN_T
}

__global__ void __launch_bounds__(NWAVES * 64, 2) mega(Args args) {
    extern __shared__ __attribute__((aligned(16))) unsigned char lds_raw[];
    Frame F;
    F.lds = (LAS unsigned char*)lds_raw;
    F.MISC = (volatile LAS unsigned*)(F.lds + MISC_OFF);
    F.wave = __builtin_amdgcn_readfirstlane((int)threadIdx.x >> 6);
    F.G = gridDim.x; { const int bx = blockIdx.x; F.vcu = (F.G % 8 == 0) ? (bx % 8) * (F.G / 8) + bx / 8 : bx; }
    unsigned char* ws = K_WS;
    F.ctl = (unsigned*)(ws + WS_CTL);
    for (int u = F_TID; u < (LDS_BYTES - LDSCTL_OFF) / 4; u += NWAVES * 64) ((LAS unsigned*)(F.lds + LDSCTL_OFF))[u] = 0u;
    __syncthreads();
    XcdBarrier bar = xcd_barrier_post(F.ctl + CW_BAR + args.li * XCD_BAR_WORDS, F.MISC + 8);
    const int lo = args.ph_lo, hi = args.ph_hi;
    float* ADA = (float*)(ws + WS_ADA); float* BND = (float*)(ws + WS_BND);
    LAS unsigned char* ring = F.lds + RING_OFF;

    if (IN(PH_PRO)) { RPT(0) {
        for (int it = F.vcu; it < DEPTH * 24; it += F.G) {
            const int l = it / 24, j0 = (it % 24) * 256; const float* c = INF(IN_C);
            const float* w = INF(IN_ADAW) + (size_t)l * DM * 6 * DM + j0 + 4 * F_LANE;
            float a0[4] = {0.f, 0.f, 0.f, 0.f}, a1[4] = {0.f, 0.f, 0.f, 0.f};
#pragma unroll 8
            for (int kk = 0; kk < 128; ++kk) { const int k = F.wave * 128 + kk; const float4 wv = *(const float4*)(w + (size_t)k * 6 * DM); const float s0 = silu_f(c[k]), s1 = silu_f(c[DM + k]);
                a0[0] += s0 * wv.x; a0[1] += s0 * wv.y; a0[2] += s0 * wv.z; a0[3] += s0 * wv.w; a1[0] += s1 * wv.x; a1[1] += s1 * wv.y; a1[2] += s1 * wv.z; a1[3] += s1 * wv.w; }
            LAS float* red = (LAS float*)ring;
#pragma unroll
            for (int i = 0; i < 4; ++i) { red[(F.wave * 2 + 0) * 256 + 4 * F_LANE + i] = a0[i]; red[(F.wave * 2 + 1) * 256 + 4 * F_LANE + i] = a1[i]; }
            __syncthreads();
            { const int b = F_TID >> 8, col = F_TID & 255; float s = INF(IN_ADAB)[l * 6 * DM + j0 + col];
#pragma unroll
              for (int w8 = 0; w8 < 8; ++w8) s += red[(w8 * 2 + b) * 256 + col];
              ADA[(size_t)(l * 2 + b) * 6 * DM + j0 + col] = s; }
            __syncthreads();
        }
        if (blockIdx.x == 0 && F_TID < DEPTH) { const int l = F_TID; float a = 0.f, b = 0.f;
            for (int i = 0; i < QKH; ++i) { a = fmaxf(a, fabsf(INF(IN_QNG)[l * QKH + i])); b = fmaxf(b, fabsf(INF(IN_KNG)[l * QKH + i])); }
            BND[l] = 9.797958971132712f * 1.4426950408889634f * a * b * 1.001f; }
        { bf16* WST = (bf16*)(ws + WS_WS_T); const float* wsrc = INF(IN_WS);
          for (int i = (F.vcu * NWAVES * 64 + F_TID); i < DEPTH * 4 * 128 * 128; i += F.G * NWAVES * 64) { const int t = (i >> 7) & 127, s = i & 127; WST[i] = (s <= t) ? f2bf(wsrc[i]) : (bf16)0; } }
        int rot = 0;
        convert_job(F, INF(IN_WIN), (size_t)DM * D_IN, DM, D_IN, (bf16*)(ws + WS_WIN_T), (size_t)6912 * DM, DM, 1, nullptr, DEPTH, rot); rot += 331;
        convert_job(F, INF(IN_WBR), (size_t)MIXW * DM, MIXW, DM, (bf16*)(ws + WS_WBR_T), (size_t)DM * MIXW, MIXW, 0, nullptr, DEPTH * 4, rot); rot += 331;
        convert_job(F, INF(IN_WO), (size_t)DM * DM, DM, DM, (bf16*)(ws + WS_WO_T), (size_t)DM * DM, DM, 0, nullptr, DEPTH, rot); rot += 331;
        convert_job(F, INF(IN_F1), 0, DM, DFF, (bf16*)(ws + WS_F13_T), 0, DM, 2, nullptr, 1, rot); rot += 331;
        convert_job(F, INF(IN_F3), 0, DM, DFF, (bf16*)(ws + WS_F13_T), 0, DM, 3, nullptr, 1, rot); rot += 331;
        convert_job(F, INF(IN_F2), 0, DFF, DM, (bf16*)(ws + WS_F2_T), 0, DFF, 0, nullptr, 1, rot); rot += 331;
        for (int l = 0; l < DEPTH; ++l) {
            convert_job(F, INF(IN_WUQ) + (size_t)l * 256 * QW, 0, 256, QW, (bf16*)(ws + WS_WUQ_T) + (size_t)l * QW * 256, 0, 256, 0, INF(IN_CQG) + l * 256, 1, rot); rot += 331;
            convert_job(F, INF(IN_WUKV) + (size_t)l * 128 * 512, 0, 128, 512, (bf16*)(ws + WS_WUKV_T) + (size_t)l * 512 * 128, 0, 128, 0, INF(IN_CKVG) + l * 128, 1, rot); rot += 331;
        }
    } }
    SEAM(PH_PRO);

    layer_phases<0>(F, args, bar, lo, hi);
    layer_phases<1>(F, args, bar, lo, hi);
}
#undef IN
#undef SEAM
#undef INF
static int g_grid = 0;
static bool mega_setup() {
    if (g_grid) return g_grid > 0;
    int dev = 0, cus = 0;
    if (hipGetDevice(&dev) != hipSuccess || hipDeviceGetAttribute(&cus, hipDeviceAttributeMultiprocessorCount, dev) != hipSuccess) { g_grid = -1; return false; }
    if (hipFuncSetAttribute((const void*)mega, hipFuncAttributeMaxDynamicSharedMemorySize, LDS_BYTES) != hipSuccess) { fprintf(stderr, "mega: hipFuncSetAttribute failed\n"); g_grid = -1; return false; }
    int per_cu = 0; (void)hipOccupancyMaxActiveBlocksPerMultiprocessor(&per_cu, (const void*)mega, NWAVES * 64, LDS_BYTES); (void)hipGetLastError();
    if (per_cu < 1) { fprintf(stderr, "mega: occupancy query reports %d workgroups per CU\n", per_cu); g_grid = -1; return false; }
    g_grid = cus; return true;
}
extern "C" void kernel_launch(void* const* d_in, const int* in_sizes, int n_in, void* d_out, int out_size, void* d_ws, size_t ws_size, hipStream_t stream) {
    if (n_in != 29 || out_size != NTOK * DM || ws_size < WS_END) { fprintf(stderr, "kernel_launch: unexpected sizes n_in %d out %d ws %zu\n", n_in, out_size, ws_size); return; }
    if (!mega_setup()) return;
    (void)hipMemsetAsync((char*)d_ws + WS_CTL, 0, CTL_ZERO_BYTES, stream);
    Args a{}; for (int i = 0; i < N_IN; ++i) a.in[i] = d_in[i];
    a.out = (float*)d_out; a.ws = (unsigned char*)d_ws; a.ph_lo = 0; a.ph_hi = N_PHASES; a.li = 0; a.pad = 0;
    hipLaunchKernelGGL(mega, dim3(g_grid), dim3(NWAVES * 64), LDS_BYTES, stream, a);
}
```

```cpp
#define MEGA_THIN 3
#include <hip/hip_runtime.h>
#include <cstdio>
#include <cstdint>
#include <cmath>

constexpr int DM = 1024, NBATCH = 2, SEQ = 16384, NTOK = NBATCH * SEQ, DEPTH = 2;
constexpr int MIXW = 256, D_IN = 6816, PROJW = 2816, GATEW = 4096, NPROJ_SRC = 2720;
constexpr int QKH = 96, NHEAD = 4, QW = NHEAD * QKH  , DFF = 2816, NEXP = 8, DFFE = 3584;
constexpr int CHUNK = 128, NCHUNK = SEQ / CHUNK  ;
constexpr float EPS = 1e-6f;
constexpr int C_AB = 0, C_AC = 256, C_AX = 512, C_CQ = 768, C_CKV = 1024, C_KR = 1152, C_SU = 1280, C_SV = 1536, C_RQ = 1792, C_RK = 2048, C_RV = 2304, C_RG = 2560;
constexpr int A_SH1 = 0, A_SC1 = 1024, A_G1 = 2048, A_SH2 = 3072, A_SC2 = 4096, A_G2 = 5120;
constexpr float ATT_C2 = 0.10206207261596575f * 1.4426950408889634f;

constexpr size_t MiB = 1u << 20;
constexpr size_t WS_CTL = 0, CTL_ZERO_BYTES = 1 * MiB;
constexpr size_t WS_ADA = 1 * MiB;
constexpr size_t WS_PSLOT = 1 * MiB + 256 * 1024;
constexpr size_t WS_PEXP = 1 * MiB + 768 * 1024;
constexpr size_t WS_BND = 1 * MiB + 800 * 1024;
constexpr size_t WS_ROUTE = 2 * MiB;
constexpr size_t WS_CNT = 2 * MiB + 512 * 1024;
constexpr size_t WS_SLOT = 2 * MiB + 768 * 1024;
constexpr size_t WS_WUQ_T = 3 * MiB;
constexpr size_t WS_WUKV_T = 3 * MiB + 512 * 1024;
constexpr size_t WS_WS_T = 3 * MiB + 768 * 1024;
constexpr size_t WS_WIN_T = 4 * MiB;
constexpr size_t WS_WBR_T = 31 * MiB;
constexpr size_t WS_WO_T = 35 * MiB;
constexpr size_t WS_F13_T = 39 * MiB;
constexpr size_t WS_F2_T = 50 * MiB;
constexpr size_t WS_H = 56 * MiB;
constexpr size_t WS_YB = 120 * MiB;
constexpr size_t WS_PROJ = 184 * MiB;
constexpr size_t WS_Q = 360 * MiB, WS_K = 384 * MiB, WS_VT = 408 * MiB;
constexpr size_t WS_RET = 424 * MiB;
constexpr size_t WS_G = 184 * MiB;
constexpr size_t WS_MIX_END = 440 * MiB;
constexpr size_t WS_H8 = 440 * MiB;
constexpr size_t WS_SH = 472 * MiB;
constexpr size_t WS_SW = 472 * MiB + 256 * 1024;
constexpr int CW_AMAXF = 230000;
constexpr size_t WS_SWF = 472 * MiB + 256 * 1024 + 64 * 1024;
constexpr int CW_AMAX = 200000;
constexpr int MAXPANEL = 264, MAXSLOT = MAXPANEL * 256, NCH = 2, CH0_PANELS = 128, CH1_PANELS = MAXPANEL - CH0_PANELS;
constexpr size_t WS_HID = 56 * MiB;
constexpr size_t WS_SCT = 176 * MiB;
constexpr size_t WS_MW13_T = 296 * MiB;
constexpr size_t WS_MW2_T = 352 * MiB;
constexpr size_t WS_XS = 464 * MiB;
constexpr size_t WS_PART = 596 * MiB;
constexpr int MAXTAIL = 8;
constexpr size_t WS_XS8 = 530 * MiB;
constexpr size_t WS_AMAXM = 612 * MiB;
constexpr size_t WS_SXS = 612 * MiB + 256 * 1024;
constexpr size_t WS_SWM = 612 * MiB + 576 * 1024;
constexpr size_t WS_SWM2 = 612 * MiB + 800 * 1024;
constexpr int AMAXM_W2 = 2 * NEXP * DFFE;
constexpr size_t WS_XB = 474 * MiB;
constexpr size_t WS_END = 613 * MiB;
static_assert(WS_HID + (size_t)CH1_PANELS * 256 * DFFE <= WS_SCT && WS_SCT + (size_t)CH1_PANELS * 28 * 1024 <= WS_MW13_T, "hid");
static_assert(WS_XS + (size_t)MAXSLOT * DM * 2 <= WS_END, "xs");
static_assert(WS_MW13_T >= WS_MIX_END - 256 * MiB, "moe weights may overlay dead mixer buffers only");

typedef unsigned short bf16;
__device__ __forceinline__ float bf2f(bf16 v) { return __uint_as_float(((unsigned)v) << 16); }
__device__ __forceinline__ bf16 f2bf(float f) { unsigned u = __float_as_uint(f); return (bf16)((u + 0x7fffu + ((u >> 16) & 1u)) >> 16); }
__device__ __forceinline__ float bfr(float f) { return bf2f(f2bf(f)); }
__device__ __forceinline__ float silu_f(float x) { return x / (1.f + __expf(-x)); }
__device__ __forceinline__ float sigmoid_f(float x) { return 1.f / (1.f + __expf(-x)); }
__device__ __forceinline__ float gelu_tanh(float x) { const float u = 0.7978845608028654f * (x + 0.044715f * x * x * x); return 0.5f * x * (1.f + tanhf(u)); }

__device__ __forceinline__ int lane_id() { unsigned z = 0u; asm volatile("" : "+s"(z)); return (int)__builtin_amdgcn_mbcnt_hi(~0u, __builtin_amdgcn_mbcnt_lo(~0u, z)); }

namespace nv {
struct Route { int e0, e1; float p0, p1; };
__device__ __forceinline__ float ret_loggamma(int h) { return log1pf(-exp2f(-5.f - (float)h)); }
}
namespace pg8 {
#define PG8_LAS __attribute__((address_space(3)))
typedef short bf16x8 __attribute__((ext_vector_type(8)));
typedef float f32x4 __attribute__((ext_vector_type(4)));
typedef float f32x2 __attribute__((ext_vector_type(2)));
typedef unsigned u32x4 __attribute__((ext_vector_type(4)));
typedef unsigned u32x2 __attribute__((ext_vector_type(2)));
constexpr int BM = 256, BK = 64, HALF = 128, HTB = HALF * BK * 2  , STAGE_BYTES = 8 * HTB, NXCD = 8, WGM = 8;

__host__ __device__ __forceinline__ int lds_byte(int r, int c) { const int st = (r >> 4) * 2 + (c >> 5), rr = r & 15, cc = c & 31, ob = rr * 64 + cc * 2; return st * 1024 + (ob ^ (((ob >> 9) & 1) << 5)); }
__host__ __device__ __forceinline__ void stage_rc(int b, int& R, int& C) { const int st = b / 1024, sb = b % 1024, swz = sb ^ (((sb >> 9) & 1) << 5); R = (st >> 1) * 16 + swz / 64; C = (st & 1) * 32 + (swz % 64) / 2; }
__host__ __device__ __forceinline__ int perm32(int rho) { const int n = rho >> 4, i = rho & 15; return 8 * (i >> 2) + 4 * n + (i & 3); }

struct Unit { const char* A; const char* B; const char* S; int pm, pn, aux, pad; };

__device__ __forceinline__ bool static_tile(int i, int G, int c, int nM, int nN, int& pm, int& pn) {
    const int nwg = nM * nN; const long L = (long)i * G + c; if (L >= nwg) return false;
    int wgid = (int)L; { const int q = nwg / NXCD, r = nwg % NXCD, xcd = wgid % NXCD, off = wgid / NXCD; wgid = (xcd < r ? xcd * (q + 1) : r * (q + 1) + (xcd - r) * q) + off; }
    const int nig = WGM * nN, gid = wgid / nig, fm = gid * WGM, gsz = (nM - fm) < WGM ? (nM - fm) : WGM;
    pm = fm + ((wgid % nig) % gsz); pn = (wgid % nig) / gsz; return true;
}
struct DenseOrder {
    const char* A; const char* B; size_t tA, tB; int nM, nN, G, c, rev = 0;
    __device__ __forceinline__ bool next(int i, Unit& u) const { int pm, pn; if (!static_tile(i, G, c, nM, nN, pm, pn)) return false; pm ^= rev; u.pm = pm; u.pn = pn; u.aux = 0; u.A = A + (size_t)pm * tA; u.B = B + (size_t)pn * tB; return true; }
};
struct ZOrder {
    const char* A; const char* B; int nM, G, c;
    __device__ __forceinline__ bool next(int i, Unit& u) const { int pm, pn; if (!static_tile(i, G, c, nM, 16, pm, pn)) return false; const int n = pn >> 2; u.pm = pm; u.pn = pn; u.aux = n;
        u.A = A + (size_t)pm * (256 * 1024 * 2) + n * 512; u.B = B + (size_t)n * (1024 * 256 * 2) + (size_t)(pn & 3) * (256 * 256 * 2); return true; }
};
struct MergeOrder {
    const char* A; const char* B; int nM, nN, G, c;
    __device__ __forceinline__ bool next(int i, Unit& u) const { int pm, pn; if (!static_tile(i >> 2, G, c, nM, nN, pm, pn)) return false; const int n = i & 3; u.pm = pm; u.pn = pn; u.aux = n;
        u.A = A + (size_t)pm * (256 * 1024 * 2) + n * 512; u.B = B + (size_t)n * (1024 * 256 * 2) + (size_t)pn * (256 * 256 * 2); return true; }
};
struct MoeOrder {
    const char* A; const char* B; size_t tA, tB; const int* pexp; int p0, nM, nN, G, c;
    __device__ __forceinline__ bool next(int i, Unit& u) const { int pm, pn; if (nM <= 0 || !static_tile(i, G, c, nM, nN, pm, pn)) return false; const int e = pexp[p0 + pm]; u.pm = pm; u.pn = pn; u.aux = e;
        u.A = A + (size_t)pm * tA; u.B = B + ((size_t)e * nN + pn) * tB; return true; }
};

typedef __bf16 bf16x2_t __attribute__((ext_vector_type(2)));
__device__ __forceinline__ unsigned cvt_pk_bf16(float lo, float hi) { const f32x2 v = {lo, hi}; return __builtin_bit_cast(unsigned, __builtin_convertvector(v, bf16x2_t)); }
__device__ __forceinline__ float fast_sigmoid(float x) { return __builtin_amdgcn_rcpf(1.f + __builtin_amdgcn_exp2f(-1.4426950408889634f * x)); }
__device__ __forceinline__ float bflo(unsigned w) { return __uint_as_float(w << 16); }
__device__ __forceinline__ float bfhi(unsigned w) { return __uint_as_float(w & 0xffff0000u); }

template <int ACT  > struct EpiBf16 {
    static constexpr bool PERM = true; static constexpr int NST = 16;
    bf16* O; int ldc, aux_cols;
    __device__ __forceinline__ void operator()(const f32x4 (&acc)[2][2][4][2], const Unit& u, int wr, int wc, int fr, int fq) const {
        const int row0 = u.pm * BM + wr * 64 + fr, col0 = u.aux * aux_cols + u.pn * BM + wc * 32 + 8 * fq;
#pragma unroll
        for (int ai = 0; ai < 2; ++ai)
#pragma unroll
            for (int m = 0; m < 4; ++m) { bf16* rowp = O + (size_t)(row0 + ai * HALF + m * 16) * ldc + col0;
#pragma unroll
                for (int bj = 0; bj < 2; ++bj) { f32x4 v0 = acc[ai][bj][m][0], v1 = acc[ai][bj][m][1];
                    if (ACT == 2) {
#pragma unroll
                        for (int i = 0; i < 4; ++i) { v0[i] = fast_sigmoid(v0[i]); v1[i] = fast_sigmoid(v1[i]); } }
                    u32x4 w; w.x = cvt_pk_bf16(v0[0], v0[1]); w.y = cvt_pk_bf16(v0[2], v0[3]); w.z = cvt_pk_bf16(v1[0], v1[1]); w.w = cvt_pk_bf16(v1[2], v1[3]);
                    *(u32x4*)(rowp + bj * HALF) = w; } }
    }
};
struct EpiSwiglu {
    static constexpr bool PERM = true; static constexpr int NST = 8;
    bf16* O; int ldc;
    __device__ __forceinline__ void operator()(const f32x4 (&acc)[2][2][4][2], const Unit& u, int wr, int wc, int fr, int fq) const {
        const int row0 = u.pm * BM + wr * 64 + fr, col0 = u.pn * HALF + wc * 32 + 8 * fq;
#pragma unroll
        for (int ai = 0; ai < 2; ++ai)
#pragma unroll
            for (int m = 0; m < 4; ++m) { bf16* rowp = O + (size_t)(row0 + ai * HALF + m * 16) * ldc + col0; float r[8];
#pragma unroll
                for (int n = 0; n < 2; ++n)
#pragma unroll
                    for (int i = 0; i < 4; ++i) { const float a = acc[ai][0][m][n][i], b = acc[ai][1][m][n][i]; r[n * 4 + i] = a * fast_sigmoid(a) * b; }
                u32x4 w; w.x = cvt_pk_bf16(r[0], r[1]); w.y = cvt_pk_bf16(r[2], r[3]); w.z = cvt_pk_bf16(r[4], r[5]); w.w = cvt_pk_bf16(r[6], r[7]);
                *(u32x4*)rowp = w; }
    }
};
struct EpiSwiglu8 {
    static constexpr bool PERM = true; static constexpr int NST = 8;
    bf16* O; int ldc; const float* sx; const float* sw;
    __device__ __forceinline__ void operator()(const f32x4 (&acc)[2][2][4][2], const Unit& u, int wr, int wc, int fr_, int fq_) const {
        int fr = fr_, fq = fq_; asm volatile("" : "+v"(fr), "+v"(fq));
        const int row0 = u.pm * BM + wr * 64 + fr, col0 = u.pn * HALF + wc * 32 + 8 * fq; const float* swp = sw + (size_t)u.aux * (2 * DFFE) + u.pn * 256 + wc * 32 + 8 * fq;
        const f32x4 sa0 = *(const f32x4*)swp, sa1 = *(const f32x4*)(swp + 4), sb0 = *(const f32x4*)(swp + 128), sb1 = *(const f32x4*)(swp + 132);
#pragma unroll
        for (int ai = 0; ai < 2; ++ai)
#pragma unroll
            for (int m = 0; m < 4; ++m) { const int row = row0 + ai * HALF + m * 16; const float rs = sx[row]; bf16* rowp = O + (size_t)row * ldc + col0; float r[8];
#pragma unroll
                for (int n = 0; n < 2; ++n) { const f32x4 ca = (n == 0 ? sa0 : sa1) * rs, cb = (n == 0 ? sb0 : sb1) * rs;
#pragma unroll
                    for (int i = 0; i < 4; ++i) { const float a = acc[ai][0][m][n][i] * ca[i], b = acc[ai][1][m][n][i] * cb[i]; r[n * 4 + i] = a * fast_sigmoid(a) * b; } }
                u32x4 w; w.x = cvt_pk_bf16(r[0], r[1]); w.y = cvt_pk_bf16(r[2], r[3]); w.z = cvt_pk_bf16(r[4], r[5]); w.w = cvt_pk_bf16(r[6], r[7]);
                *(u32x4*)rowp = w; }
    }
};
struct EpiSwiglu8X {
    static constexpr bool PERM = true; static constexpr int NST = 10;
#ifdef PROBE_X8
    static constexpr bool PROBE_REP = true;
#endif
    unsigned char* O8; unsigned char* SCT; const float* sx; const float* sw;
    __device__ __forceinline__ void operator()(const f32x4 (&acc)[2][2][4][2], const Unit& u, int wr, int wc, int fr_, int fq_) const {
        int fr = fr_, fq = fq_; asm volatile("" : "+v"(fr), "+v"(fq));
        const int row0 = u.pm * BM + wr * 64 + fr, col0 = u.pn * HALF + wc * 32 + 8 * fq; const float* swp = sw + (size_t)u.aux * (2 * DFFE) + u.pn * 256 + wc * 32 + 8 * fq;
        constexpr float NL = -1.4426950408889634f, NIL = -0.6931471805599453f;
        f32x2 sa[4], sb[4];
        { const f32x4 x0 = *(const f32x4*)swp, x1 = *(const f32x4*)(swp + 4), y0 = *(const f32x4*)(swp + 128), y1 = *(const f32x4*)(swp + 132);
          sa[0] = (f32x2){x0[0], x0[1]} * NL; sa[1] = (f32x2){x0[2], x0[3]} * NL; sa[2] = (f32x2){x1[0], x1[1]} * NL; sa[3] = (f32x2){x1[2], x1[3]} * NL;
          sb[0] = (f32x2){y0[0], y0[1]} * NIL; sb[1] = (f32x2){y0[2], y0[3]} * NIL; sb[2] = (f32x2){y1[0], y1[1]} * NIL; sb[3] = (f32x2){y1[2], y1[3]} * NIL; }
        float rsv[2][4];
#pragma unroll
        for (int ai = 0; ai < 2; ++ai)
#pragma unroll
            for (int m = 0; m < 4; ++m) rsv[ai][m] = sx[row0 + ai * HALF + m * 16];
#pragma unroll
        for (int ai = 0; ai < 2; ++ai) { unsigned sd = 0u;
#pragma unroll
            for (int m = 0; m < 4; ++m) { const int row = row0 + ai * HALF + m * 16; const float rs = rsv[ai][m]; f32x2 hp[4], na[4], dn[4]; float amax = 0.f;
#pragma unroll
                for (int j = 0; j < 4; ++j) { const f32x2 A = {acc[ai][0][m][j >> 1][(j & 1) * 2], acc[ai][0][m][j >> 1][(j & 1) * 2 + 1]}; na[j] = A * (sa[j] * rs); }
#pragma unroll
                for (int j = 0; j < 4; ++j) { dn[j][0] = __builtin_amdgcn_exp2f(na[j][0]); dn[j][1] = __builtin_amdgcn_exp2f(na[j][1]); }
#pragma unroll
                for (int j = 0; j < 4; ++j) { const f32x2 B = {acc[ai][1][m][j >> 1][(j & 1) * 2], acc[ai][1][m][j >> 1][(j & 1) * 2 + 1]}; hp[j] = na[j] * (B * sb[j]); dn[j] = dn[j] + 1.f; }
#pragma unroll
                for (int j = 0; j < 4; ++j) { dn[j][0] = __builtin_amdgcn_rcpf(dn[j][0]); dn[j][1] = __builtin_amdgcn_rcpf(dn[j][1]); }
#pragma unroll
                for (int j = 0; j < 4; ++j) { hp[j] = hp[j] * dn[j]; amax = fmaxf(fmaxf(amax, fabsf(hp[j][0])), fabsf(hp[j][1])); }
                { const auto r16 = __builtin_amdgcn_permlane16_swap(__float_as_uint(amax), __float_as_uint(amax), false, false); amax = fmaxf(__uint_as_float(r16[0]), __uint_as_float(r16[1]));
                  const auto r32 = __builtin_amdgcn_permlane32_swap(__float_as_uint(amax), __float_as_uint(amax), false, false); amax = fmaxf(__uint_as_float(r32[0]), __uint_as_float(r32[1])); }
                amax *= rs;
                const unsigned ab = __float_as_uint(amax); int e = 135 - (int)((ab >> 23) & 255u) - (((ab & 0x7fffffu) > 0x600000u) ? 1 : 0);
                e = e < -100 ? -100 : (e > 100 ? 100 : e); e = (amax > 0.f) ? e : 0;
                const float mul = __uint_as_float((unsigned)(e + 127) << 23) * rs;
                sd |= (unsigned)(127 - e) << (8 * m);
#pragma unroll
                for (int j = 0; j < 4; ++j) hp[j] = hp[j] * mul;
                int w0 = 0, w1 = 0; w0 = __builtin_amdgcn_cvt_pk_fp8_f32(hp[0][0], hp[0][1], w0, false); w0 = __builtin_amdgcn_cvt_pk_fp8_f32(hp[1][0], hp[1][1], w0, true);
                w1 = __builtin_amdgcn_cvt_pk_fp8_f32(hp[2][0], hp[2][1], w1, false); w1 = __builtin_amdgcn_cvt_pk_fp8_f32(hp[3][0], hp[3][1], w1, true);
                f32x2 w; w[0] = __int_as_float(w0); w[1] = __int_as_float(w1);
                *(f32x2*)(O8 + (size_t)row * DFFE + col0) = w; }
            if (fq == 0) *(unsigned*)(SCT + ((size_t)u.pm * 28 + u.pn) * 1024 + ((((wr * 16 + fr) * 4 + wc) * 2 + ai) << 2)) = sd; }
    }
};
struct EpiResid {
    static constexpr bool PERM = false; static constexpr int NST = 32; static constexpr bool INPLACE = true;
    const float* Xin; float* Xout; const float* gate;
    __device__ __forceinline__ void operator()(const f32x4 (&acc)[2][2][4][2], const Unit& u, int wr, int wc, int fr, int fq) const {
        const int row0 = u.pm * BM + wr * 64 + fr, col0 = u.pn * BM + wc * 32 + 4 * fq; const float* gp = gate + (size_t)(u.pm >> 6) * (6 * DM) + col0;
        f32x4 gv[2][2];
#pragma unroll
        for (int bj = 0; bj < 2; ++bj)
#pragma unroll
            for (int n = 0; n < 2; ++n) gv[bj][n] = *(const f32x4*)(gp + bj * HALF + n * 16);
#pragma unroll
        for (int ai = 0; ai < 2; ++ai)
#pragma unroll
        for (int mp = 0; mp < 4; mp += 2) {
            f32x4 xi[2][2][2];
#pragma unroll
            for (int m = 0; m < 2; ++m) { const size_t off = (size_t)(row0 + ai * HALF + (mp + m) * 16) * DM + col0;
#pragma unroll
                for (int bj = 0; bj < 2; ++bj)
#pragma unroll
                    for (int n = 0; n < 2; ++n) xi[m][bj][n] = *(const f32x4*)(Xin + off + bj * HALF + n * 16); }
            asm volatile("" ::: "memory");
#pragma unroll
            for (int m = 0; m < 2; ++m) { const size_t off = (size_t)(row0 + ai * HALF + (mp + m) * 16) * DM + col0;
#pragma unroll
                for (int bj = 0; bj < 2; ++bj)
#pragma unroll
                    for (int n = 0; n < 2; ++n) *(f32x4*)(Xout + off + bj * HALF + n * 16) = xi[m][bj][n] + gv[bj][n] * acc[ai][bj][mp + m][n]; }
            asm volatile("" ::: "memory");
        }
    }
};
template <bool IN16, bool OUT16> struct EpiResidT {
    static constexpr bool PERM = true; static constexpr int NST = OUT16 ? 16 : 32; static constexpr bool INPLACE = true;
    const void* Xin; void* Xout; const float* gate;
    __device__ __forceinline__ void operator()(const f32x4 (&acc)[2][2][4][2], const Unit& u, int wr, int wc, int fr, int fq) const {
        const int row0 = u.pm * BM + wr * 64 + fr, col0 = u.pn * BM + wc * 32 + 8 * fq; const float* gp = gate + (size_t)(u.pm >> 6) * (6 * DM) + col0;
        f32x4 gv[2][2];
#pragma unroll
        for (int bj = 0; bj < 2; ++bj)
#pragma unroll
            for (int n = 0; n < 2; ++n) gv[bj][n] = *(const f32x4*)(gp + bj * HALF + 4 * n);
#pragma unroll
        for (int ai = 0; ai < 2; ++ai)
#pragma unroll
        for (int mp = 0; mp < 4; mp += 2) {
            f32x4 xi[2][2][2];
#pragma unroll
            for (int m = 0; m < 2; ++m) { const size_t off = (size_t)(row0 + ai * HALF + (mp + m) * 16) * DM + col0;
#pragma unroll
                for (int bj = 0; bj < 2; ++bj) {
                    if (IN16) { const u32x4 r = *(const u32x4*)((const bf16*)Xin + off + bj * HALF);
                        xi[m][bj][0] = (f32x4){bflo(r.x), bfhi(r.x), bflo(r.y), bfhi(r.y)}; xi[m][bj][1] = (f32x4){bflo(r.z), bfhi(r.z), bflo(r.w), bfhi(r.w)}; }
                    else { xi[m][bj][0] = *(const f32x4*)((const float*)Xin + off + bj * HALF); xi[m][bj][1] = *(const f32x4*)((const float*)Xin + off + bj * HALF + 4); } } }
            asm volatile("" ::: "memory");
#pragma unroll
            for (int m = 0; m < 2; ++m) { const size_t off = (size_t)(row0 + ai * HALF + (mp + m) * 16) * DM + col0;
#pragma unroll
                for (int bj = 0; bj < 2; ++bj) { const f32x4 v0 = xi[m][bj][0] + gv[bj][0] * acc[ai][bj][mp + m][0], v1 = xi[m][bj][1] + gv[bj][1] * acc[ai][bj][mp + m][1];
                    if (OUT16) { u32x4 w; w.x = cvt_pk_bf16(v0[0], v0[1]); w.y = cvt_pk_bf16(v0[2], v0[3]); w.z = cvt_pk_bf16(v1[0], v1[1]); w.w = cvt_pk_bf16(v1[2], v1[3]); *(u32x4*)((bf16*)Xout + off + bj * HALF) = w; }
                    else { *(f32x4*)((float*)Xout + off + bj * HALF) = v0; *(f32x4*)((float*)Xout + off + bj * HALF + 4) = v1; } } }
            asm volatile("" ::: "memory");
        }
    }
};
struct EpiMerge {
    static constexpr bool PERM = true; static constexpr int NST = 16;
    const bf16* G; bf16* Mg;
    __device__ __forceinline__ void operator()(const f32x4 (&acc)[2][2][4][2], const Unit& u, int wr, int wc, int fr, int fq) const {
        const int row0 = u.pm * BM + wr * 64 + fr, col0 = u.pn * BM + wc * 32 + 8 * fq, n_br = u.aux;
#pragma unroll
        for (int ai = 0; ai < 2; ++ai)
#pragma unroll
        for (int mp = 0; mp < 4; mp += 2) {
            u32x4 g[2][2], o[2][2];
#pragma unroll
            for (int m = 0; m < 2; ++m) { const size_t row = (size_t)(row0 + ai * HALF + (mp + m) * 16);
#pragma unroll
                for (int bj = 0; bj < 2; ++bj) { g[m][bj] = *(const u32x4*)(G + row * GATEW + n_br * DM + col0 + bj * HALF);
                    o[m][bj] = (n_br != 0) ? *(const u32x4*)(Mg + row * DM + col0 + bj * HALF) : (u32x4){0u, 0u, 0u, 0u}; } }
            asm volatile("" ::: "memory");
#pragma unroll
            for (int m = 0; m < 2; ++m) { const size_t row = (size_t)(row0 + ai * HALF + (mp + m) * 16);
#pragma unroll
                for (int bj = 0; bj < 2; ++bj) { const u32x4 gg = g[m][bj], oo = o[m][bj]; const f32x4 a0 = acc[ai][bj][mp + m][0], a1 = acc[ai][bj][mp + m][1]; float r[8];
                    r[0] = bflo(gg.x) * a0[0] + bflo(oo.x); r[1] = bfhi(gg.x) * a0[1] + bfhi(oo.x); r[2] = bflo(gg.y) * a0[2] + bflo(oo.y); r[3] = bfhi(gg.y) * a0[3] + bfhi(oo.y);
                    r[4] = bflo(gg.z) * a1[0] + bflo(oo.z); r[5] = bfhi(gg.z) * a1[1] + bfhi(oo.z); r[6] = bflo(gg.w) * a1[2] + bflo(oo.w); r[7] = bfhi(gg.w) * a1[3] + bfhi(oo.w);
                    u32x4 w; w.x = cvt_pk_bf16(r[0], r[1]); w.y = cvt_pk_bf16(r[2], r[3]); w.z = cvt_pk_bf16(r[4], r[5]); w.w = cvt_pk_bf16(r[6], r[7]);
                    *(u32x4*)(Mg + row * DM + col0 + bj * HALF) = w; } }
            asm volatile("" ::: "memory");
        }
    }
};
struct EpiGM {
    static constexpr bool PERM = false; static constexpr int NST = 8;
    const bf16* Z; bf16* Mg;
    __device__ __forceinline__ void operator()(const f32x4 (&acc)[2][2][4][2], const Unit& u, int wr, int wc, int fr, int fq) const {
        const int row0 = u.pm * BM + wr * 64 + fr, col0 = u.pn * 64 + wc * 16 + 4 * fq;
        const bf16* zb = Z + (size_t)row0 * GATEW + col0; bf16* mb = Mg + (size_t)row0 * DM + col0;
#pragma unroll
        for (int ai = 0; ai < 2; ++ai) {
            f32x2 zz[4][4];
#pragma unroll
            for (int m = 0; m < 4; ++m)
#pragma unroll
                for (int br = 0; br < 4; ++br) zz[m][br] = *(const f32x2*)(zb + (size_t)(ai * HALF + m * 16) * GATEW + br * DM);
            asm volatile("" ::: "memory");
#pragma unroll
            for (int m = 0; m < 4; ++m) { f32x4 r = {0.f, 0.f, 0.f, 0.f};
#pragma unroll
                for (int br = 0; br < 4; ++br) { const f32x4 a = acc[ai][br >> 1][m][br & 1]; const unsigned z0 = __float_as_uint(zz[m][br][0]), z1 = __float_as_uint(zz[m][br][1]);
                    r[0] += fast_sigmoid(a[0]) * bflo(z0); r[1] += fast_sigmoid(a[1]) * bfhi(z0); r[2] += fast_sigmoid(a[2]) * bflo(z1); r[3] += fast_sigmoid(a[3]) * bfhi(z1); }
                f32x2 w; w[0] = __uint_as_float(cvt_pk_bf16(r[0], r[1])); w[1] = __uint_as_float(cvt_pk_bf16(r[2], r[3]));
                *(f32x2*)(mb + (size_t)(ai * HALF + m * 16) * DM) = w;
                __builtin_amdgcn_sched_barrier(0); }
            asm volatile("" ::: "memory");
        }
    }
};
struct MoeOrderX {
    const char* A; const char* B; const char* Sc; size_t tA, tB, tS; const int* pexp; int p0, nM, nN, G, c;
    __device__ __forceinline__ bool next(int i, Unit& u) const { int pm, pn; if (nM <= 0 || !static_tile(i, G, c, nM, nN, pm, pn)) return false; const int e = pexp[p0 + pm]; u.pm = pm; u.pn = pn; u.aux = e;
        u.A = A + (size_t)pm * tA; u.B = B + ((size_t)e * nN + pn) * tB; u.S = Sc + (size_t)pm * tS; return true; }
};
struct MoeTailOrderX {
    const char* A; const char* B; const char* Sc; size_t tA, tB, tS; const int* pexp; int p0, T, G, c;
    __device__ __forceinline__ bool next(int i, Unit& u) const { const int L = i * G + c; if (L >= T * 8) return false; const int pt = L >> 3, pn = (L >> 1) & 3, kh = L & 1, e = pexp[p0 + pt];
        u.pm = pt; u.pn = pn; u.aux = kh | (e << 8); u.A = A + (size_t)pt * tA + kh * 1792; u.B = B + ((size_t)e * 4 + pn) * tB + kh * 1792; u.S = Sc + (size_t)pt * tS + kh * (14 * 1024); return true; }
};
struct MoeTailOrder {
    const char* A; const char* B; size_t tA, tB; const int* pexp; int p0, T, G, c;
    __device__ __forceinline__ bool next(int i, Unit& u) const { const int L = i * G + c; if (L >= T * 16) return false; const int pt = L >> 4, pn = (L >> 2) & 3, kq = L & 3, e = pexp[p0 + pt];
        u.pm = pt; u.pn = pn; u.aux = kq; u.A = A + (size_t)pt * tA + kq * (896 * 2); u.B = B + ((size_t)e * 4 + pn) * tB + kq * (896 * 2); return true; }
};
struct EpiMoePart {
    static constexpr bool PERM = true; static constexpr int NST = 16;
    bf16* PART; const float* ps;
    __device__ __forceinline__ void operator()(const f32x4 (&acc)[2][2][4][2], const Unit& u, int wr, int wc, int fr, int fq) const {
        const int row0 = u.pm * BM + wr * 64 + fr, col0 = u.pn * BM + wc * 32 + 8 * fq; bf16* base = PART + (size_t)u.aux * (MAXTAIL * 256) * DM;
#pragma unroll
        for (int ai = 0; ai < 2; ++ai)
#pragma unroll
            for (int m = 0; m < 4; ++m) { const int row = row0 + ai * HALF + m * 16; const float s = ps[row]; bf16* rowp = base + (size_t)row * DM + col0;
#pragma unroll
                for (int bj = 0; bj < 2; ++bj) { const f32x4 v0 = acc[ai][bj][m][0] * s, v1 = acc[ai][bj][m][1] * s;
                    u32x4 w; w.x = cvt_pk_bf16(v0[0], v0[1]); w.y = cvt_pk_bf16(v0[2], v0[3]); w.z = cvt_pk_bf16(v1[0], v1[1]); w.w = cvt_pk_bf16(v1[2], v1[3]);
                    *(u32x4*)(rowp + bj * HALF) = w; } }
    }
};
struct EpiGM8 {
    static constexpr bool PERM = false; static constexpr int NST = 8;
#ifdef PROBE_GM8
    static constexpr bool PROBE_REP = true;
#endif
    const bf16* Z; bf16* Mg; const float* sh; const float* sw;
    __device__ __forceinline__ void operator()(const f32x4 (&acc)[2][2][4][2], const Unit& u, int wr, int wc, int fr_, int fq_) const {
        int fr = fr_, fq = fq_; asm volatile("" : "+v"(fr), "+v"(fq));
        const int row0 = u.pm * BM + wr * 64 + fr, col0 = u.pn * 64 + wc * 16 + 4 * fq;
        const bf16* zb = Z + (size_t)row0 * GATEW + col0; bf16* mb = Mg + (size_t)row0 * DM + col0;
        f32x2 zz[2][4][4]; float rs[2][4];
#pragma unroll
        for (int ai = 0; ai < 2; ++ai)
#pragma unroll
            for (int m = 0; m < 4; ++m) { rs[ai][m] = sh[row0 + ai * HALF + m * 16];
#pragma unroll
                for (int br = 0; br < 4; ++br) zz[ai][m][br] = *(const f32x2*)(zb + (size_t)(ai * HALF + m * 16) * GATEW + br * DM); }
        f32x4 craw[4];
#pragma unroll
        for (int br = 0; br < 4; ++br) craw[br] = *(const f32x4*)(sw + u.pn * 256 + 128 * (br >> 1) + 32 * wc + 16 * (br & 1) + 4 * fq);
        asm volatile("" ::: "memory");
        f32x2 cs[4][2];
#pragma unroll
        for (int br = 0; br < 4; ++br) { cs[br][0] = (f32x2){craw[br][0], craw[br][1]} * -1.4426950408889634f; cs[br][1] = (f32x2){craw[br][2], craw[br][3]} * -1.4426950408889634f; }
#pragma unroll
        for (int ai = 0; ai < 2; ++ai) {
#pragma unroll
            for (int m = 0; m < 4; ++m) { f32x2 r0 = {0.f, 0.f}, r1 = {0.f, 0.f};
#pragma unroll
                for (int br = 0; br < 4; ++br) { const f32x4 A = acc[ai][br >> 1][m][br & 1];
                    const f32x2 n0 = (f32x2){A[0], A[1]} * (cs[br][0] * rs[ai][m]), n1 = (f32x2){A[2], A[3]} * (cs[br][1] * rs[ai][m]);
                    f32x2 d0, d1; d0[0] = __builtin_amdgcn_exp2f(n0[0]); d0[1] = __builtin_amdgcn_exp2f(n0[1]); d1[0] = __builtin_amdgcn_exp2f(n1[0]); d1[1] = __builtin_amdgcn_exp2f(n1[1]);
                    d0 = d0 + 1.f; d1 = d1 + 1.f;
                    d0[0] = __builtin_amdgcn_rcpf(d0[0]); d0[1] = __builtin_amdgcn_rcpf(d0[1]); d1[0] = __builtin_amdgcn_rcpf(d1[0]); d1[1] = __builtin_amdgcn_rcpf(d1[1]);
                    const unsigned z0 = __float_as_uint(zz[ai][m][br][0]), z1 = __float_as_uint(zz[ai][m][br][1]);
                    r0 = r0 + d0 * (f32x2){bflo(z0), bfhi(z0)}; r1 = r1 + d1 * (f32x2){bflo(z1), bfhi(z1)}; }
                f32x2 w; w[0] = __uint_as_float(cvt_pk_bf16(r0[0], r0[1])); w[1] = __uint_as_float(cvt_pk_bf16(r1[0], r1[1]));
                *(f32x2*)(mb + (size_t)(ai * HALF + m * 16) * DM) = w;
                __builtin_amdgcn_sched_barrier(0); }
        }
        asm volatile("" ::: "memory");
    }
};
struct EpiMoeDown8 {
    static constexpr bool PERM = true; static constexpr int NST = 16;
    bf16* Y; const float* ps; const float* sw2;
    __device__ __forceinline__ void operator()(const f32x4 (&acc)[2][2][4][2], const Unit& u, int wr, int wc, int fr_, int fq_) const {
        int fr = fr_, fq = fq_; asm volatile("" : "+v"(fr), "+v"(fq));
        const int row0 = u.pm * BM + wr * 64 + fr, col0 = u.pn * BM + wc * 32 + 8 * fq; const float* swp = sw2 + (size_t)(u.aux & 0xff) * DM + col0;
        f32x4 cs[2][2];
#pragma unroll
        for (int bj = 0; bj < 2; ++bj) { cs[bj][0] = *(const f32x4*)(swp + bj * HALF); cs[bj][1] = *(const f32x4*)(swp + bj * HALF + 4); }
        float psv[2][4];
#pragma unroll
        for (int ai = 0; ai < 2; ++ai)
#pragma unroll
            for (int m = 0; m < 4; ++m) psv[ai][m] = ps[row0 + ai * HALF + m * 16];
#pragma unroll
        for (int ai = 0; ai < 2; ++ai)
#pragma unroll
            for (int m = 0; m < 4; ++m) { const int row = row0 + ai * HALF + m * 16; const float s = psv[ai][m]; bf16* rowp = Y + (size_t)row * DM + col0;
#pragma unroll
                for (int bj = 0; bj < 2; ++bj) { const f32x4 v0 = acc[ai][bj][m][0] * cs[bj][0] * s, v1 = acc[ai][bj][m][1] * cs[bj][1] * s;
                    u32x4 w; w.x = cvt_pk_bf16(v0[0], v0[1]); w.y = cvt_pk_bf16(v0[2], v0[3]); w.z = cvt_pk_bf16(v1[0], v1[1]); w.w = cvt_pk_bf16(v1[2], v1[3]);
                    *(u32x4*)(rowp + bj * HALF) = w; } }
    }
};
struct EpiMoePart8 {
    static constexpr bool PERM = true; static constexpr int NST = 16;
    bf16* PART; const float* ps; const float* sw2;
    __device__ __forceinline__ void operator()(const f32x4 (&acc)[2][2][4][2], const Unit& u, int wr, int wc, int fr_, int fq_) const {
        int fr = fr_, fq = fq_; asm volatile("" : "+v"(fr), "+v"(fq));
        const int row0 = u.pm * BM + wr * 64 + fr, col0 = u.pn * BM + wc * 32 + 8 * fq; const float* swp = sw2 + (size_t)(u.aux >> 8) * DM + col0; bf16* base = PART + (size_t)(u.aux & 1) * (MAXTAIL * 256) * DM;
        f32x4 cs[2][2];
#pragma unroll
        for (int bj = 0; bj < 2; ++bj) { cs[bj][0] = *(const f32x4*)(swp + bj * HALF); cs[bj][1] = *(const f32x4*)(swp + bj * HALF + 4); }
#pragma unroll
        for (int ai = 0; ai < 2; ++ai)
#pragma unroll
            for (int m = 0; m < 4; ++m) { const int row = row0 + ai * HALF + m * 16; const float s = ps[row]; bf16* rowp = base + (size_t)row * DM + col0;
#pragma unroll
                for (int bj = 0; bj < 2; ++bj) { const f32x4 v0 = acc[ai][bj][m][0] * cs[bj][0] * s, v1 = acc[ai][bj][m][1] * cs[bj][1] * s;
                    u32x4 w; w.x = cvt_pk_bf16(v0[0], v0[1]); w.y = cvt_pk_bf16(v0[2], v0[3]); w.z = cvt_pk_bf16(v1[0], v1[1]); w.w = cvt_pk_bf16(v1[2], v1[3]);
                    *(u32x4*)(rowp + bj * HALF) = w; } }
    }
};
struct EpiMoeDown {
    static constexpr bool PERM = true; static constexpr int NST = 16;
    bf16* Y; const float* ps;
    __device__ __forceinline__ void operator()(const f32x4 (&acc)[2][2][4][2], const Unit& u, int wr, int wc, int fr, int fq) const {
        const int row0 = u.pm * BM + wr * 64 + fr, col0 = u.pn * BM + wc * 32 + 8 * fq;
#pragma unroll
        for (int ai = 0; ai < 2; ++ai)
#pragma unroll
            for (int m = 0; m < 4; ++m) { const int row = row0 + ai * HALF + m * 16; const float s = ps[row]; bf16* rowp = Y + (size_t)row * DM + col0;
#pragma unroll
                for (int bj = 0; bj < 2; ++bj) { const f32x4 v0 = acc[ai][bj][m][0] * s, v1 = acc[ai][bj][m][1] * s;
                    u32x4 w; w.x = cvt_pk_bf16(v0[0], v0[1]); w.y = cvt_pk_bf16(v0[2], v0[3]); w.z = cvt_pk_bf16(v1[0], v1[1]); w.w = cvt_pk_bf16(v1[2], v1[3]);
                    *(u32x4*)(rowp + bj * HALF) = w; } }
    }
};

template <class E> constexpr auto epi_inplace(int) -> decltype(E::INPLACE) { return E::INPLACE; }
template <class E> constexpr bool epi_inplace(long) { return false; }
#ifndef EPI_REP
#define EPI_REP 1
#endif
template <class E> constexpr auto epi_rep(int) -> decltype(E::PROBE_REP, 1) { return EPI_REP; }
template <class E> constexpr int epi_rep(long) { return 1; }
typedef int v8i __attribute__((ext_vector_type(8)));
typedef int v4i __attribute__((ext_vector_type(4)));
template <int M8> __device__ __forceinline__ void mma8s(f32x4& acc, const v8i& b8, const v8i& a8, const int sA, const unsigned sB) {
    if constexpr (M8 == 0) asm volatile("v_mfma_scale_f32_16x16x128_f8f6f4 %0, %1, %2, %0, %3, %4 op_sel_hi:[0,0,0]" : "+v"(acc) : "v"(b8), "v"(a8), "v"(sA), "v"(sB));
    else if constexpr (M8 == 1) asm volatile("v_mfma_scale_f32_16x16x128_f8f6f4 %0, %1, %2, %0, %3, %4 op_sel:[0,1,0] op_sel_hi:[0,0,0]" : "+v"(acc) : "v"(b8), "v"(a8), "v"(sA), "v"(sB));
    else if constexpr (M8 == 2) asm volatile("v_mfma_scale_f32_16x16x128_f8f6f4 %0, %1, %2, %0, %3, %4 op_sel_hi:[0,1,0]" : "+v"(acc) : "v"(b8), "v"(a8), "v"(sA), "v"(sB));
    else asm volatile("v_mfma_scale_f32_16x16x128_f8f6f4 %0, %1, %2, %0, %3, %4 op_sel:[0,1,0] op_sel_hi:[0,1,0]" : "+v"(acc) : "v"(b8), "v"(a8), "v"(sA), "v"(sB));
}
template <class Epi, class Sched, int MODE = 0>
__device__ __forceinline__ void gemm_phase(PG8_LAS unsigned char* lds, const int wave_, const int lda, const int ldb, const int K, const Sched& S, const Epi& E) {
    constexpr bool F8 = (MODE != 0), SCL = (MODE == 2);
    int tid_ = wave_ * 64 + lane_id(); asm volatile("" : "+v"(tid_));
    const int tid = tid_, wid = __builtin_amdgcn_readfirstlane(tid >> 6), lane = tid & 63, wr = wid >> 2, wc = wid & 3, fr = lane & 15, fq = lane >> 4;
    const int nt = K / BK;
    unsigned voffA[2], voffB[2];
#pragma unroll
    for (int i = 0; i < 2; ++i) { int R, C; stage_rc(tid * 16 + i * 8192, R, C); const int Rb = Epi::PERM ? ((R & ~31) + perm32(R & 31)) : R;
        voffA[i] = (unsigned)(R * lda + C) * 2u; voffB[i] = (unsigned)(Rb * ldb + C) * 2u; }
    const size_t kstep = (size_t)(BK * 2);
    const size_t hstepA = (size_t)HALF * lda * 2, hstepB = (size_t)HALF * ldb * 2;
    const unsigned ldsw = (unsigned)wid * 1024u;
    const int aoff = lds_byte(wr * 64 + fr, fq * 8), boff = lds_byte(wc * 32 + fr, fq * 8);
    const int aoff8 = lds_byte(wr * 64 + fr, 32 * (fq >> 1) + 16 * (fq & 1)), boff8 = lds_byte(wc * 32 + fr, 32 * (fq >> 1) + 16 * (fq & 1));
#define PG8_SA(b, h) (((b) * 2 + (h)) * HTB)
#define PG8_SB(b, h) ((4 + (b) * 2 + (h)) * HTB)
#define PG8_STAGE(bufoff, gbase, voff) do { _Pragma("unroll") for (int _i = 0; _i < 2; ++_i) \
        __builtin_amdgcn_global_load_lds((const unsigned*)((const char*)(gbase) + (voff)[_i]), (PG8_LAS unsigned*)(lds + (bufoff) + ldsw + _i * 8192), 16, 0, 0); } while (0)
#define PG8_CAT(x0, x1) __builtin_shufflevector(__builtin_bit_cast(v4i, x0), __builtin_bit_cast(v4i, x1), 0, 1, 2, 3, 4, 5, 6, 7)
#define PG8_LDA(dst, b, h) do { _Pragma("unroll") for (int m = 0; m < 4; ++m) { if constexpr (F8) dst##8[m] = PG8_CAT(*(const PG8_LAS bf16x8*)(lds + PG8_SA(b, h) + aoff + m * 2048), *(const PG8_LAS bf16x8*)(lds + PG8_SA(b, h) + aoff + m * 2048 + 1024)); \
        else { _Pragma("unroll") for (int k = 0; k < 2; ++k) dst[m][k] = *(const PG8_LAS bf16x8*)(lds + PG8_SA(b, h) + aoff + m * 2048 + k * 1024); } } } while (0)
#define PG8_LDB(dst, b, h) do { _Pragma("unroll") for (int n = 0; n < 2; ++n) { if constexpr (F8) dst##8[n] = PG8_CAT(*(const PG8_LAS bf16x8*)(lds + PG8_SB(b, h) + boff + n * 2048), *(const PG8_LAS bf16x8*)(lds + PG8_SB(b, h) + boff + n * 2048 + 1024)); \
        else { _Pragma("unroll") for (int k = 0; k < 2; ++k) dst[n][k] = *(const PG8_LAS bf16x8*)(lds + PG8_SB(b, h) + boff + n * 2048 + k * 1024); } } } while (0)
#define PG8_MMA(ai, bj, At, Bt) do { __builtin_amdgcn_s_setprio(1); if constexpr (SCL) asm volatile("s_nop 7" ::: "memory"); _Pragma("unroll") for (int n = 0; n < 2; ++n) { \
        if constexpr (SCL) { mma8s<0>(acc[ai][bj][0][n], Bt##8[n], At##8[0], sc1, SCUR[ai]); mma8s<1>(acc[ai][bj][1][n], Bt##8[n], At##8[1], sc1, SCUR[ai]); \
                             mma8s<2>(acc[ai][bj][2][n], Bt##8[n], At##8[2], sc1, SCUR[ai]); mma8s<3>(acc[ai][bj][3][n], Bt##8[n], At##8[3], sc1, SCUR[ai]); } \
        else { _Pragma("unroll") for (int m = 0; m < 4; ++m) { \
        if constexpr (F8) asm volatile("v_mfma_scale_f32_16x16x128_f8f6f4 %0, %1, %2, %0, %3, %3 op_sel_hi:[0,0,0]" : "+v"(acc[ai][bj][m][n]) : "v"(Bt##8[n]), "v"(At##8[m]), "v"(sc1)); \
        else { _Pragma("unroll") for (int k = 0; k < 2; ++k) acc[ai][bj][m][n] = __builtin_amdgcn_mfma_f32_16x16x32_bf16(Bt[n][k], At[m][k], acc[ai][bj][m][n], 0, 0, 0); } } } } __builtin_amdgcn_s_setprio(0); } while (0)
#define PG8_WAIT_V(n) asm volatile("s_waitcnt vmcnt(" #n ")" ::: "memory")
#define PG8_WAIT_VX(n) asm volatile("s_waitcnt vmcnt(%0)" :: "n"(n) : "memory")
#define PG8_WAIT_SEG() do { if (relax) PG8_WAIT_VX(8 + Epi::NST); else PG8_WAIT_V(8); } while (0)
#define PG8_WAIT_SEG1() do { if constexpr (SCL) { if (relax) PG8_WAIT_VX(9 + Epi::NST); else PG8_WAIT_V(9); } else PG8_WAIT_SEG(); } while (0)
#define PG8_WAIT_L(n) asm volatile("s_waitcnt lgkmcnt(" #n ")" ::: "memory")
#define PG8_BAR __builtin_amdgcn_s_barrier()
#define PG8_SCHED __builtin_amdgcn_sched_barrier(0)
    Unit cur, nxt; int ui = 0;
    if (!S.next(0, cur)) return;
    f32x4 acc[2][2][4][2];
#pragma unroll
    for (int a = 0; a < 2; ++a)
#pragma unroll
        for (int b = 0; b < 2; ++b)
#pragma unroll
            for (int m = 0; m < 4; ++m)
#pragma unroll
                for (int n = 0; n < 2; ++n) acc[a][b][m][n] = (f32x4){0.f, 0.f, 0.f, 0.f};
    bf16x8 At[4][2], B0[2][2], B1[2][2]; v8i At8[4], B08[2], B18[2];
    int sc1 = 0x7f7f7f7f; asm volatile("" : "+v"(sc1));
    const unsigned soff = (unsigned)(((wr * 16 + fr) * 4 + fq) * 8);
    u32x2 sct0 = {0u, 0u}, sct1 = {0u, 0u};
    const char* cA = cur.A; const char* cB = cur.B; const char* cS = cur.S;
    if constexpr (SCL) { sct0 = *(const u32x2*)(cur.S + soff); sct1 = *(const u32x2*)(cur.S + 1024 + soff); }
    PG8_STAGE(PG8_SB(0, 0), cB, voffB); PG8_STAGE(PG8_SB(0, 1), cB + hstepB, voffB); PG8_STAGE(PG8_SA(0, 0), cA, voffA); PG8_STAGE(PG8_SA(0, 1), cA + hstepA, voffA);
    if (wr == 1) PG8_BAR;
    PG8_WAIT_V(2); PG8_BAR;
    PG8_STAGE(PG8_SB(1, 0), cB + kstep, voffB); PG8_STAGE(PG8_SA(1, 0), cA + kstep, voffA); PG8_STAGE(PG8_SB(1, 1), cB + hstepB + kstep, voffB);
    PG8_WAIT_V(6); PG8_BAR;
    for (;;) {
        const bool has_next = S.next(ui + 1, nxt);
        const char* nA = has_next ? nxt.A : cA; const char* nB = has_next ? nxt.B : cB; const char* nS = has_next ? nxt.S : cS;
        for (int t = 0; t < nt; t += 2) {
            const bool last = (t == nt - 2); int relax = __builtin_amdgcn_readfirstlane((int)(t == 0) & (int)(ui > 0)); asm volatile("" : "+s"(relax));
            const char* a1 = cA + (size_t)(t + 1) * kstep;
            const char* a2 = last ? nA : cA + (size_t)(t + 2) * kstep; const char* b2 = last ? nB : cB + (size_t)(t + 2) * kstep;
            const char* a3 = a2 + kstep; const char* b3 = b2 + kstep;
            const char* s2p = last ? nS : cS + (size_t)(t + 2) * 1024;
            u32x2 sn0 = sct0, sn1 = sct1;
#define SCUR sct0
            PG8_LDB(B0, 0, 0); PG8_LDB(B1, 0, 1); PG8_SCHED; PG8_LDA(At, 0, 0); PG8_STAGE(PG8_SA(1, 1), a1 + hstepA, voffA);
            PG8_WAIT_SEG1(); PG8_WAIT_L(0); PG8_BAR; PG8_MMA(0, 0, At, B0); PG8_MMA(0, 1, At, B1); PG8_BAR; PG8_SCHED;
            PG8_LDA(At, 0, 1); PG8_STAGE(PG8_SB(0, 0), b2, voffB); PG8_STAGE(PG8_SB(0, 1), b2 + hstepB, voffB); PG8_STAGE(PG8_SA(0, 0), a2, voffA);
            PG8_WAIT_SEG(); if constexpr (SCL) sn0 = *(const u32x2*)(s2p + soff); PG8_WAIT_L(0); PG8_BAR; PG8_MMA(1, 0, At, B0); PG8_MMA(1, 1, At, B1); PG8_BAR; PG8_SCHED;
#undef SCUR
#define SCUR sct1
            PG8_LDB(B0, 1, 0); PG8_LDB(B1, 1, 1); PG8_SCHED; PG8_LDA(At, 1, 0); PG8_STAGE(PG8_SA(0, 1), a2 + hstepA, voffA);
            if constexpr (SCL) PG8_WAIT_V(9); else PG8_WAIT_V(8); PG8_WAIT_L(0); PG8_BAR; PG8_MMA(0, 0, At, B0); PG8_MMA(0, 1, At, B1); PG8_BAR; PG8_SCHED;
            PG8_LDA(At, 1, 1); PG8_STAGE(PG8_SB(1, 0), b3, voffB); PG8_STAGE(PG8_SB(1, 1), b3 + hstepB, voffB); PG8_STAGE(PG8_SA(1, 0), a3, voffA);
            PG8_WAIT_V(8); if constexpr (SCL) sn1 = *(const u32x2*)(s2p + 1024 + soff);
            PG8_WAIT_L(0); PG8_BAR; PG8_MMA(1, 0, At, B0); PG8_MMA(1, 1, At, B1); PG8_BAR; PG8_SCHED;
#undef SCUR
            sct0 = sn0; sct1 = sn1;
        }
        if (wr == 0) PG8_BAR;
        if constexpr (F8) asm volatile("s_nop 15\n\ts_nop 15" ::: "memory");
        _Pragma("unroll") for (int er_ = 0; er_ < epi_rep<Epi>(0); ++er_) { E(acc, cur, wr, wc, fr, fq); if (EPI_REP > 1) asm volatile("" ::: "memory"); }
        if (!has_next) break;
#pragma unroll
        for (int a = 0; a < 2; ++a)
#pragma unroll
            for (int b = 0; b < 2; ++b)
#pragma unroll
                for (int m = 0; m < 4; ++m)
#pragma unroll
                    for (int n = 0; n < 2; ++n) acc[a][b][m][n] = (f32x4){0.f, 0.f, 0.f, 0.f};
        cur = nxt; cA = nA; cB = nB; cS = nS; ++ui;
        if (wr == 1) PG8_BAR;
    }
    PG8_WAIT_V(0);
    PG8_BAR;
#undef PG8_SA
#undef PG8_SB
#undef PG8_STAGE
#undef PG8_LDA
#undef PG8_LDB
#undef PG8_MMA
#undef PG8_CAT
#undef PG8_WAIT_V
#undef PG8_WAIT_VX
#undef PG8_WAIT_SEG
#undef PG8_WAIT_SEG1
#undef PG8_WAIT_L
#undef PG8_BAR
#undef PG8_SCHED
}
}
constexpr int NWAVES = 8;
constexpr int RING_OFF = 0, RING_BYTES = 131072;
constexpr int LDSCTL_OFF = RING_BYTES, MISC_OFF = LDSCTL_OFF + 320;
constexpr int LDS_BYTES = 147456;
constexpr int CW_TMO = 0, CW_CODE = 1, CW_BAR = 4096;

#define GAS __attribute__((address_space(1)))
#define LAS __attribute__((address_space(3)))
typedef unsigned v4u __attribute__((ext_vector_type(4)));
typedef unsigned v2u __attribute__((ext_vector_type(2)));
typedef GAS unsigned gu32;
#define RLX_AGENT __ATOMIC_RELAXED, __HIP_MEMORY_SCOPE_AGENT
#define LDS_WAIT() asm volatile("s_waitcnt lgkmcnt(0)" ::: "memory")
#define VM_WAIT() asm volatile("s_waitcnt vmcnt(0)" ::: "memory")
__device__ __forceinline__ unsigned pk2(float lo, float hi) { return (unsigned)f2bf(lo) | ((unsigned)f2bf(hi) << 16); }


#define XB_TMO      128
#define XB_XCNT(j)  (256  + 64 * (j))
#define XB_XSUB(j)  (1280 + 64 * (j))
#define XB_XGEN(j)  (2304 + 64 * (j))
#define XB_TOP      3328
#define XB_TOPGEN   3392
#define XCD_BAR_WORDS 3456
#define XB_SPIN_CAP (1u << 18)
__device__ __forceinline__ unsigned xb_ld(unsigned* p)              { return __hip_atomic_load(p, __ATOMIC_RELAXED, __HIP_MEMORY_SCOPE_AGENT); }
__device__ __forceinline__ unsigned xb_add(unsigned* p, unsigned v) { return __hip_atomic_fetch_add(p, v, __ATOMIC_RELAXED, __HIP_MEMORY_SCOPE_AGENT); }
__device__ __forceinline__ unsigned xb_xcc_id() { return (unsigned)__builtin_amdgcn_s_getreg((3 << 11) | 20) & 0xFu; }
#define XB_SPIN(cond, bar) do { unsigned _sp = 0; while (cond) { __builtin_amdgcn_s_sleep(1); \
    if ((++_sp & 255u) == 0u) { if (xb_ld(&(bar)[XB_TMO])) break; if (_sp > XB_SPIN_CAP) { atomicAdd(&(bar)[XB_TMO], 1u); break; } } } } while (0)
struct XcdBarrier { unsigned* bar; unsigned x; volatile LAS unsigned* st; };
__device__ __forceinline__ XcdBarrier xcd_barrier_post(unsigned* bar, volatile LAS unsigned* st) {
    XcdBarrier b; b.bar = bar; b.x = xb_xcc_id(); b.st = st;
    if (threadIdx.x == 0) (void)xb_add(&bar[XB_XCNT(b.x)], 1u);
    return b;
}
__device__ __forceinline__ void xcd_barrier_complete(unsigned* bar, unsigned x, unsigned& nloc, unsigned& nx) {
    const unsigned G = gridDim.x * gridDim.y * gridDim.z;
    unsigned sum, cnt, mine, sp = 0u;
    for (;;) {
        sum = 0u; cnt = 0u; mine = 0u;
#pragma unroll
        for (unsigned j = 0; j < 16; ++j) { const unsigned c = xb_ld(&bar[XB_XCNT(j)]); sum += c; cnt += (c > 0u) ? 1u : 0u; mine = (j == x) ? c : mine; }
        if (sum == G) break;
        __builtin_amdgcn_s_sleep(1);
        if ((++sp & 255u) == 0u) { if (xb_ld(&bar[XB_TMO])) break; if (sp > XB_SPIN_CAP) { atomicAdd(&bar[XB_TMO], 1u); break; } }
    }
    nloc = mine > 0u ? mine : 1u; nx = cnt > 0u ? cnt : 1u;
}
__device__ __forceinline__ void xcd_barrier(const XcdBarrier& b, const int wave) {
    asm volatile("s_waitcnt vmcnt(0)" ::: "memory");
    __syncthreads();
    if (wave == 0 && lane_id() == 0) {
        unsigned* bar = b.bar;
        __builtin_amdgcn_s_waitcnt(0);
        unsigned nloc = b.st[0], nx = b.st[1];
        if (nloc == 0u) { xcd_barrier_complete(bar, b.x, nloc, nx); b.st[0] = nloc; b.st[1] = nx; }
        const unsigned old = xb_add(&bar[XB_XSUB(b.x)], 1u);
        const unsigned gen = old / nloc;
        if (old + 1u == (gen + 1u) * nloc) {
            __builtin_amdgcn_fence(__ATOMIC_RELEASE, "agent");
            asm volatile("s_waitcnt vmcnt(0)" ::: "memory");
            const unsigned og = xb_add(&bar[XB_TOP], 1u);
            const unsigned tg = og / nx;
            if (og + 1u == (tg + 1u) * nx) xb_add(&bar[XB_TOPGEN], 1u);
            else XB_SPIN(xb_ld(&bar[XB_TOPGEN]) == tg, bar);
            __builtin_amdgcn_fence(__ATOMIC_ACQUIRE, "agent");
            xb_add(&bar[XB_XGEN(b.x)], 1u);
            asm volatile("s_waitcnt vmcnt(0)" ::: "memory");
        } else {
            XB_SPIN(xb_ld(&bar[XB_XGEN(b.x)]) == gen, bar);
            __builtin_amdgcn_fence(__ATOMIC_ACQUIRE, "agent");
            asm volatile("s_waitcnt vmcnt(0)" ::: "memory");
        }
    }
    __syncthreads();
}

struct Frame {
    LAS unsigned char* lds; volatile LAS unsigned* MISC; unsigned* ctl;
    int wave, vcu, G;
};
#define F_LANE (lane_id())
#define F_TID (F.wave * 64 + lane_id())
__device__ __forceinline__ float wave_sum(float v) {
#pragma unroll
    for (int o = 1; o < 64; o <<= 1) v += __shfl_xor(v, o);
    return v;
}

__host__ __device__ __forceinline__ int win_row(int sc) { if (sc < NPROJ_SRC) return sc + (sc >= 1184 ? 96 : 0); const int g = sc - NPROJ_SRC, br = g >> 10, oc = g & 1023, p = oc >> 6, j = oc & 63;
    return PROJW + p * 256 + 128 * (br >> 1) + 32 * (j >> 4) + 16 * (br & 1) + (j & 15); }
__device__ __forceinline__ void transpose_item(const float* W, int ldw, bf16* WT, int ldt, int drow0, int k0, int n0, const float* scale, LAS float* scr, int lane, const bool winmap = false) {
#pragma unroll
    for (int i = 0; i < 32; ++i) { const int kk = 2 * i + (lane >> 5); float v = W[(size_t)(k0 + kk) * ldw + n0 + (lane & 31)]; if (scale) v *= scale[k0 + kk]; scr[kk * 33 + (lane & 31)] = v; }
    LDS_WAIT(); asm volatile("" ::: "memory");
    const int c = lane & 7;
#pragma unroll
    for (int j = 0; j < 4; ++j) { const int n = (lane >> 3) + 8 * j; const LAS float* s = scr + (8 * c) * 33 + n;
        v4u o; o.x = pk2(s[0 * 33], s[1 * 33]); o.y = pk2(s[2 * 33], s[3 * 33]); o.z = pk2(s[4 * 33], s[5 * 33]); o.w = pk2(s[6 * 33], s[7 * 33]);
        *(v4u*)(WT + (size_t)(winmap ? win_row(n0 + n) : drow0 + n) * ldt + k0 + 8 * c) = o; }
    LDS_WAIT(); asm volatile("" ::: "memory");
}
__device__ __forceinline__ void convert_job(Frame& F, const float* src, size_t sstride, int K, int N, bf16* dst, size_t dstride, int ldt, int mode, const float* scale, int nmat, int rot, int ncol = 0) {
    LAS float* scr = (LAS float*)(F.lds + RING_OFF + F.wave * 16384);
    const int NGW = F.G * NWAVES, gw = (F.vcu * NWAVES + F.wave + rot) % NGW, lane = F_LANE;
    const int nkb = K / 64, nnb = (ncol ? ncol : N) / 32, per = nkb * nnb, total = per * nmat;
    for (int it = gw; it < total; it += NGW) {
        const int mi = it / per, r = it % per, kb = r / nnb, nb = r % nnb, n0 = nb * 32;
        int drow = n0;
        if (mode == 2) drow = (n0 >> 7) * 256 + (n0 & 127);
        else if (mode == 3) drow = (n0 >> 7) * 256 + 128 + (n0 & 127);
        transpose_item(src + (size_t)mi * sstride, N, dst + (size_t)mi * dstride, ldt, drow, kb * 64, n0, scale, scr, lane, mode == 1);
    }
}

__device__ __forceinline__ float fp8_scale(float amax) { return (amax > 0.f) ? exp2f(fminf(floorf(log2f(448.f / amax)), 100.f)) : 1.f; }
__device__ __forceinline__ unsigned pk4_fp8(float a, float b, float c, float d) { int w = 0; w = __builtin_amdgcn_cvt_pk_fp8_f32(a, b, w, false); w = __builtin_amdgcn_cvt_pk_fp8_f32(c, d, w, true); return (unsigned)w; }
__device__ __forceinline__ void convert_gate8(Frame& F, const float* w_in_l, const unsigned* amax_l, unsigned char* WG8, float* SW, int rot) {
    LAS float* scr = (LAS float*)(F.lds + RING_OFF + F.wave * 16384);
    const int NGW = F.G * NWAVES, gw = (F.vcu * NWAVES + F.wave + rot) % NGW, lane = F_LANE;
    for (int it = gw; it < 16 * 128; it += NGW) {
        const int kb = it / 128, nb = it % 128, k0 = kb * 64, g0 = nb * 32;
#pragma unroll
        for (int i = 0; i < 32; ++i) { const int kk = 2 * i + (lane >> 5); scr[kk * 33 + (lane & 31)] = w_in_l[(size_t)(k0 + kk) * D_IN + NPROJ_SRC + g0 + (lane & 31)]; }
        LDS_WAIT(); asm volatile("" ::: "memory");
#pragma unroll
        for (int j = 0; j < 2; ++j) { const int n = (lane >> 2) + 16 * j, c = lane & 3;
            const float sc = fp8_scale(__uint_as_float(amax_l[g0 + n])); const LAS float* sp = scr + (16 * c) * 33 + n;
            v4u o; o.x = pk4_fp8(sp[0 * 33] * sc, sp[1 * 33] * sc, sp[2 * 33] * sc, sp[3 * 33] * sc); o.y = pk4_fp8(sp[4 * 33] * sc, sp[5 * 33] * sc, sp[6 * 33] * sc, sp[7 * 33] * sc);
            o.z = pk4_fp8(sp[8 * 33] * sc, sp[9 * 33] * sc, sp[10 * 33] * sc, sp[11 * 33] * sc); o.w = pk4_fp8(sp[12 * 33] * sc, sp[13 * 33] * sc, sp[14 * 33] * sc, sp[15 * 33] * sc);
            const int drow = win_row(NPROJ_SRC + g0 + n) - PROJW;
            *(v4u*)(WG8 + (size_t)drow * DM + k0 + 16 * c) = o;
            if (kb == 0 && c == 0) SW[drow] = 1.f / sc; }
        LDS_WAIT(); asm volatile("" ::: "memory");
    }
}

__device__ __forceinline__ void convert_w8_job(Frame& F, const float* src, size_t sstride, int N, unsigned char* dst, size_t dstride, int mode, const unsigned* amax, int astride, float* SW, int swstride, int nmat, int rot, int K = DM) {
    LAS float* scr = (LAS float*)(F.lds + RING_OFF + F.wave * 16384);
    const int NGW = F.G * NWAVES, gw = (F.vcu * NWAVES + F.wave + rot) % NGW, lane = F_LANE;
    const int nnb = N / 32, per = (K / 64) * nnb, total = per * nmat;
    for (int it = gw; it < total; it += NGW) {
        const int mi = it / per, r = it % per, kb = r / nnb, nb = r % nnb, k0 = kb * 64, n0 = nb * 32;
        const float* W = src + (size_t)mi * sstride;
#pragma unroll
        for (int i = 0; i < 32; ++i) { const int kk = 2 * i + (lane >> 5); scr[kk * 33 + (lane & 31)] = W[(size_t)(k0 + kk) * N + n0 + (lane & 31)]; }
        LDS_WAIT(); asm volatile("" ::: "memory");
        const int drow0 = (mode == 0) ? n0 : (n0 >> 7) * 256 + (n0 & 127) + (mode == 3 ? 128 : 0);
#pragma unroll
        for (int j = 0; j < 2; ++j) { const int n = (lane >> 2) + 16 * j, c = lane & 3;
            const float sc = fp8_scale(__uint_as_float(amax[(size_t)mi * astride + n0 + n])); const LAS float* sp = scr + (16 * c) * 33 + n;
            v4u o; o.x = pk4_fp8(sp[0 * 33] * sc, sp[1 * 33] * sc, sp[2 * 33] * sc, sp[3 * 33] * sc); o.y = pk4_fp8(sp[4 * 33] * sc, sp[5 * 33] * sc, sp[6 * 33] * sc, sp[7 * 33] * sc);
            o.z = pk4_fp8(sp[8 * 33] * sc, sp[9 * 33] * sc, sp[10 * 33] * sc, sp[11 * 33] * sc); o.w = pk4_fp8(sp[12 * 33] * sc, sp[13 * 33] * sc, sp[14 * 33] * sc, sp[15 * 33] * sc);
            *(v4u*)(dst + (size_t)mi * dstride + (size_t)(drow0 + n) * K + k0 + 16 * c) = o;
            if (kb == 0 && c == 0) SW[(size_t)mi * swstride + drow0 + n] = 1.f / sc; }
        LDS_WAIT(); asm volatile("" ::: "memory");
    }
}
__device__ __forceinline__ void amax_job(Frame& F, const float* src, size_t sstride, int N, unsigned* amax, int astride, int nmat, int K = DM) {
    const int NGW = F.G * NWAVES, gw = F.vcu * NWAVES + F.wave, lane = F_LANE, ncb = N / 256, per = (K / 64) * ncb;
    for (int it = gw; it < per * nmat; it += NGW) { const int mi = it / per, r = it % per, kb = r / ncb, cb = r % ncb;
        const float* wp = src + (size_t)mi * sstride + (size_t)(kb * 64) * N + cb * 256 + 4 * lane; float4 mx = make_float4(0.f, 0.f, 0.f, 0.f);
#pragma unroll 16
        for (int q = 0; q < 64; ++q) { const float4 v = *(const float4*)(wp + (size_t)q * N); mx.x = fmaxf(mx.x, fabsf(v.x)); mx.y = fmaxf(mx.y, fabsf(v.y)); mx.z = fmaxf(mx.z, fabsf(v.z)); mx.w = fmaxf(mx.w, fabsf(v.w)); }
        unsigned* am = amax + (size_t)mi * astride + cb * 256 + 4 * lane;
        atomicMax(am + 0, __float_as_uint(mx.x)); atomicMax(am + 1, __float_as_uint(mx.y)); atomicMax(am + 2, __float_as_uint(mx.z)); atomicMax(am + 3, __float_as_uint(mx.w)); }
}
enum { IN_X = 0, IN_C, IN_POS, IN_N1G, IN_N2G, IN_ADAW, IN_ADAB, IN_WIN, IN_CONVW, IN_CQG, IN_WUQ, IN_CKVG, IN_WUKV, IN_QNG, IN_KNG, IN_GVG, IN_WS, IN_BS, IN_RETG, IN_WBR, IN_WO,
       IN_F1, IN_F3, IN_F2, IN_RW, IN_RB, IN_M1, IN_M3, IN_M2, N_IN };
enum { PH_PRO = 0, PH_PRO2 = 1, PL_NORM1 = 0, PL_INPROJ, PL_PRE, PL_SCAN, PL_ATTN, PL_GATE, PL_MERGE, PL_WO, PL_NORM2, PL_F0, PL_F1, PL_F2, PL_F3, PL_F4, PL_F5, PL_PER_LAYER = 16, N_PHASES = 2 + 2 * PL_PER_LAYER };
__host__ __device__ constexpr int PHL(int l, int k) { return 2 + l * PL_PER_LAYER + k; }

struct Args { const void* in[N_IN]; float* out; unsigned char* ws; int ph_lo, ph_hi, li, pad; };


typedef const __attribute__((address_space(4))) unsigned long long* karg_t;
__device__ __forceinline__ const void* karg_ptr(int idx) { karg_t k = (karg_t)__builtin_amdgcn_kernarg_segment_ptr(); asm volatile("" : "+s"(k)); return (const void*)(const __attribute__((address_space(1))) char*)k[idx]; }
#define K_IN(i) (karg_ptr(i))
#define K_OUT ((float*)karg_ptr(N_IN))
#define K_WS ((unsigned char*)karg_ptr(N_IN + 1))
__device__ __forceinline__ void norm_phase(Frame& F, const float* X, bf16* H, const float* gain, const float* ada_l, const int off_sh, const int off_sc,
                                           const float* router_w, const float* router_b, nv::Route* route, int* CNT, unsigned char* H8 = nullptr, float* SH = nullptr, const bool x16 = false, const int rbs = 4) {
    int lane_ = F_LANE; asm volatile("" : "+v"(lane_)); const int lane = lane_;
    LAS int* cnt = (LAS int*)(F.lds + RING_OFF);
    for (int blk = F.vcu; blk < NTOK / 128; blk += F.G) {
        if (router_w) { if (F_TID < NEXP) cnt[F_TID] = 0; __syncthreads(); }
        const int b = (blk * 128) / SEQ;
        for (int rb = 0; rb < 16; rb += rbs) {
          float4 gm[4], sh[4];
#pragma unroll
          for (int j = 0; j < 4; ++j) { const int col = 4 * (lane + 64 * j);
            const float4 g = *(const float4*)(gain + col), sc = *(const float4*)(ada_l + (size_t)b * 6 * DM + off_sc + col);
            gm[j] = make_float4(g.x * (1.f + sc.x), g.y * (1.f + sc.y), g.z * (1.f + sc.z), g.w * (1.f + sc.w));
            sh[j] = *(const float4*)(ada_l + (size_t)b * 6 * DM + off_sh + col); }
          {
          pg8::f32x4 v4[4][4];
#pragma unroll
          for (int q = 0; q < 4; ++q) if (q < rbs)
#pragma unroll
              for (int j = 0; j < 4; ++j) { const size_t xo = (size_t)(blk * 128 + F.wave * 16 + rb + q) * DM + 4 * (lane + 64 * j);
                  if (x16) { const pg8::u32x2 r = *(const pg8::u32x2*)((const bf16*)X + xo); v4[q][j] = (pg8::f32x4){pg8::bflo(r.x), pg8::bfhi(r.x), pg8::bflo(r.y), pg8::bfhi(r.y)}; }
                  else v4[q][j] = *(const pg8::f32x4*)(X + xo); }
#pragma unroll
          for (int qp = 0; qp < 4; qp += 2) if (qp < rbs) {
          pg8::f32x4 hall[2][4], lgq[2][2];
#pragma unroll
          for (int q = 0; q < 2; ++q) {
            const int m = blk * 128 + F.wave * 16 + rb + qp + q;
            float4 v[4]; float ss = 0.f;
#pragma unroll
            for (int j = 0; j < 4; ++j) { v[j] = make_float4(v4[qp + q][j][0], v4[qp + q][j][1], v4[qp + q][j][2], v4[qp + q][j][3]); ss += v[j].x * v[j].x + v[j].y * v[j].y + v[j].z * v[j].z + v[j].w * v[j].w; }
            ss = wave_sum(ss);
            const float rstd = rsqrtf(ss * (1.f / DM) + EPS);
            float amax = 0.f;
            lgq[q][0] = (pg8::f32x4){0.f, 0.f, 0.f, 0.f}; lgq[q][1] = lgq[q][0];
#pragma unroll
            for (int j = 0; j < 4; ++j) {
                const int col = 4 * (lane + 64 * j);
                const float h0 = v[j].x * rstd * gm[j].x + sh[j].x, h1 = v[j].y * rstd * gm[j].y + sh[j].y, h2 = v[j].z * rstd * gm[j].z + sh[j].z, h3 = v[j].w * rstd * gm[j].w + sh[j].w;
                if (H) { uint2 o; o.x = pk2(h0, h1); o.y = pk2(h2, h3); *(uint2*)(H + (size_t)m * DM + col) = o; }
                hall[q][j] = (pg8::f32x4){h0, h1, h2, h3};
                if (H8) amax = fmaxf(fmaxf(amax, fmaxf(fabsf(h0), fabsf(h1))), fmaxf(fabsf(h2), fabsf(h3)));
            }
            if (H8) {
#pragma unroll
                for (int o = 1; o < 64; o <<= 1) amax = fmaxf(amax, __shfl_xor(amax, o));
                const float sc = fp8_scale(amax);
#pragma unroll
                for (int j = 0; j < 4; ++j) *(unsigned*)(H8 + (size_t)m * DM + 4 * (lane + 64 * j)) = pk4_fp8(hall[q][j][0] * sc, hall[q][j][1] * sc, hall[q][j][2] * sc, hall[q][j][3] * sc);
                if (lane == 0) SH[m] = 1.f / sc;
            }
          }
          if (router_w) {
#pragma unroll
            for (int j = 0; j < 4; ++j) {
                const float4* rw = (const float4*)(router_w + (size_t)(4 * (lane + 64 * j)) * NEXP);
#pragma unroll
                for (int q2 = 0; q2 < 2; ++q2) { const float4 w0 = rw[q2], w1 = rw[2 + q2], w2 = rw[4 + q2], w3 = rw[6 + q2];
#pragma unroll
                    for (int q = 0; q < 2; ++q) { const float h0 = hall[q][j][0], h1 = hall[q][j][1], h2 = hall[q][j][2], h3 = hall[q][j][3];
                        lgq[q][q2][0] += h0 * w0.x + h1 * w1.x + h2 * w2.x + h3 * w3.x; lgq[q][q2][1] += h0 * w0.y + h1 * w1.y + h2 * w2.y + h3 * w3.y;
                        lgq[q][q2][2] += h0 * w0.z + h1 * w1.z + h2 * w2.z + h3 * w3.z; lgq[q][q2][3] += h0 * w0.w + h1 * w1.w + h2 * w2.w + h3 * w3.w; } }
            }
#pragma unroll
            for (int q = 0; q < 2; ++q) { const int m = blk * 128 + F.wave * 16 + rb + qp + q; float lg[NEXP];
#pragma unroll
                for (int e = 0; e < NEXP; ++e) lg[e] = wave_sum(lgq[q][e >> 2][e & 3]) + router_b[e];
                if (lane == 0) {
                    int e0 = 0; float l0 = lg[0];
#pragma unroll
                    for (int e = 1; e < NEXP; ++e) if (lg[e] > l0) { l0 = lg[e]; e0 = e; }
                    int e1 = -1; float l1 = -INFINITY;
#pragma unroll
                    for (int e = 0; e < NEXP; ++e) if (e != e0 && lg[e] > l1) { l1 = lg[e]; e1 = e; }
                    const float p0 = 1.f / (1.f + __expf(l1 - l0));
                    nv::Route r; r.e0 = e0; r.e1 = e1; r.p0 = p0; r.p1 = 1.f - p0; route[m] = r;
                    atomicAdd((int*)&cnt[e0], 1); atomicAdd((int*)&cnt[e1], 1);
                }
            }
          }
          }
          }
        }
        if (router_w) { __syncthreads(); if (F_TID < NEXP) CNT[blk * NEXP + F_TID] = cnt[F_TID]; __syncthreads(); }
    }
}

__device__ __forceinline__ void moe_assign_phase(Frame& F, const Args& args) {
    unsigned char* ws = K_WS;
    const nv::Route* route = (const nv::Route*)(ws + WS_ROUTE); const int* CNT = (const int*)(ws + WS_CNT); const unsigned char* H8 = ws + WS_H8; unsigned char* XS8 = ws + WS_XS8; const float* SH = (const float*)(ws + WS_SH); float* SXS = (float*)(ws + WS_SXS);
    int* SLOT = (int*)(ws + WS_SLOT); float* PSLOT = (float*)(ws + WS_PSLOT); int* PEXP = (int*)(ws + WS_PEXP);
    LAS int* sm = (LAS int*)(F.lds + RING_OFF);
    LAS int* tot = sm; LAS int* pre = sm + 8; LAS int* base = sm + 16; LAS int* wcnt = sm + 32; LAS int* ss0 = sm + 64; LAS int* ss1 = sm + 192;
    const int tid = F_TID, lane = F_LANE, w = F.wave;
    for (int blk = F.vcu; blk < NTOK / 128; blk += F.G) {
        if (tid < 16) sm[tid] = 0;
        __syncthreads();
        if (tid < 256) { const int4 c0 = *(const int4*)(CNT + tid * NEXP), c1 = *(const int4*)(CNT + tid * NEXP + 4); const int cc[8] = {c0.x, c0.y, c0.z, c0.w, c1.x, c1.y, c1.z, c1.w};
#pragma unroll
            for (int e = 0; e < NEXP; ++e) { int tv = cc[e], pv = (tid < blk) ? cc[e] : 0;
#pragma unroll
                for (int o = 1; o < 64; o <<= 1) { tv += __shfl_xor(tv, o); pv += __shfl_xor(pv, o); }
                if (lane == 0) { (void)__hip_atomic_fetch_add(tot + e, tv, __ATOMIC_RELAXED, __HIP_MEMORY_SCOPE_WORKGROUP); (void)__hip_atomic_fetch_add(pre + e, pv, __ATOMIC_RELAXED, __HIP_MEMORY_SCOPE_WORKGROUP); } } }
        __syncthreads();
        if (tid == 0) { int bsum = 0; for (int e = 0; e < NEXP; ++e) { base[e] = bsum; bsum += (tot[e] + 255) & ~255; } base[NEXP] = bsum; }
        __syncthreads();
        if (blk == 0) { for (int p = tid; p < MAXPANEL + 8; p += NWAVES * 64) { int e = -1;
#pragma unroll
                for (int x = 0; x < NEXP; ++x) if (p * 256 >= base[x] && p * 256 < base[x + 1]) e = x;
                if (p == MAXPANEL) e = base[NEXP] >> 8; PEXP[p] = e; } }
        if (blk < NEXP) { const int e = blk; for (int s = base[e] + tot[e] + tid; s < base[e + 1]; s += NWAVES * 64) PSLOT[s] = 0.f; }
        if (tid < 128) {
            const int t = blk * 128 + tid; const nv::Route r = route[t]; int rank0 = 0, rank1 = 0;
#pragma unroll
            for (int e = 0; e < NEXP; ++e) { const bool in = (r.e0 == e) || (r.e1 == e); const unsigned long long m = __ballot(in); if (lane == 0) wcnt[w * 8 + e] = __popcll(m);
                const int rk = __popcll(m & ((1ull << lane) - 1ull)); if (r.e0 == e) rank0 = rk; if (r.e1 == e) rank1 = rk; }
            ss0[tid] = rank0; ss1[tid] = rank1;
        }
        __syncthreads();
        if (tid < 128) {
            const int t = blk * 128 + tid; const nv::Route r = route[t]; int rank0 = ss0[tid], rank1 = ss1[tid];
            if (w == 1) { rank0 += wcnt[r.e0]; rank1 += wcnt[r.e1]; }
            const int s0 = base[r.e0] + pre[r.e0] + rank0, s1 = base[r.e1] + pre[r.e1] + rank1;
            SLOT[2 * t] = s0; SLOT[2 * t + 1] = s1; PSLOT[s0] = r.p0; PSLOT[s1] = r.p1;
            ss0[tid] = s0; ss1[tid] = s1;
        }
        __syncthreads();
        { const int rsub = tid >> 6, c16 = (tid & 63) * 16;
          v4u v[16]; float shv[16];
#pragma unroll
          for (int i = 0; i < 16; ++i) { v[i] = *(const v4u*)(H8 + (size_t)(blk * 128 + 8 * i + rsub) * DM + c16); shv[i] = SH[blk * 128 + 8 * i + rsub]; }
#pragma unroll
          for (int i = 0; i < 16; ++i) { const int row = 8 * i + rsub;
              *(v4u*)(XS8 + (size_t)ss0[row] * DM + c16) = v[i]; *(v4u*)(XS8 + (size_t)ss1[row] * DM + c16) = v[i];
              if ((tid & 63) == 0) { SXS[ss0[row]] = shv[i]; SXS[ss1[row]] = shv[i]; } } }
        __syncthreads();
    }
}

__device__ __forceinline__ float4 moe_yrow(const bf16* Y, const bf16* PART, int slot, int tail0, int c4) {
    if (slot < tail0) { const uint2 a = *(const uint2*)(Y + (size_t)slot * DM + c4); return make_float4(bf2f((bf16)(a.x & 0xffff)), bf2f((bf16)(a.x >> 16)), bf2f((bf16)(a.y & 0xffff)), bf2f((bf16)(a.y >> 16))); }
    float4 r = make_float4(0.f, 0.f, 0.f, 0.f);
#pragma unroll
    for (int kq = 0; kq < 2; ++kq) { const uint2 a = *(const uint2*)(PART + ((size_t)kq * (MAXTAIL * 256) + (slot - tail0)) * DM + c4);
        r.x += bf2f((bf16)(a.x & 0xffff)); r.y += bf2f((bf16)(a.x >> 16)); r.z += bf2f((bf16)(a.y & 0xffff)); r.w += bf2f((bf16)(a.y >> 16)); }
    return r;
}
__device__ __forceinline__ void moe_combine_phase(Frame& F, float* X, const bf16* Y, const bf16* PART, const int tail0, const int* SLOT, const float* g2) {
    const int gw = F.vcu * NWAVES + F.wave, NGW = F.G * NWAVES;
    for (int t0 = gw; t0 < NTOK; t0 += 2 * NGW) {
        const int t1 = t0 + NGW; const bool two = (t1 < NTOK); const int tb = two ? t1 : t0;
        int sl[4] = {SLOT[2 * t0], SLOT[2 * t0 + 1], SLOT[2 * tb], SLOT[2 * tb + 1]};
        const bf16* yp[4];
#pragma unroll
        for (int q = 0; q < 4; ++q) yp[q] = (sl[q] < tail0) ? Y + (size_t)sl[q] * DM : PART + (size_t)(sl[q] - tail0) * DM;
        uint2 yr[4][4]; float4 xa[4], xb[4], ga[4], gb[4];
#pragma unroll
        for (int j = 0; j < 4; ++j) { const int c4 = 4 * (F_LANE + 64 * j);
#pragma unroll
            for (int q = 0; q < 4; ++q) yr[q][j] = *(const uint2*)(yp[q] + c4);
            xa[j] = *(const float4*)(X + (size_t)t0 * DM + c4); xb[j] = *(const float4*)(X + (size_t)tb * DM + c4);
            ga[j] = *(const float4*)(g2 + (size_t)(t0 / SEQ) * 6 * DM + c4); gb[j] = *(const float4*)(g2 + (size_t)(tb / SEQ) * 6 * DM + c4); }
        float4 ys[4][4];
#pragma unroll
        for (int q = 0; q < 4; ++q)
#pragma unroll
            for (int j = 0; j < 4; ++j) { const uint2 a = yr[q][j]; ys[q][j] = make_float4(bf2f((bf16)(a.x & 0xffff)), bf2f((bf16)(a.x >> 16)), bf2f((bf16)(a.y & 0xffff)), bf2f((bf16)(a.y >> 16))); }
#pragma unroll
        for (int q = 0; q < 4; ++q) if (sl[q] >= tail0) {
#pragma unroll
            for (int j = 0; j < 4; ++j) { const int c4 = 4 * (F_LANE + 64 * j); const uint2 a = *(const uint2*)(PART + ((size_t)(MAXTAIL * 256) + (sl[q] - tail0)) * DM + c4);
                ys[q][j].x += bf2f((bf16)(a.x & 0xffff)); ys[q][j].y += bf2f((bf16)(a.x >> 16)); ys[q][j].z += bf2f((bf16)(a.y & 0xffff)); ys[q][j].w += bf2f((bf16)(a.y >> 16)); } }
#pragma unroll
        for (int j = 0; j < 4; ++j) { const int c4 = 4 * (F_LANE + 64 * j);
            { const float4 g = ga[j]; float4 x = xa[j];
              x.x += g.x * (ys[0][j].x + ys[1][j].x); x.y += g.y * (ys[0][j].y + ys[1][j].y); x.z += g.z * (ys[0][j].z + ys[1][j].z); x.w += g.w * (ys[0][j].w + ys[1][j].w); *(float4*)(X + (size_t)t0 * DM + c4) = x; }
            if (two) { const float4 g = gb[j]; float4 x = xb[j];
              x.x += g.x * (ys[2][j].x + ys[3][j].x); x.y += g.y * (ys[2][j].y + ys[3][j].y); x.z += g.z * (ys[2][j].z + ys[3][j].z); x.w += g.w * (ys[2][j].w + ys[3][j].w); *(float4*)(X + (size_t)t1 * DM + c4) = x; } }
    }
}

__device__ __forceinline__ void scan_phase(Frame& F, float* RET) {
    LAS float* T = (LAS float*)(F.lds + RING_OFF);
    const int tid = F_TID, el = tid & 127, seg = tid >> 7;
    for (int blk = F.vcu; blk < NBATCH * NHEAD * 4096 / 128; blk += F.G) {
        const int idx = blk * 128 + el, b = idx / (NHEAD * 4096), h = (idx / 4096) % NHEAD, ed = idx % 4096;
        const float cd = __expf(nv::ret_loggamma(h) * 128.f);
        float* p = RET + ((size_t)(b * NCHUNK + seg * 32) * NHEAD + h) * 4096 + ed; const size_t stp = (size_t)NHEAD * 4096;
        float v[32];
#pragma unroll
        for (int i = 0; i < 32; ++i) v[i] = p[(size_t)i * stp];
        float st = 0.f;
#pragma unroll
        for (int i = 0; i < 32; ++i) { const float kv = v[i]; v[i] = st; st = st * cd + kv; }
        T[seg * 128 + el] = st;
        __syncthreads();
        float cd32 = cd;
#pragma unroll
        for (int i = 0; i < 5; ++i) cd32 *= cd32;
        float carry = 0.f;
        for (int s2 = 0; s2 < seg; ++s2) carry = carry * cd32 + T[s2 * 128 + el];
        float w = carry;
#pragma unroll
        for (int i = 0; i < 32; ++i) { p[(size_t)i * stp] = v[i] + w; w *= cd; }
        __syncthreads();
    }
}
typedef short bf16x8 __attribute__((ext_vector_type(8)));
typedef float f32x4 __attribute__((ext_vector_type(4)));
typedef float f32x16 __attribute__((ext_vector_type(16)));
#define MFMA16(a, b, c) __builtin_amdgcn_mfma_f32_16x16x32_bf16((a), (b), (c), 0, 0, 0)
__device__ __forceinline__ float bflo_(unsigned w) { return __uint_as_float(w << 16); }
__device__ __forceinline__ float bfhi_(unsigned w) { return __uint_as_float(w & 0xffff0000u); }
__device__ __forceinline__ float sumsq8(bf16x8 v) { float s = 0.f;
#pragma unroll
    for (int i = 0; i < 8; ++i) { const float f = bf2f((bf16)v[i]); s += f * f; } return s; }
__device__ __forceinline__ int tofs(int row, int j) { return row * 256 + ((((j >> 3) ^ (row & 15)) << 4) | ((j & 7) << 1)); }
__device__ __forceinline__ float fast_gelu_tanh(float x) { const float u = 0.7978845608028654f * (x + 0.044715f * x * x * x);
    return x * __builtin_amdgcn_rcpf(1.f + __builtin_amdgcn_exp2f(-2.885390081777927f * u)); }

__device__ __forceinline__ void rope_sincos(const float fpos, const float f, float* s, float* c) {
    const float c_hi = 0.15915494f, c_lo = 6.4206e-9f;
    const float x_hi = fpos * f, x_lo = fmaf(fpos, f, -x_hi);
    const float r_hi = x_hi * c_hi, r_lo = fmaf(x_hi, c_hi, -r_hi) + x_hi * c_lo + x_lo * c_hi;
    const float fr = (r_hi - floorf(r_hi)) + r_lo;
    *s = __builtin_amdgcn_sinf(fr); *c = __builtin_amdgcn_cosf(fr);
}

template <int l> __device__ __forceinline__ void pre_conv(Frame& F, const Args& args, const int t0) {
    const bf16* P = (const bf16*)(K_WS + WS_PROJ); bf16* YB = (bf16*)(K_WS + WS_YB); const float* cw = (const float*)K_IN(IN_CONVW) + l * 3 * MIXW;
    int tid_ = F_TID; asm volatile("" : "+v"(tid_)); const int cg = tid_ & 31, tl = tid_ >> 5, c0 = cg * 8, tb = t0 + tl * 8, sb = tb % SEQ;
    float w0[8], w1[8], w2[8], u1[8], u2[8];
#pragma unroll
    for (int i = 0; i < 8; ++i) { w0[i] = cw[c0 + i]; w1[i] = cw[256 + c0 + i]; w2[i] = cw[512 + c0 + i]; u1[i] = 0.f; u2[i] = 0.f; }
    auto ldu = [&](int t, float* u) { const v4u a = *(const v4u*)(P + (size_t)t * PROJW + C_AC + c0), x = *(const v4u*)(P + (size_t)t * PROJW + C_AX + c0);
        u[0] = bflo_(a.x) * bflo_(x.x); u[1] = bfhi_(a.x) * bfhi_(x.x); u[2] = bflo_(a.y) * bflo_(x.y); u[3] = bfhi_(a.y) * bfhi_(x.y);
        u[4] = bflo_(a.z) * bflo_(x.z); u[5] = bfhi_(a.z) * bfhi_(x.z); u[6] = bflo_(a.w) * bflo_(x.w); u[7] = bfhi_(a.w) * bfhi_(x.w); };
    if (sb >= 1) ldu(tb - 1, u1);
    if (sb >= 2) ldu(tb - 2, u2);
    v4u la[8], lx[8], lb[8];
#pragma unroll
    for (int i = 0; i < 8; ++i) { const size_t o = (size_t)(tb + i) * PROJW + c0; la[i] = *(const v4u*)(P + o + C_AC); lx[i] = *(const v4u*)(P + o + C_AX); lb[i] = *(const v4u*)(P + o + C_AB); }
#pragma unroll
    for (int i = 0; i < 8; ++i) { const int t = tb + i; float u0[8];
        { const v4u a = la[i], x = lx[i];
          u0[0] = bflo_(a.x) * bflo_(x.x); u0[1] = bfhi_(a.x) * bfhi_(x.x); u0[2] = bflo_(a.y) * bflo_(x.y); u0[3] = bfhi_(a.y) * bfhi_(x.y);
          u0[4] = bflo_(a.z) * bflo_(x.z); u0[5] = bfhi_(a.z) * bfhi_(x.z); u0[6] = bflo_(a.w) * bflo_(x.w); u0[7] = bfhi_(a.w) * bfhi_(x.w); }
        const v4u ab = lb[i]; const float bb[8] = {bflo_(ab.x), bfhi_(ab.x), bflo_(ab.y), bfhi_(ab.y), bflo_(ab.z), bfhi_(ab.z), bflo_(ab.w), bfhi_(ab.w)};
        float y[8];
#pragma unroll
        for (int c = 0; c < 8; ++c) { y[c] = bb[c] * (w0[c] * u2[c] + w1[c] * u1[c] + w2[c] * u0[c]); u2[c] = u1[c]; u1[c] = u0[c]; }
        v4u o; o.x = pk2(y[0], y[1]); o.y = pk2(y[2], y[3]); o.z = pk2(y[4], y[5]); o.w = pk2(y[6], y[7]);
        *(v4u*)(YB + (size_t)t * DM + c0) = o; }
}

template <int l> __device__ __forceinline__ void pre_mla(Frame& F, const Args& args, const int t0) {
    unsigned char* ws = K_WS;
    const bf16* P = (const bf16*)(ws + WS_PROJ); bf16* Q = (bf16*)(ws + WS_Q); bf16* Kb = (bf16*)(ws + WS_K); bf16* VT = (bf16*)(ws + WS_VT);
    const bf16* WUQ = (const bf16*)(ws + WS_WUQ_T) + (size_t)l * QW * 256; const bf16* WUKV = (const bf16*)(ws + WS_WUKV_T) + (size_t)l * 512 * 128;
    const float* qn_g = (const float*)K_IN(IN_QNG) + l * QKH; const float* kn_g = (const float*)K_IN(IN_KNG) + l * QKH; const int* pos = (const int*)K_IN(IN_POS);
    int lane_ = F_LANE; asm volatile("" : "+v"(lane_)); const int lr = lane_ & 15, lq = lane_ >> 4;
    const int tw = t0 + F.wave * 16 + lr, b = t0 / SEQ, sw = (t0 % SEQ) + F.wave * 16;
    const bf16* prow = P + (size_t)tw * PROJW;
    bf16x8 xq[8], xkv[4]; float ssq = 0.f, sskv = 0.f;
#pragma unroll
    for (int s = 0; s < 8; ++s) { xq[s] = *(const bf16x8*)(prow + C_CQ + 32 * s + 8 * lq); ssq += sumsq8(xq[s]); }
#pragma unroll
    for (int s = 0; s < 4; ++s) { xkv[s] = *(const bf16x8*)(prow + C_CKV + 32 * s + 8 * lq); sskv += sumsq8(xkv[s]); }
    ssq += __shfl_xor(ssq, 16); ssq += __shfl_xor(ssq, 32); sskv += __shfl_xor(sskv, 16); sskv += __shfl_xor(sskv, 32);
    const float rq = rsqrtf(ssq * (1.f / 256) + EPS), rkv = rsqrtf(sskv * (1.f / 128) + EPS);
    float cs[4], sn[4]; { const float fpos = (float)pos[tw];
#pragma unroll
        for (int r = 0; r < 4; ++r) rope_sincos(fpos, powf(10000.f, -(float)(4 * lq + r) / 16.f), &sn[r], &cs[r]); }
    LAS unsigned char* wl = F.lds + RING_OFF; const int tid_w = F_TID;
    v4u wv6[6], wv4[4];
#pragma unroll
    for (int i = 0; i < 6; ++i) { const int p = tid_w + 512 * i; wv6[i] = *(const v4u*)(WUQ + (size_t)(p >> 5) * 256 + (p & 31) * 8); }
#pragma unroll 1
    for (int h = 0; h < NHEAD; ++h) {
        __syncthreads();
#pragma unroll
        for (int i = 0; i < 6; ++i) { const int p = tid_w + 512 * i; *(LAS v4u*)(wl + (p >> 5) * 528 + (p & 31) * 16) = wv6[i]; }
        __syncthreads();
        if (h + 1 < NHEAD) {
#pragma unroll
            for (int i = 0; i < 6; ++i) { const int p = tid_w + 512 * i; wv6[i] = *(const v4u*)(WUQ + (size_t)((h + 1) * 96 + (p >> 5)) * 256 + (p & 31) * 8); }
        } else {
#pragma unroll
            for (int i = 0; i < 4; ++i) { const int p = tid_w + 512 * i; wv4[i] = *(const v4u*)(WUKV + (size_t)(p >> 4) * 128 + (p & 15) * 8); }
        }
        f32x4 acc[6];
#pragma unroll
        for (int nt = 0; nt < 6; ++nt) acc[nt] = (f32x4){0.f, 0.f, 0.f, 0.f};
#pragma unroll
        for (int s = 0; s < 8; ++s)
#pragma unroll
            for (int nt = 0; nt < 6; ++nt) { const bf16x8 wf = *(const LAS bf16x8*)(wl + (nt * 16 + lr) * 528 + (32 * s + 8 * lq) * 2); acc[nt] = MFMA16(wf, xq[s], acc[nt]); }
        float ss = 0.f;
#pragma unroll
        for (int nt = 0; nt < 6; ++nt) { acc[nt] = acc[nt] * rq; ss += acc[nt][0] * acc[nt][0] + acc[nt][1] * acc[nt][1] + acc[nt][2] * acc[nt][2] + acc[nt][3] * acc[nt][3]; }
        ss += __shfl_xor(ss, 16); ss += __shfl_xor(ss, 32);
        const float rh = rsqrtf(ss * (1.f / 96) + EPS);
#pragma unroll
        for (int nt = 0; nt < 6; ++nt) { const f32x4 g = *(const f32x4*)(qn_g + nt * 16 + 4 * lq); acc[nt] = acc[nt] * rh * g; }
#pragma unroll
        for (int r = 0; r < 4; ++r) { const float x1 = acc[4][r], x2 = acc[5][r]; acc[4][r] = x1 * cs[r] - x2 * sn[r]; acc[5][r] = x2 * cs[r] + x1 * sn[r]; }
#pragma unroll
        for (int nt = 0; nt < 6; ++nt) { v2u o; o.x = pk2(acc[nt][0] * ATT_C2, acc[nt][1] * ATT_C2); o.y = pk2(acc[nt][2] * ATT_C2, acc[nt][3] * ATT_C2);
            *(v2u*)(Q + (size_t)tw * QW + h * 96 + nt * 16 + 4 * lq) = o; }
    }
    float kr1[4], kr2[4]; { const v2u a = *(const v2u*)(prow + C_KR + 4 * lq), c = *(const v2u*)(prow + C_KR + 16 + 4 * lq);
        kr1[0] = bflo_(a.x); kr1[1] = bfhi_(a.x); kr1[2] = bflo_(a.y); kr1[3] = bfhi_(a.y); kr2[0] = bflo_(c.x); kr2[1] = bfhi_(c.x); kr2[2] = bflo_(c.y); kr2[3] = bfhi_(c.y); }
    float sskr = 0.f;
#pragma unroll
    for (int r = 0; r < 4; ++r) sskr += kr1[r] * kr1[r] + kr2[r] * kr2[r];
    float rkv_r[4];
#pragma unroll
    for (int r = 0; r < 4; ++r) rkv_r[r] = __shfl(rkv, 4 * lq + r);
#pragma unroll 1
    for (int h = 0; h < NHEAD; ++h) {
        __syncthreads();
#pragma unroll
        for (int i = 0; i < 4; ++i) { const int p = tid_w + 512 * i; *(LAS v4u*)(wl + (p >> 4) * 272 + (p & 15) * 16) = wv4[i]; }
        __syncthreads();
        if (h + 1 < NHEAD) {
#pragma unroll
            for (int i = 0; i < 4; ++i) { const int p = tid_w + 512 * i; wv4[i] = *(const v4u*)(WUKV + (size_t)((h + 1) * 128 + (p >> 4)) * 128 + (p & 15) * 8); }
        }
        f32x4 ak[4], av[4];
#pragma unroll
        for (int nt = 0; nt < 4; ++nt) { ak[nt] = (f32x4){0.f, 0.f, 0.f, 0.f}; av[nt] = (f32x4){0.f, 0.f, 0.f, 0.f}; }
#pragma unroll
        for (int s = 0; s < 4; ++s)
#pragma unroll
            for (int nt = 0; nt < 4; ++nt) {
                const bf16x8 wk = *(const LAS bf16x8*)(wl + (nt * 16 + lr) * 272 + (32 * s + 8 * lq) * 2); ak[nt] = MFMA16(wk, xkv[s], ak[nt]);
                const bf16x8 wv = *(const LAS bf16x8*)(wl + (64 + nt * 16 + lr) * 272 + (32 * s + 8 * lq) * 2); av[nt] = MFMA16(xkv[s], wv, av[nt]);
            }
        float ss = sskr;
#pragma unroll
        for (int nt = 0; nt < 4; ++nt) { ak[nt] = ak[nt] * rkv; ss += ak[nt][0] * ak[nt][0] + ak[nt][1] * ak[nt][1] + ak[nt][2] * ak[nt][2] + ak[nt][3] * ak[nt][3]; }
        ss += __shfl_xor(ss, 16); ss += __shfl_xor(ss, 32);
        const float rk = rsqrtf(ss * (1.f / 96) + EPS);
#pragma unroll
        for (int nt = 0; nt < 4; ++nt) { const f32x4 g = *(const f32x4*)(kn_g + nt * 16 + 4 * lq); const f32x4 v = ak[nt] * rk * g; v2u o; o.x = pk2(v[0], v[1]); o.y = pk2(v[2], v[3]);
            *(v2u*)(Kb + (size_t)tw * QW + h * 96 + nt * 16 + 4 * lq) = o; }
        { const f32x4 g1 = *(const f32x4*)(kn_g + 64 + 4 * lq), g2 = *(const f32x4*)(kn_g + 80 + 4 * lq); float o1[4], o2[4];
#pragma unroll
          for (int r = 0; r < 4; ++r) { const float x1 = kr1[r] * rk * g1[r], x2 = kr2[r] * rk * g2[r]; o1[r] = x1 * cs[r] - x2 * sn[r]; o2[r] = x2 * cs[r] + x1 * sn[r]; }
          v2u a; a.x = pk2(o1[0], o1[1]); a.y = pk2(o1[2], o1[3]); *(v2u*)(Kb + (size_t)tw * QW + h * 96 + 64 + 4 * lq) = a;
          v2u c; c.x = pk2(o2[0], o2[1]); c.y = pk2(o2[2], o2[3]); *(v2u*)(Kb + (size_t)tw * QW + h * 96 + 80 + 4 * lq) = c; }
#pragma unroll
        for (int nt = 0; nt < 4; ++nt) { v2u o; o.x = pk2(av[nt][0] * rkv_r[0], av[nt][1] * rkv_r[1]); o.y = pk2(av[nt][2] * rkv_r[2], av[nt][3] * rkv_r[3]);
            *(v2u*)(VT + ((size_t)(b * NHEAD + h) * 64 + nt * 16 + lr) * SEQ + sw + 4 * lq) = o; }
    }
    __syncthreads();
}

template <int l> __device__ __forceinline__ void pre_sgu(Frame& F, const Args& args, const int t0) {
    unsigned char* ws = K_WS;
    const bf16* P = (const bf16*)(ws + WS_PROJ); bf16* YB = (bf16*)(ws + WS_YB); const bf16* WST = (const bf16*)(ws + WS_WS_T) + (size_t)l * 4 * 128 * 128;
    const float* gv_g = (const float*)K_IN(IN_GVG) + l * 256; const float* b_s = (const float*)K_IN(IN_BS) + l * 4 * 128;
    LAS unsigned char* vT = F.lds + RING_OFF;
    int lane_ = F_LANE; asm volatile("" : "+v"(lane_)); const int lane = lane_, lr = lane & 15, lq = lane >> 4, w = F.wave;
    { const f32x4 gg = *(const f32x4*)(gv_g + 4 * lane);
      v2u a16[16];
#pragma unroll
      for (int j = 0; j < 16; ++j) a16[j] = *(const v2u*)(P + (size_t)(t0 + 16 * w + j) * PROJW + C_SV + 4 * lane);
#pragma unroll
      for (int j = 0; j < 16; ++j) { const int s = 16 * w + j; const v2u a = a16[j];
          float v[4] = {fast_gelu_tanh(bflo_(a.x)), fast_gelu_tanh(bfhi_(a.x)), fast_gelu_tanh(bflo_(a.y)), fast_gelu_tanh(bfhi_(a.y))};
          float ss = v[0] * v[0] + v[1] * v[1] + v[2] * v[2] + v[3] * v[3];
          ss += __shfl_xor(ss, 1); ss += __shfl_xor(ss, 2); ss += __shfl_xor(ss, 4); ss += __shfl_xor(ss, 8);
          const float rs = rsqrtf(ss * (1.f / 64) + EPS);
#pragma unroll
          for (int i = 0; i < 4; ++i) *(LAS bf16*)(vT + tofs(4 * lane + i, s)) = f2bf(v[i] * rs * gg[i]); } }
    __syncthreads();
    const int tw = t0 + 16 * w + lr, nks = (16 * w + 15) / 32 + 1;
#pragma unroll 1
    for (int g = 0; g < 4; ++g) {
        f32x4 acc[4];
#pragma unroll
        for (int ct = 0; ct < 4; ++ct) acc[ct] = (f32x4){0.f, 0.f, 0.f, 0.f};
        bf16x8 wf4[4]; v2u au[4];
#pragma unroll
        for (int ks = 0; ks < 4; ++ks) wf4[ks] = *(const bf16x8*)(WST + ((size_t)g * 128 + 16 * w + lr) * 128 + 32 * ks + 8 * lq);
#pragma unroll
        for (int ct = 0; ct < 4; ++ct) au[ct] = *(const v2u*)(P + (size_t)tw * PROJW + C_SU + g * 64 + ct * 16 + 4 * lq);
        const float bb = b_s[g * 128 + 16 * w + lr];
#pragma unroll
        for (int ks = 0; ks < 4; ++ks) if (ks < nks) { const bf16x8 wf = wf4[ks];
#pragma unroll
            for (int ct = 0; ct < 4; ++ct) { const bf16x8 vf = *(const LAS bf16x8*)(vT + tofs(g * 64 + ct * 16 + lr, 32 * ks + 8 * lq)); acc[ct] = MFMA16(vf, wf, acc[ct]); } }
#pragma unroll
        for (int ct = 0; ct < 4; ++ct) { const v2u a = au[ct];
            v2u o; o.x = pk2(fast_gelu_tanh(bflo_(a.x)) * (acc[ct][0] + bb), fast_gelu_tanh(bfhi_(a.x)) * (acc[ct][1] + bb)); o.y = pk2(fast_gelu_tanh(bflo_(a.y)) * (acc[ct][2] + bb), fast_gelu_tanh(bfhi_(a.y)) * (acc[ct][3] + bb));
            *(v2u*)(YB + (size_t)tw * DM + 512 + g * 64 + ct * 16 + 4 * lq) = o; }
    }
    __syncthreads();
}

__device__ __forceinline__ void pre_retkv(Frame& F, const Args& args, const int t0, const int ch) {
    unsigned char* ws = K_WS;
    bf16* P = (bf16*)(ws + WS_PROJ); float* RET = (float*)(ws + WS_RET); const int* pos = (const int*)K_IN(IN_POS);
    LAS unsigned char* kT = F.lds + RING_OFF; LAS unsigned char* vT = F.lds + RING_OFF + 65536;
    int lane_ = F_LANE; asm volatile("" : "+v"(lane_)); const int lane = lane_, lr = lane & 15, lq = lane >> 4, w = F.wave;
    { const int h = lane >> 4, i0 = (lane & 15) * 2; const float lg = nv::ret_loggamma(h);
      const float f0 = powf(10000.f, -(float)i0 / 32.f), f1 = powf(10000.f, -(float)(i0 + 1) / 32.f);
      for (int jb = 0; jb < 16; jb += 8) {
        unsigned q1a[8], q2a[8], k1a[8], k2a[8]; v2u vva[8]; int posa[8];
#pragma unroll
        for (int jj = 0; jj < 8; ++jj) { const int s = 16 * w + jb + jj; const bf16* r = P + (size_t)(t0 + s) * PROJW; posa[jj] = pos[t0 + s];
            q1a[jj] = *(const unsigned*)(r + C_RQ + h * 64 + i0); q2a[jj] = *(const unsigned*)(r + C_RQ + h * 64 + 32 + i0); k1a[jj] = *(const unsigned*)(r + C_RK + h * 64 + i0); k2a[jj] = *(const unsigned*)(r + C_RK + h * 64 + 32 + i0);
            vva[jj] = *(const v2u*)(r + C_RV + 4 * lane); }
#pragma unroll
        for (int jj = 0; jj < 8; ++jj) { const int j = jb + jj; const int s = 16 * w + j; bf16* r = P + (size_t)(t0 + s) * PROJW; const float fpos = (float)posa[jj];
          const unsigned q1 = q1a[jj], q2 = q2a[jj], k1 = k1a[jj], k2 = k2a[jj];
          const v2u vv = vva[jj];
          float s0, c0, s1, c1; rope_sincos(fpos, f0, &s0, &c0); rope_sincos(fpos, f1, &s1, &c1);
          const float dq = __expf(lg * (float)s), dk = 0.125f * __expf(-lg * (float)s);
          const unsigned qa = pk2((bflo_(q1) * c0 - bflo_(q2) * s0) * dq, (bfhi_(q1) * c1 - bfhi_(q2) * s1) * dq), qb = pk2((bflo_(q2) * c0 + bflo_(q1) * s0) * dq, (bfhi_(q2) * c1 + bfhi_(q1) * s1) * dq);
          const unsigned ka = pk2((bflo_(k1) * c0 - bflo_(k2) * s0) * dk, (bfhi_(k1) * c1 - bfhi_(k2) * s1) * dk), kb = pk2((bflo_(k2) * c0 + bflo_(k1) * s0) * dk, (bfhi_(k2) * c1 + bfhi_(k1) * s1) * dk);
          *(unsigned*)(r + C_RQ + h * 64 + i0) = qa; *(unsigned*)(r + C_RQ + h * 64 + 32 + i0) = qb; *(unsigned*)(r + C_RK + h * 64 + i0) = ka; *(unsigned*)(r + C_RK + h * 64 + 32 + i0) = kb;
          *(LAS bf16*)(kT + tofs(h * 64 + i0, s)) = (bf16)(ka & 0xffff); *(LAS bf16*)(kT + tofs(h * 64 + i0 + 1, s)) = (bf16)(ka >> 16);
          *(LAS bf16*)(kT + tofs(h * 64 + 32 + i0, s)) = (bf16)(kb & 0xffff); *(LAS bf16*)(kT + tofs(h * 64 + 32 + i0 + 1, s)) = (bf16)(kb >> 16);
          *(LAS bf16*)(vT + tofs(4 * lane + 0, s)) = (bf16)(vv.x & 0xffff); *(LAS bf16*)(vT + tofs(4 * lane + 1, s)) = (bf16)(vv.x >> 16);
          *(LAS bf16*)(vT + tofs(4 * lane + 2, s)) = (bf16)(vv.y & 0xffff); *(LAS bf16*)(vT + tofs(4 * lane + 3, s)) = (bf16)(vv.y >> 16); } } }
    __syncthreads();
    { const int h = w >> 1; const float g127 = __expf(nv::ret_loggamma(h) * 127.f);
      f32x4 acc[4][2];
#pragma unroll
      for (int dt = 0; dt < 4; ++dt)
#pragma unroll
          for (int ei = 0; ei < 2; ++ei) acc[dt][ei] = (f32x4){0.f, 0.f, 0.f, 0.f};
#pragma unroll
      for (int ks = 0; ks < 4; ++ks) { bf16x8 vf[2];
#pragma unroll
          for (int ei = 0; ei < 2; ++ei) vf[ei] = *(const LAS bf16x8*)(vT + tofs(h * 64 + ((w & 1) * 2 + ei) * 16 + lr, 32 * ks + 8 * lq));
#pragma unroll
          for (int dt = 0; dt < 4; ++dt) { const bf16x8 kf = *(const LAS bf16x8*)(kT + tofs(h * 64 + dt * 16 + lr, 32 * ks + 8 * lq));
#pragma unroll
              for (int ei = 0; ei < 2; ++ei) acc[dt][ei] = MFMA16(kf, vf[ei], acc[dt][ei]); } }
#pragma unroll
      for (int dt = 0; dt < 4; ++dt)
#pragma unroll
          for (int ei = 0; ei < 2; ++ei) *(f32x4*)(RET + (((size_t)ch * NHEAD + h) * 64 + ((w & 1) * 2 + ei) * 16 + lr) * 64 + dt * 16 + 4 * lq) = acc[dt][ei] * g127; }
    __syncthreads();
}

template <int l> __device__ __forceinline__ void pre_phase(Frame& F, const Args& args) {
    for (int ch = F.vcu; ch < NTOK / CHUNK; ch += F.G) {
        const int t0 = ch * CHUNK;
        pre_conv<l>(F, args, t0);
        pre_mla<l>(F, args, t0);
        pre_sgu<l>(F, args, t0);
        pre_retkv(F, args, t0, ch);
    }
}
#define MFMA32(a, b, c) __builtin_amdgcn_mfma_f32_32x32x16_bf16((a), (b), (c), 0, 0, 0)
typedef short s16x4 __attribute__((ext_vector_type(4)));
constexpr int AT_KROW = 208, AT_VROW = 136, AT_KBYTES = 64 * AT_KROW, AT_STAGE = 22528;
__device__ __forceinline__ int crow32(int r, int hi) { return (r & 3) + 8 * (r >> 2) + 4 * hi; }

__device__ __forceinline__ void attn_unit(Frame& F, const bf16* Q, const bf16* Kb, const bf16* VT, bf16* YB, const float nbnd, const int b, const int h, const int qb) {
    int tid_ = F_TID; asm volatile("" : "+v"(tid_)); const int tid = tid_, lane = tid & 63, r32 = lane & 31, hi = lane >> 5, w = F.wave;
    LAS unsigned char* lds = F.lds + RING_OFF;
    const int bh = b * NHEAD + h, qw0 = qb * 256 + w * 32;
    const size_t tq = (size_t)b * SEQ + qw0 + r32;
    bf16x8 qf[6];
#pragma unroll
    for (int s = 0; s < 6; ++s) qf[s] = *(const bf16x8*)(Q + tq * QW + h * 96 + 16 * s + 8 * hi);
    f32x16 o0, o1, negb; float lsum = 0.f;
#pragma unroll
    for (int r = 0; r < 16; ++r) { o0[r] = 0.f; o1[r] = 0.f; negb[r] = nbnd; }
    asm volatile("" : "+v"(negb));
    const int ntile = 4 * qb + 4;
    const int kr0 = tid / 12, kc0 = tid % 12, kr1 = (tid + 512) / 12, kc1 = (tid + 512) % 12, vd = tid >> 3, vc = tid & 7;
    const bf16* kg0 = Kb + ((size_t)b * SEQ + kr0) * QW + h * 96 + kc0 * 8; const bf16* kg1 = Kb + ((size_t)b * SEQ + kr1) * QW + h * 96 + kc1 * 8;
    const bf16* vg = VT + ((size_t)bh * 64 + vd) * SEQ + vc * 8;
    const int kl0 = kr0 * AT_KROW + kc0 * 16, kl1 = kr1 * AT_KROW + kc1 * 16, vl = AT_KBYTES + vd * AT_VROW + vc * 16;
    v4u rk0, rk1, rv; rk1 = (v4u){0u, 0u, 0u, 0u};
    rk0 = *(const v4u*)kg0; if (tid < 256) rk1 = *(const v4u*)kg1; rv = *(const v4u*)vg;
    *(LAS v4u*)(lds + kl0) = rk0; if (tid < 256) *(LAS v4u*)(lds + kl1) = rk1;
    *(LAS v2u*)(lds + vl) = (v2u){rv.x, rv.y}; *(LAS v2u*)(lds + vl + 8) = (v2u){rv.z, rv.w};
    __syncthreads();
    const int ka = r32 * AT_KROW + hi * 16;
    const int va = AT_KBYTES + r32 * AT_VROW + hi * 8;
    for (int t = 0; t < ntile; ++t) {
        LAS unsigned char* cur = lds + (t & 1) * AT_STAGE; LAS unsigned char* nxt = lds + ((t + 1) & 1) * AT_STAGE;
        const bool more = (t + 1 < ntile);
        if (more) { const size_t ko = (size_t)(t + 1) * 64 * QW; rk0 = *(const v4u*)(kg0 + ko); if (tid < 256) rk1 = *(const v4u*)(kg1 + ko); rv = *(const v4u*)(vg + (t + 1) * 64); }
        if (64 * t <= qw0 + 31) {
            f32x16 p0, p1;
#pragma unroll
            for (int s = 0; s < 6; ++s) { const bf16x8 k0 = *(const LAS bf16x8*)(cur + ka + s * 32), k1 = *(const LAS bf16x8*)(cur + ka + 32 * AT_KROW + s * 32);
                if (s == 0) { p0 = MFMA32(k0, qf[0], negb); p1 = MFMA32(k1, qf[0], negb); } else { p0 = MFMA32(k0, qf[s], p0); p1 = MFMA32(k1, qf[s], p1); } }
#pragma unroll
            for (int r = 0; r < 16; ++r) { p0[r] = __builtin_amdgcn_exp2f(p0[r]); p1[r] = __builtin_amdgcn_exp2f(p1[r]); }
            if (64 * t + 63 > qw0) {
                const int qrel = qw0 + r32 - 64 * t;
#pragma unroll
                for (int r = 0; r < 16; ++r) { const int kk = crow32(r, hi); if (kk > qrel) p0[r] = 0.f; if (kk + 32 > qrel) p1[r] = 0.f; }
            }
            float sacc = 0.f;
#pragma unroll
            for (int r = 0; r < 16; ++r) sacc += p0[r] + p1[r];
            lsum += sacc;
            bf16x8 pb[2][2];
#pragma unroll
            for (int s2 = 0; s2 < 2; ++s2) {
                const v4u a = {pg8::cvt_pk_bf16(p0[8 * s2 + 0], p0[8 * s2 + 1]), pg8::cvt_pk_bf16(p0[8 * s2 + 2], p0[8 * s2 + 3]), pg8::cvt_pk_bf16(p0[8 * s2 + 4], p0[8 * s2 + 5]), pg8::cvt_pk_bf16(p0[8 * s2 + 6], p0[8 * s2 + 7])};
                const v4u c = {pg8::cvt_pk_bf16(p1[8 * s2 + 0], p1[8 * s2 + 1]), pg8::cvt_pk_bf16(p1[8 * s2 + 2], p1[8 * s2 + 3]), pg8::cvt_pk_bf16(p1[8 * s2 + 4], p1[8 * s2 + 5]), pg8::cvt_pk_bf16(p1[8 * s2 + 6], p1[8 * s2 + 7])};
                pb[0][s2] = __builtin_bit_cast(bf16x8, a); pb[1][s2] = __builtin_bit_cast(bf16x8, c); }
#pragma unroll
            for (int kh = 0; kh < 2; ++kh)
#pragma unroll
                for (int s2 = 0; s2 < 2; ++s2) {
                    const int ko = (kh * 32 + 16 * s2) * 2;
                    const s16x4 a0 = *(const LAS s16x4*)(cur + va + ko), a1 = *(const LAS s16x4*)(cur + va + ko + 16);
                    const s16x4 c0 = *(const LAS s16x4*)(cur + va + 32 * AT_VROW + ko), c1 = *(const LAS s16x4*)(cur + va + 32 * AT_VROW + ko + 16);
                    const bf16x8 vf0 = {a0[0], a0[1], a0[2], a0[3], a1[0], a1[1], a1[2], a1[3]}, vf1 = {c0[0], c0[1], c0[2], c0[3], c1[0], c1[1], c1[2], c1[3]};
                    o0 = MFMA32(vf0, pb[kh][s2], o0); o1 = MFMA32(vf1, pb[kh][s2], o1); }
        }
        if (more) { *(LAS v4u*)(nxt + kl0) = rk0; if (tid < 256) *(LAS v4u*)(nxt + kl1) = rk1; *(LAS v2u*)(nxt + vl) = (v2u){rv.x, rv.y}; *(LAS v2u*)(nxt + vl + 8) = (v2u){rv.z, rv.w}; }
        __syncthreads();
    }
    lsum += __shfl_xor(lsum, 32);
    const float il = 1.f / lsum;
    bf16* orow = YB + tq * DM + 256 + h * 64;
#pragma unroll
    for (int g = 0; g < 4; ++g) {
        v2u a; a.x = pg8::cvt_pk_bf16(o0[4 * g] * il, o0[4 * g + 1] * il); a.y = pg8::cvt_pk_bf16(o0[4 * g + 2] * il, o0[4 * g + 3] * il); *(v2u*)(orow + 8 * g + 4 * hi) = a;
        v2u c; c.x = pg8::cvt_pk_bf16(o1[4 * g] * il, o1[4 * g + 1] * il); c.y = pg8::cvt_pk_bf16(o1[4 * g + 2] * il, o1[4 * g + 3] * il); *(v2u*)(orow + 32 + 8 * g + 4 * hi) = c; }
}

template <int l> __device__ __forceinline__ void ret_out_chunk(Frame& F, const Args& args, const int ch) {
    unsigned char* ws = K_WS;
    const bf16* P = (const bf16*)(ws + WS_PROJ); const float* RET = (const float*)(ws + WS_RET); bf16* YB = (bf16*)(ws + WS_YB); const float* ret_g = (const float*)K_IN(IN_RETG) + l * 256;
    LAS unsigned char* vT = F.lds + RING_OFF;
    int lane_ = F_LANE; asm volatile("" : "+v"(lane_)); const int lane = lane_, lr = lane & 15, lq = lane >> 4, w = F.wave;
    const int t0 = ch * CHUNK;
    v2u vv16[16];
#pragma unroll
    for (int j = 0; j < 16; ++j) vv16[j] = *(const v2u*)(P + (size_t)(t0 + 16 * w + j) * PROJW + C_RV + 4 * lane);
#pragma unroll
    for (int j = 0; j < 16; ++j) { const int s = 16 * w + j; const v2u vv = vv16[j];
        *(LAS bf16*)(vT + tofs(4 * lane + 0, s)) = (bf16)(vv.x & 0xffff); *(LAS bf16*)(vT + tofs(4 * lane + 1, s)) = (bf16)(vv.x >> 16);
        *(LAS bf16*)(vT + tofs(4 * lane + 2, s)) = (bf16)(vv.y & 0xffff); *(LAS bf16*)(vT + tofs(4 * lane + 3, s)) = (bf16)(vv.y >> 16); }
    __syncthreads();
    const size_t ti = (size_t)t0 + 16 * w + lr;
#pragma unroll 1
    for (int h = 0; h < NHEAD; ++h) {
        const float gam = __expf(nv::ret_loggamma(h));
        bf16x8 qf[2];
#pragma unroll
        for (int ks = 0; ks < 2; ++ks) qf[ks] = *(const bf16x8*)(P + ti * PROJW + C_RQ + h * 64 + 32 * ks + 8 * lq);
        f32x4 acc[4];
#pragma unroll
        for (int et = 0; et < 4; ++et) acc[et] = (f32x4){0.f, 0.f, 0.f, 0.f};
        bf16x8 kfa[8][2];
#pragma unroll
        for (int jt = 0; jt < 8; ++jt) if (jt <= w) {
#pragma unroll
            for (int ks = 0; ks < 2; ++ks) kfa[jt][ks] = *(const bf16x8*)(P + (size_t)(t0 + jt * 16 + lr) * PROJW + C_RK + h * 64 + 32 * ks + 8 * lq); }
        bf16x8 stf[2][4];
#pragma unroll
        for (int ks = 0; ks < 2; ++ks)
#pragma unroll
            for (int et = 0; et < 4; ++et) { const float* pr = RET + (((size_t)ch * NHEAD + h) * 64 + et * 16 + lr) * 64 + 32 * ks + 8 * lq; const f32x4 x0 = *(const f32x4*)pr, x1 = *(const f32x4*)(pr + 4);
                const v4u pw = {pk2(x0[0] * gam, x0[1] * gam), pk2(x0[2] * gam, x0[3] * gam), pk2(x1[0] * gam, x1[1] * gam), pk2(x1[2] * gam, x1[3] * gam)};
                stf[ks][et] = __builtin_bit_cast(bf16x8, pw); }
        v2u rga[4]; f32x4 ga[4];
#pragma unroll
        for (int et = 0; et < 4; ++et) { const int c = h * 64 + et * 16 + 4 * lq; rga[et] = *(const v2u*)(P + ti * PROJW + C_RG + c); ga[et] = *(const f32x4*)(ret_g + c); }
#pragma unroll
        for (int kk = 0; kk < 4; ++kk) if (kk <= (w >> 1)) {
            const int jt0 = 2 * kk, jt1 = 2 * kk + 1;
            f32x4 s0 = {0.f, 0.f, 0.f, 0.f}, s1 = {0.f, 0.f, 0.f, 0.f};
#pragma unroll
            for (int ks = 0; ks < 2; ++ks) s0 = MFMA16(kfa[jt0][ks], qf[ks], s0);
            if (jt1 <= w) {
#pragma unroll
                for (int ks = 0; ks < 2; ++ks) s1 = MFMA16(kfa[jt1][ks], qf[ks], s1); }
            if (jt0 == w) {
#pragma unroll
                for (int r = 0; r < 4; ++r) if (4 * lq + r > lr) s0[r] = 0.f; }
            if (jt1 == w) {
#pragma unroll
                for (int r = 0; r < 4; ++r) if (4 * lq + r > lr) s1[r] = 0.f; }
            const v4u pw = {pk2(s0[0], s0[1]), pk2(s0[2], s0[3]), pk2(s1[0], s1[1]), pk2(s1[2], s1[3])};
            const bf16x8 pb = __builtin_bit_cast(bf16x8, pw);
#pragma unroll
            for (int et = 0; et < 4; ++et) { const int row = h * 64 + et * 16 + lr;
                const s16x4 a0 = *(const LAS s16x4*)(vT + tofs(row, jt0 * 16 + 4 * lq)), a1 = *(const LAS s16x4*)(vT + tofs(row, (jt1 & 7) * 16 + 4 * lq));
                const bf16x8 vf = {a0[0], a0[1], a0[2], a0[3], a1[0], a1[1], a1[2], a1[3]};
                acc[et] = MFMA16(vf, pb, acc[et]); }
        }
#pragma unroll
        for (int ks = 0; ks < 2; ++ks)
#pragma unroll
            for (int et = 0; et < 4; ++et) acc[et] = MFMA16(stf[ks][et], qf[ks], acc[et]);
        float mu = 0.f;
#pragma unroll
        for (int et = 0; et < 4; ++et) mu += acc[et][0] + acc[et][1] + acc[et][2] + acc[et][3];
        mu += __shfl_xor(mu, 16); mu += __shfl_xor(mu, 32); mu *= (1.f / 64);
        float var = 0.f;
#pragma unroll
        for (int et = 0; et < 4; ++et) { acc[et] = acc[et] - mu; var += acc[et][0] * acc[et][0] + acc[et][1] * acc[et][1] + acc[et][2] * acc[et][2] + acc[et][3] * acc[et][3]; }
        var += __shfl_xor(var, 16); var += __shfl_xor(var, 32);
        const float rs = rsqrtf(var * (1.f / 64) + EPS);
#pragma unroll
        for (int et = 0; et < 4; ++et) { const int c = h * 64 + et * 16 + 4 * lq; const v2u rg = rga[et]; const f32x4 g = ga[et];
            const float r0 = bflo_(rg.x), r1 = bfhi_(rg.x), r2 = bflo_(rg.y), r3 = bfhi_(rg.y);
            v2u o; o.x = pk2(r0 * pg8::fast_sigmoid(r0) * acc[et][0] * rs * g[0], r1 * pg8::fast_sigmoid(r1) * acc[et][1] * rs * g[1]);
            o.y = pk2(r2 * pg8::fast_sigmoid(r2) * acc[et][2] * rs * g[2], r3 * pg8::fast_sigmoid(r3) * acc[et][3] * rs * g[3]);
            *(v2u*)(YB + ti * DM + 768 + c) = o; }
    }
    __syncthreads();
}

template <int l> __device__ __forceinline__ void attn_phase(Frame& F, const Args& args) {
    for (int p = F.vcu; p < NBATCH * NHEAD * 32; p += F.G) {
        const int bh = p >> 5, s = p & 31; const float nbnd = -((const float*)(K_WS + WS_BND))[l];
        attn_unit(F, (const bf16*)(K_WS + WS_Q), (const bf16*)(K_WS + WS_K), (const bf16*)(K_WS + WS_VT), (bf16*)(K_WS + WS_YB), nbnd, bh / NHEAD, bh % NHEAD, 63 - s);
        attn_unit(F, (const bf16*)(K_WS + WS_Q), (const bf16*)(K_WS + WS_K), (const bf16*)(K_WS + WS_VT), (bf16*)(K_WS + WS_YB), nbnd, bh / NHEAD, bh % NHEAD, s);
    }
    for (int ch = F.vcu; ch < NTOK / CHUNK; ch += F.G) ret_out_chunk<l>(F, args, ch);
}
#ifndef MEGA_THIN
#define MEGA_THIN 0
#endif

#ifndef FFN_FP8
#define FFN_FP8 0
#endif
#ifndef GATE_FP8
#define GATE_FP8 1
#endif
#ifndef REV_GM
#define REV_GM 15
#endif
#ifndef REV_FD
#define REV_FD 15
#endif
#ifndef XB16
#define XB16 1
#endif
#ifndef RPT_MASK
#define RPT_MASK 0
#endif
#define RPT(bit) _Pragma("unroll") for (int rep_ = 0; rep_ < 1 + ((RPT_MASK >> (bit)) & 1); ++rep_)
__device__ __forceinline__ bool in_range(int k, int lo, int hi) { asm volatile("" : "+s"(lo)); return lo <= k && k < hi; }
#define IN(k) (in_range((k), lo, hi))
#ifndef BAR_REP
#define BAR_REP 1
#endif
#define SEAM(k) do { if (IN(k) && IN((k) + 1)) { for (int br_ = 0; br_ < BAR_REP; ++br_) xcd_barrier(bar, F.wave); } } while (0)
#define INF(i) ((const float*)K_IN(i))
template <int l> __device__ __forceinline__ void layer_phases(Frame& F, const Args& args, const XcdBarrier& bar, const int lo, const int hi) {
#define ws (K_WS)
#define ADA ((float*)(K_WS + WS_ADA))
#define bH ((bf16*)(K_WS + WS_H))
#define bYB ((bf16*)(K_WS + WS_YB))
#define bP ((bf16*)(K_WS + WS_PROJ))
#define bG ((bf16*)(K_WS + WS_G))
#define bMG bYB
#define bU bP
#define bX (K_OUT)
#define ring (F.lds + RING_OFF)
#define ada_l (ADA + (size_t)l * 2 * 6 * DM)
#define Xin ((l == 0) ? INF(IN_X) : (const float*)bX)
#define WIN_T ((const bf16*)(K_WS + WS_WIN_T) + (size_t)l * 6912 * DM)

        if (IN(PHL(l, PL_NORM1))) { RPT(8) {
#if MEGA_THIN >= 1
            norm_phase(F, (XB16 && l > 0) ? (const float*)(K_WS + WS_XB) : Xin, bH, INF(IN_N1G) + l * DM, ada_l, A_SH1, A_SC1, nullptr, nullptr, nullptr, nullptr, GATE_FP8 ? (unsigned char*)(K_WS + WS_H8) : nullptr, (float*)(K_WS + WS_SH), XB16 && l > 0);
#endif
        } }
        SEAM(PHL(l, PL_NORM1));
        if (IN(PHL(l, PL_INPROJ))) { RPT(1) {
            pg8::DenseOrder S{(const char*)bH, (const char*)WIN_T, (size_t)256 * DM * 2, (size_t)256 * DM * 2, NTOK / 256, PROJW / 256, F.G, (int)blockIdx.x};
            pg8::EpiBf16<0> E{bP, PROJW, 0};
            pg8::gemm_phase(ring, F.wave, DM, DM, DM, S, E);
        } }
        SEAM(PHL(l, PL_INPROJ));
        if (IN(PHL(l, PL_PRE))) {
#if MEGA_THIN >= 2
            pre_phase<l>(F, args);
#endif
        }
        SEAM(PHL(l, PL_PRE));
        if (IN(PHL(l, PL_SCAN))) {
#if MEGA_THIN >= 1
            scan_phase(F, (float*)(ws + WS_RET));
#endif
        }
        SEAM(PHL(l, PL_SCAN));
        if (IN(PHL(l, PL_ATTN))) { RPT(2) {
#if MEGA_THIN >= 3
            attn_phase<l>(F, args);
#endif
        } }
        SEAM(PHL(l, PL_ATTN));
        if (IN(PHL(l, PL_GATE))) { RPT(3) {
            pg8::MergeOrder S{(const char*)bYB, (const char*)((const bf16*)(K_WS + WS_WBR_T) + (size_t)l * 4 * DM * MIXW), NTOK / 256, DM / 256, F.G, (int)blockIdx.x};
            pg8::EpiBf16<0> E{bG, GATEW, DM};
            int kz = MIXW; asm volatile("" : "+s"(kz));
            pg8::gemm_phase(ring, F.wave, DM, MIXW, kz, S, E);
        } }
        SEAM(PHL(l, PL_GATE));
        if (IN(PHL(l, PL_MERGE))) { RPT(4) {
#if GATE_FP8
            pg8::DenseOrder S{(const char*)(K_WS + WS_H8), (const char*)(WIN_T + (size_t)PROJW * DM), (size_t)256 * DM, (size_t)256 * DM, NTOK / 256, GATEW / 256, F.G, (int)blockIdx.x, REV_GM};
            pg8::EpiGM8 E{bG, bMG, (const float*)(K_WS + WS_SH), (const float*)(K_WS + WS_SW) + l * GATEW};
            int kg = DM / 2; asm volatile("" : "+s"(kg));
            pg8::gemm_phase<pg8::EpiGM8, pg8::DenseOrder, true>(ring, F.wave, DM / 2, DM / 2, kg, S, E);
#else
            pg8::DenseOrder S{(const char*)bH, (const char*)(WIN_T + (size_t)PROJW * DM), (size_t)256 * DM * 2, (size_t)256 * DM * 2, NTOK / 256, GATEW / 256, F.G, (int)blockIdx.x};
            pg8::EpiGM E{bG, bMG};
            pg8::gemm_phase(ring, F.wave, DM, DM, DM, S, E);
#endif
        } }
        SEAM(PHL(l, PL_MERGE));
        if (IN(PHL(l, PL_WO))) {
            pg8::DenseOrder S{(const char*)bMG, (const char*)((const bf16*)(ws + WS_WO_T) + (size_t)l * DM * DM), (size_t)256 * DM * 2, (size_t)256 * DM * 2, NTOK / 256, DM / 256, F.G, (int)blockIdx.x};
#if XB16
            if constexpr (l == 0) { pg8::EpiResidT<false, true> E{INF(IN_X), (void*)(K_WS + WS_XB), ada_l + A_G1}; pg8::gemm_phase(ring, F.wave, DM, DM, DM, S, E); }
            else { pg8::EpiResidT<true, false> E{(const void*)(K_WS + WS_XB), (void*)bX, ada_l + A_G1}; pg8::gemm_phase(ring, F.wave, DM, DM, DM, S, E); }
#else
            pg8::EpiResid E{Xin, bX, ada_l + A_G1};
            pg8::gemm_phase(ring, F.wave, DM, DM, DM, S, E);
#endif
        }
        SEAM(PHL(l, PL_WO));
        if (IN(PHL(l, PL_NORM2))) {
#if MEGA_THIN >= 1
            if (l == 0) norm_phase(F, XB16 ? (const float*)(K_WS + WS_XB) : (const float*)bX, bH, INF(IN_N2G) + l * DM, ada_l, A_SH2, A_SC2, nullptr, nullptr, nullptr, nullptr, FFN_FP8 ? (unsigned char*)(K_WS + WS_H8) : nullptr, (float*)(K_WS + WS_SH), XB16 != 0);
            else norm_phase(F, bX, nullptr  , INF(IN_N2G) + l * DM, ada_l, A_SH2, A_SC2, INF(IN_RW), INF(IN_RB), (nv::Route*)(ws + WS_ROUTE), (int*)(ws + WS_CNT), (unsigned char*)(K_WS + WS_H8), (float*)(K_WS + WS_SH), false, 2);
#endif
        }
        SEAM(PHL(l, PL_NORM2));
        if constexpr (l == 0) {
            if (IN(PHL(l, PL_F0))) { RPT(5) {
#if FFN_FP8
                pg8::DenseOrder S{(const char*)(K_WS + WS_H8), (const char*)(ws + WS_F13_T), (size_t)256 * DM, (size_t)256 * DM, NTOK / 256, 2 * DFF / 256, F.G, (int)blockIdx.x};
                pg8::EpiSwiglu8 E{bU, DFF, (const float*)(K_WS + WS_SH), (const float*)(K_WS + WS_SWF)};
                int kf = DM / 2; asm volatile("" : "+s"(kf));
                pg8::gemm_phase<pg8::EpiSwiglu8, pg8::DenseOrder, true>(ring, F.wave, DM / 2, DM / 2, kf, S, E);
#else
                pg8::DenseOrder S{(const char*)bH, (const char*)(ws + WS_F13_T), (size_t)256 * DM * 2, (size_t)256 * DM * 2, NTOK / 256, 2 * DFF / 256, F.G, (int)blockIdx.x};
                pg8::EpiSwiglu E{bU, DFF};
                pg8::gemm_phase(ring, F.wave, DM, DM, DM, S, E);
#endif
            } }
            SEAM(PHL(l, PL_F0));
            if (IN(PHL(l, PL_F1))) {
                pg8::DenseOrder S{(const char*)bU, (const char*)(ws + WS_F2_T), (size_t)256 * DFF * 2, (size_t)256 * DFF * 2, NTOK / 256, DM / 256, F.G, (int)blockIdx.x, REV_FD};
#if XB16
                pg8::EpiResidT<true, true> E{(const void*)(K_WS + WS_XB), (void*)(K_WS + WS_XB), ada_l + A_G2};
#else
                pg8::EpiResid E{bX, bX, ada_l + A_G2};
#endif
                pg8::gemm_phase(ring, F.wave, DFF, DFF, DFF, S, E);
            }
            SEAM(PHL(l, PL_F1));
        } else {
#define XS ((bf16*)(K_WS + WS_XS))
#define HID ((bf16*)(K_WS + WS_HID))
#define PEXP ((const int*)(K_WS + WS_PEXP))
#define PSLOT ((const float*)(K_WS + WS_PSLOT))
            if (IN(PHL(l, PL_F0))) {
#if MEGA_THIN >= 1
                moe_assign_phase(F, args);
#endif
                RPT(9) {
                amax_job(F, INF(IN_M1), (size_t)DM * DFFE, DFFE, (unsigned*)(K_WS + WS_AMAXM), DFFE, NEXP);
                amax_job(F, INF(IN_M3), (size_t)DM * DFFE, DFFE, (unsigned*)(K_WS + WS_AMAXM) + NEXP * DFFE, DFFE, NEXP);
                amax_job(F, INF(IN_M2), (size_t)DFFE * DM, DM, (unsigned*)(K_WS + WS_AMAXM) + AMAXM_W2, DM, NEXP, DFFE);
                xcd_barrier(bar, F.wave);
                convert_w8_job(F, INF(IN_M1), (size_t)DM * DFFE, DFFE, (unsigned char*)(K_WS + WS_MW13_T), (size_t)2 * DFFE * DM, 2, (const unsigned*)(K_WS + WS_AMAXM), DFFE, (float*)(K_WS + WS_SWM), 2 * DFFE, NEXP, 0);
                convert_w8_job(F, INF(IN_M3), (size_t)DM * DFFE, DFFE, (unsigned char*)(K_WS + WS_MW13_T), (size_t)2 * DFFE * DM, 3, (const unsigned*)(K_WS + WS_AMAXM) + NEXP * DFFE, DFFE, (float*)(K_WS + WS_SWM), 2 * DFFE, NEXP, 977);
                convert_w8_job(F, INF(IN_M2), (size_t)DFFE * DM, DM, (unsigned char*)(K_WS + WS_MW2_T), (size_t)DM * DFFE, 0, (const unsigned*)(K_WS + WS_AMAXM) + AMAXM_W2, DM, (float*)(K_WS + WS_SWM2), DM, NEXP, 1301, DFFE);
                }
            }
            SEAM(PHL(l, PL_F0));
            for (int c = 0; c < NCH; ++c) {
                const int p0 = c * CH0_PANELS; int npan = PEXP[MAXPANEL] - p0; { const int cap = (c == 0) ? CH0_PANELS : CH1_PANELS; npan = npan > cap ? cap : npan; }
                if (IN(PHL(l, PL_F1 + 2 * c))) { RPT(6) {
                    pg8::MoeOrder S{(const char*)(K_WS + WS_XS8 + (size_t)p0 * 256 * DM), (const char*)(ws + WS_MW13_T), (size_t)256 * DM, (size_t)256 * DM, PEXP, p0, npan, 2 * DFFE / 256, F.G, (int)blockIdx.x};
                    pg8::EpiSwiglu8X E{(unsigned char*)(K_WS + WS_HID), (unsigned char*)(K_WS + WS_SCT), (const float*)(K_WS + WS_SXS) + p0 * 256, (const float*)(K_WS + WS_SWM)};
                    int ku = DM / 2; asm volatile("" : "+s"(ku));
                    pg8::gemm_phase<pg8::EpiSwiglu8X, pg8::MoeOrder, 1>(ring, F.wave, DM / 2, DM / 2, ku, S, E);
                } }
                SEAM(PHL(l, PL_F1 + 2 * c));
                if (IN(PHL(l, PL_F2 + 2 * c))) { RPT(7) {
                    const int nreg = (c == 1 && npan > CH0_PANELS) ? CH0_PANELS : npan, ntail = npan - nreg;
                    { pg8::MoeOrderX S{(const char*)(K_WS + WS_HID), (const char*)(ws + WS_MW2_T), (const char*)(K_WS + WS_SCT), (size_t)256 * DFFE, (size_t)256 * DFFE, (size_t)28 * 1024, PEXP, p0, nreg, DM / 256, F.G, (int)blockIdx.x};
                      pg8::EpiMoeDown8 E{XS + (size_t)p0 * 256 * DM, PSLOT + p0 * 256, (const float*)(K_WS + WS_SWM2)};
                      pg8::gemm_phase<pg8::EpiMoeDown8, pg8::MoeOrderX, 2>(ring, F.wave, DFFE / 2, DFFE / 2, DFFE / 2, S, E); }
                    if (c == 1 && ntail > 0) {
                        pg8::MoeTailOrderX S{(const char*)(K_WS + WS_HID) + (size_t)nreg * 256 * DFFE, (const char*)(ws + WS_MW2_T), (const char*)(K_WS + WS_SCT) + (size_t)nreg * 28 * 1024, (size_t)256 * DFFE, (size_t)256 * DFFE, (size_t)28 * 1024, PEXP, p0 + nreg, ntail, F.G, (int)blockIdx.x};
                        pg8::EpiMoePart8 E{(bf16*)(K_WS + WS_PART), PSLOT + (p0 + nreg) * 256, (const float*)(K_WS + WS_SWM2)};
                        int kq = 896; asm volatile("" : "+s"(kq));
                        pg8::gemm_phase<pg8::EpiMoePart8, pg8::MoeTailOrderX, 2>(ring, F.wave, DFFE / 2, DFFE / 2, kq, S, E);
                    }
                } }
                SEAM(PHL(l, PL_F2 + 2 * c));
            }
            if (IN(PHL(l, PL_F5))) {
#if MEGA_THIN >= 1
                { const int ptot = PEXP[MAXPANEL], tail0 = (ptot > 2 * CH0_PANELS) ? 2 * CH0_PANELS * 256 : 0x7fffffff;
                  moe_combine_phase(F, bX, XS, (const bf16*)(K_WS + WS_PART), tail0, (const int*)(ws + WS_SLOT), ada_l + A_G2); }
#endif
            }
        }
#undef XS
#undef HID
#undef PEXP
#undef PSLOT
#undef ws
#undef ADA
#undef bH
#undef bYB
#undef bP
#undef bG
#undef bMG
#undef bU
#undef bX
#undef ring
#undef ada_l
#undef Xin
#undef WIN_T
}

__global__ void __launch_bounds__(NWAVES * 64, 2) mega(Args args) {
    extern __shared__ __attribute__((aligned(16))) unsigned char lds_raw[];
    Frame F;
    F.lds = (LAS unsigned char*)lds_raw;
    F.MISC = (volatile LAS unsigned*)(F.lds + MISC_OFF);
    F.wave = __builtin_amdgcn_readfirstlane((int)threadIdx.x >> 6);
    F.G = gridDim.x; { const int bx = blockIdx.x; F.vcu = (F.G % 8 == 0) ? (bx % 8) * (F.G / 8) + bx / 8 : bx; }
    unsigned char* ws = K_WS;
    F.ctl = (unsigned*)(ws + WS_CTL);
    for (int u = F_TID; u < (LDS_BYTES - LDSCTL_OFF) / 4; u += NWAVES * 64) ((LAS unsigned*)(F.lds + LDSCTL_OFF))[u] = 0u;
    __syncthreads();
    XcdBarrier bar = xcd_barrier_post(F.ctl + CW_BAR + args.li * XCD_BAR_WORDS, F.MISC + 8);
    const int lo = args.ph_lo, hi = args.ph_hi;
    float* ADA = (float*)(ws + WS_ADA); float* BND = (float*)(ws + WS_BND);
    LAS unsigned char* ring = F.lds + RING_OFF;

    if (IN(PH_PRO)) { RPT(0) {
        for (int it = F.vcu; it < DEPTH * 96; it += F.G) {
            const int l = it / 96, j0 = (it % 96) * 64; const float* c = INF(IN_C);
            const float* w = INF(IN_ADAW) + (size_t)l * DM * 6 * DM + j0 + F_LANE;
            float a0 = 0.f, a1 = 0.f;
#pragma unroll 16
            for (int kk = 0; kk < 128; ++kk) { const int k = F.wave * 128 + kk; const float wv = w[(size_t)k * 6 * DM]; const float s0 = silu_f(c[k]), s1 = silu_f(c[DM + k]); a0 += s0 * wv; a1 += s1 * wv; }
            LAS float* red = (LAS float*)ring;
            red[(F.wave * 2 + 0) * 64 + F_LANE] = a0; red[(F.wave * 2 + 1) * 64 + F_LANE] = a1;
            __syncthreads();
            if (F_TID < 128) { const int b = F_TID >> 6, col = F_TID & 63; float s = INF(IN_ADAB)[l * 6 * DM + j0 + col];
#pragma unroll
              for (int w8 = 0; w8 < 8; ++w8) s += red[(w8 * 2 + b) * 64 + col];
              ADA[(size_t)(l * 2 + b) * 6 * DM + j0 + col] = s; }
            __syncthreads();
        }
        if (blockIdx.x == 0 && F_TID < DEPTH) { const int l = F_TID; float a = 0.f, b = 0.f;
            for (int i = 0; i < QKH; ++i) { a = fmaxf(a, fabsf(INF(IN_QNG)[l * QKH + i])); b = fmaxf(b, fabsf(INF(IN_KNG)[l * QKH + i])); }
            BND[l] = 9.797958971132712f * 1.4426950408889634f * a * b * 1.001f; }
        { bf16* WST = (bf16*)(ws + WS_WS_T); const float* wsrc = INF(IN_WS);
          for (int i = (F.vcu * NWAVES * 64 + F_TID); i < DEPTH * 4 * 128 * 128; i += F.G * NWAVES * 64) { const int t = (i >> 7) & 127, s = i & 127; WST[i] = (s <= t) ? f2bf(wsrc[i]) : (bf16)0; } }
        { unsigned* am = (unsigned*)(ws + WS_AMAXM); for (int i = F.vcu * NWAVES * 64 + F_TID; i < 2 * NEXP * DFFE + NEXP * DM; i += F.G * NWAVES * 64) am[i] = 0u; }
        int rot = 0;
        convert_job(F, INF(IN_WIN), (size_t)DM * D_IN, DM, D_IN, (bf16*)(ws + WS_WIN_T), (size_t)6912 * DM, DM, 1, nullptr, DEPTH, rot, GATE_FP8 ? NPROJ_SRC : 0); rot += 331;
        if (GATE_FP8) { const int NGW = F.G * NWAVES, gw = F.vcu * NWAVES + F.wave, lane = F_LANE;
          for (int it = gw; it < DEPTH * 16 * 16; it += NGW) { const int l = it >> 8, kb = (it >> 4) & 15, cb = it & 15; const float* wp = INF(IN_WIN) + (size_t)l * DM * D_IN + (size_t)(kb * 64) * D_IN + NPROJ_SRC + cb * 256 + 4 * lane;
              float4 mx = make_float4(0.f, 0.f, 0.f, 0.f);
#pragma unroll 16
              for (int r = 0; r < 64; ++r) { const float4 v = *(const float4*)(wp + (size_t)r * D_IN); mx.x = fmaxf(mx.x, fabsf(v.x)); mx.y = fmaxf(mx.y, fabsf(v.y)); mx.z = fmaxf(mx.z, fabsf(v.z)); mx.w = fmaxf(mx.w, fabsf(v.w)); }
              unsigned* am = F.ctl + CW_AMAX + l * GATEW + cb * 256 + 4 * lane;
              atomicMax(am + 0, __float_as_uint(mx.x)); atomicMax(am + 1, __float_as_uint(mx.y)); atomicMax(am + 2, __float_as_uint(mx.z)); atomicMax(am + 3, __float_as_uint(mx.w)); } }
        convert_job(F, INF(IN_WBR), (size_t)MIXW * DM, MIXW, DM, (bf16*)(ws + WS_WBR_T), (size_t)DM * MIXW, MIXW, 0, nullptr, DEPTH * 4, rot); rot += 331;
        convert_job(F, INF(IN_WO), (size_t)DM * DM, DM, DM, (bf16*)(ws + WS_WO_T), (size_t)DM * DM, DM, 0, nullptr, DEPTH, rot); rot += 331;
        if (!FFN_FP8) { convert_job(F, INF(IN_F1), 0, DM, DFF, (bf16*)(ws + WS_F13_T), 0, DM, 2, nullptr, 1, rot); rot += 331;
                        convert_job(F, INF(IN_F3), 0, DM, DFF, (bf16*)(ws + WS_F13_T), 0, DM, 3, nullptr, 1, rot); rot += 331; }
        else { amax_job(F, INF(IN_F1), 0, DFF, F.ctl + CW_AMAXF, 0, 1); amax_job(F, INF(IN_F3), 0, DFF, F.ctl + CW_AMAXF + DFF, 0, 1); }
        convert_job(F, INF(IN_F2), 0, DFF, DM, (bf16*)(ws + WS_F2_T), 0, DFF, 0, nullptr, 1, rot); rot += 331;
        for (int l = 0; l < DEPTH; ++l) {
            convert_job(F, INF(IN_WUQ) + (size_t)l * 256 * QW, 0, 256, QW, (bf16*)(ws + WS_WUQ_T) + (size_t)l * QW * 256, 0, 256, 0, INF(IN_CQG) + l * 256, 1, rot); rot += 331;
            convert_job(F, INF(IN_WUKV) + (size_t)l * 128 * 512, 0, 128, 512, (bf16*)(ws + WS_WUKV_T) + (size_t)l * 512 * 128, 0, 128, 0, INF(IN_CKVG) + l * 128, 1, rot); rot += 331;
        }
    } }
    SEAM(PH_PRO);
    if (IN(PH_PRO2) && FFN_FP8) {
        convert_w8_job(F, INF(IN_F1), 0, DFF, (unsigned char*)(K_WS + WS_F13_T), 0, 2, F.ctl + CW_AMAXF, 0, (float*)(K_WS + WS_SWF), 0, 1, 0);
        convert_w8_job(F, INF(IN_F3), 0, DFF, (unsigned char*)(K_WS + WS_F13_T), 0, 3, F.ctl + CW_AMAXF + DFF, 0, (float*)(K_WS + WS_SWF), 0, 1, 555);
    }
    if (IN(PH_PRO2) && GATE_FP8) {
        for (int l = 0; l < DEPTH; ++l)
            convert_gate8(F, INF(IN_WIN) + (size_t)l * DM * D_IN, F.ctl + CW_AMAX + l * GATEW, (unsigned char*)((bf16*)(K_WS + WS_WIN_T) + (size_t)l * 6912 * DM + (size_t)PROJW * DM), (float*)(K_WS + WS_SW) + l * GATEW, l * 977);
    }
    if (GATE_FP8 || FFN_FP8) SEAM(PH_PRO2);

    layer_phases<0>(F, args, bar, lo, hi);
    layer_phases<1>(F, args, bar, lo, hi);
}
#undef IN
#undef SEAM
#undef INF
static int g_grid = 0;
static bool mega_setup() {
    if (g_grid) return g_grid > 0;
    int dev = 0, cus = 0;
    if (hipGetDevice(&dev) != hipSuccess || hipDeviceGetAttribute(&cus, hipDeviceAttributeMultiprocessorCount, dev) != hipSuccess) { g_grid = -1; return false; }
    if (hipFuncSetAttribute((const void*)mega, hipFuncAttributeMaxDynamicSharedMemorySize, LDS_BYTES) != hipSuccess) { fprintf(stderr, "mega: hipFuncSetAttribute failed\n"); g_grid = -1; return false; }
    int per_cu = 0; (void)hipOccupancyMaxActiveBlocksPerMultiprocessor(&per_cu, (const void*)mega, NWAVES * 64, LDS_BYTES); (void)hipGetLastError();
    if (per_cu < 1) { fprintf(stderr, "mega: occupancy query reports %d workgroups per CU\n", per_cu); g_grid = -1; return false; }
    g_grid = cus; return true;
}
extern "C" void kernel_launch(void* const* d_in, const int* in_sizes, int n_in, void* d_out, int out_size, void* d_ws, size_t ws_size, hipStream_t stream) {
    if (n_in != 29 || out_size != NTOK * DM || ws_size < WS_END) { fprintf(stderr, "kernel_launch: unexpected sizes n_in %d out %d ws %zu\n", n_in, out_size, ws_size); return; }
    if (!mega_setup()) return;
    (void)hipMemsetAsync((char*)d_ws + WS_CTL, 0, CTL_ZERO_BYTES, stream);
    Args a{}; for (int i = 0; i < N_IN; ++i) a.in[i] = d_in[i];
    a.out = (float*)d_out; a.ws = (unsigned char*)d_ws; a.ph_lo = 0; a.ph_hi = N_PHASES; a.li = 0; a.pad = 0;
    hipLaunchKernelGGL(mega, dim3(g_grid), dim3(NWAVES * 64), LDS_BYTES, stream, a);
}
```

```cpp
#define MEGA_THIN 3
#include <hip/hip_runtime.h>
#include <cstdio>
#include <cstdint>
#include <cmath>

constexpr int DM = 1024, NBATCH = 2, SEQ = 16384, NTOK = NBATCH * SEQ, DEPTH = 2;
constexpr int MIXW = 256, D_IN = 6816, PROJW = 2816, GATEW = 4096, NPROJ_SRC = 2720;
constexpr int QKH = 96, NHEAD = 4, QW = NHEAD * QKH  , DFF = 2816, NEXP = 8, DFFE = 3584;
constexpr int CHUNK = 128, NCHUNK = SEQ / CHUNK  ;
constexpr float EPS = 1e-6f;
constexpr int C_AB = 0, C_AC = 256, C_AX = 512, C_CQ = 768, C_CKV = 1024, C_KR = 1152, C_SU = 1280, C_SV = 1536, C_RQ = 1792, C_RK = 2048, C_RV = 2304, C_RG = 2560;
constexpr int A_SH1 = 0, A_SC1 = 1024, A_G1 = 2048, A_SH2 = 3072, A_SC2 = 4096, A_G2 = 5120;
constexpr float ATT_C2 = 0.10206207261596575f * 1.4426950408889634f;

constexpr size_t MiB = 1u << 20;
constexpr size_t WS_CTL = 0, CTL_ZERO_BYTES = 1 * MiB;
constexpr size_t WS_ADA = 1 * MiB;
constexpr size_t WS_PSLOT = 1 * MiB + 256 * 1024;
constexpr size_t WS_PEXP = 1 * MiB + 768 * 1024;
constexpr size_t WS_BND = 1 * MiB + 800 * 1024;
constexpr size_t WS_ROUTE = 2 * MiB;
constexpr size_t WS_CNT = 2 * MiB + 512 * 1024;
constexpr size_t WS_SLOT = 2 * MiB + 768 * 1024;
constexpr size_t WS_WUQ_T = 3 * MiB;
constexpr size_t WS_WUKV_T = 3 * MiB + 512 * 1024;
constexpr size_t WS_WS_T = 3 * MiB + 768 * 1024;
constexpr size_t WS_WIN_T = 4 * MiB;
constexpr size_t WS_WBR_T = 31 * MiB;
constexpr size_t WS_WO_T = 35 * MiB;
constexpr size_t WS_F13_T = 39 * MiB;
constexpr size_t WS_F2_T = 50 * MiB;
constexpr size_t WS_H = 56 * MiB;
constexpr size_t WS_YB = 120 * MiB;
constexpr size_t WS_PROJ = 184 * MiB;
constexpr size_t WS_Q = 360 * MiB, WS_K = 384 * MiB, WS_VT = 408 * MiB;
constexpr size_t WS_RET = 424 * MiB;
constexpr size_t WS_G = 184 * MiB;
constexpr size_t WS_MIX_END = 440 * MiB;
constexpr size_t WS_H8 = 440 * MiB;
constexpr size_t WS_SH = 472 * MiB;
constexpr size_t WS_SW = 472 * MiB + 256 * 1024;
constexpr int CW_AMAXF = 230000;
constexpr size_t WS_SWF = 472 * MiB + 256 * 1024 + 64 * 1024;
constexpr int CW_AMAX = 200000;
constexpr int MAXPANEL = 264, MAXSLOT = MAXPANEL * 256, NCH = 2, CH0_PANELS = 128, CH1_PANELS = MAXPANEL - CH0_PANELS;
constexpr size_t WS_HID = 56 * MiB;
constexpr size_t WS_SCT = 176 * MiB;
constexpr size_t WS_MW13_T = 296 * MiB;
constexpr size_t WS_MW2_T = 352 * MiB;
constexpr size_t WS_XS = 464 * MiB;
constexpr size_t WS_PART = 596 * MiB;
constexpr int MAXTAIL = 8;
constexpr size_t WS_XS8 = 530 * MiB;
constexpr size_t WS_AMAXM = 612 * MiB;
constexpr size_t WS_SXS = 612 * MiB + 256 * 1024;
constexpr size_t WS_SWM = 612 * MiB + 576 * 1024;
constexpr size_t WS_SWM2 = 612 * MiB + 800 * 1024;
constexpr int AMAXM_W2 = 2 * NEXP * DFFE;
constexpr size_t WS_XB = 474 * MiB;
constexpr size_t WS_TOK = 613 * MiB;
constexpr size_t WS_END = 614 * MiB;
static_assert(WS_HID + (size_t)CH1_PANELS * 256 * DFFE <= WS_SCT && WS_SCT + (size_t)CH1_PANELS * 28 * 1024 <= WS_MW13_T, "hid");
static_assert(WS_XS + (size_t)MAXSLOT * DM * 2 <= WS_END, "xs");
static_assert(WS_MW13_T >= WS_MIX_END - 256 * MiB, "moe weights may overlay dead mixer buffers only");

typedef unsigned short bf16;
__device__ __forceinline__ float bf2f(bf16 v) { return __uint_as_float(((unsigned)v) << 16); }
__device__ __forceinline__ bf16 f2bf(float f) { unsigned u = __float_as_uint(f); return (bf16)((u + 0x7fffu + ((u >> 16) & 1u)) >> 16); }
__device__ __forceinline__ float bfr(float f) { return bf2f(f2bf(f)); }
__device__ __forceinline__ float silu_f(float x) { return x / (1.f + __expf(-x)); }
__device__ __forceinline__ float sigmoid_f(float x) { return 1.f / (1.f + __expf(-x)); }
__device__ __forceinline__ float gelu_tanh(float x) { const float u = 0.7978845608028654f * (x + 0.044715f * x * x * x); return 0.5f * x * (1.f + tanhf(u)); }

__device__ __forceinline__ int lane_id() { unsigned z = 0u; asm volatile("" : "+s"(z)); return (int)__builtin_amdgcn_mbcnt_hi(~0u, __builtin_amdgcn_mbcnt_lo(~0u, z)); }

namespace nv {
struct Route { int e0, e1; float p0, p1; };
__device__ __forceinline__ float ret_loggamma(int h) { return log1pf(-exp2f(-5.f - (float)h)); }
}
namespace pg8 {
#define PG8_LAS __attribute__((address_space(3)))
typedef short bf16x8 __attribute__((ext_vector_type(8)));
typedef float f32x4 __attribute__((ext_vector_type(4)));
typedef float f32x2 __attribute__((ext_vector_type(2)));
typedef unsigned u32x4 __attribute__((ext_vector_type(4)));
typedef unsigned u32x2 __attribute__((ext_vector_type(2)));
constexpr int BM = 256, BK = 64, HALF = 128, HTB = HALF * BK * 2  , STAGE_BYTES = 8 * HTB, NXCD = 8, WGM = 8;

__host__ __device__ __forceinline__ int lds_byte(int r, int c) { const int st = (r >> 4) * 2 + (c >> 5), rr = r & 15, cc = c & 31, ob = rr * 64 + cc * 2; return st * 1024 + (ob ^ (((ob >> 9) & 1) << 5)); }
__host__ __device__ __forceinline__ void stage_rc(int b, int& R, int& C) { const int st = b / 1024, sb = b % 1024, swz = sb ^ (((sb >> 9) & 1) << 5); R = (st >> 1) * 16 + swz / 64; C = (st & 1) * 32 + (swz % 64) / 2; }
__host__ __device__ __forceinline__ int perm32(int rho) { const int n = rho >> 4, i = rho & 15; return 8 * (i >> 2) + 4 * n + (i & 3); }

struct Unit { const char* A; const char* B; const char* S; int pm, pn, aux, pad; };

__device__ __forceinline__ bool static_tile(int i, int G, int c, int nM, int nN, int& pm, int& pn) {
    const int nwg = nM * nN; const long L = (long)i * G + c; if (L >= nwg) return false;
    int wgid = (int)L; { const int q = nwg / NXCD, r = nwg % NXCD, xcd = wgid % NXCD, off = wgid / NXCD; wgid = (xcd < r ? xcd * (q + 1) : r * (q + 1) + (xcd - r) * q) + off; }
    const int nig = WGM * nN, gid = wgid / nig, fm = gid * WGM, gsz = (nM - fm) < WGM ? (nM - fm) : WGM;
    pm = fm + ((wgid % nig) % gsz); pn = (wgid % nig) / gsz; return true;
}
struct DenseOrder {
    const char* A; const char* B; size_t tA, tB; int nM, nN, G, c, rev = 0;
    __device__ __forceinline__ bool next(int i, Unit& u) const { int pm, pn; if (!static_tile(i, G, c, nM, nN, pm, pn)) return false; pm ^= rev; u.pm = pm; u.pn = pn; u.aux = 0; u.A = A + (size_t)pm * tA; u.B = B + (size_t)pn * tB; return true; }
};
struct ZOrder {
    const char* A; const char* B; int nM, G, c;
    __device__ __forceinline__ bool next(int i, Unit& u) const { int pm, pn; if (!static_tile(i, G, c, nM, 16, pm, pn)) return false; const int n = pn >> 2; u.pm = pm; u.pn = pn; u.aux = n;
        u.A = A + (size_t)pm * (256 * 1024 * 2) + n * 512; u.B = B + (size_t)n * (1024 * 256 * 2) + (size_t)(pn & 3) * (256 * 256 * 2); return true; }
};
struct MergeOrder {
    const char* A; const char* B; int nM, nN, G, c;
    __device__ __forceinline__ bool next(int i, Unit& u) const { int pm, pn; if (!static_tile(i >> 2, G, c, nM, nN, pm, pn)) return false; const int n = i & 3; u.pm = pm; u.pn = pn; u.aux = n;
        u.A = A + (size_t)pm * (256 * 1024 * 2) + n * 512; u.B = B + (size_t)n * (1024 * 256 * 2) + (size_t)pn * (256 * 256 * 2); return true; }
};
struct MoeOrder {
    const char* A; const char* B; size_t tA, tB; const int* pexp; int p0, nM, nN, G, c;
    __device__ __forceinline__ bool next(int i, Unit& u) const { int pm, pn; if (nM <= 0 || !static_tile(i, G, c, nM, nN, pm, pn)) return false; const int e = pexp[p0 + pm]; u.pm = pm; u.pn = pn; u.aux = e;
        u.A = A + (size_t)pm * tA; u.B = B + ((size_t)e * nN + pn) * tB; return true; }
};

typedef __bf16 bf16x2_t __attribute__((ext_vector_type(2)));
__device__ __forceinline__ unsigned cvt_pk_bf16(float lo, float hi) { const f32x2 v = {lo, hi}; return __builtin_bit_cast(unsigned, __builtin_convertvector(v, bf16x2_t)); }
__device__ __forceinline__ float fast_sigmoid(float x) { return __builtin_amdgcn_rcpf(1.f + __builtin_amdgcn_exp2f(-1.4426950408889634f * x)); }
__device__ __forceinline__ float bflo(unsigned w) { return __uint_as_float(w << 16); }
__device__ __forceinline__ float bfhi(unsigned w) { return __uint_as_float(w & 0xffff0000u); }

template <int ACT  > struct EpiBf16 {
    static constexpr bool PERM = true; static constexpr int NST = 16;
    bf16* O; int ldc, aux_cols;
    __device__ __forceinline__ void operator()(const f32x4 (&acc)[2][2][4][2], const Unit& u, int wr, int wc, int fr, int fq) const {
        const int row0 = u.pm * BM + wr * 64 + fr, col0 = u.aux * aux_cols + u.pn * BM + wc * 32 + 8 * fq;
#pragma unroll
        for (int ai = 0; ai < 2; ++ai)
#pragma unroll
            for (int m = 0; m < 4; ++m) { bf16* rowp = O + (size_t)(row0 + ai * HALF + m * 16) * ldc + col0;
#pragma unroll
                for (int bj = 0; bj < 2; ++bj) { f32x4 v0 = acc[ai][bj][m][0], v1 = acc[ai][bj][m][1];
                    if (ACT == 2) {
#pragma unroll
                        for (int i = 0; i < 4; ++i) { v0[i] = fast_sigmoid(v0[i]); v1[i] = fast_sigmoid(v1[i]); } }
                    u32x4 w; w.x = cvt_pk_bf16(v0[0], v0[1]); w.y = cvt_pk_bf16(v0[2], v0[3]); w.z = cvt_pk_bf16(v1[0], v1[1]); w.w = cvt_pk_bf16(v1[2], v1[3]);
                    *(u32x4*)(rowp + bj * HALF) = w; } }
    }
};
struct EpiSwiglu {
    static constexpr bool PERM = true; static constexpr int NST = 8;
    bf16* O; int ldc;
    __device__ __forceinline__ void operator()(const f32x4 (&acc)[2][2][4][2], const Unit& u, int wr, int wc, int fr, int fq) const {
        const int row0 = u.pm * BM + wr * 64 + fr, col0 = u.pn * HALF + wc * 32 + 8 * fq;
#pragma unroll
        for (int ai = 0; ai < 2; ++ai)
#pragma unroll
            for (int m = 0; m < 4; ++m) { bf16* rowp = O + (size_t)(row0 + ai * HALF + m * 16) * ldc + col0; float r[8];
#pragma unroll
                for (int n = 0; n < 2; ++n)
#pragma unroll
                    for (int i = 0; i < 4; ++i) { const float a = acc[ai][0][m][n][i], b = acc[ai][1][m][n][i]; r[n * 4 + i] = a * fast_sigmoid(a) * b; }
                u32x4 w; w.x = cvt_pk_bf16(r[0], r[1]); w.y = cvt_pk_bf16(r[2], r[3]); w.z = cvt_pk_bf16(r[4], r[5]); w.w = cvt_pk_bf16(r[6], r[7]);
                *(u32x4*)rowp = w; }
    }
};
struct EpiSwiglu8 {
    static constexpr bool PERM = true; static constexpr int NST = 8;
    bf16* O; int ldc; const float* sx; const float* sw;
    __device__ __forceinline__ void operator()(const f32x4 (&acc)[2][2][4][2], const Unit& u, int wr, int wc, int fr_, int fq_) const {
        int fr = fr_, fq = fq_; asm volatile("" : "+v"(fr), "+v"(fq));
        const int row0 = u.pm * BM + wr * 64 + fr, col0 = u.pn * HALF + wc * 32 + 8 * fq; const float* swp = sw + (size_t)u.aux * (2 * DFFE) + u.pn * 256 + wc * 32 + 8 * fq;
        const f32x4 sa0 = *(const f32x4*)swp, sa1 = *(const f32x4*)(swp + 4), sb0 = *(const f32x4*)(swp + 128), sb1 = *(const f32x4*)(swp + 132);
#pragma unroll
        for (int ai = 0; ai < 2; ++ai)
#pragma unroll
            for (int m = 0; m < 4; ++m) { const int row = row0 + ai * HALF + m * 16; const float rs = sx[row]; bf16* rowp = O + (size_t)row * ldc + col0; float r[8];
#pragma unroll
                for (int n = 0; n < 2; ++n) { const f32x4 ca = (n == 0 ? sa0 : sa1) * rs, cb = (n == 0 ? sb0 : sb1) * rs;
#pragma unroll
                    for (int i = 0; i < 4; ++i) { const float a = acc[ai][0][m][n][i] * ca[i], b = acc[ai][1][m][n][i] * cb[i]; r[n * 4 + i] = a * fast_sigmoid(a) * b; } }
                u32x4 w; w.x = cvt_pk_bf16(r[0], r[1]); w.y = cvt_pk_bf16(r[2], r[3]); w.z = cvt_pk_bf16(r[4], r[5]); w.w = cvt_pk_bf16(r[6], r[7]);
                *(u32x4*)rowp = w; }
    }
};
struct EpiSwiglu8X {
    static constexpr bool PERM = true; static constexpr int NST = 10;
#ifdef PROBE_X8
    static constexpr bool PROBE_REP = true;
#endif
    unsigned char* O8; unsigned char* SCT; const float* sx; const float* sw;
    __device__ __forceinline__ void operator()(const f32x4 (&acc)[2][2][4][2], const Unit& u, int wr, int wc, int fr_, int fq_) const {
        int fr = fr_, fq = fq_; asm volatile("" : "+v"(fr), "+v"(fq));
        const int row0 = u.pm * BM + wr * 64 + fr, col0 = u.pn * HALF + wc * 32 + 8 * fq; const float* swp = sw + (size_t)u.aux * (2 * DFFE) + u.pn * 256 + wc * 32 + 8 * fq;
        constexpr float NL = -1.4426950408889634f, NIL = -0.6931471805599453f;
        f32x2 sa[4], sb[4];
        { const f32x4 x0 = *(const f32x4*)swp, x1 = *(const f32x4*)(swp + 4), y0 = *(const f32x4*)(swp + 128), y1 = *(const f32x4*)(swp + 132);
          sa[0] = (f32x2){x0[0], x0[1]} * NL; sa[1] = (f32x2){x0[2], x0[3]} * NL; sa[2] = (f32x2){x1[0], x1[1]} * NL; sa[3] = (f32x2){x1[2], x1[3]} * NL;
          sb[0] = (f32x2){y0[0], y0[1]} * NIL; sb[1] = (f32x2){y0[2], y0[3]} * NIL; sb[2] = (f32x2){y1[0], y1[1]} * NIL; sb[3] = (f32x2){y1[2], y1[3]} * NIL; }
        float rsv[2][4];
#pragma unroll
        for (int ai = 0; ai < 2; ++ai)
#pragma unroll
            for (int m = 0; m < 4; ++m) rsv[ai][m] = sx[row0 + ai * HALF + m * 16];
#pragma unroll
        for (int ai = 0; ai < 2; ++ai) { unsigned sd = 0u;
#pragma unroll
            for (int m = 0; m < 4; ++m) { const int row = row0 + ai * HALF + m * 16; const float rs = rsv[ai][m]; f32x2 hp[4], na[4], dn[4]; float amax = 0.f;
#pragma unroll
                for (int j = 0; j < 4; ++j) { const f32x2 A = {acc[ai][0][m][j >> 1][(j & 1) * 2], acc[ai][0][m][j >> 1][(j & 1) * 2 + 1]}; na[j] = A * (sa[j] * rs); }
#pragma unroll
                for (int j = 0; j < 4; ++j) { dn[j][0] = __builtin_amdgcn_exp2f(na[j][0]); dn[j][1] = __builtin_amdgcn_exp2f(na[j][1]); }
#pragma unroll
                for (int j = 0; j < 4; ++j) { const f32x2 B = {acc[ai][1][m][j >> 1][(j & 1) * 2], acc[ai][1][m][j >> 1][(j & 1) * 2 + 1]}; hp[j] = na[j] * (B * sb[j]); dn[j] = dn[j] + 1.f; }
#pragma unroll
                for (int j = 0; j < 4; ++j) { dn[j][0] = __builtin_amdgcn_rcpf(dn[j][0]); dn[j][1] = __builtin_amdgcn_rcpf(dn[j][1]); }
#pragma unroll
                for (int j = 0; j < 4; ++j) { hp[j] = hp[j] * dn[j]; amax = fmaxf(fmaxf(amax, fabsf(hp[j][0])), fabsf(hp[j][1])); }
                { const auto r16 = __builtin_amdgcn_permlane16_swap(__float_as_uint(amax), __float_as_uint(amax), false, false); amax = fmaxf(__uint_as_float(r16[0]), __uint_as_float(r16[1]));
                  const auto r32 = __builtin_amdgcn_permlane32_swap(__float_as_uint(amax), __float_as_uint(amax), false, false); amax = fmaxf(__uint_as_float(r32[0]), __uint_as_float(r32[1])); }
                amax *= rs;
                const unsigned ab = __float_as_uint(amax); int e = 135 - (int)((ab >> 23) & 255u) - (((ab & 0x7fffffu) > 0x600000u) ? 1 : 0);
                e = e < -100 ? -100 : (e > 100 ? 100 : e); e = (amax > 0.f) ? e : 0;
                const float mul = __uint_as_float((unsigned)(e + 127) << 23) * rs;
                sd |= (unsigned)(127 - e) << (8 * m);
#pragma unroll
                for (int j = 0; j < 4; ++j) hp[j] = hp[j] * mul;
                int w0 = 0, w1 = 0; w0 = __builtin_amdgcn_cvt_pk_fp8_f32(hp[0][0], hp[0][1], w0, false); w0 = __builtin_amdgcn_cvt_pk_fp8_f32(hp[1][0], hp[1][1], w0, true);
                w1 = __builtin_amdgcn_cvt_pk_fp8_f32(hp[2][0], hp[2][1], w1, false); w1 = __builtin_amdgcn_cvt_pk_fp8_f32(hp[3][0], hp[3][1], w1, true);
                f32x2 w; w[0] = __int_as_float(w0); w[1] = __int_as_float(w1);
                *(f32x2*)(O8 + (size_t)row * DFFE + col0) = w; }
            if (fq == 0) *(unsigned*)(SCT + ((size_t)u.pm * 28 + u.pn) * 1024 + ((((wr * 16 + fr) * 4 + wc) * 2 + ai) << 2)) = sd; }
    }
};
struct EpiResid {
    static constexpr bool PERM = false; static constexpr int NST = 32; static constexpr bool INPLACE = true;
    const float* Xin; float* Xout; const float* gate;
    __device__ __forceinline__ void operator()(const f32x4 (&acc)[2][2][4][2], const Unit& u, int wr, int wc, int fr, int fq) const {
        const int row0 = u.pm * BM + wr * 64 + fr, col0 = u.pn * BM + wc * 32 + 4 * fq; const float* gp = gate + (size_t)(u.pm >> 6) * (6 * DM) + col0;
        f32x4 gv[2][2];
#pragma unroll
        for (int bj = 0; bj < 2; ++bj)
#pragma unroll
            for (int n = 0; n < 2; ++n) gv[bj][n] = *(const f32x4*)(gp + bj * HALF + n * 16);
#pragma unroll
        for (int ai = 0; ai < 2; ++ai)
#pragma unroll
        for (int mp = 0; mp < 4; mp += 2) {
            f32x4 xi[2][2][2];
#pragma unroll
            for (int m = 0; m < 2; ++m) { const size_t off = (size_t)(row0 + ai * HALF + (mp + m) * 16) * DM + col0;
#pragma unroll
                for (int bj = 0; bj < 2; ++bj)
#pragma unroll
                    for (int n = 0; n < 2; ++n) xi[m][bj][n] = *(const f32x4*)(Xin + off + bj * HALF + n * 16); }
            asm volatile("" ::: "memory");
#pragma unroll
            for (int m = 0; m < 2; ++m) { const size_t off = (size_t)(row0 + ai * HALF + (mp + m) * 16) * DM + col0;
#pragma unroll
                for (int bj = 0; bj < 2; ++bj)
#pragma unroll
                    for (int n = 0; n < 2; ++n) *(f32x4*)(Xout + off + bj * HALF + n * 16) = xi[m][bj][n] + gv[bj][n] * acc[ai][bj][mp + m][n]; }
            asm volatile("" ::: "memory");
        }
    }
};
template <bool IN16, bool OUT16> struct EpiResidT {
    static constexpr bool PERM = true; static constexpr int NST = OUT16 ? 16 : 32; static constexpr bool INPLACE = true;
    const void* Xin; void* Xout; const float* gate;
    __device__ __forceinline__ void operator()(const f32x4 (&acc)[2][2][4][2], const Unit& u, int wr, int wc, int fr, int fq) const {
        const int row0 = u.pm * BM + wr * 64 + fr, col0 = u.pn * BM + wc * 32 + 8 * fq; const float* gp = gate + (size_t)(u.pm >> 6) * (6 * DM) + col0;
        f32x4 gv[2][2];
#pragma unroll
        for (int bj = 0; bj < 2; ++bj)
#pragma unroll
            for (int n = 0; n < 2; ++n) gv[bj][n] = *(const f32x4*)(gp + bj * HALF + 4 * n);
#pragma unroll
        for (int ai = 0; ai < 2; ++ai)
#pragma unroll
        for (int mp = 0; mp < 4; mp += 2) {
            f32x4 xi[2][2][2];
#pragma unroll
            for (int m = 0; m < 2; ++m) { const size_t off = (size_t)(row0 + ai * HALF + (mp + m) * 16) * DM + col0;
#pragma unroll
                for (int bj = 0; bj < 2; ++bj) {
                    if (IN16) { const u32x4 r = *(const u32x4*)((const bf16*)Xin + off + bj * HALF);
                        xi[m][bj][0] = (f32x4){bflo(r.x), bfhi(r.x), bflo(r.y), bfhi(r.y)}; xi[m][bj][1] = (f32x4){bflo(r.z), bfhi(r.z), bflo(r.w), bfhi(r.w)}; }
                    else { xi[m][bj][0] = *(const f32x4*)((const float*)Xin + off + bj * HALF); xi[m][bj][1] = *(const f32x4*)((const float*)Xin + off + bj * HALF + 4); } } }
            asm volatile("" ::: "memory");
#pragma unroll
            for (int m = 0; m < 2; ++m) { const size_t off = (size_t)(row0 + ai * HALF + (mp + m) * 16) * DM + col0;
#pragma unroll
                for (int bj = 0; bj < 2; ++bj) { const f32x4 v0 = xi[m][bj][0] + gv[bj][0] * acc[ai][bj][mp + m][0], v1 = xi[m][bj][1] + gv[bj][1] * acc[ai][bj][mp + m][1];
                    if (OUT16) { u32x4 w; w.x = cvt_pk_bf16(v0[0], v0[1]); w.y = cvt_pk_bf16(v0[2], v0[3]); w.z = cvt_pk_bf16(v1[0], v1[1]); w.w = cvt_pk_bf16(v1[2], v1[3]); *(u32x4*)((bf16*)Xout + off + bj * HALF) = w; }
                    else { *(f32x4*)((float*)Xout + off + bj * HALF) = v0; *(f32x4*)((float*)Xout + off + bj * HALF + 4) = v1; } } }
            asm volatile("" ::: "memory");
        }
    }
};
struct EpiMerge {
    static constexpr bool PERM = true; static constexpr int NST = 16;
    const bf16* G; bf16* Mg;
    __device__ __forceinline__ void operator()(const f32x4 (&acc)[2][2][4][2], const Unit& u, int wr, int wc, int fr, int fq) const {
        const int row0 = u.pm * BM + wr * 64 + fr, col0 = u.pn * BM + wc * 32 + 8 * fq, n_br = u.aux;
#pragma unroll
        for (int ai = 0; ai < 2; ++ai)
#pragma unroll
        for (int mp = 0; mp < 4; mp += 2) {
            u32x4 g[2][2], o[2][2];
#pragma unroll
            for (int m = 0; m < 2; ++m) { const size_t row = (size_t)(row0 + ai * HALF + (mp + m) * 16);
#pragma unroll
                for (int bj = 0; bj < 2; ++bj) { g[m][bj] = *(const u32x4*)(G + row * GATEW + n_br * DM + col0 + bj * HALF);
                    o[m][bj] = (n_br != 0) ? *(const u32x4*)(Mg + row * DM + col0 + bj * HALF) : (u32x4){0u, 0u, 0u, 0u}; } }
            asm volatile("" ::: "memory");
#pragma unroll
            for (int m = 0; m < 2; ++m) { const size_t row = (size_t)(row0 + ai * HALF + (mp + m) * 16);
#pragma unroll
                for (int bj = 0; bj < 2; ++bj) { const u32x4 gg = g[m][bj], oo = o[m][bj]; const f32x4 a0 = acc[ai][bj][mp + m][0], a1 = acc[ai][bj][mp + m][1]; float r[8];
                    r[0] = bflo(gg.x) * a0[0] + bflo(oo.x); r[1] = bfhi(gg.x) * a0[1] + bfhi(oo.x); r[2] = bflo(gg.y) * a0[2] + bflo(oo.y); r[3] = bfhi(gg.y) * a0[3] + bfhi(oo.y);
                    r[4] = bflo(gg.z) * a1[0] + bflo(oo.z); r[5] = bfhi(gg.z) * a1[1] + bfhi(oo.z); r[6] = bflo(gg.w) * a1[2] + bflo(oo.w); r[7] = bfhi(gg.w) * a1[3] + bfhi(oo.w);
                    u32x4 w; w.x = cvt_pk_bf16(r[0], r[1]); w.y = cvt_pk_bf16(r[2], r[3]); w.z = cvt_pk_bf16(r[4], r[5]); w.w = cvt_pk_bf16(r[6], r[7]);
                    *(u32x4*)(Mg + row * DM + col0 + bj * HALF) = w; } }
            asm volatile("" ::: "memory");
        }
    }
};
struct EpiGM {
    static constexpr bool PERM = false; static constexpr int NST = 8;
    const bf16* Z; bf16* Mg;
    __device__ __forceinline__ void operator()(const f32x4 (&acc)[2][2][4][2], const Unit& u, int wr, int wc, int fr, int fq) const {
        const int row0 = u.pm * BM + wr * 64 + fr, col0 = u.pn * 64 + wc * 16 + 4 * fq;
        const bf16* zb = Z + (size_t)row0 * GATEW + col0; bf16* mb = Mg + (size_t)row0 * DM + col0;
#pragma unroll
        for (int ai = 0; ai < 2; ++ai) {
            f32x2 zz[4][4];
#pragma unroll
            for (int m = 0; m < 4; ++m)
#pragma unroll
                for (int br = 0; br < 4; ++br) zz[m][br] = *(const f32x2*)(zb + (size_t)(ai * HALF + m * 16) * GATEW + br * DM);
            asm volatile("" ::: "memory");
#pragma unroll
            for (int m = 0; m < 4; ++m) { f32x4 r = {0.f, 0.f, 0.f, 0.f};
#pragma unroll
                for (int br = 0; br < 4; ++br) { const f32x4 a = acc[ai][br >> 1][m][br & 1]; const unsigned z0 = __float_as_uint(zz[m][br][0]), z1 = __float_as_uint(zz[m][br][1]);
                    r[0] += fast_sigmoid(a[0]) * bflo(z0); r[1] += fast_sigmoid(a[1]) * bfhi(z0); r[2] += fast_sigmoid(a[2]) * bflo(z1); r[3] += fast_sigmoid(a[3]) * bfhi(z1); }
                f32x2 w; w[0] = __uint_as_float(cvt_pk_bf16(r[0], r[1])); w[1] = __uint_as_float(cvt_pk_bf16(r[2], r[3]));
                *(f32x2*)(mb + (size_t)(ai * HALF + m * 16) * DM) = w;
                __builtin_amdgcn_sched_barrier(0); }
            asm volatile("" ::: "memory");
        }
    }
};
struct MoeOrderX {
    const char* A; const char* B; const char* Sc; size_t tA, tB, tS; const int* pexp; int p0, nM, nN, G, c;
    __device__ __forceinline__ bool next(int i, Unit& u) const { int pm, pn; if (nM <= 0 || !static_tile(i, G, c, nM, nN, pm, pn)) return false; const int e = pexp[p0 + pm]; u.pm = pm; u.pn = pn; u.aux = e;
        u.A = A + (size_t)pm * tA; u.B = B + ((size_t)e * nN + pn) * tB; u.S = Sc + (size_t)pm * tS; return true; }
};
struct MoeTailOrderX {
    const char* A; const char* B; const char* Sc; size_t tA, tB, tS; const int* pexp; int p0, T, G, c;
    __device__ __forceinline__ bool next(int i, Unit& u) const { const int L = i * G + c; if (L >= T * 8) return false; const int pt = L >> 3, pn = (L >> 1) & 3, kh = L & 1, e = pexp[p0 + pt];
        u.pm = pt; u.pn = pn; u.aux = kh | (e << 8); u.A = A + (size_t)pt * tA + kh * 1792; u.B = B + ((size_t)e * 4 + pn) * tB + kh * 1792; u.S = Sc + (size_t)pt * tS + kh * (14 * 1024); return true; }
};
struct MoeTailOrder {
    const char* A; const char* B; size_t tA, tB; const int* pexp; int p0, T, G, c;
    __device__ __forceinline__ bool next(int i, Unit& u) const { const int L = i * G + c; if (L >= T * 16) return false; const int pt = L >> 4, pn = (L >> 2) & 3, kq = L & 3, e = pexp[p0 + pt];
        u.pm = pt; u.pn = pn; u.aux = kq; u.A = A + (size_t)pt * tA + kq * (896 * 2); u.B = B + ((size_t)e * 4 + pn) * tB + kq * (896 * 2); return true; }
};
struct EpiMoePart {
    static constexpr bool PERM = true; static constexpr int NST = 16;
    bf16* PART; const float* ps;
    __device__ __forceinline__ void operator()(const f32x4 (&acc)[2][2][4][2], const Unit& u, int wr, int wc, int fr, int fq) const {
        const int row0 = u.pm * BM + wr * 64 + fr, col0 = u.pn * BM + wc * 32 + 8 * fq; bf16* base = PART + (size_t)u.aux * (MAXTAIL * 256) * DM;
#pragma unroll
        for (int ai = 0; ai < 2; ++ai)
#pragma unroll
            for (int m = 0; m < 4; ++m) { const int row = row0 + ai * HALF + m * 16; const float s = ps[row]; bf16* rowp = base + (size_t)row * DM + col0;
#pragma unroll
                for (int bj = 0; bj < 2; ++bj) { const f32x4 v0 = acc[ai][bj][m][0] * s, v1 = acc[ai][bj][m][1] * s;
                    u32x4 w; w.x = cvt_pk_bf16(v0[0], v0[1]); w.y = cvt_pk_bf16(v0[2], v0[3]); w.z = cvt_pk_bf16(v1[0], v1[1]); w.w = cvt_pk_bf16(v1[2], v1[3]);
                    *(u32x4*)(rowp + bj * HALF) = w; } }
    }
};
struct EpiGM8 {
    static constexpr bool PERM = false; static constexpr int NST = 8;
#ifdef PROBE_GM8
    static constexpr bool PROBE_REP = true;
#endif
    const bf16* Z; bf16* Mg; const float* sh; const float* sw;
    __device__ __forceinline__ void operator()(const f32x4 (&acc)[2][2][4][2], const Unit& u, int wr, int wc, int fr_, int fq_) const {
        int fr = fr_, fq = fq_; asm volatile("" : "+v"(fr), "+v"(fq));
        const int row0 = u.pm * BM + wr * 64 + fr, col0 = u.pn * 64 + wc * 16 + 4 * fq;
        const bf16* zb = Z + (size_t)row0 * GATEW + col0; bf16* mb = Mg + (size_t)row0 * DM + col0;
        f32x2 zz[2][4][4]; float rs[2][4];
#pragma unroll
        for (int ai = 0; ai < 2; ++ai)
#pragma unroll
            for (int m = 0; m < 4; ++m) { rs[ai][m] = sh[row0 + ai * HALF + m * 16];
#pragma unroll
                for (int br = 0; br < 4; ++br) zz[ai][m][br] = *(const f32x2*)(zb + (size_t)(ai * HALF + m * 16) * GATEW + br * DM); }
        f32x4 craw[4];
#pragma unroll
        for (int br = 0; br < 4; ++br) craw[br] = *(const f32x4*)(sw + u.pn * 256 + 128 * (br >> 1) + 32 * wc + 16 * (br & 1) + 4 * fq);
        asm volatile("" ::: "memory");
        f32x2 cs[4][2];
#pragma unroll
        for (int br = 0; br < 4; ++br) { cs[br][0] = (f32x2){craw[br][0], craw[br][1]} * -1.4426950408889634f; cs[br][1] = (f32x2){craw[br][2], craw[br][3]} * -1.4426950408889634f; }
#pragma unroll
        for (int ai = 0; ai < 2; ++ai) {
#pragma unroll
            for (int m = 0; m < 4; ++m) { f32x2 r0 = {0.f, 0.f}, r1 = {0.f, 0.f};
#pragma unroll
                for (int br = 0; br < 4; ++br) { const f32x4 A = acc[ai][br >> 1][m][br & 1];
                    const f32x2 n0 = (f32x2){A[0], A[1]} * (cs[br][0] * rs[ai][m]), n1 = (f32x2){A[2], A[3]} * (cs[br][1] * rs[ai][m]);
                    f32x2 d0, d1; d0[0] = __builtin_amdgcn_exp2f(n0[0]); d0[1] = __builtin_amdgcn_exp2f(n0[1]); d1[0] = __builtin_amdgcn_exp2f(n1[0]); d1[1] = __builtin_amdgcn_exp2f(n1[1]);
                    d0 = d0 + 1.f; d1 = d1 + 1.f;
                    d0[0] = __builtin_amdgcn_rcpf(d0[0]); d0[1] = __builtin_amdgcn_rcpf(d0[1]); d1[0] = __builtin_amdgcn_rcpf(d1[0]); d1[1] = __builtin_amdgcn_rcpf(d1[1]);
                    const unsigned z0 = __float_as_uint(zz[ai][m][br][0]), z1 = __float_as_uint(zz[ai][m][br][1]);
                    r0 = r0 + d0 * (f32x2){bflo(z0), bfhi(z0)}; r1 = r1 + d1 * (f32x2){bflo(z1), bfhi(z1)}; }
                f32x2 w; w[0] = __uint_as_float(cvt_pk_bf16(r0[0], r0[1])); w[1] = __uint_as_float(cvt_pk_bf16(r1[0], r1[1]));
                *(f32x2*)(mb + (size_t)(ai * HALF + m * 16) * DM) = w;
                __builtin_amdgcn_sched_barrier(0); }
        }
        asm volatile("" ::: "memory");
    }
};
struct EpiMoeDown8 {
    static constexpr bool PERM = true; static constexpr int NST = 16;
    bf16* Y; const float* ps; const float* sw2;
    __device__ __forceinline__ void operator()(const f32x4 (&acc)[2][2][4][2], const Unit& u, int wr, int wc, int fr_, int fq_) const {
        int fr = fr_, fq = fq_; asm volatile("" : "+v"(fr), "+v"(fq));
        const int row0 = u.pm * BM + wr * 64 + fr, col0 = u.pn * BM + wc * 32 + 8 * fq; const float* swp = sw2 + (size_t)(u.aux & 0xff) * DM + col0;
        f32x4 cs[2][2];
#pragma unroll
        for (int bj = 0; bj < 2; ++bj) { cs[bj][0] = *(const f32x4*)(swp + bj * HALF); cs[bj][1] = *(const f32x4*)(swp + bj * HALF + 4); }
        float psv[2][4];
#pragma unroll
        for (int ai = 0; ai < 2; ++ai)
#pragma unroll
            for (int m = 0; m < 4; ++m) psv[ai][m] = ps[row0 + ai * HALF + m * 16];
#pragma unroll
        for (int ai = 0; ai < 2; ++ai)
#pragma unroll
            for (int m = 0; m < 4; ++m) { const int row = row0 + ai * HALF + m * 16; const float s = psv[ai][m]; bf16* rowp = Y + (size_t)row * DM + col0;
#pragma unroll
                for (int bj = 0; bj < 2; ++bj) { const f32x4 v0 = acc[ai][bj][m][0] * cs[bj][0] * s, v1 = acc[ai][bj][m][1] * cs[bj][1] * s;
                    u32x4 w; w.x = cvt_pk_bf16(v0[0], v0[1]); w.y = cvt_pk_bf16(v0[2], v0[3]); w.z = cvt_pk_bf16(v1[0], v1[1]); w.w = cvt_pk_bf16(v1[2], v1[3]);
                    *(u32x4*)(rowp + bj * HALF) = w; } }
    }
};
struct EpiMoePart8 {
    static constexpr bool PERM = true; static constexpr int NST = 16;
    bf16* PART; const float* ps; const float* sw2;
    __device__ __forceinline__ void operator()(const f32x4 (&acc)[2][2][4][2], const Unit& u, int wr, int wc, int fr_, int fq_) const {
        int fr = fr_, fq = fq_; asm volatile("" : "+v"(fr), "+v"(fq));
        const int row0 = u.pm * BM + wr * 64 + fr, col0 = u.pn * BM + wc * 32 + 8 * fq; const float* swp = sw2 + (size_t)(u.aux >> 8) * DM + col0; bf16* base = PART + (size_t)(u.aux & 1) * (MAXTAIL * 256) * DM;
        f32x4 cs[2][2];
#pragma unroll
        for (int bj = 0; bj < 2; ++bj) { cs[bj][0] = *(const f32x4*)(swp + bj * HALF); cs[bj][1] = *(const f32x4*)(swp + bj * HALF + 4); }
#pragma unroll
        for (int ai = 0; ai < 2; ++ai)
#pragma unroll
            for (int m = 0; m < 4; ++m) { const int row = row0 + ai * HALF + m * 16; const float s = ps[row]; bf16* rowp = base + (size_t)row * DM + col0;
#pragma unroll
                for (int bj = 0; bj < 2; ++bj) { const f32x4 v0 = acc[ai][bj][m][0] * cs[bj][0] * s, v1 = acc[ai][bj][m][1] * cs[bj][1] * s;
                    u32x4 w; w.x = cvt_pk_bf16(v0[0], v0[1]); w.y = cvt_pk_bf16(v0[2], v0[3]); w.z = cvt_pk_bf16(v1[0], v1[1]); w.w = cvt_pk_bf16(v1[2], v1[3]);
                    *(u32x4*)(rowp + bj * HALF) = w; } }
    }
};
struct EpiMoeDown {
    static constexpr bool PERM = true; static constexpr int NST = 16;
    bf16* Y; const float* ps;
    __device__ __forceinline__ void operator()(const f32x4 (&acc)[2][2][4][2], const Unit& u, int wr, int wc, int fr, int fq) const {
        const int row0 = u.pm * BM + wr * 64 + fr, col0 = u.pn * BM + wc * 32 + 8 * fq;
#pragma unroll
        for (int ai = 0; ai < 2; ++ai)
#pragma unroll
            for (int m = 0; m < 4; ++m) { const int row = row0 + ai * HALF + m * 16; const float s = ps[row]; bf16* rowp = Y + (size_t)row * DM + col0;
#pragma unroll
                for (int bj = 0; bj < 2; ++bj) { const f32x4 v0 = acc[ai][bj][m][0] * s, v1 = acc[ai][bj][m][1] * s;
                    u32x4 w; w.x = cvt_pk_bf16(v0[0], v0[1]); w.y = cvt_pk_bf16(v0[2], v0[3]); w.z = cvt_pk_bf16(v1[0], v1[1]); w.w = cvt_pk_bf16(v1[2], v1[3]);
                    *(u32x4*)(rowp + bj * HALF) = w; } }
    }
};

template <class E> constexpr auto epi_inplace(int) -> decltype(E::INPLACE) { return E::INPLACE; }
template <class E> constexpr bool epi_inplace(long) { return false; }
#ifndef EPI_REP
#define EPI_REP 1
#endif
template <class E> constexpr auto epi_rep(int) -> decltype(E::PROBE_REP, 1) { return EPI_REP; }
template <class E> constexpr int epi_rep(long) { return 1; }
typedef int v8i __attribute__((ext_vector_type(8)));
typedef int v4i __attribute__((ext_vector_type(4)));
template <int M8> __device__ __forceinline__ void mma8s(f32x4& acc, const v8i& b8, const v8i& a8, const int sA, const unsigned sB) {
    if constexpr (M8 == 0) asm volatile("v_mfma_scale_f32_16x16x128_f8f6f4 %0, %1, %2, %0, %3, %4 op_sel_hi:[0,0,0]" : "+v"(acc) : "v"(b8), "v"(a8), "v"(sA), "v"(sB));
    else if constexpr (M8 == 1) asm volatile("v_mfma_scale_f32_16x16x128_f8f6f4 %0, %1, %2, %0, %3, %4 op_sel:[0,1,0] op_sel_hi:[0,0,0]" : "+v"(acc) : "v"(b8), "v"(a8), "v"(sA), "v"(sB));
    else if constexpr (M8 == 2) asm volatile("v_mfma_scale_f32_16x16x128_f8f6f4 %0, %1, %2, %0, %3, %4 op_sel_hi:[0,1,0]" : "+v"(acc) : "v"(b8), "v"(a8), "v"(sA), "v"(sB));
    else asm volatile("v_mfma_scale_f32_16x16x128_f8f6f4 %0, %1, %2, %0, %3, %4 op_sel:[0,1,0] op_sel_hi:[0,1,0]" : "+v"(acc) : "v"(b8), "v"(a8), "v"(sA), "v"(sB));
}
template <class Epi, class Sched, int MODE = 0>
__device__ __forceinline__ void gemm_phase(PG8_LAS unsigned char* lds, const int wave_, const int lda, const int ldb, const int K, const Sched& S, const Epi& E) {
    constexpr bool F8 = (MODE != 0), SCL = (MODE == 2);
    int tid_ = wave_ * 64 + lane_id(); asm volatile("" : "+v"(tid_));
    const int tid = tid_, wid = __builtin_amdgcn_readfirstlane(tid >> 6), lane = tid & 63, wr = wid >> 2, wc = wid & 3, fr = lane & 15, fq = lane >> 4;
    const int nt = K / BK;
    unsigned voffA[2], voffB[2];
#pragma unroll
    for (int i = 0; i < 2; ++i) { int R, C; stage_rc(tid * 16 + i * 8192, R, C); const int Rb = Epi::PERM ? ((R & ~31) + perm32(R & 31)) : R;
        voffA[i] = (unsigned)(R * lda + C) * 2u; voffB[i] = (unsigned)(Rb * ldb + C) * 2u; }
    const size_t kstep = (size_t)(BK * 2);
    const size_t hstepA = (size_t)HALF * lda * 2, hstepB = (size_t)HALF * ldb * 2;
    const unsigned ldsw = (unsigned)wid * 1024u;
    const int aoff = lds_byte(wr * 64 + fr, fq * 8), boff = lds_byte(wc * 32 + fr, fq * 8);
    const int aoff8 = lds_byte(wr * 64 + fr, 32 * (fq >> 1) + 16 * (fq & 1)), boff8 = lds_byte(wc * 32 + fr, 32 * (fq >> 1) + 16 * (fq & 1));
#define PG8_SA(b, h) (((b) * 2 + (h)) * HTB)
#define PG8_SB(b, h) ((4 + (b) * 2 + (h)) * HTB)
#define PG8_STAGE(bufoff, gbase, voff) do { _Pragma("unroll") for (int _i = 0; _i < 2; ++_i) \
        __builtin_amdgcn_global_load_lds((const unsigned*)((const char*)(gbase) + (voff)[_i]), (PG8_LAS unsigned*)(lds + (bufoff) + ldsw + _i * 8192), 16, 0, 0); } while (0)
#define PG8_CAT(x0, x1) __builtin_shufflevector(__builtin_bit_cast(v4i, x0), __builtin_bit_cast(v4i, x1), 0, 1, 2, 3, 4, 5, 6, 7)
#define PG8_LDA(dst, b, h) do { _Pragma("unroll") for (int m = 0; m < 4; ++m) { if constexpr (F8) dst##8[m] = PG8_CAT(*(const PG8_LAS bf16x8*)(lds + PG8_SA(b, h) + aoff + m * 2048), *(const PG8_LAS bf16x8*)(lds + PG8_SA(b, h) + aoff + m * 2048 + 1024)); \
        else { _Pragma("unroll") for (int k = 0; k < 2; ++k) dst[m][k] = *(const PG8_LAS bf16x8*)(lds + PG8_SA(b, h) + aoff + m * 2048 + k * 1024); } } } while (0)
#define PG8_LDB(dst, b, h) do { _Pragma("unroll") for (int n = 0; n < 2; ++n) { if constexpr (F8) dst##8[n] = PG8_CAT(*(const PG8_LAS bf16x8*)(lds + PG8_SB(b, h) + boff + n * 2048), *(const PG8_LAS bf16x8*)(lds + PG8_SB(b, h) + boff + n * 2048 + 1024)); \
        else { _Pragma("unroll") for (int k = 0; k < 2; ++k) dst[n][k] = *(const PG8_LAS bf16x8*)(lds + PG8_SB(b, h) + boff + n * 2048 + k * 1024); } } } while (0)
#define PG8_MMA(ai, bj, At, Bt) do { __builtin_amdgcn_s_setprio(1); if constexpr (SCL) asm volatile("s_nop 7" ::: "memory"); _Pragma("unroll") for (int n = 0; n < 2; ++n) { \
        if constexpr (SCL) { mma8s<0>(acc[ai][bj][0][n], Bt##8[n], At##8[0], sc1, SCUR[ai]); mma8s<1>(acc[ai][bj][1][n], Bt##8[n], At##8[1], sc1, SCUR[ai]); \
                             mma8s<2>(acc[ai][bj][2][n], Bt##8[n], At##8[2], sc1, SCUR[ai]); mma8s<3>(acc[ai][bj][3][n], Bt##8[n], At##8[3], sc1, SCUR[ai]); } \
        else { _Pragma("unroll") for (int m = 0; m < 4; ++m) { \
        if constexpr (F8) asm volatile("v_mfma_scale_f32_16x16x128_f8f6f4 %0, %1, %2, %0, %3, %3 op_sel_hi:[0,0,0]" : "+v"(acc[ai][bj][m][n]) : "v"(Bt##8[n]), "v"(At##8[m]), "v"(sc1)); \
        else { _Pragma("unroll") for (int k = 0; k < 2; ++k) acc[ai][bj][m][n] = __builtin_amdgcn_mfma_f32_16x16x32_bf16(Bt[n][k], At[m][k], acc[ai][bj][m][n], 0, 0, 0); } } } } __builtin_amdgcn_s_setprio(0); } while (0)
#define PG8_WAIT_V(n) asm volatile("s_waitcnt vmcnt(" #n ")" ::: "memory")
#define PG8_WAIT_VX(n) asm volatile("s_waitcnt vmcnt(%0)" :: "n"(n) : "memory")
#define PG8_WAIT_SEG() do { if (relax) PG8_WAIT_VX(8 + Epi::NST); else PG8_WAIT_V(8); } while (0)
#define PG8_WAIT_SEG1() do { if constexpr (SCL) { if (relax) PG8_WAIT_VX(9 + Epi::NST); else PG8_WAIT_V(9); } else PG8_WAIT_SEG(); } while (0)
#define PG8_WAIT_L(n) asm volatile("s_waitcnt lgkmcnt(" #n ")" ::: "memory")
#define PG8_BAR __builtin_amdgcn_s_barrier()
#define PG8_SCHED __builtin_amdgcn_sched_barrier(0)
    Unit cur, nxt; int ui = 0;
    if (!S.next(0, cur)) return;
    f32x4 acc[2][2][4][2];
#pragma unroll
    for (int a = 0; a < 2; ++a)
#pragma unroll
        for (int b = 0; b < 2; ++b)
#pragma unroll
            for (int m = 0; m < 4; ++m)
#pragma unroll
                for (int n = 0; n < 2; ++n) acc[a][b][m][n] = (f32x4){0.f, 0.f, 0.f, 0.f};
    bf16x8 At[4][2], B0[2][2], B1[2][2]; v8i At8[4], B08[2], B18[2];
    int sc1 = 0x7f7f7f7f; asm volatile("" : "+v"(sc1));
    const unsigned soff = (unsigned)(((wr * 16 + fr) * 4 + fq) * 8);
    u32x2 sct0 = {0u, 0u}, sct1 = {0u, 0u};
    const char* cA = cur.A; const char* cB = cur.B; const char* cS = cur.S;
    if constexpr (SCL) { sct0 = *(const u32x2*)(cur.S + soff); sct1 = *(const u32x2*)(cur.S + 1024 + soff); }
    PG8_STAGE(PG8_SB(0, 0), cB, voffB); PG8_STAGE(PG8_SB(0, 1), cB + hstepB, voffB); PG8_STAGE(PG8_SA(0, 0), cA, voffA); PG8_STAGE(PG8_SA(0, 1), cA + hstepA, voffA);
    if (wr == 1) PG8_BAR;
    PG8_WAIT_V(2); PG8_BAR;
    PG8_STAGE(PG8_SB(1, 0), cB + kstep, voffB); PG8_STAGE(PG8_SA(1, 0), cA + kstep, voffA); PG8_STAGE(PG8_SB(1, 1), cB + hstepB + kstep, voffB);
    PG8_WAIT_V(6); PG8_BAR;
    for (;;) {
        const bool has_next = S.next(ui + 1, nxt);
        const char* nA = has_next ? nxt.A : cA; const char* nB = has_next ? nxt.B : cB; const char* nS = has_next ? nxt.S : cS;
        for (int t = 0; t < nt; t += 2) {
            const bool last = (t == nt - 2); int relax = __builtin_amdgcn_readfirstlane((int)(t == 0) & (int)(ui > 0)); asm volatile("" : "+s"(relax));
            const char* a1 = cA + (size_t)(t + 1) * kstep;
            const char* a2 = last ? nA : cA + (size_t)(t + 2) * kstep; const char* b2 = last ? nB : cB + (size_t)(t + 2) * kstep;
            const char* a3 = a2 + kstep; const char* b3 = b2 + kstep;
            const char* s2p = last ? nS : cS + (size_t)(t + 2) * 1024;
            u32x2 sn0 = sct0, sn1 = sct1;
#define SCUR sct0
            PG8_LDB(B0, 0, 0); PG8_LDB(B1, 0, 1); PG8_SCHED; PG8_LDA(At, 0, 0); PG8_STAGE(PG8_SA(1, 1), a1 + hstepA, voffA);
            PG8_WAIT_SEG1(); PG8_WAIT_L(0); PG8_BAR; PG8_MMA(0, 0, At, B0); PG8_MMA(0, 1, At, B1); PG8_BAR; PG8_SCHED;
            PG8_LDA(At, 0, 1); PG8_STAGE(PG8_SB(0, 0), b2, voffB); PG8_STAGE(PG8_SB(0, 1), b2 + hstepB, voffB); PG8_STAGE(PG8_SA(0, 0), a2, voffA);
            PG8_WAIT_SEG(); if constexpr (SCL) sn0 = *(const u32x2*)(s2p + soff); PG8_WAIT_L(0); PG8_BAR; PG8_MMA(1, 0, At, B0); PG8_MMA(1, 1, At, B1); PG8_BAR; PG8_SCHED;
#undef SCUR
#define SCUR sct1
            PG8_LDB(B0, 1, 0); PG8_LDB(B1, 1, 1); PG8_SCHED; PG8_LDA(At, 1, 0); PG8_STAGE(PG8_SA(0, 1), a2 + hstepA, voffA);
            if constexpr (SCL) PG8_WAIT_V(9); else PG8_WAIT_V(8); PG8_WAIT_L(0); PG8_BAR; PG8_MMA(0, 0, At, B0); PG8_MMA(0, 1, At, B1); PG8_BAR; PG8_SCHED;
            PG8_LDA(At, 1, 1); PG8_STAGE(PG8_SB(1, 0), b3, voffB); PG8_STAGE(PG8_SB(1, 1), b3 + hstepB, voffB); PG8_STAGE(PG8_SA(1, 0), a3, voffA);
            PG8_WAIT_V(8); if constexpr (SCL) sn1 = *(const u32x2*)(s2p + 1024 + soff);
            PG8_WAIT_L(0); PG8_BAR; PG8_MMA(1, 0, At, B0); PG8_MMA(1, 1, At, B1); PG8_BAR; PG8_SCHED;
#undef SCUR
            sct0 = sn0; sct1 = sn1;
        }
        if (wr == 0) PG8_BAR;
        if constexpr (F8) asm volatile("s_nop 15\n\ts_nop 15" ::: "memory");
        _Pragma("unroll") for (int er_ = 0; er_ < epi_rep<Epi>(0); ++er_) { E(acc, cur, wr, wc, fr, fq); if (EPI_REP > 1) asm volatile("" ::: "memory"); }
        if (!has_next) break;
#pragma unroll
        for (int a = 0; a < 2; ++a)
#pragma unroll
            for (int b = 0; b < 2; ++b)
#pragma unroll
                for (int m = 0; m < 4; ++m)
#pragma unroll
                    for (int n = 0; n < 2; ++n) acc[a][b][m][n] = (f32x4){0.f, 0.f, 0.f, 0.f};
        cur = nxt; cA = nA; cB = nB; cS = nS; ++ui;
        if (wr == 1) PG8_BAR;
    }
    PG8_WAIT_V(0);
    PG8_BAR;
#undef PG8_SA
#undef PG8_SB
#undef PG8_STAGE
#undef PG8_LDA
#undef PG8_LDB
#undef PG8_MMA
#undef PG8_CAT
#undef PG8_WAIT_V
#undef PG8_WAIT_VX
#undef PG8_WAIT_SEG
#undef PG8_WAIT_SEG1
#undef PG8_WAIT_L
#undef PG8_BAR
#undef PG8_SCHED
}
}
constexpr int NWAVES = 8;
constexpr int RING_OFF = 0, RING_BYTES = 131072;
constexpr int LDSCTL_OFF = RING_BYTES, MISC_OFF = LDSCTL_OFF + 320;
constexpr int LDS_BYTES = 147456;
constexpr int CW_TMO = 0, CW_CODE = 1, CW_BAR = 4096;

#define GAS __attribute__((address_space(1)))
#define LAS __attribute__((address_space(3)))
typedef unsigned v4u __attribute__((ext_vector_type(4)));
typedef unsigned v2u __attribute__((ext_vector_type(2)));
typedef GAS unsigned gu32;
#define RLX_AGENT __ATOMIC_RELAXED, __HIP_MEMORY_SCOPE_AGENT
#define LDS_WAIT() asm volatile("s_waitcnt lgkmcnt(0)" ::: "memory")
#define VM_WAIT() asm volatile("s_waitcnt vmcnt(0)" ::: "memory")
__device__ __forceinline__ unsigned pk2(float lo, float hi) { return (unsigned)f2bf(lo) | ((unsigned)f2bf(hi) << 16); }


#define XB_TMO      128
#define XB_XCNT(j)  (256  + 64 * (j))
#define XB_XSUB(j)  (1280 + 64 * (j))
#define XB_XGEN(j)  (2304 + 64 * (j))
#define XB_TOP      3328
#define XB_TOPGEN   3392
#define XCD_BAR_WORDS 3456
#define XB_SPIN_CAP (1u << 18)
__device__ __forceinline__ unsigned xb_ld(unsigned* p)              { return __hip_atomic_load(p, __ATOMIC_RELAXED, __HIP_MEMORY_SCOPE_AGENT); }
__device__ __forceinline__ unsigned xb_add(unsigned* p, unsigned v) { return __hip_atomic_fetch_add(p, v, __ATOMIC_RELAXED, __HIP_MEMORY_SCOPE_AGENT); }
__device__ __forceinline__ unsigned xb_xcc_id() { return (unsigned)__builtin_amdgcn_s_getreg((3 << 11) | 20) & 0xFu; }
#define XB_SPIN(cond, bar) do { unsigned _sp = 0; while (cond) { __builtin_amdgcn_s_sleep(1); \
    if ((++_sp & 255u) == 0u) { if (xb_ld(&(bar)[XB_TMO])) break; if (_sp > XB_SPIN_CAP) { atomicAdd(&(bar)[XB_TMO], 1u); break; } } } } while (0)
struct XcdBarrier { unsigned* bar; unsigned x; volatile LAS unsigned* st; };
__device__ __forceinline__ XcdBarrier xcd_barrier_post(unsigned* bar, volatile LAS unsigned* st) {
    XcdBarrier b; b.bar = bar; b.x = xb_xcc_id(); b.st = st;
    if (threadIdx.x == 0) (void)xb_add(&bar[XB_XCNT(b.x)], 1u);
    return b;
}
__device__ __forceinline__ void xcd_barrier_complete(unsigned* bar, unsigned x, unsigned& nloc, unsigned& nx) {
    const unsigned G = gridDim.x * gridDim.y * gridDim.z;
    unsigned sum, cnt, mine, sp = 0u;
    for (;;) {
        sum = 0u; cnt = 0u; mine = 0u;
#pragma unroll
        for (unsigned j = 0; j < 16; ++j) { const unsigned c = xb_ld(&bar[XB_XCNT(j)]); sum += c; cnt += (c > 0u) ? 1u : 0u; mine = (j == x) ? c : mine; }
        if (sum == G) break;
        __builtin_amdgcn_s_sleep(1);
        if ((++sp & 255u) == 0u) { if (xb_ld(&bar[XB_TMO])) break; if (sp > XB_SPIN_CAP) { atomicAdd(&bar[XB_TMO], 1u); break; } }
    }
    nloc = mine > 0u ? mine : 1u; nx = cnt > 0u ? cnt : 1u;
}
__device__ __forceinline__ void xcd_barrier(const XcdBarrier& b, const int wave) {
    asm volatile("s_waitcnt vmcnt(0)" ::: "memory");
    __syncthreads();
    if (wave == 0 && lane_id() == 0) {
        unsigned* bar = b.bar;
        __builtin_amdgcn_s_waitcnt(0);
        unsigned nloc = b.st[0], nx = b.st[1];
        if (nloc == 0u) { xcd_barrier_complete(bar, b.x, nloc, nx); b.st[0] = nloc; b.st[1] = nx; }
        const unsigned old = xb_add(&bar[XB_XSUB(b.x)], 1u);
        const unsigned gen = old / nloc;
        if (old + 1u == (gen + 1u) * nloc) {
            __builtin_amdgcn_fence(__ATOMIC_RELEASE, "agent");
            asm volatile("s_waitcnt vmcnt(0)" ::: "memory");
            const unsigned og = xb_add(&bar[XB_TOP], 1u);
            const unsigned tg = og / nx;
            if (og + 1u == (tg + 1u) * nx) xb_add(&bar[XB_TOPGEN], 1u);
            else XB_SPIN(xb_ld(&bar[XB_TOPGEN]) == tg, bar);
            __builtin_amdgcn_fence(__ATOMIC_ACQUIRE, "agent");
            xb_add(&bar[XB_XGEN(b.x)], 1u);
            asm volatile("s_waitcnt vmcnt(0)" ::: "memory");
        } else {
            XB_SPIN(xb_ld(&bar[XB_XGEN(b.x)]) == gen, bar);
            __builtin_amdgcn_fence(__ATOMIC_ACQUIRE, "agent");
            asm volatile("s_waitcnt vmcnt(0)" ::: "memory");
        }
    }
    __syncthreads();
}

struct Frame {
    LAS unsigned char* lds; volatile LAS unsigned* MISC; unsigned* ctl;
    int wave, vcu, G;
};
#define F_LANE (lane_id())
#define F_TID (F.wave * 64 + lane_id())
__device__ __forceinline__ float wave_sum(float v) {
#pragma unroll
    for (int o = 1; o < 64; o <<= 1) v += __shfl_xor(v, o);
    return v;
}

__host__ __device__ __forceinline__ int win_row(int sc) { if (sc < NPROJ_SRC) return sc + (sc >= 1184 ? 96 : 0); const int g = sc - NPROJ_SRC, br = g >> 10, oc = g & 1023, p = oc >> 6, j = oc & 63;
    return PROJW + p * 256 + 128 * (br >> 1) + 32 * (j >> 4) + 16 * (br & 1) + (j & 15); }
__device__ __forceinline__ void transpose_item(const float* W, int ldw, bf16* WT, int ldt, int drow0, int k0, int n0, const float* scale, LAS float* scr, int lane, const bool winmap = false) {
#pragma unroll
    for (int i = 0; i < 32; ++i) { const int kk = 2 * i + (lane >> 5); float v = W[(size_t)(k0 + kk) * ldw + n0 + (lane & 31)]; if (scale) v *= scale[k0 + kk]; scr[kk * 33 + (lane & 31)] = v; }
    LDS_WAIT(); asm volatile("" ::: "memory");
    const int c = lane & 7;
#pragma unroll
    for (int j = 0; j < 4; ++j) { const int n = (lane >> 3) + 8 * j; const LAS float* s = scr + (8 * c) * 33 + n;
        v4u o; o.x = pk2(s[0 * 33], s[1 * 33]); o.y = pk2(s[2 * 33], s[3 * 33]); o.z = pk2(s[4 * 33], s[5 * 33]); o.w = pk2(s[6 * 33], s[7 * 33]);
        *(v4u*)(WT + (size_t)(winmap ? win_row(n0 + n) : drow0 + n) * ldt + k0 + 8 * c) = o; }
    LDS_WAIT(); asm volatile("" ::: "memory");
}
__device__ __forceinline__ void convert_job(Frame& F, const float* src, size_t sstride, int K, int N, bf16* dst, size_t dstride, int ldt, int mode, const float* scale, int nmat, int rot, int ncol = 0) {
    LAS float* scr = (LAS float*)(F.lds + RING_OFF + F.wave * 16384);
    const int NGW = F.G * NWAVES, gw = (F.vcu * NWAVES + F.wave + rot) % NGW, lane = F_LANE;
    const int nkb = K / 64, nnb = (ncol ? ncol : N) / 32, per = nkb * nnb, total = per * nmat;
    for (int it = gw; it < total; it += NGW) {
        const int mi = it / per, r = it % per, kb = r / nnb, nb = r % nnb, n0 = nb * 32;
        int drow = n0;
        if (mode == 2) drow = (n0 >> 7) * 256 + (n0 & 127);
        else if (mode == 3) drow = (n0 >> 7) * 256 + 128 + (n0 & 127);
        transpose_item(src + (size_t)mi * sstride, N, dst + (size_t)mi * dstride, ldt, drow, kb * 64, n0, scale, scr, lane, mode == 1);
    }
}

__device__ __forceinline__ float fp8_scale(float amax) { return (amax > 0.f) ? exp2f(fminf(floorf(log2f(448.f / amax)), 100.f)) : 1.f; }
__device__ __forceinline__ unsigned pk4_fp8(float a, float b, float c, float d) { int w = 0; w = __builtin_amdgcn_cvt_pk_fp8_f32(a, b, w, false); w = __builtin_amdgcn_cvt_pk_fp8_f32(c, d, w, true); return (unsigned)w; }
__device__ __forceinline__ void convert_gate8(Frame& F, const float* w_in_l, const unsigned* amax_l, unsigned char* WG8, float* SW, int rot) {
    LAS float* scr = (LAS float*)(F.lds + RING_OFF + F.wave * 16384);
    const int NGW = F.G * NWAVES, gw = (F.vcu * NWAVES + F.wave + rot) % NGW, lane = F_LANE;
    for (int it = gw; it < 16 * 128; it += NGW) {
        const int kb = it / 128, nb = it % 128, k0 = kb * 64, g0 = nb * 32;
#pragma unroll
        for (int i = 0; i < 32; ++i) { const int kk = 2 * i + (lane >> 5); scr[kk * 33 + (lane & 31)] = w_in_l[(size_t)(k0 + kk) * D_IN + NPROJ_SRC + g0 + (lane & 31)]; }
        LDS_WAIT(); asm volatile("" ::: "memory");
#pragma unroll
        for (int j = 0; j < 2; ++j) { const int n = (lane >> 2) + 16 * j, c = lane & 3;
            const float sc = fp8_scale(__uint_as_float(amax_l[g0 + n])); const LAS float* sp = scr + (16 * c) * 33 + n;
            v4u o; o.x = pk4_fp8(sp[0 * 33] * sc, sp[1 * 33] * sc, sp[2 * 33] * sc, sp[3 * 33] * sc); o.y = pk4_fp8(sp[4 * 33] * sc, sp[5 * 33] * sc, sp[6 * 33] * sc, sp[7 * 33] * sc);
            o.z = pk4_fp8(sp[8 * 33] * sc, sp[9 * 33] * sc, sp[10 * 33] * sc, sp[11 * 33] * sc); o.w = pk4_fp8(sp[12 * 33] * sc, sp[13 * 33] * sc, sp[14 * 33] * sc, sp[15 * 33] * sc);
            const int drow = win_row(NPROJ_SRC + g0 + n) - PROJW;
            *(v4u*)(WG8 + (size_t)drow * DM + k0 + 16 * c) = o;
            if (kb == 0 && c == 0) SW[drow] = 1.f / sc; }
        LDS_WAIT(); asm volatile("" ::: "memory");
    }
}

__device__ __forceinline__ void convert_w8_job(Frame& F, const float* src, size_t sstride, int N, unsigned char* dst, size_t dstride, int mode, const unsigned* amax, int astride, float* SW, int swstride, int nmat, int rot, int K = DM) {
    LAS float* scr = (LAS float*)(F.lds + RING_OFF + F.wave * 16384);
    const int NGW = F.G * NWAVES, gw = (F.vcu * NWAVES + F.wave + rot) % NGW, lane = F_LANE;
    const int nnb = N / 32, per = (K / 64) * nnb, total = per * nmat;
    for (int it = gw; it < total; it += NGW) {
        const int mi = it / per, r = it % per, kb = r / nnb, nb = r % nnb, k0 = kb * 64, n0 = nb * 32;
        const float* W = src + (size_t)mi * sstride;
#pragma unroll
        for (int i = 0; i < 32; ++i) { const int kk = 2 * i + (lane >> 5); scr[kk * 33 + (lane & 31)] = W[(size_t)(k0 + kk) * N + n0 + (lane & 31)]; }
        LDS_WAIT(); asm volatile("" ::: "memory");
        const int drow0 = (mode == 0) ? n0 : (n0 >> 7) * 256 + (n0 & 127) + (mode == 3 ? 128 : 0);
#pragma unroll
        for (int j = 0; j < 2; ++j) { const int n = (lane >> 2) + 16 * j, c = lane & 3;
            const float sc = fp8_scale(__uint_as_float(amax[(size_t)mi * astride + n0 + n])); const LAS float* sp = scr + (16 * c) * 33 + n;
            v4u o; o.x = pk4_fp8(sp[0 * 33] * sc, sp[1 * 33] * sc, sp[2 * 33] * sc, sp[3 * 33] * sc); o.y = pk4_fp8(sp[4 * 33] * sc, sp[5 * 33] * sc, sp[6 * 33] * sc, sp[7 * 33] * sc);
            o.z = pk4_fp8(sp[8 * 33] * sc, sp[9 * 33] * sc, sp[10 * 33] * sc, sp[11 * 33] * sc); o.w = pk4_fp8(sp[12 * 33] * sc, sp[13 * 33] * sc, sp[14 * 33] * sc, sp[15 * 33] * sc);
            *(v4u*)(dst + (size_t)mi * dstride + (size_t)(drow0 + n) * K + k0 + 16 * c) = o;
            if (kb == 0 && c == 0) SW[(size_t)mi * swstride + drow0 + n] = 1.f / sc; }
        LDS_WAIT(); asm volatile("" ::: "memory");
    }
}
__device__ __forceinline__ void amax_job(Frame& F, const float* src, size_t sstride, int N, unsigned* amax, int astride, int nmat, int K = DM) {
    const int NGW = F.G * NWAVES, gw = F.vcu * NWAVES + F.wave, lane = F_LANE, ncb = N / 256, per = (K / 64) * ncb;
    for (int it = gw; it < per * nmat; it += NGW) { const int mi = it / per, r = it % per, kb = r / ncb, cb = r % ncb;
        const float* wp = src + (size_t)mi * sstride + (size_t)(kb * 64) * N + cb * 256 + 4 * lane; float4 mx = make_float4(0.f, 0.f, 0.f, 0.f);
#pragma unroll 16
        for (int q = 0; q < 64; ++q) { const float4 v = *(const float4*)(wp + (size_t)q * N); mx.x = fmaxf(mx.x, fabsf(v.x)); mx.y = fmaxf(mx.y, fabsf(v.y)); mx.z = fmaxf(mx.z, fabsf(v.z)); mx.w = fmaxf(mx.w, fabsf(v.w)); }
        unsigned* am = amax + (size_t)mi * astride + cb * 256 + 4 * lane;
        atomicMax(am + 0, __float_as_uint(mx.x)); atomicMax(am + 1, __float_as_uint(mx.y)); atomicMax(am + 2, __float_as_uint(mx.z)); atomicMax(am + 3, __float_as_uint(mx.w)); }
}
enum { IN_X = 0, IN_C, IN_POS, IN_N1G, IN_N2G, IN_ADAW, IN_ADAB, IN_WIN, IN_CONVW, IN_CQG, IN_WUQ, IN_CKVG, IN_WUKV, IN_QNG, IN_KNG, IN_GVG, IN_WS, IN_BS, IN_RETG, IN_WBR, IN_WO,
       IN_F1, IN_F3, IN_F2, IN_RW, IN_RB, IN_M1, IN_M3, IN_M2, N_IN };
enum { PH_PRO = 0, PH_PRO2 = 1, PL_NORM1 = 0, PL_INPROJ, PL_PRE, PL_SCAN, PL_ATTN, PL_GATE, PL_MERGE, PL_WO, PL_NORM2, PL_F0, PL_F1, PL_F2, PL_F3, PL_F4, PL_F5, PL_PER_LAYER = 16, N_PHASES = 2 + 2 * PL_PER_LAYER };
__host__ __device__ constexpr int PHL(int l, int k) { return 2 + l * PL_PER_LAYER + k; }

struct Args { const void* in[N_IN]; float* out; unsigned char* ws; int ph_lo, ph_hi, li, pad; };


typedef const __attribute__((address_space(4))) unsigned long long* karg_t;
__device__ __forceinline__ const void* karg_ptr(int idx) { karg_t k = (karg_t)__builtin_amdgcn_kernarg_segment_ptr(); asm volatile("" : "+s"(k)); return (const void*)(const __attribute__((address_space(1))) char*)k[idx]; }
#define K_IN(i) (karg_ptr(i))
#define K_OUT ((float*)karg_ptr(N_IN))
#define K_WS ((unsigned char*)karg_ptr(N_IN + 1))
__device__ __forceinline__ void norm_phase(Frame& F, const float* X, bf16* H, const float* gain, const float* ada_l, const int off_sh, const int off_sc,
                                           const float* router_w, const float* router_b, nv::Route* route, int* CNT, unsigned char* H8 = nullptr, float* SH = nullptr, const bool x16 = false, const int rbs = 4) {
    int lane_ = F_LANE; asm volatile("" : "+v"(lane_)); const int lane = lane_;
    LAS int* cnt = (LAS int*)(F.lds + RING_OFF);
    for (int blk = F.vcu; blk < NTOK / 128; blk += F.G) {
        if (router_w) { if (F_TID < NEXP) cnt[F_TID] = 0; __syncthreads(); }
        const int b = (blk * 128) / SEQ;
        for (int rb = 0; rb < 16; rb += rbs) {
          float4 gm[4], sh[4];
#pragma unroll
          for (int j = 0; j < 4; ++j) { const int col = 4 * (lane + 64 * j);
            const float4 g = *(const float4*)(gain + col), sc = *(const float4*)(ada_l + (size_t)b * 6 * DM + off_sc + col);
            gm[j] = make_float4(g.x * (1.f + sc.x), g.y * (1.f + sc.y), g.z * (1.f + sc.z), g.w * (1.f + sc.w));
            sh[j] = *(const float4*)(ada_l + (size_t)b * 6 * DM + off_sh + col); }
          {
          pg8::f32x4 v4[4][4];
#pragma unroll
          for (int q = 0; q < 4; ++q) if (q < rbs)
#pragma unroll
              for (int j = 0; j < 4; ++j) { const size_t xo = (size_t)(blk * 128 + F.wave * 16 + rb + q) * DM + 4 * (lane + 64 * j);
                  if (x16) { const pg8::u32x2 r = *(const pg8::u32x2*)((const bf16*)X + xo); v4[q][j] = (pg8::f32x4){pg8::bflo(r.x), pg8::bfhi(r.x), pg8::bflo(r.y), pg8::bfhi(r.y)}; }
                  else v4[q][j] = *(const pg8::f32x4*)(X + xo); }
#pragma unroll
          for (int qp = 0; qp < 4; qp += 2) if (qp < rbs) {
          pg8::f32x4 hall[2][4], lgq[2][2];
#pragma unroll
          for (int q = 0; q < 2; ++q) {
            const int m = blk * 128 + F.wave * 16 + rb + qp + q;
            float4 v[4]; float ss = 0.f;
#pragma unroll
            for (int j = 0; j < 4; ++j) { v[j] = make_float4(v4[qp + q][j][0], v4[qp + q][j][1], v4[qp + q][j][2], v4[qp + q][j][3]); ss += v[j].x * v[j].x + v[j].y * v[j].y + v[j].z * v[j].z + v[j].w * v[j].w; }
            ss = wave_sum(ss);
            const float rstd = rsqrtf(ss * (1.f / DM) + EPS);
            float amax = 0.f;
            lgq[q][0] = (pg8::f32x4){0.f, 0.f, 0.f, 0.f}; lgq[q][1] = lgq[q][0];
#pragma unroll
            for (int j = 0; j < 4; ++j) {
                const int col = 4 * (lane + 64 * j);
                const float h0 = v[j].x * rstd * gm[j].x + sh[j].x, h1 = v[j].y * rstd * gm[j].y + sh[j].y, h2 = v[j].z * rstd * gm[j].z + sh[j].z, h3 = v[j].w * rstd * gm[j].w + sh[j].w;
                if (H) { uint2 o; o.x = pk2(h0, h1); o.y = pk2(h2, h3); *(uint2*)(H + (size_t)m * DM + col) = o; }
                hall[q][j] = (pg8::f32x4){h0, h1, h2, h3};
                if (H8) amax = fmaxf(fmaxf(amax, fmaxf(fabsf(h0), fabsf(h1))), fmaxf(fabsf(h2), fabsf(h3)));
            }
            if (H8) {
#pragma unroll
                for (int o = 1; o < 64; o <<= 1) amax = fmaxf(amax, __shfl_xor(amax, o));
                const float sc = fp8_scale(amax);
#pragma unroll
                for (int j = 0; j < 4; ++j) *(unsigned*)(H8 + (size_t)m * DM + 4 * (lane + 64 * j)) = pk4_fp8(hall[q][j][0] * sc, hall[q][j][1] * sc, hall[q][j][2] * sc, hall[q][j][3] * sc);
                if (lane == 0) SH[m] = 1.f / sc;
            }
          }
          if (router_w) {
#pragma unroll
            for (int j = 0; j < 4; ++j) {
                const float4* rw = (const float4*)(router_w + (size_t)(4 * (lane + 64 * j)) * NEXP);
#pragma unroll
                for (int q2 = 0; q2 < 2; ++q2) { const float4 w0 = rw[q2], w1 = rw[2 + q2], w2 = rw[4 + q2], w3 = rw[6 + q2];
#pragma unroll
                    for (int q = 0; q < 2; ++q) { const float h0 = hall[q][j][0], h1 = hall[q][j][1], h2 = hall[q][j][2], h3 = hall[q][j][3];
                        lgq[q][q2][0] += h0 * w0.x + h1 * w1.x + h2 * w2.x + h3 * w3.x; lgq[q][q2][1] += h0 * w0.y + h1 * w1.y + h2 * w2.y + h3 * w3.y;
                        lgq[q][q2][2] += h0 * w0.z + h1 * w1.z + h2 * w2.z + h3 * w3.z; lgq[q][q2][3] += h0 * w0.w + h1 * w1.w + h2 * w2.w + h3 * w3.w; } }
            }
#pragma unroll
            for (int q = 0; q < 2; ++q) { const int m = blk * 128 + F.wave * 16 + rb + qp + q; float lg[NEXP];
#pragma unroll
                for (int e = 0; e < NEXP; ++e) lg[e] = wave_sum(lgq[q][e >> 2][e & 3]) + router_b[e];
                if (lane == 0) {
                    int e0 = 0; float l0 = lg[0];
#pragma unroll
                    for (int e = 1; e < NEXP; ++e) if (lg[e] > l0) { l0 = lg[e]; e0 = e; }
                    int e1 = -1; float l1 = -INFINITY;
#pragma unroll
                    for (int e = 0; e < NEXP; ++e) if (e != e0 && lg[e] > l1) { l1 = lg[e]; e1 = e; }
                    const float p0 = 1.f / (1.f + __expf(l1 - l0));
                    nv::Route r; r.e0 = e0; r.e1 = e1; r.p0 = p0; r.p1 = 1.f - p0; route[m] = r;
                    atomicAdd((int*)&cnt[e0], 1); atomicAdd((int*)&cnt[e1], 1);
                }
            }
          }
          }
          }
        }
        if (router_w) { __syncthreads(); if (F_TID < NEXP) CNT[blk * NEXP + F_TID] = cnt[F_TID]; __syncthreads(); }
    }
}

__device__ __forceinline__ void moe_assign_phase(Frame& F, const Args& args) {
    unsigned char* ws = K_WS;
    const nv::Route* route = (const nv::Route*)(ws + WS_ROUTE); const int* CNT = (const int*)(ws + WS_CNT); const unsigned char* H8 = ws + WS_H8; unsigned char* XS8 = ws + WS_XS8; const float* SH = (const float*)(ws + WS_SH); float* SXS = (float*)(ws + WS_SXS);
    int* SLOT = (int*)(ws + WS_SLOT); float* PSLOT = (float*)(ws + WS_PSLOT); int* PEXP = (int*)(ws + WS_PEXP); int* TOK = (int*)(ws + WS_TOK);
    LAS int* sm = (LAS int*)(F.lds + RING_OFF);
    LAS int* tot = sm; LAS int* pre = sm + 8; LAS int* base = sm + 16; LAS int* wcnt = sm + 32; LAS int* ss0 = sm + 64; LAS int* ss1 = sm + 192;
    const int tid = F_TID, lane = F_LANE, w = F.wave;
    for (int blk = F.vcu; blk < NTOK / 128; blk += F.G) {
        if (tid < 16) sm[tid] = 0;
        __syncthreads();
        if (tid < 256) { const int4 c0 = *(const int4*)(CNT + tid * NEXP), c1 = *(const int4*)(CNT + tid * NEXP + 4); const int cc[8] = {c0.x, c0.y, c0.z, c0.w, c1.x, c1.y, c1.z, c1.w};
#pragma unroll
            for (int e = 0; e < NEXP; ++e) { int tv = cc[e], pv = (tid < blk) ? cc[e] : 0;
#pragma unroll
                for (int o = 1; o < 64; o <<= 1) { tv += __shfl_xor(tv, o); pv += __shfl_xor(pv, o); }
                if (lane == 0) { (void)__hip_atomic_fetch_add(tot + e, tv, __ATOMIC_RELAXED, __HIP_MEMORY_SCOPE_WORKGROUP); (void)__hip_atomic_fetch_add(pre + e, pv, __ATOMIC_RELAXED, __HIP_MEMORY_SCOPE_WORKGROUP); } } }
        __syncthreads();
        if (tid == 0) { int bsum = 0; for (int e = 0; e < NEXP; ++e) { base[e] = bsum; bsum += (tot[e] + 255) & ~255; } base[NEXP] = bsum; }
        __syncthreads();
        if (blk == 0) { for (int p = tid; p < MAXPANEL + 8; p += NWAVES * 64) { int e = -1;
#pragma unroll
                for (int x = 0; x < NEXP; ++x) if (p * 256 >= base[x] && p * 256 < base[x + 1]) e = x;
                if (p == MAXPANEL) e = base[NEXP] >> 8; PEXP[p] = e; } }
        if (blk < NEXP) { const int e = blk; for (int s = base[e] + tot[e] + tid; s < base[e + 1]; s += NWAVES * 64) { PSLOT[s] = 0.f; TOK[s] = -1; } }
        if (tid < 128) {
            const int t = blk * 128 + tid; const nv::Route r = route[t]; int rank0 = 0, rank1 = 0;
#pragma unroll
            for (int e = 0; e < NEXP; ++e) { const bool in = (r.e0 == e) || (r.e1 == e); const unsigned long long m = __ballot(in); if (lane == 0) wcnt[w * 8 + e] = __popcll(m);
                const int rk = __popcll(m & ((1ull << lane) - 1ull)); if (r.e0 == e) rank0 = rk; if (r.e1 == e) rank1 = rk; }
            ss0[tid] = rank0; ss1[tid] = rank1;
        }
        __syncthreads();
        if (tid < 128) {
            const int t = blk * 128 + tid; const nv::Route r = route[t]; int rank0 = ss0[tid], rank1 = ss1[tid];
            if (w == 1) { rank0 += wcnt[r.e0]; rank1 += wcnt[r.e1]; }
            const int s0 = base[r.e0] + pre[r.e0] + rank0, s1 = base[r.e1] + pre[r.e1] + rank1;
            SLOT[2 * t] = s0; SLOT[2 * t + 1] = s1; PSLOT[s0] = r.p0; PSLOT[s1] = r.p1; TOK[s0] = t; TOK[s1] = t;
        }
        __syncthreads();
        __syncthreads();
    }
}
__device__ __forceinline__ void moe_gather_phase(Frame& F) {
    unsigned char* ws = K_WS; const int* TOK = (const int*)(ws + WS_TOK); const unsigned char* H8 = ws + WS_H8; unsigned char* XS8 = ws + WS_XS8; const float* SH = (const float*)(ws + WS_SH); float* SXS = (float*)(ws + WS_SXS);
    const int total = ((const int*)(ws + WS_PEXP))[MAXPANEL] * 256, per = (total + F.G - 1) / F.G, lane = F_LANE;
    const int s_lo = F.vcu * per, s_hi = (s_lo + per < total) ? s_lo + per : total;
    for (int s0 = s_lo + F.wave * 8; s0 < s_hi; s0 += NWAVES * 8) {
        int tk[8];
#pragma unroll
        for (int i = 0; i < 8; ++i) tk[i] = (s0 + i < s_hi) ? TOK[s0 + i] : -1;
        v4u v[8]; float sc[8];
#pragma unroll
        for (int i = 0; i < 8; ++i) { const int tt = tk[i] < 0 ? 0 : tk[i]; v[i] = *(const v4u*)(H8 + (size_t)tt * DM + lane * 16); sc[i] = SH[tt]; }
#pragma unroll
        for (int i = 0; i < 8; ++i) if (tk[i] >= 0) { *(v4u*)(XS8 + (size_t)(s0 + i) * DM + lane * 16) = v[i]; if (lane == 0) SXS[s0 + i] = sc[i]; }
    }
}

__device__ __forceinline__ float4 moe_yrow(const bf16* Y, const bf16* PART, int slot, int tail0, int c4) {
    if (slot < tail0) { const uint2 a = *(const uint2*)(Y + (size_t)slot * DM + c4); return make_float4(bf2f((bf16)(a.x & 0xffff)), bf2f((bf16)(a.x >> 16)), bf2f((bf16)(a.y & 0xffff)), bf2f((bf16)(a.y >> 16))); }
    float4 r = make_float4(0.f, 0.f, 0.f, 0.f);
#pragma unroll
    for (int kq = 0; kq < 2; ++kq) { const uint2 a = *(const uint2*)(PART + ((size_t)kq * (MAXTAIL * 256) + (slot - tail0)) * DM + c4);
        r.x += bf2f((bf16)(a.x & 0xffff)); r.y += bf2f((bf16)(a.x >> 16)); r.z += bf2f((bf16)(a.y & 0xffff)); r.w += bf2f((bf16)(a.y >> 16)); }
    return r;
}
__device__ __forceinline__ void moe_combine_phase(Frame& F, float* X, const bf16* Y, const bf16* PART, const int tail0, const int* SLOT, const float* g2) {
    const int gw = F.vcu * NWAVES + F.wave, NGW = F.G * NWAVES;
    for (int t0 = gw; t0 < NTOK; t0 += 2 * NGW) {
        const int t1 = t0 + NGW; const bool two = (t1 < NTOK); const int tb = two ? t1 : t0;
        int sl[4] = {SLOT[2 * t0], SLOT[2 * t0 + 1], SLOT[2 * tb], SLOT[2 * tb + 1]};
        const bf16* yp[4];
#pragma unroll
        for (int q = 0; q < 4; ++q) yp[q] = (sl[q] < tail0) ? Y + (size_t)sl[q] * DM : PART + (size_t)(sl[q] - tail0) * DM;
        uint2 yr[4][4]; float4 xa[4], xb[4], ga[4], gb[4];
#pragma unroll
        for (int j = 0; j < 4; ++j) { const int c4 = 4 * (F_LANE + 64 * j);
#pragma unroll
            for (int q = 0; q < 4; ++q) yr[q][j] = *(const uint2*)(yp[q] + c4);
            xa[j] = *(const float4*)(X + (size_t)t0 * DM + c4); xb[j] = *(const float4*)(X + (size_t)tb * DM + c4);
            ga[j] = *(const float4*)(g2 + (size_t)(t0 / SEQ) * 6 * DM + c4); gb[j] = *(const float4*)(g2 + (size_t)(tb / SEQ) * 6 * DM + c4); }
        float4 ys[4][4];
#pragma unroll
        for (int q = 0; q < 4; ++q)
#pragma unroll
            for (int j = 0; j < 4; ++j) { const uint2 a = yr[q][j]; ys[q][j] = make_float4(bf2f((bf16)(a.x & 0xffff)), bf2f((bf16)(a.x >> 16)), bf2f((bf16)(a.y & 0xffff)), bf2f((bf16)(a.y >> 16))); }
#pragma unroll
        for (int q = 0; q < 4; ++q) if (sl[q] >= tail0) {
#pragma unroll
            for (int j = 0; j < 4; ++j) { const int c4 = 4 * (F_LANE + 64 * j); const uint2 a = *(const uint2*)(PART + ((size_t)(MAXTAIL * 256) + (sl[q] - tail0)) * DM + c4);
                ys[q][j].x += bf2f((bf16)(a.x & 0xffff)); ys[q][j].y += bf2f((bf16)(a.x >> 16)); ys[q][j].z += bf2f((bf16)(a.y & 0xffff)); ys[q][j].w += bf2f((bf16)(a.y >> 16)); } }
#pragma unroll
        for (int j = 0; j < 4; ++j) { const int c4 = 4 * (F_LANE + 64 * j);
            { const float4 g = ga[j]; float4 x = xa[j];
              x.x += g.x * (ys[0][j].x + ys[1][j].x); x.y += g.y * (ys[0][j].y + ys[1][j].y); x.z += g.z * (ys[0][j].z + ys[1][j].z); x.w += g.w * (ys[0][j].w + ys[1][j].w); *(float4*)(X + (size_t)t0 * DM + c4) = x; }
            if (two) { const float4 g = gb[j]; float4 x = xb[j];
              x.x += g.x * (ys[2][j].x + ys[3][j].x); x.y += g.y * (ys[2][j].y + ys[3][j].y); x.z += g.z * (ys[2][j].z + ys[3][j].z); x.w += g.w * (ys[2][j].w + ys[3][j].w); *(float4*)(X + (size_t)t1 * DM + c4) = x; } }
    }
}

__device__ __forceinline__ void scan_phase(Frame& F, float* RET) {
    LAS float* T = (LAS float*)(F.lds + RING_OFF);
    const int tid = F_TID, el = tid & 127, seg = tid >> 7;
    for (int blk = F.vcu; blk < NBATCH * NHEAD * 4096 / 128; blk += F.G) {
        const int idx = blk * 128 + el, b = idx / (NHEAD * 4096), h = (idx / 4096) % NHEAD, ed = idx % 4096;
        const float cd = __expf(nv::ret_loggamma(h) * 128.f);
        float* p = RET + ((size_t)(b * NCHUNK + seg * 32) * NHEAD + h) * 4096 + ed; const size_t stp = (size_t)NHEAD * 4096;
        float v[32];
#pragma unroll
        for (int i = 0; i < 32; ++i) v[i] = p[(size_t)i * stp];
        float st = 0.f;
#pragma unroll
        for (int i = 0; i < 32; ++i) { const float kv = v[i]; v[i] = st; st = st * cd + kv; }
        T[seg * 128 + el] = st;
        __syncthreads();
        float cd32 = cd;
#pragma unroll
        for (int i = 0; i < 5; ++i) cd32 *= cd32;
        float carry = 0.f;
        for (int s2 = 0; s2 < seg; ++s2) carry = carry * cd32 + T[s2 * 128 + el];
        float w = carry;
#pragma unroll
        for (int i = 0; i < 32; ++i) { p[(size_t)i * stp] = v[i] + w; w *= cd; }
        __syncthreads();
    }
}
typedef short bf16x8 __attribute__((ext_vector_type(8)));
typedef float f32x4 __attribute__((ext_vector_type(4)));
typedef float f32x16 __attribute__((ext_vector_type(16)));
#define MFMA16(a, b, c) __builtin_amdgcn_mfma_f32_16x16x32_bf16((a), (b), (c), 0, 0, 0)
__device__ __forceinline__ float bflo_(unsigned w) { return __uint_as_float(w << 16); }
__device__ __forceinline__ float bfhi_(unsigned w) { return __uint_as_float(w & 0xffff0000u); }
__device__ __forceinline__ float sumsq8(bf16x8 v) { float s = 0.f;
#pragma unroll
    for (int i = 0; i < 8; ++i) { const float f = bf2f((bf16)v[i]); s += f * f; } return s; }
__device__ __forceinline__ int tofs(int row, int j) { return row * 256 + ((((j >> 3) ^ (row & 15)) << 4) | ((j & 7) << 1)); }
__device__ __forceinline__ float fast_gelu_tanh(float x) { const float u = 0.7978845608028654f * (x + 0.044715f * x * x * x);
    return x * __builtin_amdgcn_rcpf(1.f + __builtin_amdgcn_exp2f(-2.885390081777927f * u)); }

__device__ __forceinline__ void rope_sincos(const float fpos, const float f, float* s, float* c) {
    const float c_hi = 0.15915494f, c_lo = 6.4206e-9f;
    const float x_hi = fpos * f, x_lo = fmaf(fpos, f, -x_hi);
    const float r_hi = x_hi * c_hi, r_lo = fmaf(x_hi, c_hi, -r_hi) + x_hi * c_lo + x_lo * c_hi;
    const float fr = (r_hi - floorf(r_hi)) + r_lo;
    *s = __builtin_amdgcn_sinf(fr); *c = __builtin_amdgcn_cosf(fr);
}

template <int l> __device__ __forceinline__ void pre_conv(Frame& F, const Args& args, const int t0) {
    const bf16* P = (const bf16*)(K_WS + WS_PROJ); bf16* YB = (bf16*)(K_WS + WS_YB); const float* cw = (const float*)K_IN(IN_CONVW) + l * 3 * MIXW;
    int tid_ = F_TID; asm volatile("" : "+v"(tid_)); const int cg = tid_ & 31, tl = tid_ >> 5, c0 = cg * 8, tb = t0 + tl * 8, sb = tb % SEQ;
    float w0[8], w1[8], w2[8], u1[8], u2[8];
#pragma unroll
    for (int i = 0; i < 8; ++i) { w0[i] = cw[c0 + i]; w1[i] = cw[256 + c0 + i]; w2[i] = cw[512 + c0 + i]; u1[i] = 0.f; u2[i] = 0.f; }
    auto ldu = [&](int t, float* u) { const v4u a = *(const v4u*)(P + (size_t)t * PROJW + C_AC + c0), x = *(const v4u*)(P + (size_t)t * PROJW + C_AX + c0);
        u[0] = bflo_(a.x) * bflo_(x.x); u[1] = bfhi_(a.x) * bfhi_(x.x); u[2] = bflo_(a.y) * bflo_(x.y); u[3] = bfhi_(a.y) * bfhi_(x.y);
        u[4] = bflo_(a.z) * bflo_(x.z); u[5] = bfhi_(a.z) * bfhi_(x.z); u[6] = bflo_(a.w) * bflo_(x.w); u[7] = bfhi_(a.w) * bfhi_(x.w); };
    if (sb >= 1) ldu(tb - 1, u1);
    if (sb >= 2) ldu(tb - 2, u2);
    v4u la[8], lx[8], lb[8];
#pragma unroll
    for (int i = 0; i < 8; ++i) { const size_t o = (size_t)(tb + i) * PROJW + c0; la[i] = *(const v4u*)(P + o + C_AC); lx[i] = *(const v4u*)(P + o + C_AX); lb[i] = *(const v4u*)(P + o + C_AB); }
#pragma unroll
    for (int i = 0; i < 8; ++i) { const int t = tb + i; float u0[8];
        { const v4u a = la[i], x = lx[i];
          u0[0] = bflo_(a.x) * bflo_(x.x); u0[1] = bfhi_(a.x) * bfhi_(x.x); u0[2] = bflo_(a.y) * bflo_(x.y); u0[3] = bfhi_(a.y) * bfhi_(x.y);
          u0[4] = bflo_(a.z) * bflo_(x.z); u0[5] = bfhi_(a.z) * bfhi_(x.z); u0[6] = bflo_(a.w) * bflo_(x.w); u0[7] = bfhi_(a.w) * bfhi_(x.w); }
        const v4u ab = lb[i]; const float bb[8] = {bflo_(ab.x), bfhi_(ab.x), bflo_(ab.y), bfhi_(ab.y), bflo_(ab.z), bfhi_(ab.z), bflo_(ab.w), bfhi_(ab.w)};
        float y[8];
#pragma unroll
        for (int c = 0; c < 8; ++c) { y[c] = bb[c] * (w0[c] * u2[c] + w1[c] * u1[c] + w2[c] * u0[c]); u2[c] = u1[c]; u1[c] = u0[c]; }
        v4u o; o.x = pk2(y[0], y[1]); o.y = pk2(y[2], y[3]); o.z = pk2(y[4], y[5]); o.w = pk2(y[6], y[7]);
        *(v4u*)(YB + (size_t)t * DM + c0) = o; }
}

template <int l> __device__ __forceinline__ void pre_mla(Frame& F, const Args& args, const int t0) {
    unsigned char* ws = K_WS;
    const bf16* P = (const bf16*)(ws + WS_PROJ); bf16* Q = (bf16*)(ws + WS_Q); bf16* Kb = (bf16*)(ws + WS_K); bf16* VT = (bf16*)(ws + WS_VT);
    const bf16* WUQ = (const bf16*)(ws + WS_WUQ_T) + (size_t)l * QW * 256; const bf16* WUKV = (const bf16*)(ws + WS_WUKV_T) + (size_t)l * 512 * 128;
    const float* qn_g = (const float*)K_IN(IN_QNG) + l * QKH; const float* kn_g = (const float*)K_IN(IN_KNG) + l * QKH; const int* pos = (const int*)K_IN(IN_POS);
    int lane_ = F_LANE; asm volatile("" : "+v"(lane_)); const int lr = lane_ & 15, lq = lane_ >> 4;
    const int tw = t0 + F.wave * 16 + lr, b = t0 / SEQ, sw = (t0 % SEQ) + F.wave * 16;
    const bf16* prow = P + (size_t)tw * PROJW;
    bf16x8 xq[8], xkv[4]; float ssq = 0.f, sskv = 0.f;
#pragma unroll
    for (int s = 0; s < 8; ++s) { xq[s] = *(const bf16x8*)(prow + C_CQ + 32 * s + 8 * lq); ssq += sumsq8(xq[s]); }
#pragma unroll
    for (int s = 0; s < 4; ++s) { xkv[s] = *(const bf16x8*)(prow + C_CKV + 32 * s + 8 * lq); sskv += sumsq8(xkv[s]); }
    ssq += __shfl_xor(ssq, 16); ssq += __shfl_xor(ssq, 32); sskv += __shfl_xor(sskv, 16); sskv += __shfl_xor(sskv, 32);
    const float rq = rsqrtf(ssq * (1.f / 256) + EPS), rkv = rsqrtf(sskv * (1.f / 128) + EPS);
    float cs[4], sn[4]; { const float fpos = (float)pos[tw];
#pragma unroll
        for (int r = 0; r < 4; ++r) rope_sincos(fpos, powf(10000.f, -(float)(4 * lq + r) / 16.f), &sn[r], &cs[r]); }
    LAS unsigned char* wl = F.lds + RING_OFF; const int tid_w = F_TID;
    v4u wv6[6], wv4[4];
#pragma unroll
    for (int i = 0; i < 6; ++i) { const int p = tid_w + 512 * i; wv6[i] = *(const v4u*)(WUQ + (size_t)(p >> 5) * 256 + (p & 31) * 8); }
#pragma unroll 1
    for (int h = 0; h < NHEAD; ++h) {
        __syncthreads();
#pragma unroll
        for (int i = 0; i < 6; ++i) { const int p = tid_w + 512 * i; *(LAS v4u*)(wl + (p >> 5) * 528 + (p & 31) * 16) = wv6[i]; }
        __syncthreads();
        if (h + 1 < NHEAD) {
#pragma unroll
            for (int i = 0; i < 6; ++i) { const int p = tid_w + 512 * i; wv6[i] = *(const v4u*)(WUQ + (size_t)((h + 1) * 96 + (p >> 5)) * 256 + (p & 31) * 8); }
        } else {
#pragma unroll
            for (int i = 0; i < 4; ++i) { const int p = tid_w + 512 * i; wv4[i] = *(const v4u*)(WUKV + (size_t)(p >> 4) * 128 + (p & 15) * 8); }
        }
        f32x4 acc[6];
#pragma unroll
        for (int nt = 0; nt < 6; ++nt) acc[nt] = (f32x4){0.f, 0.f, 0.f, 0.f};
#pragma unroll
        for (int s = 0; s < 8; ++s)
#pragma unroll
            for (int nt = 0; nt < 6; ++nt) { const bf16x8 wf = *(const LAS bf16x8*)(wl + (nt * 16 + lr) * 528 + (32 * s + 8 * lq) * 2); acc[nt] = MFMA16(wf, xq[s], acc[nt]); }
        float ss = 0.f;
#pragma unroll
        for (int nt = 0; nt < 6; ++nt) { acc[nt] = acc[nt] * rq; ss += acc[nt][0] * acc[nt][0] + acc[nt][1] * acc[nt][1] + acc[nt][2] * acc[nt][2] + acc[nt][3] * acc[nt][3]; }
        ss += __shfl_xor(ss, 16); ss += __shfl_xor(ss, 32);
        const float rh = rsqrtf(ss * (1.f / 96) + EPS);
#pragma unroll
        for (int nt = 0; nt < 6; ++nt) { const f32x4 g = *(const f32x4*)(qn_g + nt * 16 + 4 * lq); acc[nt] = acc[nt] * rh * g; }
#pragma unroll
        for (int r = 0; r < 4; ++r) { const float x1 = acc[4][r], x2 = acc[5][r]; acc[4][r] = x1 * cs[r] - x2 * sn[r]; acc[5][r] = x2 * cs[r] + x1 * sn[r]; }
#pragma unroll
        for (int nt = 0; nt < 6; ++nt) { v2u o; o.x = pk2(acc[nt][0] * ATT_C2, acc[nt][1] * ATT_C2); o.y = pk2(acc[nt][2] * ATT_C2, acc[nt][3] * ATT_C2);
            *(v2u*)(Q + (size_t)tw * QW + h * 96 + nt * 16 + 4 * lq) = o; }
    }
    float kr1[4], kr2[4]; { const v2u a = *(const v2u*)(prow + C_KR + 4 * lq), c = *(const v2u*)(prow + C_KR + 16 + 4 * lq);
        kr1[0] = bflo_(a.x); kr1[1] = bfhi_(a.x); kr1[2] = bflo_(a.y); kr1[3] = bfhi_(a.y); kr2[0] = bflo_(c.x); kr2[1] = bfhi_(c.x); kr2[2] = bflo_(c.y); kr2[3] = bfhi_(c.y); }
    float sskr = 0.f;
#pragma unroll
    for (int r = 0; r < 4; ++r) sskr += kr1[r] * kr1[r] + kr2[r] * kr2[r];
    float rkv_r[4];
#pragma unroll
    for (int r = 0; r < 4; ++r) rkv_r[r] = __shfl(rkv, 4 * lq + r);
#pragma unroll 1
    for (int h = 0; h < NHEAD; ++h) {
        __syncthreads();
#pragma unroll
        for (int i = 0; i < 4; ++i) { const int p = tid_w + 512 * i; *(LAS v4u*)(wl + (p >> 4) * 272 + (p & 15) * 16) = wv4[i]; }
        __syncthreads();
        if (h + 1 < NHEAD) {
#pragma unroll
            for (int i = 0; i < 4; ++i) { const int p = tid_w + 512 * i; wv4[i] = *(const v4u*)(WUKV + (size_t)((h + 1) * 128 + (p >> 4)) * 128 + (p & 15) * 8); }
        }
        f32x4 ak[4], av[4];
#pragma unroll
        for (int nt = 0; nt < 4; ++nt) { ak[nt] = (f32x4){0.f, 0.f, 0.f, 0.f}; av[nt] = (f32x4){0.f, 0.f, 0.f, 0.f}; }
#pragma unroll
        for (int s = 0; s < 4; ++s)
#pragma unroll
            for (int nt = 0; nt < 4; ++nt) {
                const bf16x8 wk = *(const LAS bf16x8*)(wl + (nt * 16 + lr) * 272 + (32 * s + 8 * lq) * 2); ak[nt] = MFMA16(wk, xkv[s], ak[nt]);
                const bf16x8 wv = *(const LAS bf16x8*)(wl + (64 + nt * 16 + lr) * 272 + (32 * s + 8 * lq) * 2); av[nt] = MFMA16(xkv[s], wv, av[nt]);
            }
        float ss = sskr;
#pragma unroll
        for (int nt = 0; nt < 4; ++nt) { ak[nt] = ak[nt] * rkv; ss += ak[nt][0] * ak[nt][0] + ak[nt][1] * ak[nt][1] + ak[nt][2] * ak[nt][2] + ak[nt][3] * ak[nt][3]; }
        ss += __shfl_xor(ss, 16); ss += __shfl_xor(ss, 32);
        const float rk = rsqrtf(ss * (1.f / 96) + EPS);
#pragma unroll
        for (int nt = 0; nt < 4; ++nt) { const f32x4 g = *(const f32x4*)(kn_g + nt * 16 + 4 * lq); const f32x4 v = ak[nt] * rk * g; v2u o; o.x = pk2(v[0], v[1]); o.y = pk2(v[2], v[3]);
            *(v2u*)(Kb + (size_t)tw * QW + h * 96 + nt * 16 + 4 * lq) = o; }
        { const f32x4 g1 = *(const f32x4*)(kn_g + 64 + 4 * lq), g2 = *(const f32x4*)(kn_g + 80 + 4 * lq); float o1[4], o2[4];
#pragma unroll
          for (int r = 0; r < 4; ++r) { const float x1 = kr1[r] * rk * g1[r], x2 = kr2[r] * rk * g2[r]; o1[r] = x1 * cs[r] - x2 * sn[r]; o2[r] = x2 * cs[r] + x1 * sn[r]; }
          v2u a; a.x = pk2(o1[0], o1[1]); a.y = pk2(o1[2], o1[3]); *(v2u*)(Kb + (size_t)tw * QW + h * 96 + 64 + 4 * lq) = a;
          v2u c; c.x = pk2(o2[0], o2[1]); c.y = pk2(o2[2], o2[3]); *(v2u*)(Kb + (size_t)tw * QW + h * 96 + 80 + 4 * lq) = c; }
#pragma unroll
        for (int nt = 0; nt < 4; ++nt) { v2u o; o.x = pk2(av[nt][0] * rkv_r[0], av[nt][1] * rkv_r[1]); o.y = pk2(av[nt][2] * rkv_r[2], av[nt][3] * rkv_r[3]);
            *(v2u*)(VT + ((size_t)(b * NHEAD + h) * 64 + nt * 16 + lr) * SEQ + sw + 4 * lq) = o; }
    }
    __syncthreads();
}

template <int l> __device__ __forceinline__ void pre_sgu(Frame& F, const Args& args, const int t0) {
    unsigned char* ws = K_WS;
    const bf16* P = (const bf16*)(ws + WS_PROJ); bf16* YB = (bf16*)(ws + WS_YB); const bf16* WST = (const bf16*)(ws + WS_WS_T) + (size_t)l * 4 * 128 * 128;
    const float* gv_g = (const float*)K_IN(IN_GVG) + l * 256; const float* b_s = (const float*)K_IN(IN_BS) + l * 4 * 128;
    LAS unsigned char* vT = F.lds + RING_OFF;
    int lane_ = F_LANE; asm volatile("" : "+v"(lane_)); const int lane = lane_, lr = lane & 15, lq = lane >> 4, w = F.wave;
    { const f32x4 gg = *(const f32x4*)(gv_g + 4 * lane);
      v2u a16[16];
#pragma unroll
      for (int j = 0; j < 16; ++j) a16[j] = *(const v2u*)(P + (size_t)(t0 + 16 * w + j) * PROJW + C_SV + 4 * lane);
#pragma unroll
      for (int j = 0; j < 16; ++j) { const int s = 16 * w + j; const v2u a = a16[j];
          float v[4] = {fast_gelu_tanh(bflo_(a.x)), fast_gelu_tanh(bfhi_(a.x)), fast_gelu_tanh(bflo_(a.y)), fast_gelu_tanh(bfhi_(a.y))};
          float ss = v[0] * v[0] + v[1] * v[1] + v[2] * v[2] + v[3] * v[3];
          ss += __shfl_xor(ss, 1); ss += __shfl_xor(ss, 2); ss += __shfl_xor(ss, 4); ss += __shfl_xor(ss, 8);
          const float rs = rsqrtf(ss * (1.f / 64) + EPS);
#pragma unroll
          for (int i = 0; i < 4; ++i) *(LAS bf16*)(vT + tofs(4 * lane + i, s)) = f2bf(v[i] * rs * gg[i]); } }
    __syncthreads();
    const int tw = t0 + 16 * w + lr, nks = (16 * w + 15) / 32 + 1;
#pragma unroll 1
    for (int g = 0; g < 4; ++g) {
        f32x4 acc[4];
#pragma unroll
        for (int ct = 0; ct < 4; ++ct) acc[ct] = (f32x4){0.f, 0.f, 0.f, 0.f};
        bf16x8 wf4[4]; v2u au[4];
#pragma unroll
        for (int ks = 0; ks < 4; ++ks) wf4[ks] = *(const bf16x8*)(WST + ((size_t)g * 128 + 16 * w + lr) * 128 + 32 * ks + 8 * lq);
#pragma unroll
        for (int ct = 0; ct < 4; ++ct) au[ct] = *(const v2u*)(P + (size_t)tw * PROJW + C_SU + g * 64 + ct * 16 + 4 * lq);
        const float bb = b_s[g * 128 + 16 * w + lr];
#pragma unroll
        for (int ks = 0; ks < 4; ++ks) if (ks < nks) { const bf16x8 wf = wf4[ks];
#pragma unroll
            for (int ct = 0; ct < 4; ++ct) { const bf16x8 vf = *(const LAS bf16x8*)(vT + tofs(g * 64 + ct * 16 + lr, 32 * ks + 8 * lq)); acc[ct] = MFMA16(vf, wf, acc[ct]); } }
#pragma unroll
        for (int ct = 0; ct < 4; ++ct) { const v2u a = au[ct];
            v2u o; o.x = pk2(fast_gelu_tanh(bflo_(a.x)) * (acc[ct][0] + bb), fast_gelu_tanh(bfhi_(a.x)) * (acc[ct][1] + bb)); o.y = pk2(fast_gelu_tanh(bflo_(a.y)) * (acc[ct][2] + bb), fast_gelu_tanh(bfhi_(a.y)) * (acc[ct][3] + bb));
            *(v2u*)(YB + (size_t)tw * DM + 512 + g * 64 + ct * 16 + 4 * lq) = o; }
    }
    __syncthreads();
}

__device__ __forceinline__ void pre_retkv(Frame& F, const Args& args, const int t0, const int ch) {
    unsigned char* ws = K_WS;
    bf16* P = (bf16*)(ws + WS_PROJ); float* RET = (float*)(ws + WS_RET); const int* pos = (const int*)K_IN(IN_POS);
    LAS unsigned char* kT = F.lds + RING_OFF; LAS unsigned char* vT = F.lds + RING_OFF + 65536;
    int lane_ = F_LANE; asm volatile("" : "+v"(lane_)); const int lane = lane_, lr = lane & 15, lq = lane >> 4, w = F.wave;
    { const int h = lane >> 4, i0 = (lane & 15) * 2; const float lg = nv::ret_loggamma(h);
      const float f0 = powf(10000.f, -(float)i0 / 32.f), f1 = powf(10000.f, -(float)(i0 + 1) / 32.f);
      for (int jb = 0; jb < 16; jb += 8) {
        unsigned q1a[8], q2a[8], k1a[8], k2a[8]; v2u vva[8]; int posa[8];
#pragma unroll
        for (int jj = 0; jj < 8; ++jj) { const int s = 16 * w + jb + jj; const bf16* r = P + (size_t)(t0 + s) * PROJW; posa[jj] = pos[t0 + s];
            q1a[jj] = *(const unsigned*)(r + C_RQ + h * 64 + i0); q2a[jj] = *(const unsigned*)(r + C_RQ + h * 64 + 32 + i0); k1a[jj] = *(const unsigned*)(r + C_RK + h * 64 + i0); k2a[jj] = *(const unsigned*)(r + C_RK + h * 64 + 32 + i0);
            vva[jj] = *(const v2u*)(r + C_RV + 4 * lane); }
#pragma unroll
        for (int jj = 0; jj < 8; ++jj) { const int j = jb + jj; const int s = 16 * w + j; bf16* r = P + (size_t)(t0 + s) * PROJW; const float fpos = (float)posa[jj];
          const unsigned q1 = q1a[jj], q2 = q2a[jj], k1 = k1a[jj], k2 = k2a[jj];
          const v2u vv = vva[jj];
          float s0, c0, s1, c1; rope_sincos(fpos, f0, &s0, &c0); rope_sincos(fpos, f1, &s1, &c1);
          const float dq = __expf(lg * (float)s), dk = 0.125f * __expf(-lg * (float)s);
          const unsigned qa = pk2((bflo_(q1) * c0 - bflo_(q2) * s0) * dq, (bfhi_(q1) * c1 - bfhi_(q2) * s1) * dq), qb = pk2((bflo_(q2) * c0 + bflo_(q1) * s0) * dq, (bfhi_(q2) * c1 + bfhi_(q1) * s1) * dq);
          const unsigned ka = pk2((bflo_(k1) * c0 - bflo_(k2) * s0) * dk, (bfhi_(k1) * c1 - bfhi_(k2) * s1) * dk), kb = pk2((bflo_(k2) * c0 + bflo_(k1) * s0) * dk, (bfhi_(k2) * c1 + bfhi_(k1) * s1) * dk);
          *(unsigned*)(r + C_RQ + h * 64 + i0) = qa; *(unsigned*)(r + C_RQ + h * 64 + 32 + i0) = qb; *(unsigned*)(r + C_RK + h * 64 + i0) = ka; *(unsigned*)(r + C_RK + h * 64 + 32 + i0) = kb;
          *(LAS bf16*)(kT + tofs(h * 64 + i0, s)) = (bf16)(ka & 0xffff); *(LAS bf16*)(kT + tofs(h * 64 + i0 + 1, s)) = (bf16)(ka >> 16);
          *(LAS bf16*)(kT + tofs(h * 64 + 32 + i0, s)) = (bf16)(kb & 0xffff); *(LAS bf16*)(kT + tofs(h * 64 + 32 + i0 + 1, s)) = (bf16)(kb >> 16);
          *(LAS bf16*)(vT + tofs(4 * lane + 0, s)) = (bf16)(vv.x & 0xffff); *(LAS bf16*)(vT + tofs(4 * lane + 1, s)) = (bf16)(vv.x >> 16);
          *(LAS bf16*)(vT + tofs(4 * lane + 2, s)) = (bf16)(vv.y & 0xffff); *(LAS bf16*)(vT + tofs(4 * lane + 3, s)) = (bf16)(vv.y >> 16); } } }
    __syncthreads();
    { const int h = w >> 1; const float g127 = __expf(nv::ret_loggamma(h) * 127.f);
      f32x4 acc[4][2];
#pragma unroll
      for (int dt = 0; dt < 4; ++dt)
#pragma unroll
          for (int ei = 0; ei < 2; ++ei) acc[dt][ei] = (f32x4){0.f, 0.f, 0.f, 0.f};
#pragma unroll
      for (int ks = 0; ks < 4; ++ks) { bf16x8 vf[2];
#pragma unroll
          for (int ei = 0; ei < 2; ++ei) vf[ei] = *(const LAS bf16x8*)(vT + tofs(h * 64 + ((w & 1) * 2 + ei) * 16 + lr, 32 * ks + 8 * lq));
#pragma unroll
          for (int dt = 0; dt < 4; ++dt) { const bf16x8 kf = *(const LAS bf16x8*)(kT + tofs(h * 64 + dt * 16 + lr, 32 * ks + 8 * lq));
#pragma unroll
              for (int ei = 0; ei < 2; ++ei) acc[dt][ei] = MFMA16(kf, vf[ei], acc[dt][ei]); } }
#pragma unroll
      for (int dt = 0; dt < 4; ++dt)
#pragma unroll
          for (int ei = 0; ei < 2; ++ei) *(f32x4*)(RET + (((size_t)ch * NHEAD + h) * 64 + ((w & 1) * 2 + ei) * 16 + lr) * 64 + dt * 16 + 4 * lq) = acc[dt][ei] * g127; }
    __syncthreads();
}

template <int l> __device__ __forceinline__ void pre_phase(Frame& F, const Args& args) {
    for (int ch = F.vcu; ch < NTOK / CHUNK; ch += F.G) {
        const int t0 = ch * CHUNK;
        pre_conv<l>(F, args, t0);
        pre_mla<l>(F, args, t0);
        pre_sgu<l>(F, args, t0);
        pre_retkv(F, args, t0, ch);
    }
}
#define MFMA32(a, b, c) __builtin_amdgcn_mfma_f32_32x32x16_bf16((a), (b), (c), 0, 0, 0)
typedef short s16x4 __attribute__((ext_vector_type(4)));
constexpr int AT_KROW = 208, AT_VROW = 136, AT_KBYTES = 64 * AT_KROW, AT_STAGE = 22528;
__device__ __forceinline__ int crow32(int r, int hi) { return (r & 3) + 8 * (r >> 2) + 4 * hi; }

__device__ __forceinline__ void attn_unit(Frame& F, const bf16* Q, const bf16* Kb, const bf16* VT, bf16* YB, const float nbnd, const int b, const int h, const int qb) {
    int tid_ = F_TID; asm volatile("" : "+v"(tid_)); const int tid = tid_, lane = tid & 63, r32 = lane & 31, hi = lane >> 5, w = F.wave;
    LAS unsigned char* lds = F.lds + RING_OFF;
    const int bh = b * NHEAD + h, qw0 = qb * 256 + w * 32;
    const size_t tq = (size_t)b * SEQ + qw0 + r32;
    bf16x8 qf[6];
#pragma unroll
    for (int s = 0; s < 6; ++s) qf[s] = *(const bf16x8*)(Q + tq * QW + h * 96 + 16 * s + 8 * hi);
    f32x16 o0, o1, negb; float lsum = 0.f;
#pragma unroll
    for (int r = 0; r < 16; ++r) { o0[r] = 0.f; o1[r] = 0.f; negb[r] = nbnd; }
    asm volatile("" : "+v"(negb));
    const int ntile = 4 * qb + 4;
    const int kr0 = tid / 12, kc0 = tid % 12, kr1 = (tid + 512) / 12, kc1 = (tid + 512) % 12, vd = tid >> 3, vc = tid & 7;
    const bf16* kg0 = Kb + ((size_t)b * SEQ + kr0) * QW + h * 96 + kc0 * 8; const bf16* kg1 = Kb + ((size_t)b * SEQ + kr1) * QW + h * 96 + kc1 * 8;
    const bf16* vg = VT + ((size_t)bh * 64 + vd) * SEQ + vc * 8;
    const int kl0 = kr0 * AT_KROW + kc0 * 16, kl1 = kr1 * AT_KROW + kc1 * 16, vl = AT_KBYTES + vd * AT_VROW + vc * 16;
    v4u rk0, rk1, rv; rk1 = (v4u){0u, 0u, 0u, 0u};
    rk0 = *(const v4u*)kg0; if (tid < 256) rk1 = *(const v4u*)kg1; rv = *(const v4u*)vg;
    *(LAS v4u*)(lds + kl0) = rk0; if (tid < 256) *(LAS v4u*)(lds + kl1) = rk1;
    *(LAS v2u*)(lds + vl) = (v2u){rv.x, rv.y}; *(LAS v2u*)(lds + vl + 8) = (v2u){rv.z, rv.w};
    __syncthreads();
    const int ka = r32 * AT_KROW + hi * 16;
    const int va = AT_KBYTES + r32 * AT_VROW + hi * 8;
    for (int t = 0; t < ntile; ++t) {
        LAS unsigned char* cur = lds + (t & 1) * AT_STAGE; LAS unsigned char* nxt = lds + ((t + 1) & 1) * AT_STAGE;
        const bool more = (t + 1 < ntile);
        if (more) { const size_t ko = (size_t)(t + 1) * 64 * QW; rk0 = *(const v4u*)(kg0 + ko); if (tid < 256) rk1 = *(const v4u*)(kg1 + ko); rv = *(const v4u*)(vg + (t + 1) * 64); }
        if (64 * t <= qw0 + 31) {
            f32x16 p0, p1;
#pragma unroll
            for (int s = 0; s < 6; ++s) { const bf16x8 k0 = *(const LAS bf16x8*)(cur + ka + s * 32), k1 = *(const LAS bf16x8*)(cur + ka + 32 * AT_KROW + s * 32);
                if (s == 0) { p0 = MFMA32(k0, qf[0], negb); p1 = MFMA32(k1, qf[0], negb); } else { p0 = MFMA32(k0, qf[s], p0); p1 = MFMA32(k1, qf[s], p1); } }
#pragma unroll
            for (int r = 0; r < 16; ++r) { p0[r] = __builtin_amdgcn_exp2f(p0[r]); p1[r] = __builtin_amdgcn_exp2f(p1[r]); }
            if (64 * t + 63 > qw0) {
                const int qrel = qw0 + r32 - 64 * t;
#pragma unroll
                for (int r = 0; r < 16; ++r) { const int kk = crow32(r, hi); if (kk > qrel) p0[r] = 0.f; if (kk + 32 > qrel) p1[r] = 0.f; }
            }
            float sacc = 0.f;
#pragma unroll
            for (int r = 0; r < 16; ++r) sacc += p0[r] + p1[r];
            lsum += sacc;
            bf16x8 pb[2][2];
#pragma unroll
            for (int s2 = 0; s2 < 2; ++s2) {
                const v4u a = {pg8::cvt_pk_bf16(p0[8 * s2 + 0], p0[8 * s2 + 1]), pg8::cvt_pk_bf16(p0[8 * s2 + 2], p0[8 * s2 + 3]), pg8::cvt_pk_bf16(p0[8 * s2 + 4], p0[8 * s2 + 5]), pg8::cvt_pk_bf16(p0[8 * s2 + 6], p0[8 * s2 + 7])};
                const v4u c = {pg8::cvt_pk_bf16(p1[8 * s2 + 0], p1[8 * s2 + 1]), pg8::cvt_pk_bf16(p1[8 * s2 + 2], p1[8 * s2 + 3]), pg8::cvt_pk_bf16(p1[8 * s2 + 4], p1[8 * s2 + 5]), pg8::cvt_pk_bf16(p1[8 * s2 + 6], p1[8 * s2 + 7])};
                pb[0][s2] = __builtin_bit_cast(bf16x8, a); pb[1][s2] = __builtin_bit_cast(bf16x8, c); }
#pragma unroll
            for (int kh = 0; kh < 2; ++kh)
#pragma unroll
                for (int s2 = 0; s2 < 2; ++s2) {
                    const int ko = (kh * 32 + 16 * s2) * 2;
                    const s16x4 a0 = *(const LAS s16x4*)(cur + va + ko), a1 = *(const LAS s16x4*)(cur + va + ko + 16);
                    const s16x4 c0 = *(const LAS s16x4*)(cur + va + 32 * AT_VROW + ko), c1 = *(const LAS s16x4*)(cur + va + 32 * AT_VROW + ko + 16);
                    const bf16x8 vf0 = {a0[0], a0[1], a0[2], a0[3], a1[0], a1[1], a1[2], a1[3]}, vf1 = {c0[0], c0[1], c0[2], c0[3], c1[0], c1[1], c1[2], c1[3]};
                    o0 = MFMA32(vf0, pb[kh][s2], o0); o1 = MFMA32(vf1, pb[kh][s2], o1); }
        }
        if (more) { *(LAS v4u*)(nxt + kl0) = rk0; if (tid < 256) *(LAS v4u*)(nxt + kl1) = rk1; *(LAS v2u*)(nxt + vl) = (v2u){rv.x, rv.y}; *(LAS v2u*)(nxt + vl + 8) = (v2u){rv.z, rv.w}; }
        __syncthreads();
    }
    lsum += __shfl_xor(lsum, 32);
    const float il = 1.f / lsum;
    bf16* orow = YB + tq * DM + 256 + h * 64;
#pragma unroll
    for (int g = 0; g < 4; ++g) {
        v2u a; a.x = pg8::cvt_pk_bf16(o0[4 * g] * il, o0[4 * g + 1] * il); a.y = pg8::cvt_pk_bf16(o0[4 * g + 2] * il, o0[4 * g + 3] * il); *(v2u*)(orow + 8 * g + 4 * hi) = a;
        v2u c; c.x = pg8::cvt_pk_bf16(o1[4 * g] * il, o1[4 * g + 1] * il); c.y = pg8::cvt_pk_bf16(o1[4 * g + 2] * il, o1[4 * g + 3] * il); *(v2u*)(orow + 32 + 8 * g + 4 * hi) = c; }
}

template <int l> __device__ __forceinline__ void ret_out_chunk(Frame& F, const Args& args, const int ch) {
    unsigned char* ws = K_WS;
    const bf16* P = (const bf16*)(ws + WS_PROJ); const float* RET = (const float*)(ws + WS_RET); bf16* YB = (bf16*)(ws + WS_YB); const float* ret_g = (const float*)K_IN(IN_RETG) + l * 256;
    LAS unsigned char* vT = F.lds + RING_OFF;
    int lane_ = F_LANE; asm volatile("" : "+v"(lane_)); const int lane = lane_, lr = lane & 15, lq = lane >> 4, w = F.wave;
    const int t0 = ch * CHUNK;
    v2u vv16[16];
#pragma unroll
    for (int j = 0; j < 16; ++j) vv16[j] = *(const v2u*)(P + (size_t)(t0 + 16 * w + j) * PROJW + C_RV + 4 * lane);
#pragma unroll
    for (int j = 0; j < 16; ++j) { const int s = 16 * w + j; const v2u vv = vv16[j];
        *(LAS bf16*)(vT + tofs(4 * lane + 0, s)) = (bf16)(vv.x & 0xffff); *(LAS bf16*)(vT + tofs(4 * lane + 1, s)) = (bf16)(vv.x >> 16);
        *(LAS bf16*)(vT + tofs(4 * lane + 2, s)) = (bf16)(vv.y & 0xffff); *(LAS bf16*)(vT + tofs(4 * lane + 3, s)) = (bf16)(vv.y >> 16); }
    __syncthreads();
    const size_t ti = (size_t)t0 + 16 * w + lr;
#pragma unroll 1
    for (int h = 0; h < NHEAD; ++h) {
        const float gam = __expf(nv::ret_loggamma(h));
        bf16x8 qf[2];
#pragma unroll
        for (int ks = 0; ks < 2; ++ks) qf[ks] = *(const bf16x8*)(P + ti * PROJW + C_RQ + h * 64 + 32 * ks + 8 * lq);
        f32x4 acc[4];
#pragma unroll
        for (int et = 0; et < 4; ++et) acc[et] = (f32x4){0.f, 0.f, 0.f, 0.f};
        bf16x8 kfa[8][2];
#pragma unroll
        for (int jt = 0; jt < 8; ++jt) if (jt <= w) {
#pragma unroll
            for (int ks = 0; ks < 2; ++ks) kfa[jt][ks] = *(const bf16x8*)(P + (size_t)(t0 + jt * 16 + lr) * PROJW + C_RK + h * 64 + 32 * ks + 8 * lq); }
#pragma unroll
        for (int kk = 0; kk < 4; ++kk) if (kk <= (w >> 1)) {
            const int jt0 = 2 * kk, jt1 = 2 * kk + 1;
            f32x4 s0 = {0.f, 0.f, 0.f, 0.f}, s1 = {0.f, 0.f, 0.f, 0.f};
#pragma unroll
            for (int ks = 0; ks < 2; ++ks) s0 = MFMA16(kfa[jt0][ks], qf[ks], s0);
            if (jt1 <= w) {
#pragma unroll
                for (int ks = 0; ks < 2; ++ks) s1 = MFMA16(kfa[jt1][ks], qf[ks], s1); }
            if (jt0 == w) {
#pragma unroll
                for (int r = 0; r < 4; ++r) if (4 * lq + r > lr) s0[r] = 0.f; }
            if (jt1 == w) {
#pragma unroll
                for (int r = 0; r < 4; ++r) if (4 * lq + r > lr) s1[r] = 0.f; }
            const v4u pw = {pk2(s0[0], s0[1]), pk2(s0[2], s0[3]), pk2(s1[0], s1[1]), pk2(s1[2], s1[3])};
            const bf16x8 pb = __builtin_bit_cast(bf16x8, pw);
#pragma unroll
            for (int et = 0; et < 4; ++et) { const int row = h * 64 + et * 16 + lr;
                const s16x4 a0 = *(const LAS s16x4*)(vT + tofs(row, jt0 * 16 + 4 * lq)), a1 = *(const LAS s16x4*)(vT + tofs(row, (jt1 & 7) * 16 + 4 * lq));
                const bf16x8 vf = {a0[0], a0[1], a0[2], a0[3], a1[0], a1[1], a1[2], a1[3]};
                acc[et] = MFMA16(vf, pb, acc[et]); }
        }
#pragma unroll
        for (int ks = 0; ks < 2; ++ks)
#pragma unroll
            for (int et = 0; et < 4; ++et) { const float* pr = RET + (((size_t)ch * NHEAD + h) * 64 + et * 16 + lr) * 64 + 32 * ks + 8 * lq; const f32x4 x0 = *(const f32x4*)pr, x1 = *(const f32x4*)(pr + 4);
                const v4u pw = {pk2(x0[0] * gam, x0[1] * gam), pk2(x0[2] * gam, x0[3] * gam), pk2(x1[0] * gam, x1[1] * gam), pk2(x1[2] * gam, x1[3] * gam)};
                acc[et] = MFMA16(__builtin_bit_cast(bf16x8, pw), qf[ks], acc[et]); }
        float mu = 0.f;
#pragma unroll
        for (int et = 0; et < 4; ++et) mu += acc[et][0] + acc[et][1] + acc[et][2] + acc[et][3];
        mu += __shfl_xor(mu, 16); mu += __shfl_xor(mu, 32); mu *= (1.f / 64);
        float var = 0.f;
#pragma unroll
        for (int et = 0; et < 4; ++et) { acc[et] = acc[et] - mu; var += acc[et][0] * acc[et][0] + acc[et][1] * acc[et][1] + acc[et][2] * acc[et][2] + acc[et][3] * acc[et][3]; }
        var += __shfl_xor(var, 16); var += __shfl_xor(var, 32);
        const float rs = rsqrtf(var * (1.f / 64) + EPS);
        v2u rga[4]; f32x4 ga[4];
#pragma unroll
        for (int et = 0; et < 4; ++et) { const int c = h * 64 + et * 16 + 4 * lq; rga[et] = *(const v2u*)(P + ti * PROJW + C_RG + c); ga[et] = *(const f32x4*)(ret_g + c); }
#pragma unroll
        for (int et = 0; et < 4; ++et) { const int c = h * 64 + et * 16 + 4 * lq; const v2u rg = rga[et]; const f32x4 g = ga[et];
            const float r0 = bflo_(rg.x), r1 = bfhi_(rg.x), r2 = bflo_(rg.y), r3 = bfhi_(rg.y);
            v2u o; o.x = pk2(r0 * pg8::fast_sigmoid(r0) * acc[et][0] * rs * g[0], r1 * pg8::fast_sigmoid(r1) * acc[et][1] * rs * g[1]);
            o.y = pk2(r2 * pg8::fast_sigmoid(r2) * acc[et][2] * rs * g[2], r3 * pg8::fast_sigmoid(r3) * acc[et][3] * rs * g[3]);
            *(v2u*)(YB + ti * DM + 768 + c) = o; }
    }
    __syncthreads();
}

template <int l> __device__ __forceinline__ void attn_phase(Frame& F, const Args& args) {
    for (int p = F.vcu; p < NBATCH * NHEAD * 32; p += F.G) {
        const int bh = p >> 5, s = p & 31; const float nbnd = -((const float*)(K_WS + WS_BND))[l];
        attn_unit(F, (const bf16*)(K_WS + WS_Q), (const bf16*)(K_WS + WS_K), (const bf16*)(K_WS + WS_VT), (bf16*)(K_WS + WS_YB), nbnd, bh / NHEAD, bh % NHEAD, 63 - s);
        attn_unit(F, (const bf16*)(K_WS + WS_Q), (const bf16*)(K_WS + WS_K), (const bf16*)(K_WS + WS_VT), (bf16*)(K_WS + WS_YB), nbnd, bh / NHEAD, bh % NHEAD, s);
    }
    for (int ch = F.vcu; ch < NTOK / CHUNK; ch += F.G) ret_out_chunk<l>(F, args, ch);
}
#ifndef MEGA_THIN
#define MEGA_THIN 0
#endif

#ifndef FFN_FP8
#define FFN_FP8 0
#endif
#ifndef GATE_FP8
#define GATE_FP8 1
#endif
#ifndef REV_GM
#define REV_GM 15
#endif
#ifndef REV_FD
#define REV_FD 15
#endif
#ifndef XB16
#define XB16 1
#endif
#ifndef RPT_MASK
#define RPT_MASK 0
#endif
#define RPT(bit) _Pragma("unroll") for (int rep_ = 0; rep_ < 1 + ((RPT_MASK >> (bit)) & 1); ++rep_)
__device__ __forceinline__ bool in_range(int k, int lo, int hi) { asm volatile("" : "+s"(lo)); return lo <= k && k < hi; }
#define IN(k) (in_range((k), lo, hi))
#ifndef BAR_REP
#define BAR_REP 1
#endif
#define SEAM(k) do { if (IN(k) && IN((k) + 1)) { for (int br_ = 0; br_ < BAR_REP; ++br_) xcd_barrier(bar, F.wave); } } while (0)
#define INF(i) ((const float*)K_IN(i))
template <int l> __device__ __forceinline__ void layer_phases(Frame& F, const Args& args, const XcdBarrier& bar, const int lo, const int hi) {
#define ws (K_WS)
#define ADA ((float*)(K_WS + WS_ADA))
#define bH ((bf16*)(K_WS + WS_H))
#define bYB ((bf16*)(K_WS + WS_YB))
#define bP ((bf16*)(K_WS + WS_PROJ))
#define bG ((bf16*)(K_WS + WS_G))
#define bMG bYB
#define bU bP
#define bX (K_OUT)
#define ring (F.lds + RING_OFF)
#define ada_l (ADA + (size_t)l * 2 * 6 * DM)
#define Xin ((l == 0) ? INF(IN_X) : (const float*)bX)
#define WIN_T ((const bf16*)(K_WS + WS_WIN_T) + (size_t)l * 6912 * DM)

        if (IN(PHL(l, PL_NORM1))) { RPT(8) {
#if MEGA_THIN >= 1
            norm_phase(F, (XB16 && l > 0) ? (const float*)(K_WS + WS_XB) : Xin, bH, INF(IN_N1G) + l * DM, ada_l, A_SH1, A_SC1, nullptr, nullptr, nullptr, nullptr, GATE_FP8 ? (unsigned char*)(K_WS + WS_H8) : nullptr, (float*)(K_WS + WS_SH), XB16 && l > 0);
#endif
        } }
        SEAM(PHL(l, PL_NORM1));
        if (IN(PHL(l, PL_INPROJ))) { RPT(1) {
            pg8::DenseOrder S{(const char*)bH, (const char*)WIN_T, (size_t)256 * DM * 2, (size_t)256 * DM * 2, NTOK / 256, PROJW / 256, F.G, (int)blockIdx.x};
            pg8::EpiBf16<0> E{bP, PROJW, 0};
            pg8::gemm_phase(ring, F.wave, DM, DM, DM, S, E);
        } }
        SEAM(PHL(l, PL_INPROJ));
        if (IN(PHL(l, PL_PRE))) {
#if MEGA_THIN >= 2
            pre_phase<l>(F, args);
#endif
        }
        SEAM(PHL(l, PL_PRE));
        if (IN(PHL(l, PL_SCAN))) {
#if MEGA_THIN >= 1
            scan_phase(F, (float*)(ws + WS_RET));
#endif
        }
        SEAM(PHL(l, PL_SCAN));
        if (IN(PHL(l, PL_ATTN))) { RPT(2) {
#if MEGA_THIN >= 3
            attn_phase<l>(F, args);
#endif
        } }
        SEAM(PHL(l, PL_ATTN));
        if (IN(PHL(l, PL_GATE))) { RPT(3) {
            pg8::MergeOrder S{(const char*)bYB, (const char*)((const bf16*)(K_WS + WS_WBR_T) + (size_t)l * 4 * DM * MIXW), NTOK / 256, DM / 256, F.G, (int)blockIdx.x};
            pg8::EpiBf16<0> E{bG, GATEW, DM};
            int kz = MIXW; asm volatile("" : "+s"(kz));
            pg8::gemm_phase(ring, F.wave, DM, MIXW, kz, S, E);
        } }
        SEAM(PHL(l, PL_GATE));
        if (IN(PHL(l, PL_MERGE))) { RPT(4) {
#if GATE_FP8
            pg8::DenseOrder S{(const char*)(K_WS + WS_H8), (const char*)(WIN_T + (size_t)PROJW * DM), (size_t)256 * DM, (size_t)256 * DM, NTOK / 256, GATEW / 256, F.G, (int)blockIdx.x, REV_GM};
            pg8::EpiGM8 E{bG, bMG, (const float*)(K_WS + WS_SH), (const float*)(K_WS + WS_SW) + l * GATEW};
            int kg = DM / 2; asm volatile("" : "+s"(kg));
            pg8::gemm_phase<pg8::EpiGM8, pg8::DenseOrder, true>(ring, F.wave, DM / 2, DM / 2, kg, S, E);
#else
            pg8::DenseOrder S{(const char*)bH, (const char*)(WIN_T + (size_t)PROJW * DM), (size_t)256 * DM * 2, (size_t)256 * DM * 2, NTOK / 256, GATEW / 256, F.G, (int)blockIdx.x};
            pg8::EpiGM E{bG, bMG};
            pg8::gemm_phase(ring, F.wave, DM, DM, DM, S, E);
#endif
        } }
        SEAM(PHL(l, PL_MERGE));
        if (IN(PHL(l, PL_WO))) {
            pg8::DenseOrder S{(const char*)bMG, (const char*)((const bf16*)(ws + WS_WO_T) + (size_t)l * DM * DM), (size_t)256 * DM * 2, (size_t)256 * DM * 2, NTOK / 256, DM / 256, F.G, (int)blockIdx.x};
#if XB16
            if constexpr (l == 0) { pg8::EpiResidT<false, true> E{INF(IN_X), (void*)(K_WS + WS_XB), ada_l + A_G1}; pg8::gemm_phase(ring, F.wave, DM, DM, DM, S, E); }
            else { pg8::EpiResidT<true, false> E{(const void*)(K_WS + WS_XB), (void*)bX, ada_l + A_G1}; pg8::gemm_phase(ring, F.wave, DM, DM, DM, S, E); }
#else
            pg8::EpiResid E{Xin, bX, ada_l + A_G1};
            pg8::gemm_phase(ring, F.wave, DM, DM, DM, S, E);
#endif
        }
        SEAM(PHL(l, PL_WO));
        if (IN(PHL(l, PL_NORM2))) {
#if MEGA_THIN >= 1
            if (l == 0) norm_phase(F, XB16 ? (const float*)(K_WS + WS_XB) : (const float*)bX, bH, INF(IN_N2G) + l * DM, ada_l, A_SH2, A_SC2, nullptr, nullptr, nullptr, nullptr, FFN_FP8 ? (unsigned char*)(K_WS + WS_H8) : nullptr, (float*)(K_WS + WS_SH), XB16 != 0);
            else norm_phase(F, bX, nullptr  , INF(IN_N2G) + l * DM, ada_l, A_SH2, A_SC2, INF(IN_RW), INF(IN_RB), (nv::Route*)(ws + WS_ROUTE), (int*)(ws + WS_CNT), (unsigned char*)(K_WS + WS_H8), (float*)(K_WS + WS_SH), false, 2);
#endif
        }
        SEAM(PHL(l, PL_NORM2));
        if constexpr (l == 0) {
            if (IN(PHL(l, PL_F0))) { RPT(5) {
#if FFN_FP8
                pg8::DenseOrder S{(const char*)(K_WS + WS_H8), (const char*)(ws + WS_F13_T), (size_t)256 * DM, (size_t)256 * DM, NTOK / 256, 2 * DFF / 256, F.G, (int)blockIdx.x};
                pg8::EpiSwiglu8 E{bU, DFF, (const float*)(K_WS + WS_SH), (const float*)(K_WS + WS_SWF)};
                int kf = DM / 2; asm volatile("" : "+s"(kf));
                pg8::gemm_phase<pg8::EpiSwiglu8, pg8::DenseOrder, true>(ring, F.wave, DM / 2, DM / 2, kf, S, E);
#else
                pg8::DenseOrder S{(const char*)bH, (const char*)(ws + WS_F13_T), (size_t)256 * DM * 2, (size_t)256 * DM * 2, NTOK / 256, 2 * DFF / 256, F.G, (int)blockIdx.x};
                pg8::EpiSwiglu E{bU, DFF};
                pg8::gemm_phase(ring, F.wave, DM, DM, DM, S, E);
#endif
            } }
            SEAM(PHL(l, PL_F0));
            if (IN(PHL(l, PL_F1))) {
                pg8::DenseOrder S{(const char*)bU, (const char*)(ws + WS_F2_T), (size_t)256 * DFF * 2, (size_t)256 * DFF * 2, NTOK / 256, DM / 256, F.G, (int)blockIdx.x, REV_FD};
#if XB16
                pg8::EpiResidT<true, true> E{(const void*)(K_WS + WS_XB), (void*)(K_WS + WS_XB), ada_l + A_G2};
#else
                pg8::EpiResid E{bX, bX, ada_l + A_G2};
#endif
                pg8::gemm_phase(ring, F.wave, DFF, DFF, DFF, S, E);
            }
            SEAM(PHL(l, PL_F1));
        } else {
#define XS ((bf16*)(K_WS + WS_XS))
#define HID ((bf16*)(K_WS + WS_HID))
#define PEXP ((const int*)(K_WS + WS_PEXP))
#define PSLOT ((const float*)(K_WS + WS_PSLOT))
            if (IN(PHL(l, PL_F0))) {
#if MEGA_THIN >= 1
                moe_assign_phase(F, args);
#endif
                RPT(9) {
                amax_job(F, INF(IN_M1), (size_t)DM * DFFE, DFFE, (unsigned*)(K_WS + WS_AMAXM), DFFE, NEXP);
                amax_job(F, INF(IN_M3), (size_t)DM * DFFE, DFFE, (unsigned*)(K_WS + WS_AMAXM) + NEXP * DFFE, DFFE, NEXP);
                amax_job(F, INF(IN_M2), (size_t)DFFE * DM, DM, (unsigned*)(K_WS + WS_AMAXM) + AMAXM_W2, DM, NEXP, DFFE);
                xcd_barrier(bar, F.wave);
                if (rep_ == 0) moe_gather_phase(F);
                convert_w8_job(F, INF(IN_M1), (size_t)DM * DFFE, DFFE, (unsigned char*)(K_WS + WS_MW13_T), (size_t)2 * DFFE * DM, 2, (const unsigned*)(K_WS + WS_AMAXM), DFFE, (float*)(K_WS + WS_SWM), 2 * DFFE, NEXP, 0);
                convert_w8_job(F, INF(IN_M3), (size_t)DM * DFFE, DFFE, (unsigned char*)(K_WS + WS_MW13_T), (size_t)2 * DFFE * DM, 3, (const unsigned*)(K_WS + WS_AMAXM) + NEXP * DFFE, DFFE, (float*)(K_WS + WS_SWM), 2 * DFFE, NEXP, 977);
                convert_w8_job(F, INF(IN_M2), (size_t)DFFE * DM, DM, (unsigned char*)(K_WS + WS_MW2_T), (size_t)DM * DFFE, 0, (const unsigned*)(K_WS + WS_AMAXM) + AMAXM_W2, DM, (float*)(K_WS + WS_SWM2), DM, NEXP, 1301, DFFE);
                }
            }
            SEAM(PHL(l, PL_F0));
            for (int c = 0; c < NCH; ++c) {
                const int p0 = c * CH0_PANELS; int npan = PEXP[MAXPANEL] - p0; { const int cap = (c == 0) ? CH0_PANELS : CH1_PANELS; npan = npan > cap ? cap : npan; }
                if (IN(PHL(l, PL_F1 + 2 * c))) { RPT(6) {
                    pg8::MoeOrder S{(const char*)(K_WS + WS_XS8 + (size_t)p0 * 256 * DM), (const char*)(ws + WS_MW13_T), (size_t)256 * DM, (size_t)256 * DM, PEXP, p0, npan, 2 * DFFE / 256, F.G, (int)blockIdx.x};
                    pg8::EpiSwiglu8X E{(unsigned char*)(K_WS + WS_HID), (unsigned char*)(K_WS + WS_SCT), (const float*)(K_WS + WS_SXS) + p0 * 256, (const float*)(K_WS + WS_SWM)};
                    int ku = DM / 2; asm volatile("" : "+s"(ku));
                    pg8::gemm_phase<pg8::EpiSwiglu8X, pg8::MoeOrder, 1>(ring, F.wave, DM / 2, DM / 2, ku, S, E);
                } }
                SEAM(PHL(l, PL_F1 + 2 * c));
                if (IN(PHL(l, PL_F2 + 2 * c))) { RPT(7) {
                    const int nreg = (c == 1 && npan > CH0_PANELS) ? CH0_PANELS : npan, ntail = npan - nreg;
                    { pg8::MoeOrderX S{(const char*)(K_WS + WS_HID), (const char*)(ws + WS_MW2_T), (const char*)(K_WS + WS_SCT), (size_t)256 * DFFE, (size_t)256 * DFFE, (size_t)28 * 1024, PEXP, p0, nreg, DM / 256, F.G, (int)blockIdx.x};
                      pg8::EpiMoeDown8 E{XS + (size_t)p0 * 256 * DM, PSLOT + p0 * 256, (const float*)(K_WS + WS_SWM2)};
                      pg8::gemm_phase<pg8::EpiMoeDown8, pg8::MoeOrderX, 2>(ring, F.wave, DFFE / 2, DFFE / 2, DFFE / 2, S, E); }
                    if (c == 1 && ntail > 0) {
                        pg8::MoeTailOrderX S{(const char*)(K_WS + WS_HID) + (size_t)nreg * 256 * DFFE, (const char*)(ws + WS_MW2_T), (const char*)(K_WS + WS_SCT) + (size_t)nreg * 28 * 1024, (size_t)256 * DFFE, (size_t)256 * DFFE, (size_t)28 * 1024, PEXP, p0 + nreg, ntail, F.G, (int)blockIdx.x};
                        pg8::EpiMoePart8 E{(bf16*)(K_WS + WS_PART), PSLOT + (p0 + nreg) * 256, (const float*)(K_WS + WS_SWM2)};
                        int kq = 896; asm volatile("" : "+s"(kq));
                        pg8::gemm_phase<pg8::EpiMoePart8, pg8::MoeTailOrderX, 2>(ring, F.wave, DFFE / 2, DFFE / 2, kq, S, E);
                    }
                } }
                SEAM(PHL(l, PL_F2 + 2 * c));
            }
            if (IN(PHL(l, PL_F5))) {
#if MEGA_THIN >= 1
                { const int ptot = PEXP[MAXPANEL], tail0 = (ptot > 2 * CH0_PANELS) ? 2 * CH0_PANELS * 256 : 0x7fffffff;
                  moe_combine_phase(F, bX, XS, (const bf16*)(K_WS + WS_PART), tail0, (const int*)(ws + WS_SLOT), ada_l + A_G2); }
#endif
            }
        }
#undef XS
#undef HID
#undef PEXP
#undef PSLOT
#undef ws
#undef ADA
#undef bH
#undef bYB
#undef bP
#undef bG
#undef bMG
#undef bU
#undef bX
#undef ring
#undef ada_l
#undef Xin
#undef WIN_T
}

__global__ void __launch_bounds__(NWAVES * 64, 2) mega(Args args) {
    extern __shared__ __attribute__((aligned(16))) unsigned char lds_raw[];
    Frame F;
    F.lds = (LAS unsigned char*)lds_raw;
    F.MISC = (volatile LAS unsigned*)(F.lds + MISC_OFF);
    F.wave = __builtin_amdgcn_readfirstlane((int)threadIdx.x >> 6);
    F.G = gridDim.x; { const int bx = blockIdx.x; F.vcu = (F.G % 8 == 0) ? (bx % 8) * (F.G / 8) + bx / 8 : bx; }
    unsigned char* ws = K_WS;
    F.ctl = (unsigned*)(ws + WS_CTL);
    for (int u = F_TID; u < (LDS_BYTES - LDSCTL_OFF) / 4; u += NWAVES * 64) ((LAS unsigned*)(F.lds + LDSCTL_OFF))[u] = 0u;
    __syncthreads();
    XcdBarrier bar = xcd_barrier_post(F.ctl + CW_BAR + args.li * XCD_BAR_WORDS, F.MISC + 8);
    const int lo = args.ph_lo, hi = args.ph_hi;
    float* ADA = (float*)(ws + WS_ADA); float* BND = (float*)(ws + WS_BND);
    LAS unsigned char* ring = F.lds + RING_OFF;

    if (IN(PH_PRO)) { RPT(0) {
        for (int it = F.vcu; it < DEPTH * 96; it += F.G) {
            const int l = it / 96, j0 = (it % 96) * 64; const float* c = INF(IN_C);
            const float* w = INF(IN_ADAW) + (size_t)l * DM * 6 * DM + j0 + F_LANE;
            float a0 = 0.f, a1 = 0.f;
#pragma unroll 16
            for (int kk = 0; kk < 128; ++kk) { const int k = F.wave * 128 + kk; const float wv = w[(size_t)k * 6 * DM]; const float s0 = silu_f(c[k]), s1 = silu_f(c[DM + k]); a0 += s0 * wv; a1 += s1 * wv; }
            LAS float* red = (LAS float*)ring;
            red[(F.wave * 2 + 0) * 64 + F_LANE] = a0; red[(F.wave * 2 + 1) * 64 + F_LANE] = a1;
            __syncthreads();
            if (F_TID < 128) { const int b = F_TID >> 6, col = F_TID & 63; float s = INF(IN_ADAB)[l * 6 * DM + j0 + col];
#pragma unroll
              for (int w8 = 0; w8 < 8; ++w8) s += red[(w8 * 2 + b) * 64 + col];
              ADA[(size_t)(l * 2 + b) * 6 * DM + j0 + col] = s; }
            __syncthreads();
        }
        if (blockIdx.x == 0 && F_TID < DEPTH) { const int l = F_TID; float a = 0.f, b = 0.f;
            for (int i = 0; i < QKH; ++i) { a = fmaxf(a, fabsf(INF(IN_QNG)[l * QKH + i])); b = fmaxf(b, fabsf(INF(IN_KNG)[l * QKH + i])); }
            BND[l] = 9.797958971132712f * 1.4426950408889634f * a * b * 1.001f; }
        { bf16* WST = (bf16*)(ws + WS_WS_T); const float* wsrc = INF(IN_WS);
          for (int i = (F.vcu * NWAVES * 64 + F_TID); i < DEPTH * 4 * 128 * 128; i += F.G * NWAVES * 64) { const int t = (i >> 7) & 127, s = i & 127; WST[i] = (s <= t) ? f2bf(wsrc[i]) : (bf16)0; } }
        { unsigned* am = (unsigned*)(ws + WS_AMAXM); for (int i = F.vcu * NWAVES * 64 + F_TID; i < 2 * NEXP * DFFE + NEXP * DM; i += F.G * NWAVES * 64) am[i] = 0u; }
        int rot = 0;
        convert_job(F, INF(IN_WIN), (size_t)DM * D_IN, DM, D_IN, (bf16*)(ws + WS_WIN_T), (size_t)6912 * DM, DM, 1, nullptr, DEPTH, rot, GATE_FP8 ? NPROJ_SRC : 0); rot += 331;
        if (GATE_FP8) { const int NGW = F.G * NWAVES, gw = F.vcu * NWAVES + F.wave, lane = F_LANE;
          for (int it = gw; it < DEPTH * 16 * 16; it += NGW) { const int l = it >> 8, kb = (it >> 4) & 15, cb = it & 15; const float* wp = INF(IN_WIN) + (size_t)l * DM * D_IN + (size_t)(kb * 64) * D_IN + NPROJ_SRC + cb * 256 + 4 * lane;
              float4 mx = make_float4(0.f, 0.f, 0.f, 0.f);
#pragma unroll 16
              for (int r = 0; r < 64; ++r) { const float4 v = *(const float4*)(wp + (size_t)r * D_IN); mx.x = fmaxf(mx.x, fabsf(v.x)); mx.y = fmaxf(mx.y, fabsf(v.y)); mx.z = fmaxf(mx.z, fabsf(v.z)); mx.w = fmaxf(mx.w, fabsf(v.w)); }
              unsigned* am = F.ctl + CW_AMAX + l * GATEW + cb * 256 + 4 * lane;
              atomicMax(am + 0, __float_as_uint(mx.x)); atomicMax(am + 1, __float_as_uint(mx.y)); atomicMax(am + 2, __float_as_uint(mx.z)); atomicMax(am + 3, __float_as_uint(mx.w)); } }
        convert_job(F, INF(IN_WBR), (size_t)MIXW * DM, MIXW, DM, (bf16*)(ws + WS_WBR_T), (size_t)DM * MIXW, MIXW, 0, nullptr, DEPTH * 4, rot); rot += 331;
        convert_job(F, INF(IN_WO), (size_t)DM * DM, DM, DM, (bf16*)(ws + WS_WO_T), (size_t)DM * DM, DM, 0, nullptr, DEPTH, rot); rot += 331;
        if (!FFN_FP8) { convert_job(F, INF(IN_F1), 0, DM, DFF, (bf16*)(ws + WS_F13_T), 0, DM, 2, nullptr, 1, rot); rot += 331;
                        convert_job(F, INF(IN_F3), 0, DM, DFF, (bf16*)(ws + WS_F13_T), 0, DM, 3, nullptr, 1, rot); rot += 331; }
        else { amax_job(F, INF(IN_F1), 0, DFF, F.ctl + CW_AMAXF, 0, 1); amax_job(F, INF(IN_F3), 0, DFF, F.ctl + CW_AMAXF + DFF, 0, 1); }
        convert_job(F, INF(IN_F2), 0, DFF, DM, (bf16*)(ws + WS_F2_T), 0, DFF, 0, nullptr, 1, rot); rot += 331;
        for (int l = 0; l < DEPTH; ++l) {
            convert_job(F, INF(IN_WUQ) + (size_t)l * 256 * QW, 0, 256, QW, (bf16*)(ws + WS_WUQ_T) + (size_t)l * QW * 256, 0, 256, 0, INF(IN_CQG) + l * 256, 1, rot); rot += 331;
            convert_job(F, INF(IN_WUKV) + (size_t)l * 128 * 512, 0, 128, 512, (bf16*)(ws + WS_WUKV_T) + (size_t)l * 512 * 128, 0, 128, 0, INF(IN_CKVG) + l * 128, 1, rot); rot += 331;
        }
    } }
    SEAM(PH_PRO);
    if (IN(PH_PRO2) && FFN_FP8) {
        convert_w8_job(F, INF(IN_F1), 0, DFF, (unsigned char*)(K_WS + WS_F13_T), 0, 2, F.ctl + CW_AMAXF, 0, (float*)(K_WS + WS_SWF), 0, 1, 0);
        convert_w8_job(F, INF(IN_F3), 0, DFF, (unsigned char*)(K_WS + WS_F13_T), 0, 3, F.ctl + CW_AMAXF + DFF, 0, (float*)(K_WS + WS_SWF), 0, 1, 555);
    }
    if (IN(PH_PRO2) && GATE_FP8) {
        for (int l = 0; l < DEPTH; ++l)
            convert_gate8(F, INF(IN_WIN) + (size_t)l * DM * D_IN, F.ctl + CW_AMAX + l * GATEW, (unsigned char*)((bf16*)(K_WS + WS_WIN_T) + (size_t)l * 6912 * DM + (size_t)PROJW * DM), (float*)(K_WS + WS_SW) + l * GATEW, l * 977);
    }
    if (GATE_FP8 || FFN_FP8) SEAM(PH_PRO2);

    layer_phases<0>(F, args, bar, lo, hi);
    layer_phases<1>(F, args, bar, lo, hi);
}
#undef IN
#undef SEAM
#undef INF
static int g_grid = 0;
static bool mega_setup() {
    if (g_grid) return g_grid > 0;
    int dev = 0, cus = 0;
    if (hipGetDevice(&dev) != hipSuccess || hipDeviceGetAttribute(&cus, hipDeviceAttributeMultiprocessorCount, dev) != hipSuccess) { g_grid = -1; return false; }
    if (hipFuncSetAttribute((const void*)mega, hipFuncAttributeMaxDynamicSharedMemorySize, LDS_BYTES) != hipSuccess) { fprintf(stderr, "mega: hipFuncSetAttribute failed\n"); g_grid = -1; return false; }
    int per_cu = 0; (void)hipOccupancyMaxActiveBlocksPerMultiprocessor(&per_cu, (const void*)mega, NWAVES * 64, LDS_BYTES); (void)hipGetLastError();
    if (per_cu < 1) { fprintf(stderr, "mega: occupancy query reports %d workgroups per CU\n", per_cu); g_grid = -1; return false; }
    g_grid = cus; return true;
}
extern "C" void kernel_launch(void* const* d_in, const int* in_sizes, int n_in, void* d_out, int out_size, void* d_ws, size_t ws_size, hipStream_t stream) {
    if (n_in != 29 || out_size != NTOK * DM || ws_size < WS_END) { fprintf(stderr, "kernel_launch: unexpected sizes n_in %d out %d ws %zu\n", n_in, out_size, ws_size); return; }
    if (!mega_setup()) return;
    (void)hipMemsetAsync((char*)d_ws + WS_CTL, 0, CTL_ZERO_BYTES, stream);
    Args a{}; for (int i = 0; i < N_IN; ++i) a.in[i] = d_in[i];
    a.out = (float*)d_out; a.ws = (unsigned char*)d_ws; a.ph_lo = 0; a.ph_hi = N_PHASES; a.li = 0; a.pad = 0;
    hipLaunchKernelGGL(mega, dim3(g_grid), dim3(NWAVES * 64), LDS_BYTES, stream, a);
}
```

```cpp
#define MEGA_THIN 3
#include <hip/hip_runtime.h>
#include <cstdio>
#include <cstdint>
#include <cmath>

constexpr int DM = 1024, NBATCH = 2, SEQ = 16384, NTOK = NBATCH * SEQ, DEPTH = 2;
constexpr int MIXW = 256, D_IN = 6816, PROJW = 2816, GATEW = 4096, NPROJ_SRC = 2720;
constexpr int QKH = 96, NHEAD = 4, QW = NHEAD * QKH  , DFF = 2816, NEXP = 8, DFFE = 3584;
constexpr int CHUNK = 128, NCHUNK = SEQ / CHUNK  ;
constexpr float EPS = 1e-6f;
constexpr int C_AB = 0, C_AC = 256, C_AX = 512, C_CQ = 768, C_CKV = 1024, C_KR = 1152, C_SU = 1280, C_SV = 1536, C_RQ = 1792, C_RK = 2048, C_RV = 2304, C_RG = 2560;
constexpr int A_SH1 = 0, A_SC1 = 1024, A_G1 = 2048, A_SH2 = 3072, A_SC2 = 4096, A_G2 = 5120;
constexpr float ATT_C2 = 0.10206207261596575f * 1.4426950408889634f;

constexpr size_t MiB = 1u << 20;
constexpr size_t WS_CTL = 0, CTL_ZERO_BYTES = 1 * MiB;
constexpr size_t WS_ADA = 1 * MiB;
constexpr size_t WS_PSLOT = 1 * MiB + 256 * 1024;
constexpr size_t WS_PEXP = 1 * MiB + 768 * 1024;
constexpr size_t WS_BND = 1 * MiB + 800 * 1024;
constexpr size_t WS_ROUTE = 2 * MiB;
constexpr size_t WS_CNT = 2 * MiB + 512 * 1024;
constexpr size_t WS_SLOT = 2 * MiB + 768 * 1024;
constexpr size_t WS_WUQ_T = 3 * MiB;
constexpr size_t WS_WUKV_T = 3 * MiB + 512 * 1024;
constexpr size_t WS_WS_T = 3 * MiB + 768 * 1024;
constexpr size_t WS_WIN_T = 4 * MiB;
constexpr size_t WS_WBR_T = 31 * MiB;
constexpr size_t WS_WO_T = 35 * MiB;
constexpr size_t WS_F13_T = 39 * MiB;
constexpr size_t WS_F2_T = 50 * MiB;
constexpr size_t WS_H = 56 * MiB;
constexpr size_t WS_YB = 120 * MiB;
constexpr size_t WS_PROJ = 184 * MiB;
constexpr size_t WS_Q = 360 * MiB, WS_K = 384 * MiB, WS_VT = 408 * MiB;
constexpr size_t WS_RET = 424 * MiB;
constexpr size_t WS_G = 184 * MiB;
constexpr size_t WS_MIX_END = 440 * MiB;
constexpr size_t WS_H8 = 440 * MiB;
constexpr size_t WS_SH = 472 * MiB;
constexpr size_t WS_SW = 472 * MiB + 256 * 1024;
constexpr int CW_AMAXF = 230000;
constexpr size_t WS_SWF = 472 * MiB + 256 * 1024 + 64 * 1024;
constexpr int CW_AMAX = 200000;
constexpr int MAXPANEL = 264, MAXSLOT = MAXPANEL * 256, NCH = 2, CH0_PANELS = 128, CH1_PANELS = MAXPANEL - CH0_PANELS;
constexpr size_t WS_HID = 56 * MiB;
constexpr size_t WS_SCT = 176 * MiB;
constexpr size_t WS_MW13_T = 296 * MiB;
constexpr size_t WS_MW2_T = 352 * MiB;
constexpr size_t WS_XS = 464 * MiB;
constexpr size_t WS_PART = 596 * MiB;
constexpr int MAXTAIL = 8;
constexpr size_t WS_XS8 = 530 * MiB;
constexpr size_t WS_AMAXM = 612 * MiB;
constexpr size_t WS_SXS = 612 * MiB + 256 * 1024;
constexpr size_t WS_SWM = 612 * MiB + 576 * 1024;
constexpr size_t WS_SWM2 = 612 * MiB + 800 * 1024;
constexpr int AMAXM_W2 = 2 * NEXP * DFFE;
constexpr size_t WS_XB = 474 * MiB;
constexpr size_t WS_TOK = 613 * MiB;
constexpr size_t WS_END = 614 * MiB;
static_assert(WS_HID + (size_t)CH1_PANELS * 256 * DFFE <= WS_SCT && WS_SCT + (size_t)CH1_PANELS * 28 * 1024 <= WS_MW13_T, "hid");
static_assert(WS_XS + (size_t)MAXSLOT * DM * 2 <= WS_END, "xs");
static_assert(WS_MW13_T >= WS_MIX_END - 256 * MiB, "moe weights may overlay dead mixer buffers only");

typedef unsigned short bf16;
__device__ __forceinline__ float bf2f(bf16 v) { return __uint_as_float(((unsigned)v) << 16); }
__device__ __forceinline__ bf16 f2bf(float f) { unsigned u = __float_as_uint(f); return (bf16)((u + 0x7fffu + ((u >> 16) & 1u)) >> 16); }
__device__ __forceinline__ float bfr(float f) { return bf2f(f2bf(f)); }
__device__ __forceinline__ float silu_f(float x) { return x / (1.f + __expf(-x)); }
__device__ __forceinline__ float sigmoid_f(float x) { return 1.f / (1.f + __expf(-x)); }
__device__ __forceinline__ float gelu_tanh(float x) { const float u = 0.7978845608028654f * (x + 0.044715f * x * x * x); return 0.5f * x * (1.f + tanhf(u)); }

__device__ __forceinline__ int lane_id() { unsigned z = 0u; asm volatile("" : "+s"(z)); return (int)__builtin_amdgcn_mbcnt_hi(~0u, __builtin_amdgcn_mbcnt_lo(~0u, z)); }

namespace nv {
struct Route { int e0, e1; float p0, p1; };
__device__ __forceinline__ float ret_loggamma(int h) { return log1pf(-exp2f(-5.f - (float)h)); }
}
namespace pg8 {
#define PG8_LAS __attribute__((address_space(3)))
typedef short bf16x8 __attribute__((ext_vector_type(8)));
typedef float f32x4 __attribute__((ext_vector_type(4)));
typedef float f32x2 __attribute__((ext_vector_type(2)));
typedef unsigned u32x4 __attribute__((ext_vector_type(4)));
typedef unsigned u32x2 __attribute__((ext_vector_type(2)));
constexpr int BM = 256, BK = 64, HALF = 128, HTB = HALF * BK * 2  , STAGE_BYTES = 8 * HTB, NXCD = 8, WGM = 8;

__host__ __device__ __forceinline__ int lds_byte(int r, int c) { const int st = (r >> 4) * 2 + (c >> 5), rr = r & 15, cc = c & 31, ob = rr * 64 + cc * 2; return st * 1024 + (ob ^ (((ob >> 9) & 1) << 5)); }
__host__ __device__ __forceinline__ void stage_rc(int b, int& R, int& C) { const int st = b / 1024, sb = b % 1024, swz = sb ^ (((sb >> 9) & 1) << 5); R = (st >> 1) * 16 + swz / 64; C = (st & 1) * 32 + (swz % 64) / 2; }
__host__ __device__ __forceinline__ int perm32(int rho) { const int n = rho >> 4, i = rho & 15; return 8 * (i >> 2) + 4 * n + (i & 3); }

struct Unit { const char* A; const char* B; const char* S; int pm, pn, aux, pad; };

__device__ __forceinline__ bool static_tile(int i, int G, int c, int nM, int nN, int& pm, int& pn) {
    const int nwg = nM * nN; const long L = (long)i * G + c; if (L >= nwg) return false;
    int wgid = (int)L; { const int q = nwg / NXCD, r = nwg % NXCD, xcd = wgid % NXCD, off = wgid / NXCD; wgid = (xcd < r ? xcd * (q + 1) : r * (q + 1) + (xcd - r) * q) + off; }
    const int nig = WGM * nN, gid = wgid / nig, fm = gid * WGM, gsz = (nM - fm) < WGM ? (nM - fm) : WGM;
    pm = fm + ((wgid % nig) % gsz); pn = (wgid % nig) / gsz; return true;
}
struct DenseOrder {
    const char* A; const char* B; size_t tA, tB; int nM, nN, G, c, rev = 0;
    __device__ __forceinline__ bool next(int i, Unit& u) const { int pm, pn; if (!static_tile(i, G, c, nM, nN, pm, pn)) return false; pm ^= rev; u.pm = pm; u.pn = pn; u.aux = 0; u.A = A + (size_t)pm * tA; u.B = B + (size_t)pn * tB; return true; }
};
struct ZOrder {
    const char* A; const char* B; int nM, G, c;
    __device__ __forceinline__ bool next(int i, Unit& u) const { int pm, pn; if (!static_tile(i, G, c, nM, 16, pm, pn)) return false; const int n = pn >> 2; u.pm = pm; u.pn = pn; u.aux = n;
        u.A = A + (size_t)pm * (256 * 1024 * 2) + n * 512; u.B = B + (size_t)n * (1024 * 256 * 2) + (size_t)(pn & 3) * (256 * 256 * 2); return true; }
};
struct MergeOrder {
    const char* A; const char* B; int nM, nN, G, c;
    __device__ __forceinline__ bool next(int i, Unit& u) const { int pm, pn; if (!static_tile(i >> 2, G, c, nM, nN, pm, pn)) return false; const int n = i & 3; u.pm = pm; u.pn = pn; u.aux = n;
        u.A = A + (size_t)pm * (256 * 1024 * 2) + n * 512; u.B = B + (size_t)n * (1024 * 256 * 2) + (size_t)pn * (256 * 256 * 2); return true; }
};
struct MoeOrder {
    const char* A; const char* B; size_t tA, tB; const int* pexp; int p0, nM, nN, G, c;
    __device__ __forceinline__ bool next(int i, Unit& u) const { int pm, pn; if (nM <= 0 || !static_tile(i, G, c, nM, nN, pm, pn)) return false; const int e = pexp[p0 + pm]; u.pm = pm; u.pn = pn; u.aux = e;
        u.A = A + (size_t)pm * tA; u.B = B + ((size_t)e * nN + pn) * tB; return true; }
};

typedef __bf16 bf16x2_t __attribute__((ext_vector_type(2)));
__device__ __forceinline__ unsigned cvt_pk_bf16(float lo, float hi) { const f32x2 v = {lo, hi}; return __builtin_bit_cast(unsigned, __builtin_convertvector(v, bf16x2_t)); }
__device__ __forceinline__ float fast_sigmoid(float x) { return __builtin_amdgcn_rcpf(1.f + __builtin_amdgcn_exp2f(-1.4426950408889634f * x)); }
__device__ __forceinline__ float bflo(unsigned w) { return __uint_as_float(w << 16); }
__device__ __forceinline__ float bfhi(unsigned w) { return __uint_as_float(w & 0xffff0000u); }

template <int ACT  > struct EpiBf16 {
    static constexpr bool PERM = true; static constexpr int NST = 16;
    bf16* O; int ldc, aux_cols;
    __device__ __forceinline__ void operator()(const f32x4 (&acc)[2][2][4][2], const Unit& u, int wr, int wc, int fr, int fq) const {
        const int row0 = u.pm * BM + wr * 64 + fr, col0 = u.aux * aux_cols + u.pn * BM + wc * 32 + 8 * fq;
#pragma unroll
        for (int ai = 0; ai < 2; ++ai)
#pragma unroll
            for (int m = 0; m < 4; ++m) { bf16* rowp = O + (size_t)(row0 + ai * HALF + m * 16) * ldc + col0;
#pragma unroll
                for (int bj = 0; bj < 2; ++bj) { f32x4 v0 = acc[ai][bj][m][0], v1 = acc[ai][bj][m][1];
                    if (ACT == 2) {
#pragma unroll
                        for (int i = 0; i < 4; ++i) { v0[i] = fast_sigmoid(v0[i]); v1[i] = fast_sigmoid(v1[i]); } }
                    u32x4 w; w.x = cvt_pk_bf16(v0[0], v0[1]); w.y = cvt_pk_bf16(v0[2], v0[3]); w.z = cvt_pk_bf16(v1[0], v1[1]); w.w = cvt_pk_bf16(v1[2], v1[3]);
                    *(u32x4*)(rowp + bj * HALF) = w; } }
    }
};
struct EpiZTile {
    static constexpr bool PERM = true; static constexpr int NST = 16;
    bf16* O;
    __device__ __forceinline__ void operator()(const f32x4 (&acc)[2][2][4][2], const Unit& u, int wr, int wc, int fr, int fq) const {
        const int rl = wr * 64 + fr;
#pragma unroll
        for (int ai = 0; ai < 2; ++ai)
#pragma unroll
            for (int m = 0; m < 4; ++m)
#pragma unroll
                for (int bj = 0; bj < 2; ++bj) { const f32x4 v0 = acc[ai][bj][m][0], v1 = acc[ai][bj][m][1];
                    const int c = u.pn * BM + bj * HALF + wc * 32 + 8 * fq, pg = c >> 6, cc = c & 63;
                    u32x4 w; w.x = cvt_pk_bf16(v0[0], v0[1]); w.y = cvt_pk_bf16(v0[2], v0[3]); w.z = cvt_pk_bf16(v1[0], v1[1]); w.w = cvt_pk_bf16(v1[2], v1[3]);
                    *(u32x4*)(O + (((size_t)u.pm * 16 + pg) * 256 + rl + ai * HALF + m * 16) * 256 + u.aux * 64 + cc) = w; }
    }
};
struct EpiSwiglu {
    static constexpr bool PERM = true; static constexpr int NST = 8;
    bf16* O; int ldc;
    __device__ __forceinline__ void operator()(const f32x4 (&acc)[2][2][4][2], const Unit& u, int wr, int wc, int fr, int fq) const {
        const int row0 = u.pm * BM + wr * 64 + fr, col0 = u.pn * HALF + wc * 32 + 8 * fq;
#pragma unroll
        for (int ai = 0; ai < 2; ++ai)
#pragma unroll
            for (int m = 0; m < 4; ++m) { bf16* rowp = O + (size_t)(row0 + ai * HALF + m * 16) * ldc + col0; float r[8];
#pragma unroll
                for (int n = 0; n < 2; ++n)
#pragma unroll
                    for (int i = 0; i < 4; ++i) { const float a = acc[ai][0][m][n][i], b = acc[ai][1][m][n][i]; r[n * 4 + i] = a * fast_sigmoid(a) * b; }
                u32x4 w; w.x = cvt_pk_bf16(r[0], r[1]); w.y = cvt_pk_bf16(r[2], r[3]); w.z = cvt_pk_bf16(r[4], r[5]); w.w = cvt_pk_bf16(r[6], r[7]);
                *(u32x4*)rowp = w; }
    }
};
struct EpiSwiglu8 {
    static constexpr bool PERM = true; static constexpr int NST = 8;
    bf16* O; int ldc; const float* sx; const float* sw;
    __device__ __forceinline__ void operator()(const f32x4 (&acc)[2][2][4][2], const Unit& u, int wr, int wc, int fr_, int fq_) const {
        int fr = fr_, fq = fq_; asm volatile("" : "+v"(fr), "+v"(fq));
        const int row0 = u.pm * BM + wr * 64 + fr, col0 = u.pn * HALF + wc * 32 + 8 * fq; const float* swp = sw + (size_t)u.aux * (2 * DFFE) + u.pn * 256 + wc * 32 + 8 * fq;
        const f32x4 sa0 = *(const f32x4*)swp, sa1 = *(const f32x4*)(swp + 4), sb0 = *(const f32x4*)(swp + 128), sb1 = *(const f32x4*)(swp + 132);
#pragma unroll
        for (int ai = 0; ai < 2; ++ai)
#pragma unroll
            for (int m = 0; m < 4; ++m) { const int row = row0 + ai * HALF + m * 16; const float rs = sx[row]; bf16* rowp = O + (size_t)row * ldc + col0; float r[8];
#pragma unroll
                for (int n = 0; n < 2; ++n) { const f32x4 ca = (n == 0 ? sa0 : sa1) * rs, cb = (n == 0 ? sb0 : sb1) * rs;
#pragma unroll
                    for (int i = 0; i < 4; ++i) { const float a = acc[ai][0][m][n][i] * ca[i], b = acc[ai][1][m][n][i] * cb[i]; r[n * 4 + i] = a * fast_sigmoid(a) * b; } }
                u32x4 w; w.x = cvt_pk_bf16(r[0], r[1]); w.y = cvt_pk_bf16(r[2], r[3]); w.z = cvt_pk_bf16(r[4], r[5]); w.w = cvt_pk_bf16(r[6], r[7]);
                *(u32x4*)rowp = w; }
    }
};
struct EpiSwiglu8X {
    static constexpr bool PERM = true; static constexpr int NST = 10;
#ifdef PROBE_X8
    static constexpr bool PROBE_REP = true;
#endif
    unsigned char* O8; unsigned char* SCT; const float* sx; const float* sw;
    __device__ __forceinline__ void operator()(const f32x4 (&acc)[2][2][4][2], const Unit& u, int wr, int wc, int fr_, int fq_) const {
        int fr = fr_, fq = fq_; asm volatile("" : "+v"(fr), "+v"(fq));
        const int row0 = u.pm * BM + wr * 64 + fr, col0 = u.pn * HALF + wc * 32 + 8 * fq; const float* swp = sw + (size_t)u.aux * (2 * DFFE) + u.pn * 256 + wc * 32 + 8 * fq;
        constexpr float NL = -1.4426950408889634f, NIL = -0.6931471805599453f;
        f32x2 sa[4], sb[4];
        { const f32x4 x0 = *(const f32x4*)swp, x1 = *(const f32x4*)(swp + 4), y0 = *(const f32x4*)(swp + 128), y1 = *(const f32x4*)(swp + 132);
          sa[0] = (f32x2){x0[0], x0[1]} * NL; sa[1] = (f32x2){x0[2], x0[3]} * NL; sa[2] = (f32x2){x1[0], x1[1]} * NL; sa[3] = (f32x2){x1[2], x1[3]} * NL;
          sb[0] = (f32x2){y0[0], y0[1]} * NIL; sb[1] = (f32x2){y0[2], y0[3]} * NIL; sb[2] = (f32x2){y1[0], y1[1]} * NIL; sb[3] = (f32x2){y1[2], y1[3]} * NIL; }
        float rsv[2][4];
#pragma unroll
        for (int ai = 0; ai < 2; ++ai)
#pragma unroll
            for (int m = 0; m < 4; ++m) rsv[ai][m] = sx[row0 + ai * HALF + m * 16];
#pragma unroll
        for (int ai = 0; ai < 2; ++ai) { unsigned sd = 0u;
#pragma unroll
            for (int m = 0; m < 4; ++m) { const int row = row0 + ai * HALF + m * 16; const float rs = rsv[ai][m]; f32x2 hp[4], na[4], dn[4]; float amax = 0.f;
#pragma unroll
                for (int j = 0; j < 4; ++j) { const f32x2 A = {acc[ai][0][m][j >> 1][(j & 1) * 2], acc[ai][0][m][j >> 1][(j & 1) * 2 + 1]}; na[j] = A * (sa[j] * rs); }
#pragma unroll
                for (int j = 0; j < 4; ++j) { dn[j][0] = __builtin_amdgcn_exp2f(na[j][0]); dn[j][1] = __builtin_amdgcn_exp2f(na[j][1]); }
#pragma unroll
                for (int j = 0; j < 4; ++j) { const f32x2 B = {acc[ai][1][m][j >> 1][(j & 1) * 2], acc[ai][1][m][j >> 1][(j & 1) * 2 + 1]}; hp[j] = na[j] * (B * sb[j]); dn[j] = dn[j] + 1.f; }
#pragma unroll
                for (int j = 0; j < 4; ++j) { dn[j][0] = __builtin_amdgcn_rcpf(dn[j][0]); dn[j][1] = __builtin_amdgcn_rcpf(dn[j][1]); }
#pragma unroll
                for (int j = 0; j < 4; ++j) { hp[j] = hp[j] * dn[j]; amax = fmaxf(fmaxf(amax, fabsf(hp[j][0])), fabsf(hp[j][1])); }
                { const auto r16 = __builtin_amdgcn_permlane16_swap(__float_as_uint(amax), __float_as_uint(amax), false, false); amax = fmaxf(__uint_as_float(r16[0]), __uint_as_float(r16[1]));
                  const auto r32 = __builtin_amdgcn_permlane32_swap(__float_as_uint(amax), __float_as_uint(amax), false, false); amax = fmaxf(__uint_as_float(r32[0]), __uint_as_float(r32[1])); }
                amax *= rs;
                const unsigned ab = __float_as_uint(amax); int e = 135 - (int)((ab >> 23) & 255u) - (((ab & 0x7fffffu) > 0x600000u) ? 1 : 0);
                e = e < -100 ? -100 : (e > 100 ? 100 : e); e = (amax > 0.f) ? e : 0;
                const float mul = __uint_as_float((unsigned)(e + 127) << 23) * rs;
                sd |= (unsigned)(127 - e) << (8 * m);
#pragma unroll
                for (int j = 0; j < 4; ++j) hp[j] = hp[j] * mul;
                int w0 = 0, w1 = 0; w0 = __builtin_amdgcn_cvt_pk_fp8_f32(hp[0][0], hp[0][1], w0, false); w0 = __builtin_amdgcn_cvt_pk_fp8_f32(hp[1][0], hp[1][1], w0, true);
                w1 = __builtin_amdgcn_cvt_pk_fp8_f32(hp[2][0], hp[2][1], w1, false); w1 = __builtin_amdgcn_cvt_pk_fp8_f32(hp[3][0], hp[3][1], w1, true);
                f32x2 w; w[0] = __int_as_float(w0); w[1] = __int_as_float(w1);
                *(f32x2*)(O8 + (size_t)row * DFFE + col0) = w; }
            if (fq == 0) *(unsigned*)(SCT + ((size_t)u.pm * 28 + u.pn) * 1024 + ((((wr * 16 + fr) * 4 + wc) * 2 + ai) << 2)) = sd; }
    }
};
struct EpiResid {
    static constexpr bool PERM = false; static constexpr int NST = 32; static constexpr bool INPLACE = true;
    const float* Xin; float* Xout; const float* gate;
    __device__ __forceinline__ void operator()(const f32x4 (&acc)[2][2][4][2], const Unit& u, int wr, int wc, int fr, int fq) const {
        const int row0 = u.pm * BM + wr * 64 + fr, col0 = u.pn * BM + wc * 32 + 4 * fq; const float* gp = gate + (size_t)(u.pm >> 6) * (6 * DM) + col0;
        f32x4 gv[2][2];
#pragma unroll
        for (int bj = 0; bj < 2; ++bj)
#pragma unroll
            for (int n = 0; n < 2; ++n) gv[bj][n] = *(const f32x4*)(gp + bj * HALF + n * 16);
#pragma unroll
        for (int ai = 0; ai < 2; ++ai)
#pragma unroll
        for (int mp = 0; mp < 4; mp += 2) {
            f32x4 xi[2][2][2];
#pragma unroll
            for (int m = 0; m < 2; ++m) { const size_t off = (size_t)(row0 + ai * HALF + (mp + m) * 16) * DM + col0;
#pragma unroll
                for (int bj = 0; bj < 2; ++bj)
#pragma unroll
                    for (int n = 0; n < 2; ++n) xi[m][bj][n] = *(const f32x4*)(Xin + off + bj * HALF + n * 16); }
            asm volatile("" ::: "memory");
#pragma unroll
            for (int m = 0; m < 2; ++m) { const size_t off = (size_t)(row0 + ai * HALF + (mp + m) * 16) * DM + col0;
#pragma unroll
                for (int bj = 0; bj < 2; ++bj)
#pragma unroll
                    for (int n = 0; n < 2; ++n) *(f32x4*)(Xout + off + bj * HALF + n * 16) = xi[m][bj][n] + gv[bj][n] * acc[ai][bj][mp + m][n]; }
            asm volatile("" ::: "memory");
        }
    }
};
template <bool IN16, bool OUT16> struct EpiResidT {
    static constexpr bool PERM = true; static constexpr int NST = OUT16 ? 16 : 32; static constexpr bool INPLACE = true;
    const void* Xin; void* Xout; const float* gate;
    __device__ __forceinline__ void operator()(const f32x4 (&acc)[2][2][4][2], const Unit& u, int wr, int wc, int fr, int fq) const {
        const int row0 = u.pm * BM + wr * 64 + fr, col0 = u.pn * BM + wc * 32 + 8 * fq; const float* gp = gate + (size_t)(u.pm >> 6) * (6 * DM) + col0;
        f32x4 gv[2][2];
#pragma unroll
        for (int bj = 0; bj < 2; ++bj)
#pragma unroll
            for (int n = 0; n < 2; ++n) gv[bj][n] = *(const f32x4*)(gp + bj * HALF + 4 * n);
#pragma unroll
        for (int ai = 0; ai < 2; ++ai)
#pragma unroll
        for (int mp = 0; mp < 4; mp += 2) {
            f32x4 xi[2][2][2];
#pragma unroll
            for (int m = 0; m < 2; ++m) { const size_t off = (size_t)(row0 + ai * HALF + (mp + m) * 16) * DM + col0;
#pragma unroll
                for (int bj = 0; bj < 2; ++bj) {
                    if (IN16) { const u32x4 r = *(const u32x4*)((const bf16*)Xin + off + bj * HALF);
                        xi[m][bj][0] = (f32x4){bflo(r.x), bfhi(r.x), bflo(r.y), bfhi(r.y)}; xi[m][bj][1] = (f32x4){bflo(r.z), bfhi(r.z), bflo(r.w), bfhi(r.w)}; }
                    else { xi[m][bj][0] = *(const f32x4*)((const float*)Xin + off + bj * HALF); xi[m][bj][1] = *(const f32x4*)((const float*)Xin + off + bj * HALF + 4); } } }
            asm volatile("" ::: "memory");
#pragma unroll
            for (int m = 0; m < 2; ++m) { const size_t off = (size_t)(row0 + ai * HALF + (mp + m) * 16) * DM + col0;
#pragma unroll
                for (int bj = 0; bj < 2; ++bj) { const f32x4 v0 = xi[m][bj][0] + gv[bj][0] * acc[ai][bj][mp + m][0], v1 = xi[m][bj][1] + gv[bj][1] * acc[ai][bj][mp + m][1];
                    if (OUT16) { u32x4 w; w.x = cvt_pk_bf16(v0[0], v0[1]); w.y = cvt_pk_bf16(v0[2], v0[3]); w.z = cvt_pk_bf16(v1[0], v1[1]); w.w = cvt_pk_bf16(v1[2], v1[3]); *(u32x4*)((bf16*)Xout + off + bj * HALF) = w; }
                    else { *(f32x4*)((float*)Xout + off + bj * HALF) = v0; *(f32x4*)((float*)Xout + off + bj * HALF + 4) = v1; } } }
            asm volatile("" ::: "memory");
        }
    }
};
struct EpiMerge {
    static constexpr bool PERM = true; static constexpr int NST = 16;
    const bf16* G; bf16* Mg;
    __device__ __forceinline__ void operator()(const f32x4 (&acc)[2][2][4][2], const Unit& u, int wr, int wc, int fr, int fq) const {
        const int row0 = u.pm * BM + wr * 64 + fr, col0 = u.pn * BM + wc * 32 + 8 * fq, n_br = u.aux;
#pragma unroll
        for (int ai = 0; ai < 2; ++ai)
#pragma unroll
        for (int mp = 0; mp < 4; mp += 2) {
            u32x4 g[2][2], o[2][2];
#pragma unroll
            for (int m = 0; m < 2; ++m) { const size_t row = (size_t)(row0 + ai * HALF + (mp + m) * 16);
#pragma unroll
                for (int bj = 0; bj < 2; ++bj) { g[m][bj] = *(const u32x4*)(G + row * GATEW + n_br * DM + col0 + bj * HALF);
                    o[m][bj] = (n_br != 0) ? *(const u32x4*)(Mg + row * DM + col0 + bj * HALF) : (u32x4){0u, 0u, 0u, 0u}; } }
            asm volatile("" ::: "memory");
#pragma unroll
            for (int m = 0; m < 2; ++m) { const size_t row = (size_t)(row0 + ai * HALF + (mp + m) * 16);
#pragma unroll
                for (int bj = 0; bj < 2; ++bj) { const u32x4 gg = g[m][bj], oo = o[m][bj]; const f32x4 a0 = acc[ai][bj][mp + m][0], a1 = acc[ai][bj][mp + m][1]; float r[8];
                    r[0] = bflo(gg.x) * a0[0] + bflo(oo.x); r[1] = bfhi(gg.x) * a0[1] + bfhi(oo.x); r[2] = bflo(gg.y) * a0[2] + bflo(oo.y); r[3] = bfhi(gg.y) * a0[3] + bfhi(oo.y);
                    r[4] = bflo(gg.z) * a1[0] + bflo(oo.z); r[5] = bfhi(gg.z) * a1[1] + bfhi(oo.z); r[6] = bflo(gg.w) * a1[2] + bflo(oo.w); r[7] = bfhi(gg.w) * a1[3] + bfhi(oo.w);
                    u32x4 w; w.x = cvt_pk_bf16(r[0], r[1]); w.y = cvt_pk_bf16(r[2], r[3]); w.z = cvt_pk_bf16(r[4], r[5]); w.w = cvt_pk_bf16(r[6], r[7]);
                    *(u32x4*)(Mg + row * DM + col0 + bj * HALF) = w; } }
            asm volatile("" ::: "memory");
        }
    }
};
struct EpiGM {
    static constexpr bool PERM = false; static constexpr int NST = 8;
    const bf16* Z; bf16* Mg;
    __device__ __forceinline__ void operator()(const f32x4 (&acc)[2][2][4][2], const Unit& u, int wr, int wc, int fr, int fq) const {
        const int row0 = u.pm * BM + wr * 64 + fr, col0 = u.pn * 64 + wc * 16 + 4 * fq;
        const bf16* zb = Z + (size_t)row0 * GATEW + col0; bf16* mb = Mg + (size_t)row0 * DM + col0;
#pragma unroll
        for (int ai = 0; ai < 2; ++ai) {
            f32x2 zz[4][4];
#pragma unroll
            for (int m = 0; m < 4; ++m)
#pragma unroll
                for (int br = 0; br < 4; ++br) zz[m][br] = *(const f32x2*)(zb + (size_t)(ai * HALF + m * 16) * GATEW + br * DM);
            asm volatile("" ::: "memory");
#pragma unroll
            for (int m = 0; m < 4; ++m) { f32x4 r = {0.f, 0.f, 0.f, 0.f};
#pragma unroll
                for (int br = 0; br < 4; ++br) { const f32x4 a = acc[ai][br >> 1][m][br & 1]; const unsigned z0 = __float_as_uint(zz[m][br][0]), z1 = __float_as_uint(zz[m][br][1]);
                    r[0] += fast_sigmoid(a[0]) * bflo(z0); r[1] += fast_sigmoid(a[1]) * bfhi(z0); r[2] += fast_sigmoid(a[2]) * bflo(z1); r[3] += fast_sigmoid(a[3]) * bfhi(z1); }
                f32x2 w; w[0] = __uint_as_float(cvt_pk_bf16(r[0], r[1])); w[1] = __uint_as_float(cvt_pk_bf16(r[2], r[3]));
                *(f32x2*)(mb + (size_t)(ai * HALF + m * 16) * DM) = w;
                __builtin_amdgcn_sched_barrier(0); }
            asm volatile("" ::: "memory");
        }
    }
};
struct MoeOrderX {
    const char* A; const char* B; const char* Sc; size_t tA, tB, tS; const int* pexp; int p0, nM, nN, G, c;
    __device__ __forceinline__ bool next(int i, Unit& u) const { int pm, pn; if (nM <= 0 || !static_tile(i, G, c, nM, nN, pm, pn)) return false; const int e = pexp[p0 + pm]; u.pm = pm; u.pn = pn; u.aux = e;
        u.A = A + (size_t)pm * tA; u.B = B + ((size_t)e * nN + pn) * tB; u.S = Sc + (size_t)pm * tS; return true; }
};
struct MoeTailOrderX {
    const char* A; const char* B; const char* Sc; size_t tA, tB, tS; const int* pexp; int p0, T, G, c;
    __device__ __forceinline__ bool next(int i, Unit& u) const { const int L = i * G + c; if (L >= T * 8) return false; const int pt = L >> 3, pn = (L >> 1) & 3, kh = L & 1, e = pexp[p0 + pt];
        u.pm = pt; u.pn = pn; u.aux = kh | (e << 8); u.A = A + (size_t)pt * tA + kh * 1792; u.B = B + ((size_t)e * 4 + pn) * tB + kh * 1792; u.S = Sc + (size_t)pt * tS + kh * (14 * 1024); return true; }
};
struct MoeTailOrder {
    const char* A; const char* B; size_t tA, tB; const int* pexp; int p0, T, G, c;
    __device__ __forceinline__ bool next(int i, Unit& u) const { const int L = i * G + c; if (L >= T * 16) return false; const int pt = L >> 4, pn = (L >> 2) & 3, kq = L & 3, e = pexp[p0 + pt];
        u.pm = pt; u.pn = pn; u.aux = kq; u.A = A + (size_t)pt * tA + kq * (896 * 2); u.B = B + ((size_t)e * 4 + pn) * tB + kq * (896 * 2); return true; }
};
struct EpiMoePart {
    static constexpr bool PERM = true; static constexpr int NST = 16;
    bf16* PART; const float* ps;
    __device__ __forceinline__ void operator()(const f32x4 (&acc)[2][2][4][2], const Unit& u, int wr, int wc, int fr, int fq) const {
        const int row0 = u.pm * BM + wr * 64 + fr, col0 = u.pn * BM + wc * 32 + 8 * fq; bf16* base = PART + (size_t)u.aux * (MAXTAIL * 256) * DM;
#pragma unroll
        for (int ai = 0; ai < 2; ++ai)
#pragma unroll
            for (int m = 0; m < 4; ++m) { const int row = row0 + ai * HALF + m * 16; const float s = ps[row]; bf16* rowp = base + (size_t)row * DM + col0;
#pragma unroll
                for (int bj = 0; bj < 2; ++bj) { const f32x4 v0 = acc[ai][bj][m][0] * s, v1 = acc[ai][bj][m][1] * s;
                    u32x4 w; w.x = cvt_pk_bf16(v0[0], v0[1]); w.y = cvt_pk_bf16(v0[2], v0[3]); w.z = cvt_pk_bf16(v1[0], v1[1]); w.w = cvt_pk_bf16(v1[2], v1[3]);
                    *(u32x4*)(rowp + bj * HALF) = w; } }
    }
};
struct EpiGM8 {
    static constexpr bool PERM = false; static constexpr int NST = 8;
#ifdef PROBE_GM8
    static constexpr bool PROBE_REP = true;
#endif
    const bf16* Z; bf16* Mg; const float* sh; const float* sw;
    __device__ __forceinline__ void operator()(const f32x4 (&acc)[2][2][4][2], const Unit& u, int wr, int wc, int fr_, int fq_) const {
        int fr = fr_, fq = fq_; asm volatile("" : "+v"(fr), "+v"(fq));
        const int row0 = u.pm * BM + wr * 64 + fr, col0 = u.pn * 64 + wc * 16 + 4 * fq;
        bf16* mb = Mg + (size_t)row0 * DM + col0;
        const bf16* zb = Z + (((size_t)u.pm * 16 + u.pn) * 256 + wr * 64 + fr) * 256 + wc * 16 + 4 * fq;
        f32x2 zz[2][4][4]; float rs[2][4];
#pragma unroll
        for (int ai = 0; ai < 2; ++ai)
#pragma unroll
            for (int m = 0; m < 4; ++m) { rs[ai][m] = sh[row0 + ai * HALF + m * 16];
#pragma unroll
                for (int br = 0; br < 4; ++br) zz[ai][m][br] = *(const f32x2*)(zb + (size_t)(ai * HALF + m * 16) * 256 + br * 64); }
        f32x4 craw[4];
#pragma unroll
        for (int br = 0; br < 4; ++br) craw[br] = *(const f32x4*)(sw + u.pn * 256 + 128 * (br >> 1) + 32 * wc + 16 * (br & 1) + 4 * fq);
        asm volatile("" ::: "memory");
        f32x2 cs[4][2];
#pragma unroll
        for (int br = 0; br < 4; ++br) { cs[br][0] = (f32x2){craw[br][0], craw[br][1]} * -1.4426950408889634f; cs[br][1] = (f32x2){craw[br][2], craw[br][3]} * -1.4426950408889634f; }
#pragma unroll
        for (int ai = 0; ai < 2; ++ai) {
#pragma unroll
            for (int m = 0; m < 4; ++m) { f32x2 r0 = {0.f, 0.f}, r1 = {0.f, 0.f};
#pragma unroll
                for (int br = 0; br < 4; ++br) { const f32x4 A = acc[ai][br >> 1][m][br & 1];
                    const f32x2 n0 = (f32x2){A[0], A[1]} * (cs[br][0] * rs[ai][m]), n1 = (f32x2){A[2], A[3]} * (cs[br][1] * rs[ai][m]);
                    f32x2 d0, d1; d0[0] = __builtin_amdgcn_exp2f(n0[0]); d0[1] = __builtin_amdgcn_exp2f(n0[1]); d1[0] = __builtin_amdgcn_exp2f(n1[0]); d1[1] = __builtin_amdgcn_exp2f(n1[1]);
                    d0 = d0 + 1.f; d1 = d1 + 1.f;
                    d0[0] = __builtin_amdgcn_rcpf(d0[0]); d0[1] = __builtin_amdgcn_rcpf(d0[1]); d1[0] = __builtin_amdgcn_rcpf(d1[0]); d1[1] = __builtin_amdgcn_rcpf(d1[1]);
                    const unsigned z0 = __float_as_uint(zz[ai][m][br][0]), z1 = __float_as_uint(zz[ai][m][br][1]);
                    r0 = r0 + d0 * (f32x2){bflo(z0), bfhi(z0)}; r1 = r1 + d1 * (f32x2){bflo(z1), bfhi(z1)}; }
                f32x2 w; w[0] = __uint_as_float(cvt_pk_bf16(r0[0], r0[1])); w[1] = __uint_as_float(cvt_pk_bf16(r1[0], r1[1]));
                *(f32x2*)(mb + (size_t)(ai * HALF + m * 16) * DM) = w;
                __builtin_amdgcn_sched_barrier(0); }
        }
        asm volatile("" ::: "memory");
    }
};
struct EpiMoeDown8 {
    static constexpr bool PERM = true; static constexpr int NST = 16;
    bf16* Y; const float* ps; const float* sw2;
    __device__ __forceinline__ void operator()(const f32x4 (&acc)[2][2][4][2], const Unit& u, int wr, int wc, int fr_, int fq_) const {
        int fr = fr_, fq = fq_; asm volatile("" : "+v"(fr), "+v"(fq));
        const int row0 = u.pm * BM + wr * 64 + fr, col0 = u.pn * BM + wc * 32 + 8 * fq; const float* swp = sw2 + (size_t)(u.aux & 0xff) * DM + col0;
        f32x4 cs[2][2];
#pragma unroll
        for (int bj = 0; bj < 2; ++bj) { cs[bj][0] = *(const f32x4*)(swp + bj * HALF); cs[bj][1] = *(const f32x4*)(swp + bj * HALF + 4); }
        float psv[2][4];
#pragma unroll
        for (int ai = 0; ai < 2; ++ai)
#pragma unroll
            for (int m = 0; m < 4; ++m) psv[ai][m] = ps[row0 + ai * HALF + m * 16];
#pragma unroll
        for (int ai = 0; ai < 2; ++ai)
#pragma unroll
            for (int m = 0; m < 4; ++m) { const int row = row0 + ai * HALF + m * 16; const float s = psv[ai][m]; bf16* rowp = Y + (size_t)row * DM + col0;
#pragma unroll
                for (int bj = 0; bj < 2; ++bj) { const f32x4 v0 = acc[ai][bj][m][0] * cs[bj][0] * s, v1 = acc[ai][bj][m][1] * cs[bj][1] * s;
                    u32x4 w; w.x = cvt_pk_bf16(v0[0], v0[1]); w.y = cvt_pk_bf16(v0[2], v0[3]); w.z = cvt_pk_bf16(v1[0], v1[1]); w.w = cvt_pk_bf16(v1[2], v1[3]);
                    *(u32x4*)(rowp + bj * HALF) = w; } }
    }
};
struct EpiMoePart8 {
    static constexpr bool PERM = true; static constexpr int NST = 16;
    bf16* PART; const float* ps; const float* sw2;
    __device__ __forceinline__ void operator()(const f32x4 (&acc)[2][2][4][2], const Unit& u, int wr, int wc, int fr_, int fq_) const {
        int fr = fr_, fq = fq_; asm volatile("" : "+v"(fr), "+v"(fq));
        const int row0 = u.pm * BM + wr * 64 + fr, col0 = u.pn * BM + wc * 32 + 8 * fq; const float* swp = sw2 + (size_t)(u.aux >> 8) * DM + col0; bf16* base = PART + (size_t)(u.aux & 1) * (MAXTAIL * 256) * DM;
        f32x4 cs[2][2];
#pragma unroll
        for (int bj = 0; bj < 2; ++bj) { cs[bj][0] = *(const f32x4*)(swp + bj * HALF); cs[bj][1] = *(const f32x4*)(swp + bj * HALF + 4); }
#pragma unroll
        for (int ai = 0; ai < 2; ++ai)
#pragma unroll
            for (int m = 0; m < 4; ++m) { const int row = row0 + ai * HALF + m * 16; const float s = ps[row]; bf16* rowp = base + (size_t)row * DM + col0;
#pragma unroll
                for (int bj = 0; bj < 2; ++bj) { const f32x4 v0 = acc[ai][bj][m][0] * cs[bj][0] * s, v1 = acc[ai][bj][m][1] * cs[bj][1] * s;
                    u32x4 w; w.x = cvt_pk_bf16(v0[0], v0[1]); w.y = cvt_pk_bf16(v0[2], v0[3]); w.z = cvt_pk_bf16(v1[0], v1[1]); w.w = cvt_pk_bf16(v1[2], v1[3]);
                    *(u32x4*)(rowp + bj * HALF) = w; } }
    }
};
struct EpiMoeDown {
    static constexpr bool PERM = true; static constexpr int NST = 16;
    bf16* Y; const float* ps;
    __device__ __forceinline__ void operator()(const f32x4 (&acc)[2][2][4][2], const Unit& u, int wr, int wc, int fr, int fq) const {
        const int row0 = u.pm * BM + wr * 64 + fr, col0 = u.pn * BM + wc * 32 + 8 * fq;
#pragma unroll
        for (int ai = 0; ai < 2; ++ai)
#pragma unroll
            for (int m = 0; m < 4; ++m) { const int row = row0 + ai * HALF + m * 16; const float s = ps[row]; bf16* rowp = Y + (size_t)row * DM + col0;
#pragma unroll
                for (int bj = 0; bj < 2; ++bj) { const f32x4 v0 = acc[ai][bj][m][0] * s, v1 = acc[ai][bj][m][1] * s;
                    u32x4 w; w.x = cvt_pk_bf16(v0[0], v0[1]); w.y = cvt_pk_bf16(v0[2], v0[3]); w.z = cvt_pk_bf16(v1[0], v1[1]); w.w = cvt_pk_bf16(v1[2], v1[3]);
                    *(u32x4*)(rowp + bj * HALF) = w; } }
    }
};

template <class E> constexpr auto epi_inplace(int) -> decltype(E::INPLACE) { return E::INPLACE; }
template <class E> constexpr bool epi_inplace(long) { return false; }
#ifndef EPI_REP
#define EPI_REP 1
#endif
template <class E> constexpr auto epi_rep(int) -> decltype(E::PROBE_REP, 1) { return EPI_REP; }
template <class E> constexpr int epi_rep(long) { return 1; }
typedef int v8i __attribute__((ext_vector_type(8)));
typedef int v4i __attribute__((ext_vector_type(4)));
template <int M8> __device__ __forceinline__ void mma8s(f32x4& acc, const v8i& b8, const v8i& a8, const int sA, const unsigned sB) {
    if constexpr (M8 == 0) asm volatile("v_mfma_scale_f32_16x16x128_f8f6f4 %0, %1, %2, %0, %3, %4 op_sel_hi:[0,0,0]" : "+v"(acc) : "v"(b8), "v"(a8), "v"(sA), "v"(sB));
    else if constexpr (M8 == 1) asm volatile("v_mfma_scale_f32_16x16x128_f8f6f4 %0, %1, %2, %0, %3, %4 op_sel:[0,1,0] op_sel_hi:[0,0,0]" : "+v"(acc) : "v"(b8), "v"(a8), "v"(sA), "v"(sB));
    else if constexpr (M8 == 2) asm volatile("v_mfma_scale_f32_16x16x128_f8f6f4 %0, %1, %2, %0, %3, %4 op_sel_hi:[0,1,0]" : "+v"(acc) : "v"(b8), "v"(a8), "v"(sA), "v"(sB));
    else asm volatile("v_mfma_scale_f32_16x16x128_f8f6f4 %0, %1, %2, %0, %3, %4 op_sel:[0,1,0] op_sel_hi:[0,1,0]" : "+v"(acc) : "v"(b8), "v"(a8), "v"(sA), "v"(sB));
}
template <class Epi, class Sched, int MODE = 0>
__device__ __forceinline__ void gemm_phase(PG8_LAS unsigned char* lds, const int wave_, const int lda, const int ldb, const int K, const Sched& S, const Epi& E) {
    constexpr bool F8 = (MODE != 0), SCL = (MODE == 2);
    int tid_ = wave_ * 64 + lane_id(); asm volatile("" : "+v"(tid_));
    const int tid = tid_, wid = __builtin_amdgcn_readfirstlane(tid >> 6), lane = tid & 63, wr = wid >> 2, wc = wid & 3, fr = lane & 15, fq = lane >> 4;
    const int nt = K / BK;
    unsigned voffA[2], voffB[2];
#pragma unroll
    for (int i = 0; i < 2; ++i) { int R, C; stage_rc(tid * 16 + i * 8192, R, C); const int Rb = Epi::PERM ? ((R & ~31) + perm32(R & 31)) : R;
        voffA[i] = (unsigned)(R * lda + C) * 2u; voffB[i] = (unsigned)(Rb * ldb + C) * 2u; }
    const size_t kstep = (size_t)(BK * 2);
    const size_t hstepA = (size_t)HALF * lda * 2, hstepB = (size_t)HALF * ldb * 2;
    const unsigned ldsw = (unsigned)wid * 1024u;
    const int aoff = lds_byte(wr * 64 + fr, fq * 8), boff = lds_byte(wc * 32 + fr, fq * 8);
    const int aoff8 = lds_byte(wr * 64 + fr, 32 * (fq >> 1) + 16 * (fq & 1)), boff8 = lds_byte(wc * 32 + fr, 32 * (fq >> 1) + 16 * (fq & 1));
#define PG8_SA(b, h) (((b) * 2 + (h)) * HTB)
#define PG8_SB(b, h) ((4 + (b) * 2 + (h)) * HTB)
#define PG8_STAGE(bufoff, gbase, voff) do { _Pragma("unroll") for (int _i = 0; _i < 2; ++_i) \
        __builtin_amdgcn_global_load_lds((const unsigned*)((const char*)(gbase) + (voff)[_i]), (PG8_LAS unsigned*)(lds + (bufoff) + ldsw + _i * 8192), 16, 0, 0); } while (0)
#define PG8_CAT(x0, x1) __builtin_shufflevector(__builtin_bit_cast(v4i, x0), __builtin_bit_cast(v4i, x1), 0, 1, 2, 3, 4, 5, 6, 7)
#define PG8_LDA(dst, b, h) do { _Pragma("unroll") for (int m = 0; m < 4; ++m) { if constexpr (F8) dst##8[m] = PG8_CAT(*(const PG8_LAS bf16x8*)(lds + PG8_SA(b, h) + aoff + m * 2048), *(const PG8_LAS bf16x8*)(lds + PG8_SA(b, h) + aoff + m * 2048 + 1024)); \
        else { _Pragma("unroll") for (int k = 0; k < 2; ++k) dst[m][k] = *(const PG8_LAS bf16x8*)(lds + PG8_SA(b, h) + aoff + m * 2048 + k * 1024); } } } while (0)
#define PG8_LDB(dst, b, h) do { _Pragma("unroll") for (int n = 0; n < 2; ++n) { if constexpr (F8) dst##8[n] = PG8_CAT(*(const PG8_LAS bf16x8*)(lds + PG8_SB(b, h) + boff + n * 2048), *(const PG8_LAS bf16x8*)(lds + PG8_SB(b, h) + boff + n * 2048 + 1024)); \
        else { _Pragma("unroll") for (int k = 0; k < 2; ++k) dst[n][k] = *(const PG8_LAS bf16x8*)(lds + PG8_SB(b, h) + boff + n * 2048 + k * 1024); } } } while (0)
#define PG8_MMA(ai, bj, At, Bt) do { __builtin_amdgcn_s_setprio(1); if constexpr (SCL) asm volatile("s_nop 7" ::: "memory"); _Pragma("unroll") for (int n = 0; n < 2; ++n) { \
        if constexpr (SCL) { mma8s<0>(acc[ai][bj][0][n], Bt##8[n], At##8[0], sc1, SCUR[ai]); mma8s<1>(acc[ai][bj][1][n], Bt##8[n], At##8[1], sc1, SCUR[ai]); \
                             mma8s<2>(acc[ai][bj][2][n], Bt##8[n], At##8[2], sc1, SCUR[ai]); mma8s<3>(acc[ai][bj][3][n], Bt##8[n], At##8[3], sc1, SCUR[ai]); } \
        else { _Pragma("unroll") for (int m = 0; m < 4; ++m) { \
        if constexpr (F8) asm volatile("v_mfma_scale_f32_16x16x128_f8f6f4 %0, %1, %2, %0, %3, %3 op_sel_hi:[0,0,0]" : "+v"(acc[ai][bj][m][n]) : "v"(Bt##8[n]), "v"(At##8[m]), "v"(sc1)); \
        else { _Pragma("unroll") for (int k = 0; k < 2; ++k) acc[ai][bj][m][n] = __builtin_amdgcn_mfma_f32_16x16x32_bf16(Bt[n][k], At[m][k], acc[ai][bj][m][n], 0, 0, 0); } } } } __builtin_amdgcn_s_setprio(0); } while (0)
#define PG8_WAIT_V(n) asm volatile("s_waitcnt vmcnt(" #n ")" ::: "memory")
#define PG8_WAIT_VX(n) asm volatile("s_waitcnt vmcnt(%0)" :: "n"(n) : "memory")
#define PG8_WAIT_SEG() do { if (relax) PG8_WAIT_VX(8 + Epi::NST); else PG8_WAIT_V(8); } while (0)
#define PG8_WAIT_SEG1() do { if constexpr (SCL) { if (relax) PG8_WAIT_VX(9 + Epi::NST); else PG8_WAIT_V(9); } else PG8_WAIT_SEG(); } while (0)
#define PG8_WAIT_L(n) asm volatile("s_waitcnt lgkmcnt(" #n ")" ::: "memory")
#define PG8_BAR __builtin_amdgcn_s_barrier()
#define PG8_SCHED __builtin_amdgcn_sched_barrier(0)
    Unit cur, nxt; int ui = 0;
    if (!S.next(0, cur)) return;
    f32x4 acc[2][2][4][2];
#pragma unroll
    for (int a = 0; a < 2; ++a)
#pragma unroll
        for (int b = 0; b < 2; ++b)
#pragma unroll
            for (int m = 0; m < 4; ++m)
#pragma unroll
                for (int n = 0; n < 2; ++n) acc[a][b][m][n] = (f32x4){0.f, 0.f, 0.f, 0.f};
    bf16x8 At[4][2], B0[2][2], B1[2][2]; v8i At8[4], B08[2], B18[2];
    int sc1 = 0x7f7f7f7f; asm volatile("" : "+v"(sc1));
    const unsigned soff = (unsigned)(((wr * 16 + fr) * 4 + fq) * 8);
    u32x2 sct0 = {0u, 0u}, sct1 = {0u, 0u};
    const char* cA = cur.A; const char* cB = cur.B; const char* cS = cur.S;
    if constexpr (SCL) { sct0 = *(const u32x2*)(cur.S + soff); sct1 = *(const u32x2*)(cur.S + 1024 + soff); }
    PG8_STAGE(PG8_SB(0, 0), cB, voffB); PG8_STAGE(PG8_SB(0, 1), cB + hstepB, voffB); PG8_STAGE(PG8_SA(0, 0), cA, voffA); PG8_STAGE(PG8_SA(0, 1), cA + hstepA, voffA);
    if (wr == 1) PG8_BAR;
    PG8_WAIT_V(2); PG8_BAR;
    PG8_STAGE(PG8_SB(1, 0), cB + kstep, voffB); PG8_STAGE(PG8_SA(1, 0), cA + kstep, voffA); PG8_STAGE(PG8_SB(1, 1), cB + hstepB + kstep, voffB);
    PG8_WAIT_V(6); PG8_BAR;
    for (;;) {
        const bool has_next = S.next(ui + 1, nxt);
        const char* nA = has_next ? nxt.A : cA; const char* nB = has_next ? nxt.B : cB; const char* nS = has_next ? nxt.S : cS;
        for (int t = 0; t < nt; t += 2) {
            const bool last = (t == nt - 2); int relax = __builtin_amdgcn_readfirstlane((int)(t == 0) & (int)(ui > 0)); asm volatile("" : "+s"(relax));
            const char* a1 = cA + (size_t)(t + 1) * kstep;
            const char* a2 = last ? nA : cA + (size_t)(t + 2) * kstep; const char* b2 = last ? nB : cB + (size_t)(t + 2) * kstep;
            const char* a3 = a2 + kstep; const char* b3 = b2 + kstep;
            const char* s2p = last ? nS : cS + (size_t)(t + 2) * 1024;
            u32x2 sn0 = sct0, sn1 = sct1;
#define SCUR sct0
            PG8_LDB(B0, 0, 0); PG8_LDB(B1, 0, 1); PG8_SCHED; PG8_LDA(At, 0, 0); PG8_STAGE(PG8_SA(1, 1), a1 + hstepA, voffA);
            PG8_WAIT_SEG1(); PG8_WAIT_L(0); PG8_BAR; PG8_MMA(0, 0, At, B0); PG8_MMA(0, 1, At, B1); PG8_BAR; PG8_SCHED;
            PG8_LDA(At, 0, 1); PG8_STAGE(PG8_SB(0, 0), b2, voffB); PG8_STAGE(PG8_SB(0, 1), b2 + hstepB, voffB); PG8_STAGE(PG8_SA(0, 0), a2, voffA);
            PG8_WAIT_SEG(); if constexpr (SCL) sn0 = *(const u32x2*)(s2p + soff); PG8_WAIT_L(0); PG8_BAR; PG8_MMA(1, 0, At, B0); PG8_MMA(1, 1, At, B1); PG8_BAR; PG8_SCHED;
#undef SCUR
#define SCUR sct1
            PG8_LDB(B0, 1, 0); PG8_LDB(B1, 1, 1); PG8_SCHED; PG8_LDA(At, 1, 0); PG8_STAGE(PG8_SA(0, 1), a2 + hstepA, voffA);
            if constexpr (SCL) PG8_WAIT_V(9); else PG8_WAIT_V(8); PG8_WAIT_L(0); PG8_BAR; PG8_MMA(0, 0, At, B0); PG8_MMA(0, 1, At, B1); PG8_BAR; PG8_SCHED;
            PG8_LDA(At, 1, 1); PG8_STAGE(PG8_SB(1, 0), b3, voffB); PG8_STAGE(PG8_SB(1, 1), b3 + hstepB, voffB); PG8_STAGE(PG8_SA(1, 0), a3, voffA);
            PG8_WAIT_V(8); if constexpr (SCL) sn1 = *(const u32x2*)(s2p + 1024 + soff);
            PG8_WAIT_L(0); PG8_BAR; PG8_MMA(1, 0, At, B0); PG8_MMA(1, 1, At, B1); PG8_BAR; PG8_SCHED;
#undef SCUR
            sct0 = sn0; sct1 = sn1;
        }
        if (wr == 0) PG8_BAR;
        if constexpr (F8) asm volatile("s_nop 15\n\ts_nop 15" ::: "memory");
        _Pragma("unroll") for (int er_ = 0; er_ < epi_rep<Epi>(0); ++er_) { E(acc, cur, wr, wc, fr, fq); if (EPI_REP > 1) asm volatile("" ::: "memory"); }
        if (!has_next) break;
#pragma unroll
        for (int a = 0; a < 2; ++a)
#pragma unroll
            for (int b = 0; b < 2; ++b)
#pragma unroll
                for (int m = 0; m < 4; ++m)
#pragma unroll
                    for (int n = 0; n < 2; ++n) acc[a][b][m][n] = (f32x4){0.f, 0.f, 0.f, 0.f};
        cur = nxt; cA = nA; cB = nB; cS = nS; ++ui;
        if (wr == 1) PG8_BAR;
    }
    PG8_WAIT_V(0);
    PG8_BAR;
#undef PG8_SA
#undef PG8_SB
#undef PG8_STAGE
#undef PG8_LDA
#undef PG8_LDB
#undef PG8_MMA
#undef PG8_CAT
#undef PG8_WAIT_V
#undef PG8_WAIT_VX
#undef PG8_WAIT_SEG
#undef PG8_WAIT_SEG1
#undef PG8_WAIT_L
#undef PG8_BAR
#undef PG8_SCHED
}
}
constexpr int NWAVES = 8;
constexpr int RING_OFF = 0, RING_BYTES = 131072;
constexpr int LDSCTL_OFF = RING_BYTES, MISC_OFF = LDSCTL_OFF + 320;
constexpr int LDS_BYTES = 147456;
constexpr int CW_TMO = 0, CW_CODE = 1, CW_BAR = 4096;

#define GAS __attribute__((address_space(1)))
#define LAS __attribute__((address_space(3)))
typedef unsigned v4u __attribute__((ext_vector_type(4)));
typedef unsigned v2u __attribute__((ext_vector_type(2)));
typedef GAS unsigned gu32;
#define RLX_AGENT __ATOMIC_RELAXED, __HIP_MEMORY_SCOPE_AGENT
#define LDS_WAIT() asm volatile("s_waitcnt lgkmcnt(0)" ::: "memory")
#define VM_WAIT() asm volatile("s_waitcnt vmcnt(0)" ::: "memory")
__device__ __forceinline__ unsigned pk2(float lo, float hi) { return (unsigned)f2bf(lo) | ((unsigned)f2bf(hi) << 16); }


#define XB_TMO      128
#define XB_XCNT(j)  (256  + 64 * (j))
#define XB_XSUB(j)  (1280 + 64 * (j))
#define XB_XGEN(j)  (2304 + 64 * (j))
#define XB_TOP      3328
#define XB_TOPGEN   3392
#define XCD_BAR_WORDS 3456
#define XB_SPIN_CAP (1u << 18)
__device__ __forceinline__ unsigned xb_ld(unsigned* p)              { return __hip_atomic_load(p, __ATOMIC_RELAXED, __HIP_MEMORY_SCOPE_AGENT); }
__device__ __forceinline__ unsigned xb_add(unsigned* p, unsigned v) { return __hip_atomic_fetch_add(p, v, __ATOMIC_RELAXED, __HIP_MEMORY_SCOPE_AGENT); }
__device__ __forceinline__ unsigned xb_xcc_id() { return (unsigned)__builtin_amdgcn_s_getreg((3 << 11) | 20) & 0xFu; }
#define XB_SPIN(cond, bar) do { unsigned _sp = 0; while (cond) { __builtin_amdgcn_s_sleep(1); \
    if ((++_sp & 255u) == 0u) { if (xb_ld(&(bar)[XB_TMO])) break; if (_sp > XB_SPIN_CAP) { atomicAdd(&(bar)[XB_TMO], 1u); break; } } } } while (0)
struct XcdBarrier { unsigned* bar; unsigned x; volatile LAS unsigned* st; };
__device__ __forceinline__ XcdBarrier xcd_barrier_post(unsigned* bar, volatile LAS unsigned* st) {
    XcdBarrier b; b.bar = bar; b.x = xb_xcc_id(); b.st = st;
    if (threadIdx.x == 0) (void)xb_add(&bar[XB_XCNT(b.x)], 1u);
    return b;
}
__device__ __forceinline__ void xcd_barrier_complete(unsigned* bar, unsigned x, unsigned& nloc, unsigned& nx) {
    const unsigned G = gridDim.x * gridDim.y * gridDim.z;
    unsigned sum, cnt, mine, sp = 0u;
    for (;;) {
        sum = 0u; cnt = 0u; mine = 0u;
#pragma unroll
        for (unsigned j = 0; j < 16; ++j) { const unsigned c = xb_ld(&bar[XB_XCNT(j)]); sum += c; cnt += (c > 0u) ? 1u : 0u; mine = (j == x) ? c : mine; }
        if (sum == G) break;
        __builtin_amdgcn_s_sleep(1);
        if ((++sp & 255u) == 0u) { if (xb_ld(&bar[XB_TMO])) break; if (sp > XB_SPIN_CAP) { atomicAdd(&bar[XB_TMO], 1u); break; } }
    }
    nloc = mine > 0u ? mine : 1u; nx = cnt > 0u ? cnt : 1u;
}
__device__ __forceinline__ void xcd_barrier(const XcdBarrier& b, const int wave) {
    asm volatile("s_waitcnt vmcnt(0)" ::: "memory");
    __syncthreads();
    if (wave == 0 && lane_id() == 0) {
        unsigned* bar = b.bar;
        __builtin_amdgcn_s_waitcnt(0);
        unsigned nloc = b.st[0], nx = b.st[1];
        if (nloc == 0u) { xcd_barrier_complete(bar, b.x, nloc, nx); b.st[0] = nloc; b.st[1] = nx; }
        const unsigned old = xb_add(&bar[XB_XSUB(b.x)], 1u);
        const unsigned gen = old / nloc;
        if (old + 1u == (gen + 1u) * nloc) {
            __builtin_amdgcn_fence(__ATOMIC_RELEASE, "agent");
            asm volatile("s_waitcnt vmcnt(0)" ::: "memory");
            const unsigned og = xb_add(&bar[XB_TOP], 1u);
            const unsigned tg = og / nx;
            if (og + 1u == (tg + 1u) * nx) xb_add(&bar[XB_TOPGEN], 1u);
            else XB_SPIN(xb_ld(&bar[XB_TOPGEN]) == tg, bar);
            __builtin_amdgcn_fence(__ATOMIC_ACQUIRE, "agent");
            xb_add(&bar[XB_XGEN(b.x)], 1u);
            asm volatile("s_waitcnt vmcnt(0)" ::: "memory");
        } else {
            XB_SPIN(xb_ld(&bar[XB_XGEN(b.x)]) == gen, bar);
            __builtin_amdgcn_fence(__ATOMIC_ACQUIRE, "agent");
            asm volatile("s_waitcnt vmcnt(0)" ::: "memory");
        }
    }
    __syncthreads();
}

struct Frame {
    LAS unsigned char* lds; volatile LAS unsigned* MISC; unsigned* ctl;
    int wave, vcu, G;
};
#define F_LANE (lane_id())
#define F_TID (F.wave * 64 + lane_id())
__device__ __forceinline__ float wave_sum(float v) {
#pragma unroll
    for (int o = 1; o < 64; o <<= 1) v += __shfl_xor(v, o);
    return v;
}

__host__ __device__ __forceinline__ int win_row(int sc) { if (sc < NPROJ_SRC) return sc + (sc >= 1184 ? 96 : 0); const int g = sc - NPROJ_SRC, br = g >> 10, oc = g & 1023, p = oc >> 6, j = oc & 63;
    return PROJW + p * 256 + 128 * (br >> 1) + 32 * (j >> 4) + 16 * (br & 1) + (j & 15); }
__device__ __forceinline__ void transpose_item(const float* W, int ldw, bf16* WT, int ldt, int drow0, int k0, int n0, const float* scale, LAS float* scr, int lane, const bool winmap = false) {
#pragma unroll
    for (int i = 0; i < 32; ++i) { const int kk = 2 * i + (lane >> 5); float v = W[(size_t)(k0 + kk) * ldw + n0 + (lane & 31)]; if (scale) v *= scale[k0 + kk]; scr[kk * 33 + (lane & 31)] = v; }
    LDS_WAIT(); asm volatile("" ::: "memory");
    const int c = lane & 7;
#pragma unroll
    for (int j = 0; j < 4; ++j) { const int n = (lane >> 3) + 8 * j; const LAS float* s = scr + (8 * c) * 33 + n;
        v4u o; o.x = pk2(s[0 * 33], s[1 * 33]); o.y = pk2(s[2 * 33], s[3 * 33]); o.z = pk2(s[4 * 33], s[5 * 33]); o.w = pk2(s[6 * 33], s[7 * 33]);
        *(v4u*)(WT + (size_t)(winmap ? win_row(n0 + n) : drow0 + n) * ldt + k0 + 8 * c) = o; }
    LDS_WAIT(); asm volatile("" ::: "memory");
}
__device__ __forceinline__ void convert_job(Frame& F, const float* src, size_t sstride, int K, int N, bf16* dst, size_t dstride, int ldt, int mode, const float* scale, int nmat, int rot, int ncol = 0) {
    LAS float* scr = (LAS float*)(F.lds + RING_OFF + F.wave * 16384);
    const int NGW = F.G * NWAVES, gw = (F.vcu * NWAVES + F.wave + rot) % NGW, lane = F_LANE;
    const int nkb = K / 64, nnb = (ncol ? ncol : N) / 32, per = nkb * nnb, total = per * nmat;
    for (int it = gw; it < total; it += NGW) {
        const int mi = it / per, r = it % per, kb = r / nnb, nb = r % nnb, n0 = nb * 32;
        int drow = n0;
        if (mode == 2) drow = (n0 >> 7) * 256 + (n0 & 127);
        else if (mode == 3) drow = (n0 >> 7) * 256 + 128 + (n0 & 127);
        transpose_item(src + (size_t)mi * sstride, N, dst + (size_t)mi * dstride, ldt, drow, kb * 64, n0, scale, scr, lane, mode == 1);
    }
}

__device__ __forceinline__ float fp8_scale(float amax) { return (amax > 0.f) ? exp2f(fminf(floorf(log2f(448.f / amax)), 100.f)) : 1.f; }
__device__ __forceinline__ unsigned pk4_fp8(float a, float b, float c, float d) { int w = 0; w = __builtin_amdgcn_cvt_pk_fp8_f32(a, b, w, false); w = __builtin_amdgcn_cvt_pk_fp8_f32(c, d, w, true); return (unsigned)w; }
__device__ __forceinline__ void convert_gate8(Frame& F, const float* w_in_l, const unsigned* amax_l, unsigned char* WG8, float* SW, int rot) {
    LAS float* scr = (LAS float*)(F.lds + RING_OFF + F.wave * 16384);
    const int NGW = F.G * NWAVES, gw = (F.vcu * NWAVES + F.wave + rot) % NGW, lane = F_LANE;
    for (int it = gw; it < 16 * 128; it += NGW) {
        const int kb = it / 128, nb = it % 128, k0 = kb * 64, g0 = nb * 32;
#pragma unroll
        for (int i = 0; i < 32; ++i) { const int kk = 2 * i + (lane >> 5); scr[kk * 33 + (lane & 31)] = w_in_l[(size_t)(k0 + kk) * D_IN + NPROJ_SRC + g0 + (lane & 31)]; }
        LDS_WAIT(); asm volatile("" ::: "memory");
#pragma unroll
        for (int j = 0; j < 2; ++j) { const int n = (lane >> 2) + 16 * j, c = lane & 3;
            const float sc = fp8_scale(__uint_as_float(amax_l[g0 + n])); const LAS float* sp = scr + (16 * c) * 33 + n;
            v4u o; o.x = pk4_fp8(sp[0 * 33] * sc, sp[1 * 33] * sc, sp[2 * 33] * sc, sp[3 * 33] * sc); o.y = pk4_fp8(sp[4 * 33] * sc, sp[5 * 33] * sc, sp[6 * 33] * sc, sp[7 * 33] * sc);
            o.z = pk4_fp8(sp[8 * 33] * sc, sp[9 * 33] * sc, sp[10 * 33] * sc, sp[11 * 33] * sc); o.w = pk4_fp8(sp[12 * 33] * sc, sp[13 * 33] * sc, sp[14 * 33] * sc, sp[15 * 33] * sc);
            const int drow = win_row(NPROJ_SRC + g0 + n) - PROJW;
            *(v4u*)(WG8 + (size_t)drow * DM + k0 + 16 * c) = o;
            if (kb == 0 && c == 0) SW[drow] = 1.f / sc; }
        LDS_WAIT(); asm volatile("" ::: "memory");
    }
}

__device__ __forceinline__ void convert_w8_job(Frame& F, const float* src, size_t sstride, int N, unsigned char* dst, size_t dstride, int mode, const unsigned* amax, int astride, float* SW, int swstride, int nmat, int rot, int K = DM) {
    LAS float* scr = (LAS float*)(F.lds + RING_OFF + F.wave * 16384);
    const int NGW = F.G * NWAVES, gw = (F.vcu * NWAVES + F.wave + rot) % NGW, lane = F_LANE;
    const int nnb = N / 32, per = (K / 64) * nnb, total = per * nmat;
    for (int it = gw; it < total; it += NGW) {
        const int mi = it / per, r = it % per, kb = r / nnb, nb = r % nnb, k0 = kb * 64, n0 = nb * 32;
        const float* W = src + (size_t)mi * sstride;
#pragma unroll
        for (int i = 0; i < 32; ++i) { const int kk = 2 * i + (lane >> 5); scr[kk * 33 + (lane & 31)] = W[(size_t)(k0 + kk) * N + n0 + (lane & 31)]; }
        LDS_WAIT(); asm volatile("" ::: "memory");
        const int drow0 = (mode == 0) ? n0 : (n0 >> 7) * 256 + (n0 & 127) + (mode == 3 ? 128 : 0);
#pragma unroll
        for (int j = 0; j < 2; ++j) { const int n = (lane >> 2) + 16 * j, c = lane & 3;
            const float sc = fp8_scale(__uint_as_float(amax[(size_t)mi * astride + n0 + n])); const LAS float* sp = scr + (16 * c) * 33 + n;
            v4u o; o.x = pk4_fp8(sp[0 * 33] * sc, sp[1 * 33] * sc, sp[2 * 33] * sc, sp[3 * 33] * sc); o.y = pk4_fp8(sp[4 * 33] * sc, sp[5 * 33] * sc, sp[6 * 33] * sc, sp[7 * 33] * sc);
            o.z = pk4_fp8(sp[8 * 33] * sc, sp[9 * 33] * sc, sp[10 * 33] * sc, sp[11 * 33] * sc); o.w = pk4_fp8(sp[12 * 33] * sc, sp[13 * 33] * sc, sp[14 * 33] * sc, sp[15 * 33] * sc);
            *(v4u*)(dst + (size_t)mi * dstride + (size_t)(drow0 + n) * K + k0 + 16 * c) = o;
            if (kb == 0 && c == 0) SW[(size_t)mi * swstride + drow0 + n] = 1.f / sc; }
        LDS_WAIT(); asm volatile("" ::: "memory");
    }
}
__device__ __forceinline__ void amax_job(Frame& F, const float* src, size_t sstride, int N, unsigned* amax, int astride, int nmat, int K = DM) {
    const int NGW = F.G * NWAVES, gw = F.vcu * NWAVES + F.wave, lane = F_LANE, ncb = N / 256, per = (K / 64) * ncb;
    for (int it = gw; it < per * nmat; it += NGW) { const int mi = it / per, r = it % per, kb = r / ncb, cb = r % ncb;
        const float* wp = src + (size_t)mi * sstride + (size_t)(kb * 64) * N + cb * 256 + 4 * lane; float4 mx = make_float4(0.f, 0.f, 0.f, 0.f);
#pragma unroll 16
        for (int q = 0; q < 64; ++q) { const float4 v = *(const float4*)(wp + (size_t)q * N); mx.x = fmaxf(mx.x, fabsf(v.x)); mx.y = fmaxf(mx.y, fabsf(v.y)); mx.z = fmaxf(mx.z, fabsf(v.z)); mx.w = fmaxf(mx.w, fabsf(v.w)); }
        unsigned* am = amax + (size_t)mi * astride + cb * 256 + 4 * lane;
        atomicMax(am + 0, __float_as_uint(mx.x)); atomicMax(am + 1, __float_as_uint(mx.y)); atomicMax(am + 2, __float_as_uint(mx.z)); atomicMax(am + 3, __float_as_uint(mx.w)); }
}
enum { IN_X = 0, IN_C, IN_POS, IN_N1G, IN_N2G, IN_ADAW, IN_ADAB, IN_WIN, IN_CONVW, IN_CQG, IN_WUQ, IN_CKVG, IN_WUKV, IN_QNG, IN_KNG, IN_GVG, IN_WS, IN_BS, IN_RETG, IN_WBR, IN_WO,
       IN_F1, IN_F3, IN_F2, IN_RW, IN_RB, IN_M1, IN_M3, IN_M2, N_IN };
enum { PH_PRO = 0, PH_PRO2 = 1, PL_NORM1 = 0, PL_INPROJ, PL_PRE, PL_SCAN, PL_ATTN, PL_GATE, PL_MERGE, PL_WO, PL_NORM2, PL_F0, PL_F1, PL_F2, PL_F3, PL_F4, PL_F5, PL_PER_LAYER = 16, N_PHASES = 2 + 2 * PL_PER_LAYER };
__host__ __device__ constexpr int PHL(int l, int k) { return 2 + l * PL_PER_LAYER + k; }

struct Args { const void* in[N_IN]; float* out; unsigned char* ws; int ph_lo, ph_hi, li, pad; };


typedef const __attribute__((address_space(4))) unsigned long long* karg_t;
__device__ __forceinline__ const void* karg_ptr(int idx) { karg_t k = (karg_t)__builtin_amdgcn_kernarg_segment_ptr(); asm volatile("" : "+s"(k)); return (const void*)(const __attribute__((address_space(1))) char*)k[idx]; }
#define K_IN(i) (karg_ptr(i))
#define K_OUT ((float*)karg_ptr(N_IN))
#define K_WS ((unsigned char*)karg_ptr(N_IN + 1))
__device__ __forceinline__ void norm_phase(Frame& F, const float* X, bf16* H, const float* gain, const float* ada_l, const int off_sh, const int off_sc,
                                           const float* router_w, const float* router_b, nv::Route* route, int* CNT, unsigned char* H8 = nullptr, float* SH = nullptr, const bool x16 = false, const int rbs = 4) {
    int lane_ = F_LANE; asm volatile("" : "+v"(lane_)); const int lane = lane_;
    LAS int* cnt = (LAS int*)(F.lds + RING_OFF);
    for (int blk = F.vcu; blk < NTOK / 128; blk += F.G) {
        if (router_w) { if (F_TID < NEXP) cnt[F_TID] = 0; __syncthreads(); }
        const int b = (blk * 128) / SEQ;
        for (int rb = 0; rb < 16; rb += rbs) {
          float4 gm[4], sh[4];
#pragma unroll
          for (int j = 0; j < 4; ++j) { const int col = 4 * (lane + 64 * j);
            const float4 g = *(const float4*)(gain + col), sc = *(const float4*)(ada_l + (size_t)b * 6 * DM + off_sc + col);
            gm[j] = make_float4(g.x * (1.f + sc.x), g.y * (1.f + sc.y), g.z * (1.f + sc.z), g.w * (1.f + sc.w));
            sh[j] = *(const float4*)(ada_l + (size_t)b * 6 * DM + off_sh + col); }
          {
          pg8::f32x4 v4[4][4];
#pragma unroll
          for (int q = 0; q < 4; ++q) if (q < rbs)
#pragma unroll
              for (int j = 0; j < 4; ++j) { const size_t xo = (size_t)(blk * 128 + F.wave * 16 + rb + q) * DM + 4 * (lane + 64 * j);
                  if (x16) { const pg8::u32x2 r = *(const pg8::u32x2*)((const bf16*)X + xo); v4[q][j] = (pg8::f32x4){pg8::bflo(r.x), pg8::bfhi(r.x), pg8::bflo(r.y), pg8::bfhi(r.y)}; }
                  else v4[q][j] = *(const pg8::f32x4*)(X + xo); }
#pragma unroll
          for (int qp = 0; qp < 4; qp += 2) if (qp < rbs) {
          pg8::f32x4 hall[2][4], lgq[2][2];
#pragma unroll
          for (int q = 0; q < 2; ++q) {
            const int m = blk * 128 + F.wave * 16 + rb + qp + q;
            float4 v[4]; float ss = 0.f;
#pragma unroll
            for (int j = 0; j < 4; ++j) { v[j] = make_float4(v4[qp + q][j][0], v4[qp + q][j][1], v4[qp + q][j][2], v4[qp + q][j][3]); ss += v[j].x * v[j].x + v[j].y * v[j].y + v[j].z * v[j].z + v[j].w * v[j].w; }
            ss = wave_sum(ss);
            const float rstd = rsqrtf(ss * (1.f / DM) + EPS);
            float amax = 0.f;
            lgq[q][0] = (pg8::f32x4){0.f, 0.f, 0.f, 0.f}; lgq[q][1] = lgq[q][0];
#pragma unroll
            for (int j = 0; j < 4; ++j) {
                const int col = 4 * (lane + 64 * j);
                const float h0 = v[j].x * rstd * gm[j].x + sh[j].x, h1 = v[j].y * rstd * gm[j].y + sh[j].y, h2 = v[j].z * rstd * gm[j].z + sh[j].z, h3 = v[j].w * rstd * gm[j].w + sh[j].w;
                if (H) { uint2 o; o.x = pk2(h0, h1); o.y = pk2(h2, h3); *(uint2*)(H + (size_t)m * DM + col) = o; }
                hall[q][j] = (pg8::f32x4){h0, h1, h2, h3};
                if (H8) amax = fmaxf(fmaxf(amax, fmaxf(fabsf(h0), fabsf(h1))), fmaxf(fabsf(h2), fabsf(h3)));
            }
            if (H8) {
#pragma unroll
                for (int o = 1; o < 64; o <<= 1) amax = fmaxf(amax, __shfl_xor(amax, o));
                const float sc = fp8_scale(amax);
#pragma unroll
                for (int j = 0; j < 4; ++j) *(unsigned*)(H8 + (size_t)m * DM + 4 * (lane + 64 * j)) = pk4_fp8(hall[q][j][0] * sc, hall[q][j][1] * sc, hall[q][j][2] * sc, hall[q][j][3] * sc);
                if (lane == 0) SH[m] = 1.f / sc;
            }
          }
          if (router_w) {
#pragma unroll
            for (int j = 0; j < 4; ++j) {
                const float4* rw = (const float4*)(router_w + (size_t)(4 * (lane + 64 * j)) * NEXP);
#pragma unroll
                for (int q2 = 0; q2 < 2; ++q2) { const float4 w0 = rw[q2], w1 = rw[2 + q2], w2 = rw[4 + q2], w3 = rw[6 + q2];
#pragma unroll
                    for (int q = 0; q < 2; ++q) { const float h0 = hall[q][j][0], h1 = hall[q][j][1], h2 = hall[q][j][2], h3 = hall[q][j][3];
                        lgq[q][q2][0] += h0 * w0.x + h1 * w1.x + h2 * w2.x + h3 * w3.x; lgq[q][q2][1] += h0 * w0.y + h1 * w1.y + h2 * w2.y + h3 * w3.y;
                        lgq[q][q2][2] += h0 * w0.z + h1 * w1.z + h2 * w2.z + h3 * w3.z; lgq[q][q2][3] += h0 * w0.w + h1 * w1.w + h2 * w2.w + h3 * w3.w; } }
            }
#pragma unroll
            for (int q = 0; q < 2; ++q) { const int m = blk * 128 + F.wave * 16 + rb + qp + q; float lg[NEXP];
#pragma unroll
                for (int e = 0; e < NEXP; ++e) lg[e] = wave_sum(lgq[q][e >> 2][e & 3]) + router_b[e];
                if (lane == 0) {
                    int e0 = 0; float l0 = lg[0];
#pragma unroll
                    for (int e = 1; e < NEXP; ++e) if (lg[e] > l0) { l0 = lg[e]; e0 = e; }
                    int e1 = -1; float l1 = -INFINITY;
#pragma unroll
                    for (int e = 0; e < NEXP; ++e) if (e != e0 && lg[e] > l1) { l1 = lg[e]; e1 = e; }
                    const float p0 = 1.f / (1.f + __expf(l1 - l0));
                    nv::Route r; r.e0 = e0; r.e1 = e1; r.p0 = p0; r.p1 = 1.f - p0; route[m] = r;
                    atomicAdd((int*)&cnt[e0], 1); atomicAdd((int*)&cnt[e1], 1);
                }
            }
          }
          }
          }
        }
        if (router_w) { __syncthreads(); if (F_TID < NEXP) CNT[blk * NEXP + F_TID] = cnt[F_TID]; __syncthreads(); }
    }
}

__device__ __forceinline__ void moe_assign_phase(Frame& F, const Args& args) {
    unsigned char* ws = K_WS;
    const nv::Route* route = (const nv::Route*)(ws + WS_ROUTE); const int* CNT = (const int*)(ws + WS_CNT); const unsigned char* H8 = ws + WS_H8; unsigned char* XS8 = ws + WS_XS8; const float* SH = (const float*)(ws + WS_SH); float* SXS = (float*)(ws + WS_SXS);
    int* SLOT = (int*)(ws + WS_SLOT); float* PSLOT = (float*)(ws + WS_PSLOT); int* PEXP = (int*)(ws + WS_PEXP); int* TOK = (int*)(ws + WS_TOK);
    LAS int* sm = (LAS int*)(F.lds + RING_OFF);
    LAS int* tot = sm; LAS int* pre = sm + 8; LAS int* base = sm + 16; LAS int* wcnt = sm + 32; LAS int* ss0 = sm + 64; LAS int* ss1 = sm + 192;
    const int tid = F_TID, lane = F_LANE, w = F.wave;
    for (int blk = F.vcu; blk < NTOK / 128; blk += F.G) {
        if (tid < 16) sm[tid] = 0;
        __syncthreads();
        if (tid < 256) { const int4 c0 = *(const int4*)(CNT + tid * NEXP), c1 = *(const int4*)(CNT + tid * NEXP + 4); const int cc[8] = {c0.x, c0.y, c0.z, c0.w, c1.x, c1.y, c1.z, c1.w};
#pragma unroll
            for (int e = 0; e < NEXP; ++e) { int tv = cc[e], pv = (tid < blk) ? cc[e] : 0;
#pragma unroll
                for (int o = 1; o < 64; o <<= 1) { tv += __shfl_xor(tv, o); pv += __shfl_xor(pv, o); }
                if (lane == 0) { (void)__hip_atomic_fetch_add(tot + e, tv, __ATOMIC_RELAXED, __HIP_MEMORY_SCOPE_WORKGROUP); (void)__hip_atomic_fetch_add(pre + e, pv, __ATOMIC_RELAXED, __HIP_MEMORY_SCOPE_WORKGROUP); } } }
        __syncthreads();
        if (tid == 0) { int bsum = 0; for (int e = 0; e < NEXP; ++e) { base[e] = bsum; bsum += (tot[e] + 255) & ~255; } base[NEXP] = bsum; }
        __syncthreads();
        if (blk == 0) { for (int p = tid; p < MAXPANEL + 8; p += NWAVES * 64) { int e = -1;
#pragma unroll
                for (int x = 0; x < NEXP; ++x) if (p * 256 >= base[x] && p * 256 < base[x + 1]) e = x;
                if (p == MAXPANEL) e = base[NEXP] >> 8; PEXP[p] = e; } }
        if (blk < NEXP) { const int e = blk; for (int s = base[e] + tot[e] + tid; s < base[e + 1]; s += NWAVES * 64) { PSLOT[s] = 0.f; TOK[s] = -1; } }
        if (tid < 128) {
            const int t = blk * 128 + tid; const nv::Route r = route[t]; int rank0 = 0, rank1 = 0;
#pragma unroll
            for (int e = 0; e < NEXP; ++e) { const bool in = (r.e0 == e) || (r.e1 == e); const unsigned long long m = __ballot(in); if (lane == 0) wcnt[w * 8 + e] = __popcll(m);
                const int rk = __popcll(m & ((1ull << lane) - 1ull)); if (r.e0 == e) rank0 = rk; if (r.e1 == e) rank1 = rk; }
            ss0[tid] = rank0; ss1[tid] = rank1;
        }
        __syncthreads();
        if (tid < 128) {
            const int t = blk * 128 + tid; const nv::Route r = route[t]; int rank0 = ss0[tid], rank1 = ss1[tid];
            if (w == 1) { rank0 += wcnt[r.e0]; rank1 += wcnt[r.e1]; }
            const int s0 = base[r.e0] + pre[r.e0] + rank0, s1 = base[r.e1] + pre[r.e1] + rank1;
            SLOT[2 * t] = s0; SLOT[2 * t + 1] = s1; PSLOT[s0] = r.p0; PSLOT[s1] = r.p1; TOK[s0] = t; TOK[s1] = t;
        }
        __syncthreads();
        __syncthreads();
    }
}
__device__ __forceinline__ void moe_gather_phase(Frame& F) {
    unsigned char* ws = K_WS; const int* TOK = (const int*)(ws + WS_TOK); const unsigned char* H8 = ws + WS_H8; unsigned char* XS8 = ws + WS_XS8; const float* SH = (const float*)(ws + WS_SH); float* SXS = (float*)(ws + WS_SXS);
    const int total = ((const int*)(ws + WS_PEXP))[MAXPANEL] * 256, per = (total + F.G - 1) / F.G, lane = F_LANE;
    const int s_lo = F.vcu * per, s_hi = (s_lo + per < total) ? s_lo + per : total;
    for (int s0 = s_lo + F.wave * 8; s0 < s_hi; s0 += NWAVES * 8) {
        int tk[8];
#pragma unroll
        for (int i = 0; i < 8; ++i) tk[i] = (s0 + i < s_hi) ? TOK[s0 + i] : -1;
        v4u v[8]; float sc[8];
#pragma unroll
        for (int i = 0; i < 8; ++i) { const int tt = tk[i] < 0 ? 0 : tk[i]; v[i] = *(const v4u*)(H8 + (size_t)tt * DM + lane * 16); sc[i] = SH[tt]; }
#pragma unroll
        for (int i = 0; i < 8; ++i) if (tk[i] >= 0) { *(v4u*)(XS8 + (size_t)(s0 + i) * DM + lane * 16) = v[i]; if (lane == 0) SXS[s0 + i] = sc[i]; }
    }
}

__device__ __forceinline__ float4 moe_yrow(const bf16* Y, const bf16* PART, int slot, int tail0, int c4) {
    if (slot < tail0) { const uint2 a = *(const uint2*)(Y + (size_t)slot * DM + c4); return make_float4(bf2f((bf16)(a.x & 0xffff)), bf2f((bf16)(a.x >> 16)), bf2f((bf16)(a.y & 0xffff)), bf2f((bf16)(a.y >> 16))); }
    float4 r = make_float4(0.f, 0.f, 0.f, 0.f);
#pragma unroll
    for (int kq = 0; kq < 2; ++kq) { const uint2 a = *(const uint2*)(PART + ((size_t)kq * (MAXTAIL * 256) + (slot - tail0)) * DM + c4);
        r.x += bf2f((bf16)(a.x & 0xffff)); r.y += bf2f((bf16)(a.x >> 16)); r.z += bf2f((bf16)(a.y & 0xffff)); r.w += bf2f((bf16)(a.y >> 16)); }
    return r;
}
__device__ __forceinline__ void moe_combine_phase(Frame& F, float* X, const bf16* Y, const bf16* PART, const int tail0, const int* SLOT, const float* g2) {
    const int gw = F.vcu * NWAVES + F.wave, NGW = F.G * NWAVES;
    for (int t0 = gw; t0 < NTOK; t0 += 2 * NGW) {
        const int t1 = t0 + NGW; const bool two = (t1 < NTOK); const int tb = two ? t1 : t0;
        int sl[4] = {SLOT[2 * t0], SLOT[2 * t0 + 1], SLOT[2 * tb], SLOT[2 * tb + 1]};
        const bf16* yp[4];
#pragma unroll
        for (int q = 0; q < 4; ++q) yp[q] = (sl[q] < tail0) ? Y + (size_t)sl[q] * DM : PART + (size_t)(sl[q] - tail0) * DM;
        uint2 yr[4][4]; float4 xa[4], xb[4], ga[4], gb[4];
#pragma unroll
        for (int j = 0; j < 4; ++j) { const int c4 = 4 * (F_LANE + 64 * j);
#pragma unroll
            for (int q = 0; q < 4; ++q) yr[q][j] = *(const uint2*)(yp[q] + c4);
            xa[j] = *(const float4*)(X + (size_t)t0 * DM + c4); xb[j] = *(const float4*)(X + (size_t)tb * DM + c4);
            ga[j] = *(const float4*)(g2 + (size_t)(t0 / SEQ) * 6 * DM + c4); gb[j] = *(const float4*)(g2 + (size_t)(tb / SEQ) * 6 * DM + c4); }
        float4 ys[4][4];
#pragma unroll
        for (int q = 0; q < 4; ++q)
#pragma unroll
            for (int j = 0; j < 4; ++j) { const uint2 a = yr[q][j]; ys[q][j] = make_float4(bf2f((bf16)(a.x & 0xffff)), bf2f((bf16)(a.x >> 16)), bf2f((bf16)(a.y & 0xffff)), bf2f((bf16)(a.y >> 16))); }
#pragma unroll
        for (int q = 0; q < 4; ++q) if (sl[q] >= tail0) {
#pragma unroll
            for (int j = 0; j < 4; ++j) { const int c4 = 4 * (F_LANE + 64 * j); const uint2 a = *(const uint2*)(PART + ((size_t)(MAXTAIL * 256) + (sl[q] - tail0)) * DM + c4);
                ys[q][j].x += bf2f((bf16)(a.x & 0xffff)); ys[q][j].y += bf2f((bf16)(a.x >> 16)); ys[q][j].z += bf2f((bf16)(a.y & 0xffff)); ys[q][j].w += bf2f((bf16)(a.y >> 16)); } }
#pragma unroll
        for (int j = 0; j < 4; ++j) { const int c4 = 4 * (F_LANE + 64 * j);
            { const float4 g = ga[j]; float4 x = xa[j];
              x.x += g.x * (ys[0][j].x + ys[1][j].x); x.y += g.y * (ys[0][j].y + ys[1][j].y); x.z += g.z * (ys[0][j].z + ys[1][j].z); x.w += g.w * (ys[0][j].w + ys[1][j].w); *(float4*)(X + (size_t)t0 * DM + c4) = x; }
            if (two) { const float4 g = gb[j]; float4 x = xb[j];
              x.x += g.x * (ys[2][j].x + ys[3][j].x); x.y += g.y * (ys[2][j].y + ys[3][j].y); x.z += g.z * (ys[2][j].z + ys[3][j].z); x.w += g.w * (ys[2][j].w + ys[3][j].w); *(float4*)(X + (size_t)t1 * DM + c4) = x; } }
    }
}

__device__ __forceinline__ void scan_phase(Frame& F, float* RET) {
    LAS float* T = (LAS float*)(F.lds + RING_OFF);
    const int tid = F_TID, el = tid & 127, seg = tid >> 7;
    for (int blk = F.vcu; blk < NBATCH * NHEAD * 4096 / 128; blk += F.G) {
        const int idx = blk * 128 + el, b = idx / (NHEAD * 4096), h = (idx / 4096) % NHEAD, ed = idx % 4096;
        const float cd = __expf(nv::ret_loggamma(h) * 128.f);
        float* p = RET + ((size_t)(b * NCHUNK + seg * 32) * NHEAD + h) * 4096 + ed; const size_t stp = (size_t)NHEAD * 4096;
        float v[32];
#pragma unroll
        for (int i = 0; i < 32; ++i) v[i] = p[(size_t)i * stp];
        float st = 0.f;
#pragma unroll
        for (int i = 0; i < 32; ++i) { const float kv = v[i]; v[i] = st; st = st * cd + kv; }
        T[seg * 128 + el] = st;
        __syncthreads();
        float cd32 = cd;
#pragma unroll
        for (int i = 0; i < 5; ++i) cd32 *= cd32;
        float carry = 0.f;
        for (int s2 = 0; s2 < seg; ++s2) carry = carry * cd32 + T[s2 * 128 + el];
        float w = carry;
#pragma unroll
        for (int i = 0; i < 32; ++i) { p[(size_t)i * stp] = v[i] + w; w *= cd; }
        __syncthreads();
    }
}
typedef short bf16x8 __attribute__((ext_vector_type(8)));
typedef float f32x4 __attribute__((ext_vector_type(4)));
typedef float f32x16 __attribute__((ext_vector_type(16)));
#define MFMA16(a, b, c) __builtin_amdgcn_mfma_f32_16x16x32_bf16((a), (b), (c), 0, 0, 0)
__device__ __forceinline__ float bflo_(unsigned w) { return __uint_as_float(w << 16); }
__device__ __forceinline__ float bfhi_(unsigned w) { return __uint_as_float(w & 0xffff0000u); }
__device__ __forceinline__ float sumsq8(bf16x8 v) { float s = 0.f;
#pragma unroll
    for (int i = 0; i < 8; ++i) { const float f = bf2f((bf16)v[i]); s += f * f; } return s; }
__device__ __forceinline__ int tofs(int row, int j) { return row * 256 + ((((j >> 3) ^ (row & 15)) << 4) | ((j & 7) << 1)); }
__device__ __forceinline__ float fast_gelu_tanh(float x) { const float u = 0.7978845608028654f * (x + 0.044715f * x * x * x);
    return x * __builtin_amdgcn_rcpf(1.f + __builtin_amdgcn_exp2f(-2.885390081777927f * u)); }

__device__ __forceinline__ void rope_sincos(const float fpos, const float f, float* s, float* c) {
    const float c_hi = 0.15915494f, c_lo = 6.4206e-9f;
    const float x_hi = fpos * f, x_lo = fmaf(fpos, f, -x_hi);
    const float r_hi = x_hi * c_hi, r_lo = fmaf(x_hi, c_hi, -r_hi) + x_hi * c_lo + x_lo * c_hi;
    const float fr = (r_hi - floorf(r_hi)) + r_lo;
    *s = __builtin_amdgcn_sinf(fr); *c = __builtin_amdgcn_cosf(fr);
}

template <int l> __device__ __forceinline__ void pre_conv(Frame& F, const Args& args, const int t0) {
    const bf16* P = (const bf16*)(K_WS + WS_PROJ); bf16* YB = (bf16*)(K_WS + WS_YB); const float* cw = (const float*)K_IN(IN_CONVW) + l * 3 * MIXW;
    int tid_ = F_TID; asm volatile("" : "+v"(tid_)); const int cg = tid_ & 31, tl = tid_ >> 5, c0 = cg * 8, tb = t0 + tl * 8, sb = tb % SEQ;
    float w0[8], w1[8], w2[8], u1[8], u2[8];
#pragma unroll
    for (int i = 0; i < 8; ++i) { w0[i] = cw[c0 + i]; w1[i] = cw[256 + c0 + i]; w2[i] = cw[512 + c0 + i]; u1[i] = 0.f; u2[i] = 0.f; }
    auto ldu = [&](int t, float* u) { const v4u a = *(const v4u*)(P + (size_t)t * PROJW + C_AC + c0), x = *(const v4u*)(P + (size_t)t * PROJW + C_AX + c0);
        u[0] = bflo_(a.x) * bflo_(x.x); u[1] = bfhi_(a.x) * bfhi_(x.x); u[2] = bflo_(a.y) * bflo_(x.y); u[3] = bfhi_(a.y) * bfhi_(x.y);
        u[4] = bflo_(a.z) * bflo_(x.z); u[5] = bfhi_(a.z) * bfhi_(x.z); u[6] = bflo_(a.w) * bflo_(x.w); u[7] = bfhi_(a.w) * bfhi_(x.w); };
    if (sb >= 1) ldu(tb - 1, u1);
    if (sb >= 2) ldu(tb - 2, u2);
    v4u la[8], lx[8], lb[8];
#pragma unroll
    for (int i = 0; i < 8; ++i) { const size_t o = (size_t)(tb + i) * PROJW + c0; la[i] = *(const v4u*)(P + o + C_AC); lx[i] = *(const v4u*)(P + o + C_AX); lb[i] = *(const v4u*)(P + o + C_AB); }
#pragma unroll
    for (int i = 0; i < 8; ++i) { const int t = tb + i; float u0[8];
        { const v4u a = la[i], x = lx[i];
          u0[0] = bflo_(a.x) * bflo_(x.x); u0[1] = bfhi_(a.x) * bfhi_(x.x); u0[2] = bflo_(a.y) * bflo_(x.y); u0[3] = bfhi_(a.y) * bfhi_(x.y);
          u0[4] = bflo_(a.z) * bflo_(x.z); u0[5] = bfhi_(a.z) * bfhi_(x.z); u0[6] = bflo_(a.w) * bflo_(x.w); u0[7] = bfhi_(a.w) * bfhi_(x.w); }
        const v4u ab = lb[i]; const float bb[8] = {bflo_(ab.x), bfhi_(ab.x), bflo_(ab.y), bfhi_(ab.y), bflo_(ab.z), bfhi_(ab.z), bflo_(ab.w), bfhi_(ab.w)};
        float y[8];
#pragma unroll
        for (int c = 0; c < 8; ++c) { y[c] = bb[c] * (w0[c] * u2[c] + w1[c] * u1[c] + w2[c] * u0[c]); u2[c] = u1[c]; u1[c] = u0[c]; }
        v4u o; o.x = pk2(y[0], y[1]); o.y = pk2(y[2], y[3]); o.z = pk2(y[4], y[5]); o.w = pk2(y[6], y[7]);
        *(v4u*)(YB + (size_t)t * DM + c0) = o; }
}

template <int l> __device__ __forceinline__ void pre_mla(Frame& F, const Args& args, const int t0) {
    unsigned char* ws = K_WS;
    const bf16* P = (const bf16*)(ws + WS_PROJ); bf16* Q = (bf16*)(ws + WS_Q); bf16* Kb = (bf16*)(ws + WS_K); bf16* VT = (bf16*)(ws + WS_VT);
    const bf16* WUQ = (const bf16*)(ws + WS_WUQ_T) + (size_t)l * QW * 256; const bf16* WUKV = (const bf16*)(ws + WS_WUKV_T) + (size_t)l * 512 * 128;
    const float* qn_g = (const float*)K_IN(IN_QNG) + l * QKH; const float* kn_g = (const float*)K_IN(IN_KNG) + l * QKH; const int* pos = (const int*)K_IN(IN_POS);
    int lane_ = F_LANE; asm volatile("" : "+v"(lane_)); const int lr = lane_ & 15, lq = lane_ >> 4;
    const int tw = t0 + F.wave * 16 + lr, b = t0 / SEQ, sw = (t0 % SEQ) + F.wave * 16;
    const bf16* prow = P + (size_t)tw * PROJW;
    bf16x8 xq[8], xkv[4]; float ssq = 0.f, sskv = 0.f;
#pragma unroll
    for (int s = 0; s < 8; ++s) { xq[s] = *(const bf16x8*)(prow + C_CQ + 32 * s + 8 * lq); ssq += sumsq8(xq[s]); }
#pragma unroll
    for (int s = 0; s < 4; ++s) { xkv[s] = *(const bf16x8*)(prow + C_CKV + 32 * s + 8 * lq); sskv += sumsq8(xkv[s]); }
    ssq += __shfl_xor(ssq, 16); ssq += __shfl_xor(ssq, 32); sskv += __shfl_xor(sskv, 16); sskv += __shfl_xor(sskv, 32);
    const float rq = rsqrtf(ssq * (1.f / 256) + EPS), rkv = rsqrtf(sskv * (1.f / 128) + EPS);
    float cs[4], sn[4]; { const float fpos = (float)pos[tw];
#pragma unroll
        for (int r = 0; r < 4; ++r) rope_sincos(fpos, powf(10000.f, -(float)(4 * lq + r) / 16.f), &sn[r], &cs[r]); }
    LAS unsigned char* wl = F.lds + RING_OFF; const int tid_w = F_TID;
    v4u wv6[6], wv4[4];
#pragma unroll
    for (int i = 0; i < 6; ++i) { const int p = tid_w + 512 * i; wv6[i] = *(const v4u*)(WUQ + (size_t)(p >> 5) * 256 + (p & 31) * 8); }
#pragma unroll 1
    for (int h = 0; h < NHEAD; ++h) {
        __syncthreads();
#pragma unroll
        for (int i = 0; i < 6; ++i) { const int p = tid_w + 512 * i; *(LAS v4u*)(wl + (p >> 5) * 528 + (p & 31) * 16) = wv6[i]; }
        __syncthreads();
        if (h + 1 < NHEAD) {
#pragma unroll
            for (int i = 0; i < 6; ++i) { const int p = tid_w + 512 * i; wv6[i] = *(const v4u*)(WUQ + (size_t)((h + 1) * 96 + (p >> 5)) * 256 + (p & 31) * 8); }
        } else {
#pragma unroll
            for (int i = 0; i < 4; ++i) { const int p = tid_w + 512 * i; wv4[i] = *(const v4u*)(WUKV + (size_t)(p >> 4) * 128 + (p & 15) * 8); }
        }
        f32x4 acc[6];
#pragma unroll
        for (int nt = 0; nt < 6; ++nt) acc[nt] = (f32x4){0.f, 0.f, 0.f, 0.f};
#pragma unroll
        for (int s = 0; s < 8; ++s)
#pragma unroll
            for (int nt = 0; nt < 6; ++nt) { const bf16x8 wf = *(const LAS bf16x8*)(wl + (nt * 16 + lr) * 528 + (32 * s + 8 * lq) * 2); acc[nt] = MFMA16(wf, xq[s], acc[nt]); }
        float ss = 0.f;
#pragma unroll
        for (int nt = 0; nt < 6; ++nt) { acc[nt] = acc[nt] * rq; ss += acc[nt][0] * acc[nt][0] + acc[nt][1] * acc[nt][1] + acc[nt][2] * acc[nt][2] + acc[nt][3] * acc[nt][3]; }
        ss += __shfl_xor(ss, 16); ss += __shfl_xor(ss, 32);
        const float rh = rsqrtf(ss * (1.f / 96) + EPS);
#pragma unroll
        for (int nt = 0; nt < 6; ++nt) { const f32x4 g = *(const f32x4*)(qn_g + nt * 16 + 4 * lq); acc[nt] = acc[nt] * rh * g; }
#pragma unroll
        for (int r = 0; r < 4; ++r) { const float x1 = acc[4][r], x2 = acc[5][r]; acc[4][r] = x1 * cs[r] - x2 * sn[r]; acc[5][r] = x2 * cs[r] + x1 * sn[r]; }
#pragma unroll
        for (int nt = 0; nt < 6; ++nt) { v2u o; o.x = pk2(acc[nt][0] * ATT_C2, acc[nt][1] * ATT_C2); o.y = pk2(acc[nt][2] * ATT_C2, acc[nt][3] * ATT_C2);
            *(v2u*)(Q + (size_t)tw * QW + h * 96 + nt * 16 + 4 * lq) = o; }
    }
    float kr1[4], kr2[4]; { const v2u a = *(const v2u*)(prow + C_KR + 4 * lq), c = *(const v2u*)(prow + C_KR + 16 + 4 * lq);
        kr1[0] = bflo_(a.x); kr1[1] = bfhi_(a.x); kr1[2] = bflo_(a.y); kr1[3] = bfhi_(a.y); kr2[0] = bflo_(c.x); kr2[1] = bfhi_(c.x); kr2[2] = bflo_(c.y); kr2[3] = bfhi_(c.y); }
    float sskr = 0.f;
#pragma unroll
    for (int r = 0; r < 4; ++r) sskr += kr1[r] * kr1[r] + kr2[r] * kr2[r];
    float rkv_r[4];
#pragma unroll
    for (int r = 0; r < 4; ++r) rkv_r[r] = __shfl(rkv, 4 * lq + r);
#pragma unroll 1
    for (int h = 0; h < NHEAD; ++h) {
        __syncthreads();
#pragma unroll
        for (int i = 0; i < 4; ++i) { const int p = tid_w + 512 * i; *(LAS v4u*)(wl + (p >> 4) * 272 + (p & 15) * 16) = wv4[i]; }
        __syncthreads();
        if (h + 1 < NHEAD) {
#pragma unroll
            for (int i = 0; i < 4; ++i) { const int p = tid_w + 512 * i; wv4[i] = *(const v4u*)(WUKV + (size_t)((h + 1) * 128 + (p >> 4)) * 128 + (p & 15) * 8); }
        }
        f32x4 ak[4], av[4];
#pragma unroll
        for (int nt = 0; nt < 4; ++nt) { ak[nt] = (f32x4){0.f, 0.f, 0.f, 0.f}; av[nt] = (f32x4){0.f, 0.f, 0.f, 0.f}; }
#pragma unroll
        for (int s = 0; s < 4; ++s)
#pragma unroll
            for (int nt = 0; nt < 4; ++nt) {
                const bf16x8 wk = *(const LAS bf16x8*)(wl + (nt * 16 + lr) * 272 + (32 * s + 8 * lq) * 2); ak[nt] = MFMA16(wk, xkv[s], ak[nt]);
                const bf16x8 wv = *(const LAS bf16x8*)(wl + (64 + nt * 16 + lr) * 272 + (32 * s + 8 * lq) * 2); av[nt] = MFMA16(xkv[s], wv, av[nt]);
            }
        float ss = sskr;
#pragma unroll
        for (int nt = 0; nt < 4; ++nt) { ak[nt] = ak[nt] * rkv; ss += ak[nt][0] * ak[nt][0] + ak[nt][1] * ak[nt][1] + ak[nt][2] * ak[nt][2] + ak[nt][3] * ak[nt][3]; }
        ss += __shfl_xor(ss, 16); ss += __shfl_xor(ss, 32);
        const float rk = rsqrtf(ss * (1.f / 96) + EPS);
#pragma unroll
        for (int nt = 0; nt < 4; ++nt) { const f32x4 g = *(const f32x4*)(kn_g + nt * 16 + 4 * lq); const f32x4 v = ak[nt] * rk * g; v2u o; o.x = pk2(v[0], v[1]); o.y = pk2(v[2], v[3]);
            *(v2u*)(Kb + (size_t)tw * QW + h * 96 + nt * 16 + 4 * lq) = o; }
        { const f32x4 g1 = *(const f32x4*)(kn_g + 64 + 4 * lq), g2 = *(const f32x4*)(kn_g + 80 + 4 * lq); float o1[4], o2[4];
#pragma unroll
          for (int r = 0; r < 4; ++r) { const float x1 = kr1[r] * rk * g1[r], x2 = kr2[r] * rk * g2[r]; o1[r] = x1 * cs[r] - x2 * sn[r]; o2[r] = x2 * cs[r] + x1 * sn[r]; }
          v2u a; a.x = pk2(o1[0], o1[1]); a.y = pk2(o1[2], o1[3]); *(v2u*)(Kb + (size_t)tw * QW + h * 96 + 64 + 4 * lq) = a;
          v2u c; c.x = pk2(o2[0], o2[1]); c.y = pk2(o2[2], o2[3]); *(v2u*)(Kb + (size_t)tw * QW + h * 96 + 80 + 4 * lq) = c; }
#pragma unroll
        for (int nt = 0; nt < 4; ++nt) { v2u o; o.x = pk2(av[nt][0] * rkv_r[0], av[nt][1] * rkv_r[1]); o.y = pk2(av[nt][2] * rkv_r[2], av[nt][3] * rkv_r[3]);
            *(v2u*)(VT + ((size_t)(b * NHEAD + h) * 64 + nt * 16 + lr) * SEQ + sw + 4 * lq) = o; }
    }
    __syncthreads();
}

template <int l> __device__ __forceinline__ void pre_sgu(Frame& F, const Args& args, const int t0) {
    unsigned char* ws = K_WS;
    const bf16* P = (const bf16*)(ws + WS_PROJ); bf16* YB = (bf16*)(ws + WS_YB); const bf16* WST = (const bf16*)(ws + WS_WS_T) + (size_t)l * 4 * 128 * 128;
    const float* gv_g = (const float*)K_IN(IN_GVG) + l * 256; const float* b_s = (const float*)K_IN(IN_BS) + l * 4 * 128;
    LAS unsigned char* vT = F.lds + RING_OFF;
    int lane_ = F_LANE; asm volatile("" : "+v"(lane_)); const int lane = lane_, lr = lane & 15, lq = lane >> 4, w = F.wave;
    { const f32x4 gg = *(const f32x4*)(gv_g + 4 * lane);
      v2u a16[16];
#pragma unroll
      for (int j = 0; j < 16; ++j) a16[j] = *(const v2u*)(P + (size_t)(t0 + 16 * w + j) * PROJW + C_SV + 4 * lane);
#pragma unroll
      for (int j = 0; j < 16; ++j) { const int s = 16 * w + j; const v2u a = a16[j];
          float v[4] = {fast_gelu_tanh(bflo_(a.x)), fast_gelu_tanh(bfhi_(a.x)), fast_gelu_tanh(bflo_(a.y)), fast_gelu_tanh(bfhi_(a.y))};
          float ss = v[0] * v[0] + v[1] * v[1] + v[2] * v[2] + v[3] * v[3];
          ss += __shfl_xor(ss, 1); ss += __shfl_xor(ss, 2); ss += __shfl_xor(ss, 4); ss += __shfl_xor(ss, 8);
          const float rs = rsqrtf(ss * (1.f / 64) + EPS);
#pragma unroll
          for (int i = 0; i < 4; ++i) *(LAS bf16*)(vT + tofs(4 * lane + i, s)) = f2bf(v[i] * rs * gg[i]); } }
    __syncthreads();
    const int tw = t0 + 16 * w + lr, nks = (16 * w + 15) / 32 + 1;
#pragma unroll 1
    for (int g = 0; g < 4; ++g) {
        f32x4 acc[4];
#pragma unroll
        for (int ct = 0; ct < 4; ++ct) acc[ct] = (f32x4){0.f, 0.f, 0.f, 0.f};
        bf16x8 wf4[4]; v2u au[4];
#pragma unroll
        for (int ks = 0; ks < 4; ++ks) wf4[ks] = *(const bf16x8*)(WST + ((size_t)g * 128 + 16 * w + lr) * 128 + 32 * ks + 8 * lq);
#pragma unroll
        for (int ct = 0; ct < 4; ++ct) au[ct] = *(const v2u*)(P + (size_t)tw * PROJW + C_SU + g * 64 + ct * 16 + 4 * lq);
        const float bb = b_s[g * 128 + 16 * w + lr];
#pragma unroll
        for (int ks = 0; ks < 4; ++ks) if (ks < nks) { const bf16x8 wf = wf4[ks];
#pragma unroll
            for (int ct = 0; ct < 4; ++ct) { const bf16x8 vf = *(const LAS bf16x8*)(vT + tofs(g * 64 + ct * 16 + lr, 32 * ks + 8 * lq)); acc[ct] = MFMA16(vf, wf, acc[ct]); } }
#pragma unroll
        for (int ct = 0; ct < 4; ++ct) { const v2u a = au[ct];
            v2u o; o.x = pk2(fast_gelu_tanh(bflo_(a.x)) * (acc[ct][0] + bb), fast_gelu_tanh(bfhi_(a.x)) * (acc[ct][1] + bb)); o.y = pk2(fast_gelu_tanh(bflo_(a.y)) * (acc[ct][2] + bb), fast_gelu_tanh(bfhi_(a.y)) * (acc[ct][3] + bb));
            *(v2u*)(YB + (size_t)tw * DM + 512 + g * 64 + ct * 16 + 4 * lq) = o; }
    }
    __syncthreads();
}

__device__ __forceinline__ void pre_retkv(Frame& F, const Args& args, const int t0, const int ch) {
    unsigned char* ws = K_WS;
    bf16* P = (bf16*)(ws + WS_PROJ); float* RET = (float*)(ws + WS_RET); const int* pos = (const int*)K_IN(IN_POS);
    LAS unsigned char* kT = F.lds + RING_OFF; LAS unsigned char* vT = F.lds + RING_OFF + 65536;
    int lane_ = F_LANE; asm volatile("" : "+v"(lane_)); const int lane = lane_, lr = lane & 15, lq = lane >> 4, w = F.wave;
    { const int h = lane >> 4, i0 = (lane & 15) * 2; const float lg = nv::ret_loggamma(h);
      const float f0 = powf(10000.f, -(float)i0 / 32.f), f1 = powf(10000.f, -(float)(i0 + 1) / 32.f);
      for (int jb = 0; jb < 16; jb += 8) {
        unsigned q1a[8], q2a[8], k1a[8], k2a[8]; v2u vva[8]; int posa[8];
#pragma unroll
        for (int jj = 0; jj < 8; ++jj) { const int s = 16 * w + jb + jj; const bf16* r = P + (size_t)(t0 + s) * PROJW; posa[jj] = pos[t0 + s];
            q1a[jj] = *(const unsigned*)(r + C_RQ + h * 64 + i0); q2a[jj] = *(const unsigned*)(r + C_RQ + h * 64 + 32 + i0); k1a[jj] = *(const unsigned*)(r + C_RK + h * 64 + i0); k2a[jj] = *(const unsigned*)(r + C_RK + h * 64 + 32 + i0);
            vva[jj] = *(const v2u*)(r + C_RV + 4 * lane); }
#pragma unroll
        for (int jj = 0; jj < 8; ++jj) { const int j = jb + jj; const int s = 16 * w + j; bf16* r = P + (size_t)(t0 + s) * PROJW; const float fpos = (float)posa[jj];
          const unsigned q1 = q1a[jj], q2 = q2a[jj], k1 = k1a[jj], k2 = k2a[jj];
          const v2u vv = vva[jj];
          float s0, c0, s1, c1; rope_sincos(fpos, f0, &s0, &c0); rope_sincos(fpos, f1, &s1, &c1);
          const float dq = __expf(lg * (float)s), dk = 0.125f * __expf(-lg * (float)s);
          const unsigned qa = pk2((bflo_(q1) * c0 - bflo_(q2) * s0) * dq, (bfhi_(q1) * c1 - bfhi_(q2) * s1) * dq), qb = pk2((bflo_(q2) * c0 + bflo_(q1) * s0) * dq, (bfhi_(q2) * c1 + bfhi_(q1) * s1) * dq);
          const unsigned ka = pk2((bflo_(k1) * c0 - bflo_(k2) * s0) * dk, (bfhi_(k1) * c1 - bfhi_(k2) * s1) * dk), kb = pk2((bflo_(k2) * c0 + bflo_(k1) * s0) * dk, (bfhi_(k2) * c1 + bfhi_(k1) * s1) * dk);
          *(unsigned*)(r + C_RQ + h * 64 + i0) = qa; *(unsigned*)(r + C_RQ + h * 64 + 32 + i0) = qb; *(unsigned*)(r + C_RK + h * 64 + i0) = ka; *(unsigned*)(r + C_RK + h * 64 + 32 + i0) = kb;
          *(LAS bf16*)(kT + tofs(h * 64 + i0, s)) = (bf16)(ka & 0xffff); *(LAS bf16*)(kT + tofs(h * 64 + i0 + 1, s)) = (bf16)(ka >> 16);
          *(LAS bf16*)(kT + tofs(h * 64 + 32 + i0, s)) = (bf16)(kb & 0xffff); *(LAS bf16*)(kT + tofs(h * 64 + 32 + i0 + 1, s)) = (bf16)(kb >> 16);
          *(LAS bf16*)(vT + tofs(4 * lane + 0, s)) = (bf16)(vv.x & 0xffff); *(LAS bf16*)(vT + tofs(4 * lane + 1, s)) = (bf16)(vv.x >> 16);
          *(LAS bf16*)(vT + tofs(4 * lane + 2, s)) = (bf16)(vv.y & 0xffff); *(LAS bf16*)(vT + tofs(4 * lane + 3, s)) = (bf16)(vv.y >> 16); } } }
    __syncthreads();
    { const int h = w >> 1; const float g127 = __expf(nv::ret_loggamma(h) * 127.f);
      f32x4 acc[4][2];
#pragma unroll
      for (int dt = 0; dt < 4; ++dt)
#pragma unroll
          for (int ei = 0; ei < 2; ++ei) acc[dt][ei] = (f32x4){0.f, 0.f, 0.f, 0.f};
#pragma unroll
      for (int ks = 0; ks < 4; ++ks) { bf16x8 vf[2];
#pragma unroll
          for (int ei = 0; ei < 2; ++ei) vf[ei] = *(const LAS bf16x8*)(vT + tofs(h * 64 + ((w & 1) * 2 + ei) * 16 + lr, 32 * ks + 8 * lq));
#pragma unroll
          for (int dt = 0; dt < 4; ++dt) { const bf16x8 kf = *(const LAS bf16x8*)(kT + tofs(h * 64 + dt * 16 + lr, 32 * ks + 8 * lq));
#pragma unroll
              for (int ei = 0; ei < 2; ++ei) acc[dt][ei] = MFMA16(kf, vf[ei], acc[dt][ei]); } }
#pragma unroll
      for (int dt = 0; dt < 4; ++dt)
#pragma unroll
          for (int ei = 0; ei < 2; ++ei) *(f32x4*)(RET + (((size_t)ch * NHEAD + h) * 64 + ((w & 1) * 2 + ei) * 16 + lr) * 64 + dt * 16 + 4 * lq) = acc[dt][ei] * g127; }
    __syncthreads();
}

template <int l> __device__ __forceinline__ void pre_phase(Frame& F, const Args& args) {
    for (int ch = F.vcu; ch < NTOK / CHUNK; ch += F.G) {
        const int t0 = ch * CHUNK;
        pre_conv<l>(F, args, t0);
        pre_mla<l>(F, args, t0);
        pre_sgu<l>(F, args, t0);
        pre_retkv(F, args, t0, ch);
    }
}
#define MFMA32(a, b, c) __builtin_amdgcn_mfma_f32_32x32x16_bf16((a), (b), (c), 0, 0, 0)
typedef short s16x4 __attribute__((ext_vector_type(4)));
constexpr int AT_KROW = 208, AT_VROW = 136, AT_KBYTES = 64 * AT_KROW, AT_STAGE = 22528;
__device__ __forceinline__ int crow32(int r, int hi) { return (r & 3) + 8 * (r >> 2) + 4 * hi; }

__device__ __forceinline__ void attn_unit(Frame& F, const bf16* Q, const bf16* Kb, const bf16* VT, bf16* YB, const float nbnd, const int b, const int h, const int qb) {
    int tid_ = F_TID; asm volatile("" : "+v"(tid_)); const int tid = tid_, lane = tid & 63, r32 = lane & 31, hi = lane >> 5, w = F.wave;
    LAS unsigned char* lds = F.lds + RING_OFF;
    const int bh = b * NHEAD + h, qw0 = qb * 256 + w * 32;
    const size_t tq = (size_t)b * SEQ + qw0 + r32;
    bf16x8 qf[6];
#pragma unroll
    for (int s = 0; s < 6; ++s) qf[s] = *(const bf16x8*)(Q + tq * QW + h * 96 + 16 * s + 8 * hi);
    f32x16 o0, o1, negb; float lsum = 0.f;
#pragma unroll
    for (int r = 0; r < 16; ++r) { o0[r] = 0.f; o1[r] = 0.f; negb[r] = nbnd; }
    asm volatile("" : "+v"(negb));
    const int ntile = 4 * qb + 4;
    const int kr0 = tid / 12, kc0 = tid % 12, kr1 = (tid + 512) / 12, kc1 = (tid + 512) % 12, vd = tid >> 3, vc = tid & 7;
    const bf16* kg0 = Kb + ((size_t)b * SEQ + kr0) * QW + h * 96 + kc0 * 8; const bf16* kg1 = Kb + ((size_t)b * SEQ + kr1) * QW + h * 96 + kc1 * 8;
    const bf16* vg = VT + ((size_t)bh * 64 + vd) * SEQ + vc * 8;
    const int kl0 = kr0 * AT_KROW + kc0 * 16, kl1 = kr1 * AT_KROW + kc1 * 16, vl = AT_KBYTES + vd * AT_VROW + vc * 16;
    v4u rk0, rk1, rv; rk1 = (v4u){0u, 0u, 0u, 0u};
    rk0 = *(const v4u*)kg0; if (tid < 256) rk1 = *(const v4u*)kg1; rv = *(const v4u*)vg;
    *(LAS v4u*)(lds + kl0) = rk0; if (tid < 256) *(LAS v4u*)(lds + kl1) = rk1;
    *(LAS v2u*)(lds + vl) = (v2u){rv.x, rv.y}; *(LAS v2u*)(lds + vl + 8) = (v2u){rv.z, rv.w};
    __syncthreads();
    const int ka = r32 * AT_KROW + hi * 16;
    const int va = AT_KBYTES + r32 * AT_VROW + hi * 8;
    for (int t = 0; t < ntile; ++t) {
        LAS unsigned char* cur = lds + (t & 1) * AT_STAGE; LAS unsigned char* nxt = lds + ((t + 1) & 1) * AT_STAGE;
        const bool more = (t + 1 < ntile);
        if (more) { const size_t ko = (size_t)(t + 1) * 64 * QW; rk0 = *(const v4u*)(kg0 + ko); if (tid < 256) rk1 = *(const v4u*)(kg1 + ko); rv = *(const v4u*)(vg + (t + 1) * 64); }
        if (64 * t <= qw0 + 31) {
            f32x16 p0, p1;
#pragma unroll
            for (int s = 0; s < 6; ++s) { const bf16x8 k0 = *(const LAS bf16x8*)(cur + ka + s * 32), k1 = *(const LAS bf16x8*)(cur + ka + 32 * AT_KROW + s * 32);
                if (s == 0) { p0 = MFMA32(k0, qf[0], negb); p1 = MFMA32(k1, qf[0], negb); } else { p0 = MFMA32(k0, qf[s], p0); p1 = MFMA32(k1, qf[s], p1); } }
#pragma unroll
            for (int r = 0; r < 16; ++r) { p0[r] = __builtin_amdgcn_exp2f(p0[r]); p1[r] = __builtin_amdgcn_exp2f(p1[r]); }
            if (64 * t + 63 > qw0) {
                const int qrel = qw0 + r32 - 64 * t;
#pragma unroll
                for (int r = 0; r < 16; ++r) { const int kk = crow32(r, hi); if (kk > qrel) p0[r] = 0.f; if (kk + 32 > qrel) p1[r] = 0.f; }
            }
            float sacc = 0.f;
#pragma unroll
            for (int r = 0; r < 16; ++r) sacc += p0[r] + p1[r];
            lsum += sacc;
            bf16x8 pb[2][2];
#pragma unroll
            for (int s2 = 0; s2 < 2; ++s2) {
                const v4u a = {pg8::cvt_pk_bf16(p0[8 * s2 + 0], p0[8 * s2 + 1]), pg8::cvt_pk_bf16(p0[8 * s2 + 2], p0[8 * s2 + 3]), pg8::cvt_pk_bf16(p0[8 * s2 + 4], p0[8 * s2 + 5]), pg8::cvt_pk_bf16(p0[8 * s2 + 6], p0[8 * s2 + 7])};
                const v4u c = {pg8::cvt_pk_bf16(p1[8 * s2 + 0], p1[8 * s2 + 1]), pg8::cvt_pk_bf16(p1[8 * s2 + 2], p1[8 * s2 + 3]), pg8::cvt_pk_bf16(p1[8 * s2 + 4], p1[8 * s2 + 5]), pg8::cvt_pk_bf16(p1[8 * s2 + 6], p1[8 * s2 + 7])};
                pb[0][s2] = __builtin_bit_cast(bf16x8, a); pb[1][s2] = __builtin_bit_cast(bf16x8, c); }
#pragma unroll
            for (int kh = 0; kh < 2; ++kh)
#pragma unroll
                for (int s2 = 0; s2 < 2; ++s2) {
                    const int ko = (kh * 32 + 16 * s2) * 2;
                    const s16x4 a0 = *(const LAS s16x4*)(cur + va + ko), a1 = *(const LAS s16x4*)(cur + va + ko + 16);
                    const s16x4 c0 = *(const LAS s16x4*)(cur + va + 32 * AT_VROW + ko), c1 = *(const LAS s16x4*)(cur + va + 32 * AT_VROW + ko + 16);
                    const bf16x8 vf0 = {a0[0], a0[1], a0[2], a0[3], a1[0], a1[1], a1[2], a1[3]}, vf1 = {c0[0], c0[1], c0[2], c0[3], c1[0], c1[1], c1[2], c1[3]};
                    o0 = MFMA32(vf0, pb[kh][s2], o0); o1 = MFMA32(vf1, pb[kh][s2], o1); }
        }
        if (more) { *(LAS v4u*)(nxt + kl0) = rk0; if (tid < 256) *(LAS v4u*)(nxt + kl1) = rk1; *(LAS v2u*)(nxt + vl) = (v2u){rv.x, rv.y}; *(LAS v2u*)(nxt + vl + 8) = (v2u){rv.z, rv.w}; }
        __syncthreads();
    }
    lsum += __shfl_xor(lsum, 32);
    const float il = 1.f / lsum;
    bf16* orow = YB + tq * DM + 256 + h * 64;
#pragma unroll
    for (int g = 0; g < 4; ++g) {
        v2u a; a.x = pg8::cvt_pk_bf16(o0[4 * g] * il, o0[4 * g + 1] * il); a.y = pg8::cvt_pk_bf16(o0[4 * g + 2] * il, o0[4 * g + 3] * il); *(v2u*)(orow + 8 * g + 4 * hi) = a;
        v2u c; c.x = pg8::cvt_pk_bf16(o1[4 * g] * il, o1[4 * g + 1] * il); c.y = pg8::cvt_pk_bf16(o1[4 * g + 2] * il, o1[4 * g + 3] * il); *(v2u*)(orow + 32 + 8 * g + 4 * hi) = c; }
}

template <int l> __device__ __forceinline__ void ret_out_chunk(Frame& F, const Args& args, const int ch) {
    unsigned char* ws = K_WS;
    const bf16* P = (const bf16*)(ws + WS_PROJ); const float* RET = (const float*)(ws + WS_RET); bf16* YB = (bf16*)(ws + WS_YB); const float* ret_g = (const float*)K_IN(IN_RETG) + l * 256;
    LAS unsigned char* vT = F.lds + RING_OFF;
    int lane_ = F_LANE; asm volatile("" : "+v"(lane_)); const int lane = lane_, lr = lane & 15, lq = lane >> 4, w = F.wave;
    const int t0 = ch * CHUNK;
    v2u vv16[16];
#pragma unroll
    for (int j = 0; j < 16; ++j) vv16[j] = *(const v2u*)(P + (size_t)(t0 + 16 * w + j) * PROJW + C_RV + 4 * lane);
#pragma unroll
    for (int j = 0; j < 16; ++j) { const int s = 16 * w + j; const v2u vv = vv16[j];
        *(LAS bf16*)(vT + tofs(4 * lane + 0, s)) = (bf16)(vv.x & 0xffff); *(LAS bf16*)(vT + tofs(4 * lane + 1, s)) = (bf16)(vv.x >> 16);
        *(LAS bf16*)(vT + tofs(4 * lane + 2, s)) = (bf16)(vv.y & 0xffff); *(LAS bf16*)(vT + tofs(4 * lane + 3, s)) = (bf16)(vv.y >> 16); }
    __syncthreads();
    const size_t ti = (size_t)t0 + 16 * w + lr;
#pragma unroll 1
    for (int h = 0; h < NHEAD; ++h) {
        const float gam = __expf(nv::ret_loggamma(h));
        bf16x8 qf[2];
#pragma unroll
        for (int ks = 0; ks < 2; ++ks) qf[ks] = *(const bf16x8*)(P + ti * PROJW + C_RQ + h * 64 + 32 * ks + 8 * lq);
        f32x4 acc[4];
#pragma unroll
        for (int et = 0; et < 4; ++et) acc[et] = (f32x4){0.f, 0.f, 0.f, 0.f};
        bf16x8 kfa[8][2];
#pragma unroll
        for (int jt = 0; jt < 8; ++jt) if (jt <= w) {
#pragma unroll
            for (int ks = 0; ks < 2; ++ks) kfa[jt][ks] = *(const bf16x8*)(P + (size_t)(t0 + jt * 16 + lr) * PROJW + C_RK + h * 64 + 32 * ks + 8 * lq); }
#pragma unroll
        for (int kk = 0; kk < 4; ++kk) if (kk <= (w >> 1)) {
            const int jt0 = 2 * kk, jt1 = 2 * kk + 1;
            f32x4 s0 = {0.f, 0.f, 0.f, 0.f}, s1 = {0.f, 0.f, 0.f, 0.f};
#pragma unroll
            for (int ks = 0; ks < 2; ++ks) s0 = MFMA16(kfa[jt0][ks], qf[ks], s0);
            if (jt1 <= w) {
#pragma unroll
                for (int ks = 0; ks < 2; ++ks) s1 = MFMA16(kfa[jt1][ks], qf[ks], s1); }
            if (jt0 == w) {
#pragma unroll
                for (int r = 0; r < 4; ++r) if (4 * lq + r > lr) s0[r] = 0.f; }
            if (jt1 == w) {
#pragma unroll
                for (int r = 0; r < 4; ++r) if (4 * lq + r > lr) s1[r] = 0.f; }
            const v4u pw = {pk2(s0[0], s0[1]), pk2(s0[2], s0[3]), pk2(s1[0], s1[1]), pk2(s1[2], s1[3])};
            const bf16x8 pb = __builtin_bit_cast(bf16x8, pw);
#pragma unroll
            for (int et = 0; et < 4; ++et) { const int row = h * 64 + et * 16 + lr;
                const s16x4 a0 = *(const LAS s16x4*)(vT + tofs(row, jt0 * 16 + 4 * lq)), a1 = *(const LAS s16x4*)(vT + tofs(row, (jt1 & 7) * 16 + 4 * lq));
                const bf16x8 vf = {a0[0], a0[1], a0[2], a0[3], a1[0], a1[1], a1[2], a1[3]};
                acc[et] = MFMA16(vf, pb, acc[et]); }
        }
#pragma unroll
        for (int ks = 0; ks < 2; ++ks)
#pragma unroll
            for (int et = 0; et < 4; ++et) { const float* pr = RET + (((size_t)ch * NHEAD + h) * 64 + et * 16 + lr) * 64 + 32 * ks + 8 * lq; const f32x4 x0 = *(const f32x4*)pr, x1 = *(const f32x4*)(pr + 4);
                const v4u pw = {pk2(x0[0] * gam, x0[1] * gam), pk2(x0[2] * gam, x0[3] * gam), pk2(x1[0] * gam, x1[1] * gam), pk2(x1[2] * gam, x1[3] * gam)};
                acc[et] = MFMA16(__builtin_bit_cast(bf16x8, pw), qf[ks], acc[et]); }
        float mu = 0.f;
#pragma unroll
        for (int et = 0; et < 4; ++et) mu += acc[et][0] + acc[et][1] + acc[et][2] + acc[et][3];
        mu += __shfl_xor(mu, 16); mu += __shfl_xor(mu, 32); mu *= (1.f / 64);
        float var = 0.f;
#pragma unroll
        for (int et = 0; et < 4; ++et) { acc[et] = acc[et] - mu; var += acc[et][0] * acc[et][0] + acc[et][1] * acc[et][1] + acc[et][2] * acc[et][2] + acc[et][3] * acc[et][3]; }
        var += __shfl_xor(var, 16); var += __shfl_xor(var, 32);
        const float rs = rsqrtf(var * (1.f / 64) + EPS);
        v2u rga[4]; f32x4 ga[4];
#pragma unroll
        for (int et = 0; et < 4; ++et) { const int c = h * 64 + et * 16 + 4 * lq; rga[et] = *(const v2u*)(P + ti * PROJW + C_RG + c); ga[et] = *(const f32x4*)(ret_g + c); }
#pragma unroll
        for (int et = 0; et < 4; ++et) { const int c = h * 64 + et * 16 + 4 * lq; const v2u rg = rga[et]; const f32x4 g = ga[et];
            const float r0 = bflo_(rg.x), r1 = bfhi_(rg.x), r2 = bflo_(rg.y), r3 = bfhi_(rg.y);
            v2u o; o.x = pk2(r0 * pg8::fast_sigmoid(r0) * acc[et][0] * rs * g[0], r1 * pg8::fast_sigmoid(r1) * acc[et][1] * rs * g[1]);
            o.y = pk2(r2 * pg8::fast_sigmoid(r2) * acc[et][2] * rs * g[2], r3 * pg8::fast_sigmoid(r3) * acc[et][3] * rs * g[3]);
            *(v2u*)(YB + ti * DM + 768 + c) = o; }
    }
    __syncthreads();
}

template <int l> __device__ __forceinline__ void attn_phase(Frame& F, const Args& args) {
    for (int p = F.vcu; p < NBATCH * NHEAD * 32; p += F.G) {
        const int bh = p >> 5, s = p & 31; const float nbnd = -((const float*)(K_WS + WS_BND))[l];
        attn_unit(F, (const bf16*)(K_WS + WS_Q), (const bf16*)(K_WS + WS_K), (const bf16*)(K_WS + WS_VT), (bf16*)(K_WS + WS_YB), nbnd, bh / NHEAD, bh % NHEAD, 63 - s);
        attn_unit(F, (const bf16*)(K_WS + WS_Q), (const bf16*)(K_WS + WS_K), (const bf16*)(K_WS + WS_VT), (bf16*)(K_WS + WS_YB), nbnd, bh / NHEAD, bh % NHEAD, s);
    }
    for (int ch = F.vcu; ch < NTOK / CHUNK; ch += F.G) ret_out_chunk<l>(F, args, ch);
}
#ifndef MEGA_THIN
#define MEGA_THIN 0
#endif

#ifndef FFN_FP8
#define FFN_FP8 0
#endif
#ifndef GATE_FP8
#define GATE_FP8 1
#endif
#ifndef REV_GM
#define REV_GM 15
#endif
#ifndef REV_FD
#define REV_FD 15
#endif
#ifndef XB16
#define XB16 1
#endif
#ifndef RPT_MASK
#define RPT_MASK 0
#endif
#define RPT(bit) _Pragma("unroll") for (int rep_ = 0; rep_ < 1 + ((RPT_MASK >> (bit)) & 1); ++rep_)
__device__ __forceinline__ bool in_range(int k, int lo, int hi) { asm volatile("" : "+s"(lo)); return lo <= k && k < hi; }
#define IN(k) (in_range((k), lo, hi))
#ifndef BAR_REP
#define BAR_REP 1
#endif
#define SEAM(k) do { if (IN(k) && IN((k) + 1)) { for (int br_ = 0; br_ < BAR_REP; ++br_) xcd_barrier(bar, F.wave); } } while (0)
#define INF(i) ((const float*)K_IN(i))
template <int l> __device__ __forceinline__ void layer_phases(Frame& F, const Args& args, const XcdBarrier& bar, const int lo, const int hi) {
#define ws (K_WS)
#define ADA ((float*)(K_WS + WS_ADA))
#define bH ((bf16*)(K_WS + WS_H))
#define bYB ((bf16*)(K_WS + WS_YB))
#define bP ((bf16*)(K_WS + WS_PROJ))
#define bG ((bf16*)(K_WS + WS_G))
#define bMG bYB
#define bU bP
#define bX (K_OUT)
#define ring (F.lds + RING_OFF)
#define ada_l (ADA + (size_t)l * 2 * 6 * DM)
#define Xin ((l == 0) ? INF(IN_X) : (const float*)bX)
#define WIN_T ((const bf16*)(K_WS + WS_WIN_T) + (size_t)l * 6912 * DM)

        if (IN(PHL(l, PL_NORM1))) { RPT(8) {
#if MEGA_THIN >= 1
            norm_phase(F, (XB16 && l > 0) ? (const float*)(K_WS + WS_XB) : Xin, bH, INF(IN_N1G) + l * DM, ada_l, A_SH1, A_SC1, nullptr, nullptr, nullptr, nullptr, GATE_FP8 ? (unsigned char*)(K_WS + WS_H8) : nullptr, (float*)(K_WS + WS_SH), XB16 && l > 0);
#endif
        } }
        SEAM(PHL(l, PL_NORM1));
        if (IN(PHL(l, PL_INPROJ))) { RPT(1) {
            pg8::DenseOrder S{(const char*)bH, (const char*)WIN_T, (size_t)256 * DM * 2, (size_t)256 * DM * 2, NTOK / 256, PROJW / 256, F.G, (int)blockIdx.x};
            pg8::EpiBf16<0> E{bP, PROJW, 0};
            pg8::gemm_phase(ring, F.wave, DM, DM, DM, S, E);
        } }
        SEAM(PHL(l, PL_INPROJ));
        if (IN(PHL(l, PL_PRE))) {
#if MEGA_THIN >= 2
            pre_phase<l>(F, args);
#endif
        }
        SEAM(PHL(l, PL_PRE));
        if (IN(PHL(l, PL_SCAN))) {
#if MEGA_THIN >= 1
            scan_phase(F, (float*)(ws + WS_RET));
#endif
        }
        SEAM(PHL(l, PL_SCAN));
        if (IN(PHL(l, PL_ATTN))) { RPT(2) {
#if MEGA_THIN >= 3
            attn_phase<l>(F, args);
#endif
        } }
        SEAM(PHL(l, PL_ATTN));
        if (IN(PHL(l, PL_GATE))) { RPT(3) {
            pg8::MergeOrder S{(const char*)bYB, (const char*)((const bf16*)(K_WS + WS_WBR_T) + (size_t)l * 4 * DM * MIXW), NTOK / 256, DM / 256, F.G, (int)blockIdx.x};
            pg8::EpiZTile E{bG};
            int kz = MIXW; asm volatile("" : "+s"(kz));
            pg8::gemm_phase(ring, F.wave, DM, MIXW, kz, S, E);
        } }
        SEAM(PHL(l, PL_GATE));
        if (IN(PHL(l, PL_MERGE))) { RPT(4) {
#if GATE_FP8
            pg8::DenseOrder S{(const char*)(K_WS + WS_H8), (const char*)(WIN_T + (size_t)PROJW * DM), (size_t)256 * DM, (size_t)256 * DM, NTOK / 256, GATEW / 256, F.G, (int)blockIdx.x, REV_GM};
            pg8::EpiGM8 E{bG, bMG, (const float*)(K_WS + WS_SH), (const float*)(K_WS + WS_SW) + l * GATEW};
            int kg = DM / 2; asm volatile("" : "+s"(kg));
            pg8::gemm_phase<pg8::EpiGM8, pg8::DenseOrder, true>(ring, F.wave, DM / 2, DM / 2, kg, S, E);
#else
            pg8::DenseOrder S{(const char*)bH, (const char*)(WIN_T + (size_t)PROJW * DM), (size_t)256 * DM * 2, (size_t)256 * DM * 2, NTOK / 256, GATEW / 256, F.G, (int)blockIdx.x};
            pg8::EpiGM E{bG, bMG};
            pg8::gemm_phase(ring, F.wave, DM, DM, DM, S, E);
#endif
        } }
        SEAM(PHL(l, PL_MERGE));
        if (IN(PHL(l, PL_WO))) {
            pg8::DenseOrder S{(const char*)bMG, (const char*)((const bf16*)(ws + WS_WO_T) + (size_t)l * DM * DM), (size_t)256 * DM * 2, (size_t)256 * DM * 2, NTOK / 256, DM / 256, F.G, (int)blockIdx.x};
#if XB16
            if constexpr (l == 0) { pg8::EpiResidT<false, true> E{INF(IN_X), (void*)(K_WS + WS_XB), ada_l + A_G1}; pg8::gemm_phase(ring, F.wave, DM, DM, DM, S, E); }
            else { pg8::EpiResidT<true, false> E{(const void*)(K_WS + WS_XB), (void*)bX, ada_l + A_G1}; pg8::gemm_phase(ring, F.wave, DM, DM, DM, S, E); }
#else
            pg8::EpiResid E{Xin, bX, ada_l + A_G1};
            pg8::gemm_phase(ring, F.wave, DM, DM, DM, S, E);
#endif
        }
        SEAM(PHL(l, PL_WO));
        if (IN(PHL(l, PL_NORM2))) {
#if MEGA_THIN >= 1
            if (l == 0) norm_phase(F, XB16 ? (const float*)(K_WS + WS_XB) : (const float*)bX, bH, INF(IN_N2G) + l * DM, ada_l, A_SH2, A_SC2, nullptr, nullptr, nullptr, nullptr, FFN_FP8 ? (unsigned char*)(K_WS + WS_H8) : nullptr, (float*)(K_WS + WS_SH), XB16 != 0);
            else norm_phase(F, bX, nullptr  , INF(IN_N2G) + l * DM, ada_l, A_SH2, A_SC2, INF(IN_RW), INF(IN_RB), (nv::Route*)(ws + WS_ROUTE), (int*)(ws + WS_CNT), (unsigned char*)(K_WS + WS_H8), (float*)(K_WS + WS_SH), false, 2);
#endif
        }
        SEAM(PHL(l, PL_NORM2));
        if constexpr (l == 0) {
            if (IN(PHL(l, PL_F0))) { RPT(5) {
#if FFN_FP8
                pg8::DenseOrder S{(const char*)(K_WS + WS_H8), (const char*)(ws + WS_F13_T), (size_t)256 * DM, (size_t)256 * DM, NTOK / 256, 2 * DFF / 256, F.G, (int)blockIdx.x};
                pg8::EpiSwiglu8 E{bU, DFF, (const float*)(K_WS + WS_SH), (const float*)(K_WS + WS_SWF)};
                int kf = DM / 2; asm volatile("" : "+s"(kf));
                pg8::gemm_phase<pg8::EpiSwiglu8, pg8::DenseOrder, true>(ring, F.wave, DM / 2, DM / 2, kf, S, E);
#else
                pg8::DenseOrder S{(const char*)bH, (const char*)(ws + WS_F13_T), (size_t)256 * DM * 2, (size_t)256 * DM * 2, NTOK / 256, 2 * DFF / 256, F.G, (int)blockIdx.x};
                pg8::EpiSwiglu E{bU, DFF};
                pg8::gemm_phase(ring, F.wave, DM, DM, DM, S, E);
#endif
            } }
            SEAM(PHL(l, PL_F0));
            if (IN(PHL(l, PL_F1))) {
                pg8::DenseOrder S{(const char*)bU, (const char*)(ws + WS_F2_T), (size_t)256 * DFF * 2, (size_t)256 * DFF * 2, NTOK / 256, DM / 256, F.G, (int)blockIdx.x, REV_FD};
#if XB16
                pg8::EpiResidT<true, true> E{(const void*)(K_WS + WS_XB), (void*)(K_WS + WS_XB), ada_l + A_G2};
#else
                pg8::EpiResid E{bX, bX, ada_l + A_G2};
#endif
                pg8::gemm_phase(ring, F.wave, DFF, DFF, DFF, S, E);
            }
            SEAM(PHL(l, PL_F1));
        } else {
#define XS ((bf16*)(K_WS + WS_XS))
#define HID ((bf16*)(K_WS + WS_HID))
#define PEXP ((const int*)(K_WS + WS_PEXP))
#define PSLOT ((const float*)(K_WS + WS_PSLOT))
            if (IN(PHL(l, PL_F0))) {
#if MEGA_THIN >= 1
                moe_assign_phase(F, args);
#endif
                RPT(9) {
                amax_job(F, INF(IN_M1), (size_t)DM * DFFE, DFFE, (unsigned*)(K_WS + WS_AMAXM), DFFE, NEXP);
                amax_job(F, INF(IN_M3), (size_t)DM * DFFE, DFFE, (unsigned*)(K_WS + WS_AMAXM) + NEXP * DFFE, DFFE, NEXP);
                amax_job(F, INF(IN_M2), (size_t)DFFE * DM, DM, (unsigned*)(K_WS + WS_AMAXM) + AMAXM_W2, DM, NEXP, DFFE);
                xcd_barrier(bar, F.wave);
                if (rep_ == 0) moe_gather_phase(F);
                convert_w8_job(F, INF(IN_M1), (size_t)DM * DFFE, DFFE, (unsigned char*)(K_WS + WS_MW13_T), (size_t)2 * DFFE * DM, 2, (const unsigned*)(K_WS + WS_AMAXM), DFFE, (float*)(K_WS + WS_SWM), 2 * DFFE, NEXP, 0);
                convert_w8_job(F, INF(IN_M3), (size_t)DM * DFFE, DFFE, (unsigned char*)(K_WS + WS_MW13_T), (size_t)2 * DFFE * DM, 3, (const unsigned*)(K_WS + WS_AMAXM) + NEXP * DFFE, DFFE, (float*)(K_WS + WS_SWM), 2 * DFFE, NEXP, 977);
                convert_w8_job(F, INF(IN_M2), (size_t)DFFE * DM, DM, (unsigned char*)(K_WS + WS_MW2_T), (size_t)DM * DFFE, 0, (const unsigned*)(K_WS + WS_AMAXM) + AMAXM_W2, DM, (float*)(K_WS + WS_SWM2), DM, NEXP, 1301, DFFE);
                }
            }
            SEAM(PHL(l, PL_F0));
            for (int c = 0; c < NCH; ++c) {
                const int p0 = c * CH0_PANELS; int npan = PEXP[MAXPANEL] - p0; { const int cap = (c == 0) ? CH0_PANELS : CH1_PANELS; npan = npan > cap ? cap : npan; }
                if (IN(PHL(l, PL_F1 + 2 * c))) { RPT(6) {
                    pg8::MoeOrder S{(const char*)(K_WS + WS_XS8 + (size_t)p0 * 256 * DM), (const char*)(ws + WS_MW13_T), (size_t)256 * DM, (size_t)256 * DM, PEXP, p0, npan, 2 * DFFE / 256, F.G, (int)blockIdx.x};
                    pg8::EpiSwiglu8X E{(unsigned char*)(K_WS + WS_HID), (unsigned char*)(K_WS + WS_SCT), (const float*)(K_WS + WS_SXS) + p0 * 256, (const float*)(K_WS + WS_SWM)};
                    int ku = DM / 2; asm volatile("" : "+s"(ku));
                    pg8::gemm_phase<pg8::EpiSwiglu8X, pg8::MoeOrder, 1>(ring, F.wave, DM / 2, DM / 2, ku, S, E);
                } }
                SEAM(PHL(l, PL_F1 + 2 * c));
                if (IN(PHL(l, PL_F2 + 2 * c))) { RPT(7) {
                    const int nreg = (c == 1 && npan > CH0_PANELS) ? CH0_PANELS : npan, ntail = npan - nreg;
                    { pg8::MoeOrderX S{(const char*)(K_WS + WS_HID), (const char*)(ws + WS_MW2_T), (const char*)(K_WS + WS_SCT), (size_t)256 * DFFE, (size_t)256 * DFFE, (size_t)28 * 1024, PEXP, p0, nreg, DM / 256, F.G, (int)blockIdx.x};
                      pg8::EpiMoeDown8 E{XS + (size_t)p0 * 256 * DM, PSLOT + p0 * 256, (const float*)(K_WS + WS_SWM2)};
                      pg8::gemm_phase<pg8::EpiMoeDown8, pg8::MoeOrderX, 2>(ring, F.wave, DFFE / 2, DFFE / 2, DFFE / 2, S, E); }
                    if (c == 1 && ntail > 0) {
                        pg8::MoeTailOrderX S{(const char*)(K_WS + WS_HID) + (size_t)nreg * 256 * DFFE, (const char*)(ws + WS_MW2_T), (const char*)(K_WS + WS_SCT) + (size_t)nreg * 28 * 1024, (size_t)256 * DFFE, (size_t)256 * DFFE, (size_t)28 * 1024, PEXP, p0 + nreg, ntail, F.G, (int)blockIdx.x};
                        pg8::EpiMoePart8 E{(bf16*)(K_WS + WS_PART), PSLOT + (p0 + nreg) * 256, (const float*)(K_WS + WS_SWM2)};
                        int kq = 896; asm volatile("" : "+s"(kq));
                        pg8::gemm_phase<pg8::EpiMoePart8, pg8::MoeTailOrderX, 2>(ring, F.wave, DFFE / 2, DFFE / 2, kq, S, E);
                    }
                } }
                SEAM(PHL(l, PL_F2 + 2 * c));
            }
            if (IN(PHL(l, PL_F5))) {
#if MEGA_THIN >= 1
                { const int ptot = PEXP[MAXPANEL], tail0 = (ptot > 2 * CH0_PANELS) ? 2 * CH0_PANELS * 256 : 0x7fffffff;
                  moe_combine_phase(F, bX, XS, (const bf16*)(K_WS + WS_PART), tail0, (const int*)(ws + WS_SLOT), ada_l + A_G2); }
#endif
            }
        }
#undef XS
#undef HID
#undef PEXP
#undef PSLOT
#undef ws
#undef ADA
#undef bH
#undef bYB
#undef bP
#undef bG
#undef bMG
#undef bU
#undef bX
#undef ring
#undef ada_l
#undef Xin
#undef WIN_T
}

__global__ void __launch_bounds__(NWAVES * 64, 2) mega(Args args) {
    extern __shared__ __attribute__((aligned(16))) unsigned char lds_raw[];
    Frame F;
    F.lds = (LAS unsigned char*)lds_raw;
    F.MISC = (volatile LAS unsigned*)(F.lds + MISC_OFF);
    F.wave = __builtin_amdgcn_readfirstlane((int)threadIdx.x >> 6);
    F.G = gridDim.x; { const int bx = blockIdx.x; F.vcu = (F.G % 8 == 0) ? (bx % 8) * (F.G / 8) + bx / 8 : bx; }
    unsigned char* ws = K_WS;
    F.ctl = (unsigned*)(ws + WS_CTL);
    for (int u = F_TID; u < (LDS_BYTES - LDSCTL_OFF) / 4; u += NWAVES * 64) ((LAS unsigned*)(F.lds + LDSCTL_OFF))[u] = 0u;
    __syncthreads();
    XcdBarrier bar = xcd_barrier_post(F.ctl + CW_BAR + args.li * XCD_BAR_WORDS, F.MISC + 8);
    const int lo = args.ph_lo, hi = args.ph_hi;
    float* ADA = (float*)(ws + WS_ADA); float* BND = (float*)(ws + WS_BND);
    LAS unsigned char* ring = F.lds + RING_OFF;

    if (IN(PH_PRO)) { RPT(0) {
        for (int it = F.vcu; it < DEPTH * 96; it += F.G) {
            const int l = it / 96, j0 = (it % 96) * 64; const float* c = INF(IN_C);
            const float* w = INF(IN_ADAW) + (size_t)l * DM * 6 * DM + j0 + F_LANE;
            float a0 = 0.f, a1 = 0.f;
#pragma unroll 16
            for (int kk = 0; kk < 128; ++kk) { const int k = F.wave * 128 + kk; const float wv = w[(size_t)k * 6 * DM]; const float s0 = silu_f(c[k]), s1 = silu_f(c[DM + k]); a0 += s0 * wv; a1 += s1 * wv; }
            LAS float* red = (LAS float*)ring;
            red[(F.wave * 2 + 0) * 64 + F_LANE] = a0; red[(F.wave * 2 + 1) * 64 + F_LANE] = a1;
            __syncthreads();
            if (F_TID < 128) { const int b = F_TID >> 6, col = F_TID & 63; float s = INF(IN_ADAB)[l * 6 * DM + j0 + col];
#pragma unroll
              for (int w8 = 0; w8 < 8; ++w8) s += red[(w8 * 2 + b) * 64 + col];
              ADA[(size_t)(l * 2 + b) * 6 * DM + j0 + col] = s; }
            __syncthreads();
        }
        if (blockIdx.x == 0 && F_TID < DEPTH) { const int l = F_TID; float a = 0.f, b = 0.f;
            for (int i = 0; i < QKH; ++i) { a = fmaxf(a, fabsf(INF(IN_QNG)[l * QKH + i])); b = fmaxf(b, fabsf(INF(IN_KNG)[l * QKH + i])); }
            BND[l] = 9.797958971132712f * 1.4426950408889634f * a * b * 1.001f; }
        { bf16* WST = (bf16*)(ws + WS_WS_T); const float* wsrc = INF(IN_WS);
          for (int i = (F.vcu * NWAVES * 64 + F_TID); i < DEPTH * 4 * 128 * 128; i += F.G * NWAVES * 64) { const int t = (i >> 7) & 127, s = i & 127; WST[i] = (s <= t) ? f2bf(wsrc[i]) : (bf16)0; } }
        { unsigned* am = (unsigned*)(ws + WS_AMAXM); for (int i = F.vcu * NWAVES * 64 + F_TID; i < 2 * NEXP * DFFE + NEXP * DM; i += F.G * NWAVES * 64) am[i] = 0u; }
        int rot = 0;
        convert_job(F, INF(IN_WIN), (size_t)DM * D_IN, DM, D_IN, (bf16*)(ws + WS_WIN_T), (size_t)6912 * DM, DM, 1, nullptr, DEPTH, rot, GATE_FP8 ? NPROJ_SRC : 0); rot += 331;
        if (GATE_FP8) { const int NGW = F.G * NWAVES, gw = F.vcu * NWAVES + F.wave, lane = F_LANE;
          for (int it = gw; it < DEPTH * 16 * 16; it += NGW) { const int l = it >> 8, kb = (it >> 4) & 15, cb = it & 15; const float* wp = INF(IN_WIN) + (size_t)l * DM * D_IN + (size_t)(kb * 64) * D_IN + NPROJ_SRC + cb * 256 + 4 * lane;
              float4 mx = make_float4(0.f, 0.f, 0.f, 0.f);
#pragma unroll 16
              for (int r = 0; r < 64; ++r) { const float4 v = *(const float4*)(wp + (size_t)r * D_IN); mx.x = fmaxf(mx.x, fabsf(v.x)); mx.y = fmaxf(mx.y, fabsf(v.y)); mx.z = fmaxf(mx.z, fabsf(v.z)); mx.w = fmaxf(mx.w, fabsf(v.w)); }
              unsigned* am = F.ctl + CW_AMAX + l * GATEW + cb * 256 + 4 * lane;
              atomicMax(am + 0, __float_as_uint(mx.x)); atomicMax(am + 1, __float_as_uint(mx.y)); atomicMax(am + 2, __float_as_uint(mx.z)); atomicMax(am + 3, __float_as_uint(mx.w)); } }
        convert_job(F, INF(IN_WBR), (size_t)MIXW * DM, MIXW, DM, (bf16*)(ws + WS_WBR_T), (size_t)DM * MIXW, MIXW, 0, nullptr, DEPTH * 4, rot); rot += 331;
        convert_job(F, INF(IN_WO), (size_t)DM * DM, DM, DM, (bf16*)(ws + WS_WO_T), (size_t)DM * DM, DM, 0, nullptr, DEPTH, rot); rot += 331;
        if (!FFN_FP8) { convert_job(F, INF(IN_F1), 0, DM, DFF, (bf16*)(ws + WS_F13_T), 0, DM, 2, nullptr, 1, rot); rot += 331;
                        convert_job(F, INF(IN_F3), 0, DM, DFF, (bf16*)(ws + WS_F13_T), 0, DM, 3, nullptr, 1, rot); rot += 331; }
        else { amax_job(F, INF(IN_F1), 0, DFF, F.ctl + CW_AMAXF, 0, 1); amax_job(F, INF(IN_F3), 0, DFF, F.ctl + CW_AMAXF + DFF, 0, 1); }
        convert_job(F, INF(IN_F2), 0, DFF, DM, (bf16*)(ws + WS_F2_T), 0, DFF, 0, nullptr, 1, rot); rot += 331;
        for (int l = 0; l < DEPTH; ++l) {
            convert_job(F, INF(IN_WUQ) + (size_t)l * 256 * QW, 0, 256, QW, (bf16*)(ws + WS_WUQ_T) + (size_t)l * QW * 256, 0, 256, 0, INF(IN_CQG) + l * 256, 1, rot); rot += 331;
            convert_job(F, INF(IN_WUKV) + (size_t)l * 128 * 512, 0, 128, 512, (bf16*)(ws + WS_WUKV_T) + (size_t)l * 512 * 128, 0, 128, 0, INF(IN_CKVG) + l * 128, 1, rot); rot += 331;
        }
    } }
    SEAM(PH_PRO);
    if (IN(PH_PRO2) && FFN_FP8) {
        convert_w8_job(F, INF(IN_F1), 0, DFF, (unsigned char*)(K_WS + WS_F13_T), 0, 2, F.ctl + CW_AMAXF, 0, (float*)(K_WS + WS_SWF), 0, 1, 0);
        convert_w8_job(F, INF(IN_F3), 0, DFF, (unsigned char*)(K_WS + WS_F13_T), 0, 3, F.ctl + CW_AMAXF + DFF, 0, (float*)(K_WS + WS_SWF), 0, 1, 555);
    }
    if (IN(PH_PRO2) && GATE_FP8) {
        for (int l = 0; l < DEPTH; ++l)
            convert_gate8(F, INF(IN_WIN) + (size_t)l * DM * D_IN, F.ctl + CW_AMAX + l * GATEW, (unsigned char*)((bf16*)(K_WS + WS_WIN_T) + (size_t)l * 6912 * DM + (size_t)PROJW * DM), (float*)(K_WS + WS_SW) + l * GATEW, l * 977);
    }
    if (GATE_FP8 || FFN_FP8) SEAM(PH_PRO2);

    layer_phases<0>(F, args, bar, lo, hi);
    layer_phases<1>(F, args, bar, lo, hi);
}
#undef IN
#undef SEAM
#undef INF
static int g_grid = 0;
static bool mega_setup() {
    if (g_grid) return g_grid > 0;
    int dev = 0, cus = 0;
    if (hipGetDevice(&dev) != hipSuccess || hipDeviceGetAttribute(&cus, hipDeviceAttributeMultiprocessorCount, dev) != hipSuccess) { g_grid = -1; return false; }
    if (hipFuncSetAttribute((const void*)mega, hipFuncAttributeMaxDynamicSharedMemorySize, LDS_BYTES) != hipSuccess) { fprintf(stderr, "mega: hipFuncSetAttribute failed\n"); g_grid = -1; return false; }
    int per_cu = 0; (void)hipOccupancyMaxActiveBlocksPerMultiprocessor(&per_cu, (const void*)mega, NWAVES * 64, LDS_BYTES); (void)hipGetLastError();
    if (per_cu < 1) { fprintf(stderr, "mega: occupancy query reports %d workgroups per CU\n", per_cu); g_grid = -1; return false; }
    g_grid = cus; return true;
}
extern "C" void kernel_launch(void* const* d_in, const int* in_sizes, int n_in, void* d_out, int out_size, void* d_ws, size_t ws_size, hipStream_t stream) {
    if (n_in != 29 || out_size != NTOK * DM || ws_size < WS_END) { fprintf(stderr, "kernel_launch: unexpected sizes n_in %d out %d ws %zu\n", n_in, out_size, ws_size); return; }
    if (!mega_setup()) return;
    (void)hipMemsetAsync((char*)d_ws + WS_CTL, 0, CTL_ZERO_BYTES, stream);
    Args a{}; for (int i = 0; i < N_IN; ++i) a.in[i] = d_in[i];
    a.out = (float*)d_out; a.ws = (unsigned char*)d_ws; a.ph_lo = 0; a.ph_hi = N_PHASES; a.li = 0; a.pad = 0;
    hipLaunchKernelGGL(mega, dim3(g_grid), dim3(NWAVES * 64), LDS_BYTES, stream, a);
}
```

```cpp
#define MEGA_THIN 3
#include <hip/hip_runtime.h>
#include <cstdio>
#include <cstdint>
#include <cmath>

constexpr int DM = 1024, NBATCH = 2, SEQ = 16384, NTOK = NBATCH * SEQ, DEPTH = 2;
constexpr int MIXW = 256, D_IN = 6816, PROJW = 2816, GATEW = 4096, NPROJ_SRC = 2720;
constexpr int QKH = 96, NHEAD = 4, QW = NHEAD * QKH  , DFF = 2816, NEXP = 8, DFFE = 3584;
constexpr int CHUNK = 128, NCHUNK = SEQ / CHUNK  ;
constexpr float EPS = 1e-6f;
constexpr int C_AB = 0, C_AC = 256, C_AX = 512, C_CQ = 768, C_CKV = 1024, C_KR = 1152, C_SU = 1280, C_SV = 1536, C_RQ = 1792, C_RK = 2048, C_RV = 2304, C_RG = 2560;
constexpr int A_SH1 = 0, A_SC1 = 1024, A_G1 = 2048, A_SH2 = 3072, A_SC2 = 4096, A_G2 = 5120;
constexpr float ATT_C2 = 0.10206207261596575f * 1.4426950408889634f;

constexpr size_t MiB = 1u << 20;
constexpr size_t WS_CTL = 0, CTL_ZERO_BYTES = 1 * MiB;
constexpr size_t WS_ADA = 1 * MiB;
constexpr size_t WS_PSLOT = 1 * MiB + 256 * 1024;
constexpr size_t WS_PEXP = 1 * MiB + 768 * 1024;
constexpr size_t WS_BND = 1 * MiB + 800 * 1024;
constexpr size_t WS_ROUTE = 2 * MiB;
constexpr size_t WS_CNT = 2 * MiB + 512 * 1024;
constexpr size_t WS_SLOT = 2 * MiB + 768 * 1024;
constexpr size_t WS_WUQ_T = 3 * MiB;
constexpr size_t WS_WUKV_T = 3 * MiB + 512 * 1024;
constexpr size_t WS_WS_T = 3 * MiB + 768 * 1024;
constexpr size_t WS_WIN_T = 4 * MiB;
constexpr size_t WS_WBR_T = 31 * MiB;
constexpr size_t WS_WO_T = 35 * MiB;
constexpr size_t WS_F13_T = 39 * MiB;
constexpr size_t WS_F2_T = 50 * MiB;
constexpr size_t WS_H = 56 * MiB;
constexpr size_t WS_YB = 120 * MiB;
constexpr size_t WS_PROJ = 184 * MiB;
constexpr size_t WS_Q = 360 * MiB, WS_K = 384 * MiB, WS_VT = 408 * MiB;
constexpr size_t WS_RET = 424 * MiB;
constexpr size_t WS_G = 184 * MiB;
constexpr size_t WS_MIX_END = 440 * MiB;
constexpr size_t WS_H8 = 440 * MiB;
constexpr size_t WS_SH = 472 * MiB;
constexpr size_t WS_SW = 472 * MiB + 256 * 1024;
constexpr int CW_AMAXF = 230000;
constexpr size_t WS_SWF = 472 * MiB + 256 * 1024 + 64 * 1024;
constexpr int CW_AMAX = 200000;
constexpr int MAXPANEL = 264, MAXSLOT = MAXPANEL * 256, NCH = 2, CH0_PANELS = 128, CH1_PANELS = MAXPANEL - CH0_PANELS;
constexpr size_t WS_HID = 56 * MiB;
constexpr size_t WS_SCT = 176 * MiB;
constexpr size_t WS_MW13_T = 296 * MiB;
constexpr size_t WS_MW2_T = 352 * MiB;
constexpr size_t WS_XS = 464 * MiB;
constexpr size_t WS_PART = 596 * MiB;
constexpr int MAXTAIL = 8;
constexpr size_t WS_XS8 = 530 * MiB;
constexpr size_t WS_AMAXM = 612 * MiB;
constexpr size_t WS_SXS = 612 * MiB + 256 * 1024;
constexpr size_t WS_SWM = 612 * MiB + 576 * 1024;
constexpr size_t WS_SWM2 = 612 * MiB + 800 * 1024;
constexpr int AMAXM_W2 = 2 * NEXP * DFFE;
constexpr size_t WS_XB = 474 * MiB;
constexpr size_t WS_TOK = 613 * MiB;
constexpr size_t WS_END = 614 * MiB;
static_assert(WS_HID + (size_t)CH1_PANELS * 256 * DFFE <= WS_SCT && WS_SCT + (size_t)CH1_PANELS * 28 * 1024 <= WS_MW13_T, "hid");
static_assert(WS_XS + (size_t)MAXSLOT * DM * 2 <= WS_END, "xs");
static_assert(WS_MW13_T >= WS_MIX_END - 256 * MiB, "moe weights may overlay dead mixer buffers only");

typedef unsigned short bf16;
__device__ __forceinline__ float bf2f(bf16 v) { return __uint_as_float(((unsigned)v) << 16); }
__device__ __forceinline__ bf16 f2bf(float f) { unsigned u = __float_as_uint(f); return (bf16)((u + 0x7fffu + ((u >> 16) & 1u)) >> 16); }
__device__ __forceinline__ float bfr(float f) { return bf2f(f2bf(f)); }
__device__ __forceinline__ float silu_f(float x) { return x / (1.f + __expf(-x)); }
__device__ __forceinline__ float sigmoid_f(float x) { return 1.f / (1.f + __expf(-x)); }
__device__ __forceinline__ float gelu_tanh(float x) { const float u = 0.7978845608028654f * (x + 0.044715f * x * x * x); return 0.5f * x * (1.f + tanhf(u)); }

__device__ __forceinline__ int lane_id() { unsigned z = 0u; asm volatile("" : "+s"(z)); return (int)__builtin_amdgcn_mbcnt_hi(~0u, __builtin_amdgcn_mbcnt_lo(~0u, z)); }

namespace nv {
struct Route { int e0, e1; float p0, p1; };
__device__ __forceinline__ float ret_loggamma(int h) { return log1pf(-exp2f(-5.f - (float)h)); }
}
namespace pg8 {
#define PG8_LAS __attribute__((address_space(3)))
typedef short bf16x8 __attribute__((ext_vector_type(8)));
typedef float f32x4 __attribute__((ext_vector_type(4)));
typedef float f32x2 __attribute__((ext_vector_type(2)));
typedef unsigned u32x4 __attribute__((ext_vector_type(4)));
typedef unsigned u32x2 __attribute__((ext_vector_type(2)));
constexpr int BM = 256, BK = 64, HALF = 128, HTB = HALF * BK * 2  , STAGE_BYTES = 8 * HTB, NXCD = 8, WGM = 8;

__host__ __device__ __forceinline__ int lds_byte(int r, int c) { const int st = (r >> 4) * 2 + (c >> 5), rr = r & 15, cc = c & 31, ob = rr * 64 + cc * 2; return st * 1024 + (ob ^ (((ob >> 9) & 1) << 5)); }
__host__ __device__ __forceinline__ void stage_rc(int b, int& R, int& C) { const int st = b / 1024, sb = b % 1024, swz = sb ^ (((sb >> 9) & 1) << 5); R = (st >> 1) * 16 + swz / 64; C = (st & 1) * 32 + (swz % 64) / 2; }
__host__ __device__ __forceinline__ int perm32(int rho) { const int n = rho >> 4, i = rho & 15; return 8 * (i >> 2) + 4 * n + (i & 3); }

struct Unit { const char* A; const char* B; const char* S; int pm, pn, aux, pad; };

__device__ __forceinline__ bool static_tile(int i, int G, int c, int nM, int nN, int& pm, int& pn) {
    const int nwg = nM * nN; const long L = (long)i * G + c; if (L >= nwg) return false;
    int wgid = (int)L; { const int q = nwg / NXCD, r = nwg % NXCD, xcd = wgid % NXCD, off = wgid / NXCD; wgid = (xcd < r ? xcd * (q + 1) : r * (q + 1) + (xcd - r) * q) + off; }
    const int nig = WGM * nN, gid = wgid / nig, fm = gid * WGM, gsz = (nM - fm) < WGM ? (nM - fm) : WGM;
    pm = fm + ((wgid % nig) % gsz); pn = (wgid % nig) / gsz; return true;
}
struct DenseOrder {
    const char* A; const char* B; size_t tA, tB; int nM, nN, G, c, rev = 0;
    __device__ __forceinline__ bool next(int i, Unit& u) const { int pm, pn; if (!static_tile(i, G, c, nM, nN, pm, pn)) return false; pm ^= rev; u.pm = pm; u.pn = pn; u.aux = 0; u.A = A + (size_t)pm * tA; u.B = B + (size_t)pn * tB; return true; }
};
struct ZOrder {
    const char* A; const char* B; int nM, G, c;
    __device__ __forceinline__ bool next(int i, Unit& u) const { int pm, pn; if (!static_tile(i, G, c, nM, 16, pm, pn)) return false; const int n = pn >> 2; u.pm = pm; u.pn = pn; u.aux = n;
        u.A = A + (size_t)pm * (256 * 1024 * 2) + n * 512; u.B = B + (size_t)n * (1024 * 256 * 2) + (size_t)(pn & 3) * (256 * 256 * 2); return true; }
};
struct MergeOrder {
    const char* A; const char* B; int nM, nN, G, c;
    __device__ __forceinline__ bool next(int i, Unit& u) const { int pm, pn; if (!static_tile(i >> 2, G, c, nM, nN, pm, pn)) return false; const int n = i & 3; u.pm = pm; u.pn = pn; u.aux = n;
        u.A = A + (size_t)pm * (256 * 1024 * 2) + n * 512; u.B = B + (size_t)n * (1024 * 256 * 2) + (size_t)pn * (256 * 256 * 2); return true; }
};
struct MoeOrder {
    const char* A; const char* B; size_t tA, tB; const int* pexp; int p0, nM, nN, G, c;
    __device__ __forceinline__ bool next(int i, Unit& u) const { int pm, pn; if (nM <= 0 || !static_tile(i, G, c, nM, nN, pm, pn)) return false; const int e = pexp[p0 + pm]; u.pm = pm; u.pn = pn; u.aux = e;
        u.A = A + (size_t)pm * tA; u.B = B + ((size_t)e * nN + pn) * tB; return true; }
};

typedef __bf16 bf16x2_t __attribute__((ext_vector_type(2)));
__device__ __forceinline__ unsigned cvt_pk_bf16(float lo, float hi) { const f32x2 v = {lo, hi}; return __builtin_bit_cast(unsigned, __builtin_convertvector(v, bf16x2_t)); }
__device__ __forceinline__ float fast_sigmoid(float x) { return __builtin_amdgcn_rcpf(1.f + __builtin_amdgcn_exp2f(-1.4426950408889634f * x)); }
__device__ __forceinline__ float bflo(unsigned w) { return __uint_as_float(w << 16); }
__device__ __forceinline__ float bfhi(unsigned w) { return __uint_as_float(w & 0xffff0000u); }

template <int ACT  > struct EpiBf16 {
    static constexpr bool PERM = true; static constexpr int NST = 16;
    bf16* O; int ldc, aux_cols;
    __device__ __forceinline__ void operator()(const f32x4 (&acc)[2][2][4][2], const Unit& u, int wr, int wc, int fr, int fq) const {
        const int row0 = u.pm * BM + wr * 64 + fr, col0 = u.aux * aux_cols + u.pn * BM + wc * 32 + 8 * fq;
#pragma unroll
        for (int ai = 0; ai < 2; ++ai)
#pragma unroll
            for (int m = 0; m < 4; ++m) { bf16* rowp = O + (size_t)(row0 + ai * HALF + m * 16) * ldc + col0;
#pragma unroll
                for (int bj = 0; bj < 2; ++bj) { f32x4 v0 = acc[ai][bj][m][0], v1 = acc[ai][bj][m][1];
                    if (ACT == 2) {
#pragma unroll
                        for (int i = 0; i < 4; ++i) { v0[i] = fast_sigmoid(v0[i]); v1[i] = fast_sigmoid(v1[i]); } }
                    u32x4 w; w.x = cvt_pk_bf16(v0[0], v0[1]); w.y = cvt_pk_bf16(v0[2], v0[3]); w.z = cvt_pk_bf16(v1[0], v1[1]); w.w = cvt_pk_bf16(v1[2], v1[3]);
                    *(u32x4*)(rowp + bj * HALF) = w; } }
    }
};
struct EpiZTile {
    static constexpr bool PERM = true; static constexpr int NST = 16;
    bf16* O;
    __device__ __forceinline__ void operator()(const f32x4 (&acc)[2][2][4][2], const Unit& u, int wr, int wc, int fr, int fq) const {
        const int rl = wr * 64 + fr;
#pragma unroll
        for (int ai = 0; ai < 2; ++ai)
#pragma unroll
            for (int m = 0; m < 4; ++m)
#pragma unroll
                for (int bj = 0; bj < 2; ++bj) { const f32x4 v0 = acc[ai][bj][m][0], v1 = acc[ai][bj][m][1];
                    const int c = u.pn * BM + bj * HALF + wc * 32 + 8 * fq, pg = c >> 6, cc = c & 63;
                    u32x4 w; w.x = cvt_pk_bf16(v0[0], v0[1]); w.y = cvt_pk_bf16(v0[2], v0[3]); w.z = cvt_pk_bf16(v1[0], v1[1]); w.w = cvt_pk_bf16(v1[2], v1[3]);
                    *(u32x4*)(O + (((size_t)u.pm * 16 + pg) * 256 + rl + ai * HALF + m * 16) * 256 + u.aux * 64 + cc) = w; }
    }
};
struct EpiSwiglu {
    static constexpr bool PERM = true; static constexpr int NST = 8;
    bf16* O; int ldc;
    __device__ __forceinline__ void operator()(const f32x4 (&acc)[2][2][4][2], const Unit& u, int wr, int wc, int fr, int fq) const {
        const int row0 = u.pm * BM + wr * 64 + fr, col0 = u.pn * HALF + wc * 32 + 8 * fq;
#pragma unroll
        for (int ai = 0; ai < 2; ++ai)
#pragma unroll
            for (int m = 0; m < 4; ++m) { bf16* rowp = O + (size_t)(row0 + ai * HALF + m * 16) * ldc + col0; float r[8];
#pragma unroll
                for (int n = 0; n < 2; ++n)
#pragma unroll
                    for (int i = 0; i < 4; ++i) { const float a = acc[ai][0][m][n][i], b = acc[ai][1][m][n][i]; r[n * 4 + i] = a * fast_sigmoid(a) * b; }
                u32x4 w; w.x = cvt_pk_bf16(r[0], r[1]); w.y = cvt_pk_bf16(r[2], r[3]); w.z = cvt_pk_bf16(r[4], r[5]); w.w = cvt_pk_bf16(r[6], r[7]);
                *(u32x4*)rowp = w; }
    }
};
struct EpiSwiglu8 {
    static constexpr bool PERM = true; static constexpr int NST = 8;
    bf16* O; int ldc; const float* sx; const float* sw;
    __device__ __forceinline__ void operator()(const f32x4 (&acc)[2][2][4][2], const Unit& u, int wr, int wc, int fr_, int fq_) const {
        int fr = fr_, fq = fq_; asm volatile("" : "+v"(fr), "+v"(fq));
        const int row0 = u.pm * BM + wr * 64 + fr, col0 = u.pn * HALF + wc * 32 + 8 * fq; const float* swp = sw + (size_t)u.aux * (2 * DFFE) + u.pn * 256 + wc * 32 + 8 * fq;
        const f32x4 sa0 = *(const f32x4*)swp, sa1 = *(const f32x4*)(swp + 4), sb0 = *(const f32x4*)(swp + 128), sb1 = *(const f32x4*)(swp + 132);
#pragma unroll
        for (int ai = 0; ai < 2; ++ai)
#pragma unroll
            for (int m = 0; m < 4; ++m) { const int row = row0 + ai * HALF + m * 16; const float rs = sx[row]; bf16* rowp = O + (size_t)row * ldc + col0; float r[8];
#pragma unroll
                for (int n = 0; n < 2; ++n) { const f32x4 ca = (n == 0 ? sa0 : sa1) * rs, cb = (n == 0 ? sb0 : sb1) * rs;
#pragma unroll
                    for (int i = 0; i < 4; ++i) { const float a = acc[ai][0][m][n][i] * ca[i], b = acc[ai][1][m][n][i] * cb[i]; r[n * 4 + i] = a * fast_sigmoid(a) * b; } }
                u32x4 w; w.x = cvt_pk_bf16(r[0], r[1]); w.y = cvt_pk_bf16(r[2], r[3]); w.z = cvt_pk_bf16(r[4], r[5]); w.w = cvt_pk_bf16(r[6], r[7]);
                *(u32x4*)rowp = w; }
    }
};
struct EpiSwiglu8X {
    static constexpr bool PERM = true; static constexpr int NST = 10;
#ifdef PROBE_X8
    static constexpr bool PROBE_REP = true;
#endif
    unsigned char* O8; unsigned char* SCT; const float* sx; const float* sw;
    __device__ __forceinline__ void operator()(const f32x4 (&acc)[2][2][4][2], const Unit& u, int wr, int wc, int fr_, int fq_) const {
        int fr = fr_, fq = fq_; asm volatile("" : "+v"(fr), "+v"(fq));
        const int row0 = u.pm * BM + wr * 64 + fr, col0 = u.pn * HALF + wc * 32 + 8 * fq; const float* swp = sw + (size_t)u.aux * (2 * DFFE) + u.pn * 256 + wc * 32 + 8 * fq;
        constexpr float NL = -1.4426950408889634f, NIL = -0.6931471805599453f;
        f32x2 sa[4], sb[4];
        { const f32x4 x0 = *(const f32x4*)swp, x1 = *(const f32x4*)(swp + 4), y0 = *(const f32x4*)(swp + 128), y1 = *(const f32x4*)(swp + 132);
          sa[0] = (f32x2){x0[0], x0[1]} * NL; sa[1] = (f32x2){x0[2], x0[3]} * NL; sa[2] = (f32x2){x1[0], x1[1]} * NL; sa[3] = (f32x2){x1[2], x1[3]} * NL;
          sb[0] = (f32x2){y0[0], y0[1]} * NIL; sb[1] = (f32x2){y0[2], y0[3]} * NIL; sb[2] = (f32x2){y1[0], y1[1]} * NIL; sb[3] = (f32x2){y1[2], y1[3]} * NIL; }
        float rsv[2][4];
#pragma unroll
        for (int ai = 0; ai < 2; ++ai)
#pragma unroll
            for (int m = 0; m < 4; ++m) rsv[ai][m] = sx[row0 + ai * HALF + m * 16];
#pragma unroll
        for (int ai = 0; ai < 2; ++ai) { unsigned sd = 0u;
#pragma unroll
            for (int m = 0; m < 4; ++m) { const int row = row0 + ai * HALF + m * 16; const float rs = rsv[ai][m]; f32x2 hp[4], na[4], dn[4]; float amax = 0.f;
#pragma unroll
                for (int j = 0; j < 4; ++j) { const f32x2 A = {acc[ai][0][m][j >> 1][(j & 1) * 2], acc[ai][0][m][j >> 1][(j & 1) * 2 + 1]}; na[j] = A * (sa[j] * rs); }
#pragma unroll
                for (int j = 0; j < 4; ++j) { dn[j][0] = __builtin_amdgcn_exp2f(na[j][0]); dn[j][1] = __builtin_amdgcn_exp2f(na[j][1]); }
#pragma unroll
                for (int j = 0; j < 4; ++j) { const f32x2 B = {acc[ai][1][m][j >> 1][(j & 1) * 2], acc[ai][1][m][j >> 1][(j & 1) * 2 + 1]}; hp[j] = na[j] * (B * sb[j]); dn[j] = dn[j] + 1.f; }
#pragma unroll
                for (int j = 0; j < 4; ++j) { dn[j][0] = __builtin_amdgcn_rcpf(dn[j][0]); dn[j][1] = __builtin_amdgcn_rcpf(dn[j][1]); }
#pragma unroll
                for (int j = 0; j < 4; ++j) { hp[j] = hp[j] * dn[j]; amax = fmaxf(fmaxf(amax, fabsf(hp[j][0])), fabsf(hp[j][1])); }
                { const auto r16 = __builtin_amdgcn_permlane16_swap(__float_as_uint(amax), __float_as_uint(amax), false, false); amax = fmaxf(__uint_as_float(r16[0]), __uint_as_float(r16[1]));
                  const auto r32 = __builtin_amdgcn_permlane32_swap(__float_as_uint(amax), __float_as_uint(amax), false, false); amax = fmaxf(__uint_as_float(r32[0]), __uint_as_float(r32[1])); }
                amax *= rs;
                const unsigned ab = __float_as_uint(amax); int e = 135 - (int)((ab >> 23) & 255u) - (((ab & 0x7fffffu) > 0x600000u) ? 1 : 0);
                e = e < -100 ? -100 : (e > 100 ? 100 : e); e = (amax > 0.f) ? e : 0;
                const float mul = __uint_as_float((unsigned)(e + 127) << 23) * rs;
                sd |= (unsigned)(127 - e) << (8 * m);
#pragma unroll
                for (int j = 0; j < 4; ++j) hp[j] = hp[j] * mul;
                int w0 = 0, w1 = 0; w0 = __builtin_amdgcn_cvt_pk_fp8_f32(hp[0][0], hp[0][1], w0, false); w0 = __builtin_amdgcn_cvt_pk_fp8_f32(hp[1][0], hp[1][1], w0, true);
                w1 = __builtin_amdgcn_cvt_pk_fp8_f32(hp[2][0], hp[2][1], w1, false); w1 = __builtin_amdgcn_cvt_pk_fp8_f32(hp[3][0], hp[3][1], w1, true);
                f32x2 w; w[0] = __int_as_float(w0); w[1] = __int_as_float(w1);
                *(f32x2*)(O8 + (size_t)row * DFFE + col0) = w; }
            if (fq == 0) *(unsigned*)(SCT + ((size_t)u.pm * 28 + u.pn) * 1024 + ((((wr * 16 + fr) * 4 + wc) * 2 + ai) << 2)) = sd; }
    }
};
struct EpiResid {
    static constexpr bool PERM = false; static constexpr int NST = 32; static constexpr bool INPLACE = true;
    const float* Xin; float* Xout; const float* gate;
    __device__ __forceinline__ void operator()(const f32x4 (&acc)[2][2][4][2], const Unit& u, int wr, int wc, int fr, int fq) const {
        const int row0 = u.pm * BM + wr * 64 + fr, col0 = u.pn * BM + wc * 32 + 4 * fq; const float* gp = gate + (size_t)(u.pm >> 6) * (6 * DM) + col0;
        f32x4 gv[2][2];
#pragma unroll
        for (int bj = 0; bj < 2; ++bj)
#pragma unroll
            for (int n = 0; n < 2; ++n) gv[bj][n] = *(const f32x4*)(gp + bj * HALF + n * 16);
#pragma unroll
        for (int ai = 0; ai < 2; ++ai)
#pragma unroll
        for (int mp = 0; mp < 4; mp += 2) {
            f32x4 xi[2][2][2];
#pragma unroll
            for (int m = 0; m < 2; ++m) { const size_t off = (size_t)(row0 + ai * HALF + (mp + m) * 16) * DM + col0;
#pragma unroll
                for (int bj = 0; bj < 2; ++bj)
#pragma unroll
                    for (int n = 0; n < 2; ++n) xi[m][bj][n] = *(const f32x4*)(Xin + off + bj * HALF + n * 16); }
            asm volatile("" ::: "memory");
#pragma unroll
            for (int m = 0; m < 2; ++m) { const size_t off = (size_t)(row0 + ai * HALF + (mp + m) * 16) * DM + col0;
#pragma unroll
                for (int bj = 0; bj < 2; ++bj)
#pragma unroll
                    for (int n = 0; n < 2; ++n) *(f32x4*)(Xout + off + bj * HALF + n * 16) = xi[m][bj][n] + gv[bj][n] * acc[ai][bj][mp + m][n]; }
            asm volatile("" ::: "memory");
        }
    }
};
template <bool IN16, bool OUT16> struct EpiResidT {
    static constexpr bool PERM = true; static constexpr int NST = OUT16 ? 16 : 32; static constexpr bool INPLACE = true;
    const void* Xin; void* Xout; const float* gate;
    __device__ __forceinline__ void operator()(const f32x4 (&acc)[2][2][4][2], const Unit& u, int wr, int wc, int fr, int fq) const {
        const int row0 = u.pm * BM + wr * 64 + fr, col0 = u.pn * BM + wc * 32 + 8 * fq; const float* gp = gate + (size_t)(u.pm >> 6) * (6 * DM) + col0;
        f32x4 gv[2][2];
#pragma unroll
        for (int bj = 0; bj < 2; ++bj)
#pragma unroll
            for (int n = 0; n < 2; ++n) gv[bj][n] = *(const f32x4*)(gp + bj * HALF + 4 * n);
#pragma unroll
        for (int ai = 0; ai < 2; ++ai)
#pragma unroll
        for (int mp = 0; mp < 4; mp += 2) {
            f32x4 xi[2][2][2];
#pragma unroll
            for (int m = 0; m < 2; ++m) { const size_t off = (size_t)(row0 + ai * HALF + (mp + m) * 16) * DM + col0;
#pragma unroll
                for (int bj = 0; bj < 2; ++bj) {
                    if (IN16) { const u32x4 r = *(const u32x4*)((const bf16*)Xin + off + bj * HALF);
                        xi[m][bj][0] = (f32x4){bflo(r.x), bfhi(r.x), bflo(r.y), bfhi(r.y)}; xi[m][bj][1] = (f32x4){bflo(r.z), bfhi(r.z), bflo(r.w), bfhi(r.w)}; }
                    else { xi[m][bj][0] = *(const f32x4*)((const float*)Xin + off + bj * HALF); xi[m][bj][1] = *(const f32x4*)((const float*)Xin + off + bj * HALF + 4); } } }
            asm volatile("" ::: "memory");
#pragma unroll
            for (int m = 0; m < 2; ++m) { const size_t off = (size_t)(row0 + ai * HALF + (mp + m) * 16) * DM + col0;
#pragma unroll
                for (int bj = 0; bj < 2; ++bj) { const f32x4 v0 = xi[m][bj][0] + gv[bj][0] * acc[ai][bj][mp + m][0], v1 = xi[m][bj][1] + gv[bj][1] * acc[ai][bj][mp + m][1];
                    if (OUT16) { u32x4 w; w.x = cvt_pk_bf16(v0[0], v0[1]); w.y = cvt_pk_bf16(v0[2], v0[3]); w.z = cvt_pk_bf16(v1[0], v1[1]); w.w = cvt_pk_bf16(v1[2], v1[3]); *(u32x4*)((bf16*)Xout + off + bj * HALF) = w; }
                    else { *(f32x4*)((float*)Xout + off + bj * HALF) = v0; *(f32x4*)((float*)Xout + off + bj * HALF + 4) = v1; } } }
            asm volatile("" ::: "memory");
        }
    }
};
struct EpiMerge {
    static constexpr bool PERM = true; static constexpr int NST = 16;
    const bf16* G; bf16* Mg;
    __device__ __forceinline__ void operator()(const f32x4 (&acc)[2][2][4][2], const Unit& u, int wr, int wc, int fr, int fq) const {
        const int row0 = u.pm * BM + wr * 64 + fr, col0 = u.pn * BM + wc * 32 + 8 * fq, n_br = u.aux;
#pragma unroll
        for (int ai = 0; ai < 2; ++ai)
#pragma unroll
        for (int mp = 0; mp < 4; mp += 2) {
            u32x4 g[2][2], o[2][2];
#pragma unroll
            for (int m = 0; m < 2; ++m) { const size_t row = (size_t)(row0 + ai * HALF + (mp + m) * 16);
#pragma unroll
                for (int bj = 0; bj < 2; ++bj) { g[m][bj] = *(const u32x4*)(G + row * GATEW + n_br * DM + col0 + bj * HALF);
                    o[m][bj] = (n_br != 0) ? *(const u32x4*)(Mg + row * DM + col0 + bj * HALF) : (u32x4){0u, 0u, 0u, 0u}; } }
            asm volatile("" ::: "memory");
#pragma unroll
            for (int m = 0; m < 2; ++m) { const size_t row = (size_t)(row0 + ai * HALF + (mp + m) * 16);
#pragma unroll
                for (int bj = 0; bj < 2; ++bj) { const u32x4 gg = g[m][bj], oo = o[m][bj]; const f32x4 a0 = acc[ai][bj][mp + m][0], a1 = acc[ai][bj][mp + m][1]; float r[8];
                    r[0] = bflo(gg.x) * a0[0] + bflo(oo.x); r[1] = bfhi(gg.x) * a0[1] + bfhi(oo.x); r[2] = bflo(gg.y) * a0[2] + bflo(oo.y); r[3] = bfhi(gg.y) * a0[3] + bfhi(oo.y);
                    r[4] = bflo(gg.z) * a1[0] + bflo(oo.z); r[5] = bfhi(gg.z) * a1[1] + bfhi(oo.z); r[6] = bflo(gg.w) * a1[2] + bflo(oo.w); r[7] = bfhi(gg.w) * a1[3] + bfhi(oo.w);
                    u32x4 w; w.x = cvt_pk_bf16(r[0], r[1]); w.y = cvt_pk_bf16(r[2], r[3]); w.z = cvt_pk_bf16(r[4], r[5]); w.w = cvt_pk_bf16(r[6], r[7]);
                    *(u32x4*)(Mg + row * DM + col0 + bj * HALF) = w; } }
            asm volatile("" ::: "memory");
        }
    }
};
struct EpiGM {
    static constexpr bool PERM = false; static constexpr int NST = 8;
    const bf16* Z; bf16* Mg;
    __device__ __forceinline__ void operator()(const f32x4 (&acc)[2][2][4][2], const Unit& u, int wr, int wc, int fr, int fq) const {
        const int row0 = u.pm * BM + wr * 64 + fr, col0 = u.pn * 64 + wc * 16 + 4 * fq;
        const bf16* zb = Z + (size_t)row0 * GATEW + col0; bf16* mb = Mg + (size_t)row0 * DM + col0;
#pragma unroll
        for (int ai = 0; ai < 2; ++ai) {
            f32x2 zz[4][4];
#pragma unroll
            for (int m = 0; m < 4; ++m)
#pragma unroll
                for (int br = 0; br < 4; ++br) zz[m][br] = *(const f32x2*)(zb + (size_t)(ai * HALF + m * 16) * GATEW + br * DM);
            asm volatile("" ::: "memory");
#pragma unroll
            for (int m = 0; m < 4; ++m) { f32x4 r = {0.f, 0.f, 0.f, 0.f};
#pragma unroll
                for (int br = 0; br < 4; ++br) { const f32x4 a = acc[ai][br >> 1][m][br & 1]; const unsigned z0 = __float_as_uint(zz[m][br][0]), z1 = __float_as_uint(zz[m][br][1]);
                    r[0] += fast_sigmoid(a[0]) * bflo(z0); r[1] += fast_sigmoid(a[1]) * bfhi(z0); r[2] += fast_sigmoid(a[2]) * bflo(z1); r[3] += fast_sigmoid(a[3]) * bfhi(z1); }
                f32x2 w; w[0] = __uint_as_float(cvt_pk_bf16(r[0], r[1])); w[1] = __uint_as_float(cvt_pk_bf16(r[2], r[3]));
                *(f32x2*)(mb + (size_t)(ai * HALF + m * 16) * DM) = w;
                __builtin_amdgcn_sched_barrier(0); }
            asm volatile("" ::: "memory");
        }
    }
};
struct MoeOrderX {
    const char* A; const char* B; const char* Sc; size_t tA, tB, tS; const int* pexp; int p0, nM, nN, G, c;
    __device__ __forceinline__ bool next(int i, Unit& u) const { int pm, pn; if (nM <= 0 || !static_tile(i, G, c, nM, nN, pm, pn)) return false; const int e = pexp[p0 + pm]; u.pm = pm; u.pn = pn; u.aux = e;
        u.A = A + (size_t)pm * tA; u.B = B + ((size_t)e * nN + pn) * tB; u.S = Sc + (size_t)pm * tS; return true; }
};
struct MoeTailOrderX {
    const char* A; const char* B; const char* Sc; size_t tA, tB, tS; const int* pexp; int p0, T, G, c;
    __device__ __forceinline__ bool next(int i, Unit& u) const { const int L = i * G + c; if (L >= T * 8) return false; const int pt = L >> 3, pn = (L >> 1) & 3, kh = L & 1, e = pexp[p0 + pt];
        u.pm = pt; u.pn = pn; u.aux = kh | (e << 8); u.A = A + (size_t)pt * tA + kh * 1792; u.B = B + ((size_t)e * 4 + pn) * tB + kh * 1792; u.S = Sc + (size_t)pt * tS + kh * (14 * 1024); return true; }
};
struct MoeTailOrder {
    const char* A; const char* B; size_t tA, tB; const int* pexp; int p0, T, G, c;
    __device__ __forceinline__ bool next(int i, Unit& u) const { const int L = i * G + c; if (L >= T * 16) return false; const int pt = L >> 4, pn = (L >> 2) & 3, kq = L & 3, e = pexp[p0 + pt];
        u.pm = pt; u.pn = pn; u.aux = kq; u.A = A + (size_t)pt * tA + kq * (896 * 2); u.B = B + ((size_t)e * 4 + pn) * tB + kq * (896 * 2); return true; }
};
struct EpiMoePart {
    static constexpr bool PERM = true; static constexpr int NST = 16;
    bf16* PART; const float* ps;
    __device__ __forceinline__ void operator()(const f32x4 (&acc)[2][2][4][2], const Unit& u, int wr, int wc, int fr, int fq) const {
        const int row0 = u.pm * BM + wr * 64 + fr, col0 = u.pn * BM + wc * 32 + 8 * fq; bf16* base = PART + (size_t)u.aux * (MAXTAIL * 256) * DM;
#pragma unroll
        for (int ai = 0; ai < 2; ++ai)
#pragma unroll
            for (int m = 0; m < 4; ++m) { const int row = row0 + ai * HALF + m * 16; const float s = ps[row]; bf16* rowp = base + (size_t)row * DM + col0;
#pragma unroll
                for (int bj = 0; bj < 2; ++bj) { const f32x4 v0 = acc[ai][bj][m][0] * s, v1 = acc[ai][bj][m][1] * s;
                    u32x4 w; w.x = cvt_pk_bf16(v0[0], v0[1]); w.y = cvt_pk_bf16(v0[2], v0[3]); w.z = cvt_pk_bf16(v1[0], v1[1]); w.w = cvt_pk_bf16(v1[2], v1[3]);
                    *(u32x4*)(rowp + bj * HALF) = w; } }
    }
};
struct EpiGM8 {
    static constexpr bool PERM = false; static constexpr int NST = 8;
#ifdef PROBE_GM8
    static constexpr bool PROBE_REP = true;
#endif
    const bf16* Z; bf16* Mg; const float* sh; const float* sw;
    __device__ __forceinline__ void operator()(const f32x4 (&acc)[2][2][4][2], const Unit& u, int wr, int wc, int fr_, int fq_) const {
        int fr = fr_, fq = fq_; asm volatile("" : "+v"(fr), "+v"(fq));
        const int row0 = u.pm * BM + wr * 64 + fr, col0 = u.pn * 64 + wc * 16 + 4 * fq;
        bf16* mb = Mg + (size_t)row0 * DM + col0;
        const bf16* zb = Z + (((size_t)u.pm * 16 + u.pn) * 256 + wr * 64 + fr) * 256 + wc * 16 + 4 * fq;
        f32x2 zz[2][4][4]; float rs[2][4];
#pragma unroll
        for (int ai = 0; ai < 2; ++ai)
#pragma unroll
            for (int m = 0; m < 4; ++m) { rs[ai][m] = sh[row0 + ai * HALF + m * 16];
#pragma unroll
                for (int br = 0; br < 4; ++br) zz[ai][m][br] = *(const f32x2*)(zb + (size_t)(ai * HALF + m * 16) * 256 + br * 64); }
        f32x4 craw[4];
#pragma unroll
        for (int br = 0; br < 4; ++br) craw[br] = *(const f32x4*)(sw + u.pn * 256 + 128 * (br >> 1) + 32 * wc + 16 * (br & 1) + 4 * fq);
        asm volatile("" ::: "memory");
        f32x2 cs[4][2];
#pragma unroll
        for (int br = 0; br < 4; ++br) { cs[br][0] = (f32x2){craw[br][0], craw[br][1]} * -1.4426950408889634f; cs[br][1] = (f32x2){craw[br][2], craw[br][3]} * -1.4426950408889634f; }
#pragma unroll
        for (int ai = 0; ai < 2; ++ai) {
#pragma unroll
            for (int m = 0; m < 4; ++m) { f32x2 r0 = {0.f, 0.f}, r1 = {0.f, 0.f};
#pragma unroll
                for (int br = 0; br < 4; ++br) { const f32x4 A = acc[ai][br >> 1][m][br & 1];
                    const f32x2 n0 = (f32x2){A[0], A[1]} * (cs[br][0] * rs[ai][m]), n1 = (f32x2){A[2], A[3]} * (cs[br][1] * rs[ai][m]);
                    f32x2 d0, d1; d0[0] = __builtin_amdgcn_exp2f(n0[0]); d0[1] = __builtin_amdgcn_exp2f(n0[1]); d1[0] = __builtin_amdgcn_exp2f(n1[0]); d1[1] = __builtin_amdgcn_exp2f(n1[1]);
                    d0 = d0 + 1.f; d1 = d1 + 1.f;
                    d0[0] = __builtin_amdgcn_rcpf(d0[0]); d0[1] = __builtin_amdgcn_rcpf(d0[1]); d1[0] = __builtin_amdgcn_rcpf(d1[0]); d1[1] = __builtin_amdgcn_rcpf(d1[1]);
                    const unsigned z0 = __float_as_uint(zz[ai][m][br][0]), z1 = __float_as_uint(zz[ai][m][br][1]);
                    r0 = r0 + d0 * (f32x2){bflo(z0), bfhi(z0)}; r1 = r1 + d1 * (f32x2){bflo(z1), bfhi(z1)}; }
                f32x2 w; w[0] = __uint_as_float(cvt_pk_bf16(r0[0], r0[1])); w[1] = __uint_as_float(cvt_pk_bf16(r1[0], r1[1]));
                *(f32x2*)(mb + (size_t)(ai * HALF + m * 16) * DM) = w;
                __builtin_amdgcn_sched_barrier(0); }
        }
        asm volatile("" ::: "memory");
    }
};
struct EpiMoeDown8 {
    static constexpr bool PERM = true; static constexpr int NST = 16;
    bf16* Y; const float* ps; const float* sw2;
    __device__ __forceinline__ void operator()(const f32x4 (&acc)[2][2][4][2], const Unit& u, int wr, int wc, int fr_, int fq_) const {
        int fr = fr_, fq = fq_; asm volatile("" : "+v"(fr), "+v"(fq));
        const int row0 = u.pm * BM + wr * 64 + fr, col0 = u.pn * BM + wc * 32 + 8 * fq; const float* swp = sw2 + (size_t)(u.aux & 0xff) * DM + col0;
        f32x4 cs[2][2];
#pragma unroll
        for (int bj = 0; bj < 2; ++bj) { cs[bj][0] = *(const f32x4*)(swp + bj * HALF); cs[bj][1] = *(const f32x4*)(swp + bj * HALF + 4); }
        float psv[2][4];
#pragma unroll
        for (int ai = 0; ai < 2; ++ai)
#pragma unroll
            for (int m = 0; m < 4; ++m) psv[ai][m] = ps[row0 + ai * HALF + m * 16];
#pragma unroll
        for (int ai = 0; ai < 2; ++ai)
#pragma unroll
            for (int m = 0; m < 4; ++m) { const int row = row0 + ai * HALF + m * 16; const float s = psv[ai][m]; bf16* rowp = Y + (size_t)row * DM + col0;
#pragma unroll
                for (int bj = 0; bj < 2; ++bj) { const f32x4 v0 = acc[ai][bj][m][0] * cs[bj][0] * s, v1 = acc[ai][bj][m][1] * cs[bj][1] * s;
                    u32x4 w; w.x = cvt_pk_bf16(v0[0], v0[1]); w.y = cvt_pk_bf16(v0[2], v0[3]); w.z = cvt_pk_bf16(v1[0], v1[1]); w.w = cvt_pk_bf16(v1[2], v1[3]);
                    *(u32x4*)(rowp + bj * HALF) = w; } }
    }
};
struct EpiMoePart8 {
    static constexpr bool PERM = true; static constexpr int NST = 16;
    bf16* PART; const float* ps; const float* sw2;
    __device__ __forceinline__ void operator()(const f32x4 (&acc)[2][2][4][2], const Unit& u, int wr, int wc, int fr_, int fq_) const {
        int fr = fr_, fq = fq_; asm volatile("" : "+v"(fr), "+v"(fq));
        const int row0 = u.pm * BM + wr * 64 + fr, col0 = u.pn * BM + wc * 32 + 8 * fq; const float* swp = sw2 + (size_t)(u.aux >> 8) * DM + col0; bf16* base = PART + (size_t)(u.aux & 1) * (MAXTAIL * 256) * DM;
        f32x4 cs[2][2];
#pragma unroll
        for (int bj = 0; bj < 2; ++bj) { cs[bj][0] = *(const f32x4*)(swp + bj * HALF); cs[bj][1] = *(const f32x4*)(swp + bj * HALF + 4); }
#pragma unroll
        for (int ai = 0; ai < 2; ++ai)
#pragma unroll
            for (int m = 0; m < 4; ++m) { const int row = row0 + ai * HALF + m * 16; const float s = ps[row]; bf16* rowp = base + (size_t)row * DM + col0;
#pragma unroll
                for (int bj = 0; bj < 2; ++bj) { const f32x4 v0 = acc[ai][bj][m][0] * cs[bj][0] * s, v1 = acc[ai][bj][m][1] * cs[bj][1] * s;
                    u32x4 w; w.x = cvt_pk_bf16(v0[0], v0[1]); w.y = cvt_pk_bf16(v0[2], v0[3]); w.z = cvt_pk_bf16(v1[0], v1[1]); w.w = cvt_pk_bf16(v1[2], v1[3]);
                    *(u32x4*)(rowp + bj * HALF) = w; } }
    }
};
struct EpiMoeDown {
    static constexpr bool PERM = true; static constexpr int NST = 16;
    bf16* Y; const float* ps;
    __device__ __forceinline__ void operator()(const f32x4 (&acc)[2][2][4][2], const Unit& u, int wr, int wc, int fr, int fq) const {
        const int row0 = u.pm * BM + wr * 64 + fr, col0 = u.pn * BM + wc * 32 + 8 * fq;
#pragma unroll
        for (int ai = 0; ai < 2; ++ai)
#pragma unroll
            for (int m = 0; m < 4; ++m) { const int row = row0 + ai * HALF + m * 16; const float s = ps[row]; bf16* rowp = Y + (size_t)row * DM + col0;
#pragma unroll
                for (int bj = 0; bj < 2; ++bj) { const f32x4 v0 = acc[ai][bj][m][0] * s, v1 = acc[ai][bj][m][1] * s;
                    u32x4 w; w.x = cvt_pk_bf16(v0[0], v0[1]); w.y = cvt_pk_bf16(v0[2], v0[3]); w.z = cvt_pk_bf16(v1[0], v1[1]); w.w = cvt_pk_bf16(v1[2], v1[3]);
                    *(u32x4*)(rowp + bj * HALF) = w; } }
    }
};

template <class E> constexpr auto epi_inplace(int) -> decltype(E::INPLACE) { return E::INPLACE; }
template <class E> constexpr bool epi_inplace(long) { return false; }
#ifndef EPI_REP
#define EPI_REP 1
#endif
template <class E> constexpr auto epi_rep(int) -> decltype(E::PROBE_REP, 1) { return EPI_REP; }
template <class E> constexpr int epi_rep(long) { return 1; }
typedef int v8i __attribute__((ext_vector_type(8)));
typedef int v4i __attribute__((ext_vector_type(4)));
template <int M8> __device__ __forceinline__ void mma8s(f32x4& acc, const v8i& b8, const v8i& a8, const int sA, const unsigned sB) {
    if constexpr (M8 == 0) asm volatile("v_mfma_scale_f32_16x16x128_f8f6f4 %0, %1, %2, %0, %3, %4 op_sel_hi:[0,0,0]" : "+v"(acc) : "v"(b8), "v"(a8), "v"(sA), "v"(sB));
    else if constexpr (M8 == 1) asm volatile("v_mfma_scale_f32_16x16x128_f8f6f4 %0, %1, %2, %0, %3, %4 op_sel:[0,1,0] op_sel_hi:[0,0,0]" : "+v"(acc) : "v"(b8), "v"(a8), "v"(sA), "v"(sB));
    else if constexpr (M8 == 2) asm volatile("v_mfma_scale_f32_16x16x128_f8f6f4 %0, %1, %2, %0, %3, %4 op_sel_hi:[0,1,0]" : "+v"(acc) : "v"(b8), "v"(a8), "v"(sA), "v"(sB));
    else asm volatile("v_mfma_scale_f32_16x16x128_f8f6f4 %0, %1, %2, %0, %3, %4 op_sel:[0,1,0] op_sel_hi:[0,1,0]" : "+v"(acc) : "v"(b8), "v"(a8), "v"(sA), "v"(sB));
}
template <class Epi, class Sched, int MODE = 0>
__device__ __forceinline__ void gemm_phase(PG8_LAS unsigned char* lds, const int wave_, const int lda, const int ldb, const int K, const Sched& S, const Epi& E) {
    constexpr bool F8 = (MODE != 0), SCL = (MODE == 2);
    int tid_ = wave_ * 64 + lane_id(); asm volatile("" : "+v"(tid_));
    const int tid = tid_, wid = __builtin_amdgcn_readfirstlane(tid >> 6), lane = tid & 63, wr = wid >> 2, wc = wid & 3, fr = lane & 15, fq = lane >> 4;
    const int nt = K / BK;
    unsigned voffA[2], voffB[2];
#pragma unroll
    for (int i = 0; i < 2; ++i) { int R, C; stage_rc(tid * 16 + i * 8192, R, C); const int Rb = Epi::PERM ? ((R & ~31) + perm32(R & 31)) : R;
        voffA[i] = (unsigned)(R * lda + C) * 2u; voffB[i] = (unsigned)(Rb * ldb + C) * 2u; }
    const size_t kstep = (size_t)(BK * 2);
    const size_t hstepA = (size_t)HALF * lda * 2, hstepB = (size_t)HALF * ldb * 2;
    const unsigned ldsw = (unsigned)wid * 1024u;
    const int aoff = lds_byte(wr * 64 + fr, fq * 8), boff = lds_byte(wc * 32 + fr, fq * 8);
    const int aoff8 = lds_byte(wr * 64 + fr, 32 * (fq >> 1) + 16 * (fq & 1)), boff8 = lds_byte(wc * 32 + fr, 32 * (fq >> 1) + 16 * (fq & 1));
#define PG8_SA(b, h) (((b) * 2 + (h)) * HTB)
#define PG8_SB(b, h) ((4 + (b) * 2 + (h)) * HTB)
#define PG8_STAGE(bufoff, gbase, voff) do { _Pragma("unroll") for (int _i = 0; _i < 2; ++_i) \
        __builtin_amdgcn_global_load_lds((const unsigned*)((const char*)(gbase) + (voff)[_i]), (PG8_LAS unsigned*)(lds + (bufoff) + ldsw + _i * 8192), 16, 0, 0); } while (0)
#define PG8_CAT(x0, x1) __builtin_shufflevector(__builtin_bit_cast(v4i, x0), __builtin_bit_cast(v4i, x1), 0, 1, 2, 3, 4, 5, 6, 7)
#define PG8_LDA(dst, b, h) do { _Pragma("unroll") for (int m = 0; m < 4; ++m) { if constexpr (F8) dst##8[m] = PG8_CAT(*(const PG8_LAS bf16x8*)(lds + PG8_SA(b, h) + aoff + m * 2048), *(const PG8_LAS bf16x8*)(lds + PG8_SA(b, h) + aoff + m * 2048 + 1024)); \
        else { _Pragma("unroll") for (int k = 0; k < 2; ++k) dst[m][k] = *(const PG8_LAS bf16x8*)(lds + PG8_SA(b, h) + aoff + m * 2048 + k * 1024); } } } while (0)
#define PG8_LDB(dst, b, h) do { _Pragma("unroll") for (int n = 0; n < 2; ++n) { if constexpr (F8) dst##8[n] = PG8_CAT(*(const PG8_LAS bf16x8*)(lds + PG8_SB(b, h) + boff + n * 2048), *(const PG8_LAS bf16x8*)(lds + PG8_SB(b, h) + boff + n * 2048 + 1024)); \
        else { _Pragma("unroll") for (int k = 0; k < 2; ++k) dst[n][k] = *(const PG8_LAS bf16x8*)(lds + PG8_SB(b, h) + boff + n * 2048 + k * 1024); } } } while (0)
#define PG8_MMA(ai, bj, At, Bt) do { __builtin_amdgcn_s_setprio(1); if constexpr (SCL) asm volatile("s_nop 7" ::: "memory"); _Pragma("unroll") for (int n = 0; n < 2; ++n) { \
        if constexpr (SCL) { mma8s<0>(acc[ai][bj][0][n], Bt##8[n], At##8[0], sc1, SCUR[ai]); mma8s<1>(acc[ai][bj][1][n], Bt##8[n], At##8[1], sc1, SCUR[ai]); \
                             mma8s<2>(acc[ai][bj][2][n], Bt##8[n], At##8[2], sc1, SCUR[ai]); mma8s<3>(acc[ai][bj][3][n], Bt##8[n], At##8[3], sc1, SCUR[ai]); } \
        else { _Pragma("unroll") for (int m = 0; m < 4; ++m) { \
        if constexpr (F8) asm volatile("v_mfma_scale_f32_16x16x128_f8f6f4 %0, %1, %2, %0, %3, %3 op_sel_hi:[0,0,0]" : "+v"(acc[ai][bj][m][n]) : "v"(Bt##8[n]), "v"(At##8[m]), "v"(sc1)); \
        else { _Pragma("unroll") for (int k = 0; k < 2; ++k) acc[ai][bj][m][n] = __builtin_amdgcn_mfma_f32_16x16x32_bf16(Bt[n][k], At[m][k], acc[ai][bj][m][n], 0, 0, 0); } } } } __builtin_amdgcn_s_setprio(0); } while (0)
#define PG8_WAIT_V(n) asm volatile("s_waitcnt vmcnt(" #n ")" ::: "memory")
#define PG8_WAIT_VX(n) asm volatile("s_waitcnt vmcnt(%0)" :: "n"(n) : "memory")
#define PG8_WAIT_SEG() do { if (relax) PG8_WAIT_VX(8 + Epi::NST); else PG8_WAIT_V(8); } while (0)
#define PG8_WAIT_SEG1() do { if constexpr (SCL) { if (relax) PG8_WAIT_VX(9 + Epi::NST); else PG8_WAIT_V(9); } else PG8_WAIT_SEG(); } while (0)
#define PG8_WAIT_L(n) asm volatile("s_waitcnt lgkmcnt(" #n ")" ::: "memory")
#define PG8_BAR __builtin_amdgcn_s_barrier()
#define PG8_SCHED __builtin_amdgcn_sched_barrier(0)
    Unit cur, nxt; int ui = 0;
    if (!S.next(0, cur)) return;
    f32x4 acc[2][2][4][2];
#pragma unroll
    for (int a = 0; a < 2; ++a)
#pragma unroll
        for (int b = 0; b < 2; ++b)
#pragma unroll
            for (int m = 0; m < 4; ++m)
#pragma unroll
                for (int n = 0; n < 2; ++n) acc[a][b][m][n] = (f32x4){0.f, 0.f, 0.f, 0.f};
    bf16x8 At[4][2], B0[2][2], B1[2][2]; v8i At8[4], B08[2], B18[2];
    int sc1 = 0x7f7f7f7f; asm volatile("" : "+v"(sc1));
    const unsigned soff = (unsigned)(((wr * 16 + fr) * 4 + fq) * 8);
    u32x2 sct0 = {0u, 0u}, sct1 = {0u, 0u};
    const char* cA = cur.A; const char* cB = cur.B; const char* cS = cur.S;
    if constexpr (SCL) { sct0 = *(const u32x2*)(cur.S + soff); sct1 = *(const u32x2*)(cur.S + 1024 + soff); }
    PG8_STAGE(PG8_SB(0, 0), cB, voffB); PG8_STAGE(PG8_SB(0, 1), cB + hstepB, voffB); PG8_STAGE(PG8_SA(0, 0), cA, voffA); PG8_STAGE(PG8_SA(0, 1), cA + hstepA, voffA);
    if (wr == 1) PG8_BAR;
    PG8_WAIT_V(2); PG8_BAR;
    PG8_STAGE(PG8_SB(1, 0), cB + kstep, voffB); PG8_STAGE(PG8_SA(1, 0), cA + kstep, voffA); PG8_STAGE(PG8_SB(1, 1), cB + hstepB + kstep, voffB);
    PG8_WAIT_V(6); PG8_BAR;
    for (;;) {
        const bool has_next = S.next(ui + 1, nxt);
        const char* nA = has_next ? nxt.A : cA; const char* nB = has_next ? nxt.B : cB; const char* nS = has_next ? nxt.S : cS;
        for (int t = 0; t < nt; t += 2) {
            const bool last = (t == nt - 2); int relax = __builtin_amdgcn_readfirstlane((int)(t == 0) & (int)(ui > 0)); asm volatile("" : "+s"(relax));
            const char* a1 = cA + (size_t)(t + 1) * kstep;
            const char* a2 = last ? nA : cA + (size_t)(t + 2) * kstep; const char* b2 = last ? nB : cB + (size_t)(t + 2) * kstep;
            const char* a3 = a2 + kstep; const char* b3 = b2 + kstep;
            const char* s2p = last ? nS : cS + (size_t)(t + 2) * 1024;
            u32x2 sn0 = sct0, sn1 = sct1;
#define SCUR sct0
            PG8_LDB(B0, 0, 0); PG8_LDB(B1, 0, 1); PG8_SCHED; PG8_LDA(At, 0, 0); PG8_STAGE(PG8_SA(1, 1), a1 + hstepA, voffA);
            PG8_WAIT_SEG1(); PG8_WAIT_L(0); PG8_BAR; PG8_MMA(0, 0, At, B0); PG8_MMA(0, 1, At, B1); PG8_BAR; PG8_SCHED;
            PG8_LDA(At, 0, 1); PG8_STAGE(PG8_SB(0, 0), b2, voffB); PG8_STAGE(PG8_SB(0, 1), b2 + hstepB, voffB); PG8_STAGE(PG8_SA(0, 0), a2, voffA);
            PG8_WAIT_SEG(); if constexpr (SCL) sn0 = *(const u32x2*)(s2p + soff); PG8_WAIT_L(0); PG8_BAR; PG8_MMA(1, 0, At, B0); PG8_MMA(1, 1, At, B1); PG8_BAR; PG8_SCHED;
#undef SCUR
#define SCUR sct1
            PG8_LDB(B0, 1, 0); PG8_LDB(B1, 1, 1); PG8_SCHED; PG8_LDA(At, 1, 0); PG8_STAGE(PG8_SA(0, 1), a2 + hstepA, voffA);
            if constexpr (SCL) PG8_WAIT_V(9); else PG8_WAIT_V(8); PG8_WAIT_L(0); PG8_BAR; PG8_MMA(0, 0, At, B0); PG8_MMA(0, 1, At, B1); PG8_BAR; PG8_SCHED;
            PG8_LDA(At, 1, 1); PG8_STAGE(PG8_SB(1, 0), b3, voffB); PG8_STAGE(PG8_SB(1, 1), b3 + hstepB, voffB); PG8_STAGE(PG8_SA(1, 0), a3, voffA);
            PG8_WAIT_V(8); if constexpr (SCL) sn1 = *(const u32x2*)(s2p + 1024 + soff);
            PG8_WAIT_L(0); PG8_BAR; PG8_MMA(1, 0, At, B0); PG8_MMA(1, 1, At, B1); PG8_BAR; PG8_SCHED;
#undef SCUR
            sct0 = sn0; sct1 = sn1;
        }
        if (wr == 0) PG8_BAR;
        if constexpr (F8) asm volatile("s_nop 15\n\ts_nop 15" ::: "memory");
        _Pragma("unroll") for (int er_ = 0; er_ < epi_rep<Epi>(0); ++er_) { E(acc, cur, wr, wc, fr, fq); if (EPI_REP > 1) asm volatile("" ::: "memory"); }
        if (!has_next) break;
#pragma unroll
        for (int a = 0; a < 2; ++a)
#pragma unroll
            for (int b = 0; b < 2; ++b)
#pragma unroll
                for (int m = 0; m < 4; ++m)
#pragma unroll
                    for (int n = 0; n < 2; ++n) acc[a][b][m][n] = (f32x4){0.f, 0.f, 0.f, 0.f};
        cur = nxt; cA = nA; cB = nB; cS = nS; ++ui;
        if (wr == 1) PG8_BAR;
    }
    PG8_WAIT_V(0);
    PG8_BAR;
#undef PG8_SA
#undef PG8_SB
#undef PG8_STAGE
#undef PG8_LDA
#undef PG8_LDB
#undef PG8_MMA
#undef PG8_CAT
#undef PG8_WAIT_V
#undef PG8_WAIT_VX
#undef PG8_WAIT_SEG
#undef PG8_WAIT_SEG1
#undef PG8_WAIT_L
#undef PG8_BAR
#undef PG8_SCHED
}
}
constexpr int NWAVES = 8;
constexpr int RING_OFF = 0, RING_BYTES = 131072;
constexpr int LDSCTL_OFF = RING_BYTES, MISC_OFF = LDSCTL_OFF + 320;
constexpr int LDS_BYTES = 147456;
constexpr int CW_TMO = 0, CW_CODE = 1, CW_BAR = 4096;

#define GAS __attribute__((address_space(1)))
#define LAS __attribute__((address_space(3)))
typedef unsigned v4u __attribute__((ext_vector_type(4)));
typedef unsigned v2u __attribute__((ext_vector_type(2)));
typedef GAS unsigned gu32;
#define RLX_AGENT __ATOMIC_RELAXED, __HIP_MEMORY_SCOPE_AGENT
#define LDS_WAIT() asm volatile("s_waitcnt lgkmcnt(0)" ::: "memory")
#define VM_WAIT() asm volatile("s_waitcnt vmcnt(0)" ::: "memory")
__device__ __forceinline__ unsigned pk2(float lo, float hi) { return (unsigned)f2bf(lo) | ((unsigned)f2bf(hi) << 16); }


#define XB_TMO      128
#define XB_XCNT(j)  (256  + 64 * (j))
#define XB_XSUB(j)  (1280 + 64 * (j))
#define XB_XGEN(j)  (2304 + 64 * (j))
#define XB_TOP      3328
#define XB_TOPGEN   3392
#define XCD_BAR_WORDS 3456
#define XB_SPIN_CAP (1u << 18)
__device__ __forceinline__ unsigned xb_ld(unsigned* p)              { return __hip_atomic_load(p, __ATOMIC_RELAXED, __HIP_MEMORY_SCOPE_AGENT); }
__device__ __forceinline__ unsigned xb_add(unsigned* p, unsigned v) { return __hip_atomic_fetch_add(p, v, __ATOMIC_RELAXED, __HIP_MEMORY_SCOPE_AGENT); }
__device__ __forceinline__ unsigned xb_xcc_id() { return (unsigned)__builtin_amdgcn_s_getreg((3 << 11) | 20) & 0xFu; }
#define XB_SPIN(cond, bar) do { unsigned _sp = 0; while (cond) { __builtin_amdgcn_s_sleep(1); \
    if ((++_sp & 255u) == 0u) { if (xb_ld(&(bar)[XB_TMO])) break; if (_sp > XB_SPIN_CAP) { atomicAdd(&(bar)[XB_TMO], 1u); break; } } } } while (0)
struct XcdBarrier { unsigned* bar; unsigned x; volatile LAS unsigned* st; };
__device__ __forceinline__ XcdBarrier xcd_barrier_post(unsigned* bar, volatile LAS unsigned* st) {
    XcdBarrier b; b.bar = bar; b.x = xb_xcc_id(); b.st = st;
    if (threadIdx.x == 0) (void)xb_add(&bar[XB_XCNT(b.x)], 1u);
    return b;
}
__device__ __forceinline__ void xcd_barrier_complete(unsigned* bar, unsigned x, unsigned& nloc, unsigned& nx) {
    const unsigned G = gridDim.x * gridDim.y * gridDim.z;
    unsigned sum, cnt, mine, sp = 0u;
    for (;;) {
        sum = 0u; cnt = 0u; mine = 0u;
#pragma unroll
        for (unsigned j = 0; j < 16; ++j) { const unsigned c = xb_ld(&bar[XB_XCNT(j)]); sum += c; cnt += (c > 0u) ? 1u : 0u; mine = (j == x) ? c : mine; }
        if (sum == G) break;
        __builtin_amdgcn_s_sleep(1);
        if ((++sp & 255u) == 0u) { if (xb_ld(&bar[XB_TMO])) break; if (sp > XB_SPIN_CAP) { atomicAdd(&bar[XB_TMO], 1u); break; } }
    }
    nloc = mine > 0u ? mine : 1u; nx = cnt > 0u ? cnt : 1u;
}
__device__ __forceinline__ void xcd_barrier(const XcdBarrier& b, const int wave) {
    asm volatile("s_waitcnt vmcnt(0)" ::: "memory");
    __syncthreads();
    if (wave == 0 && lane_id() == 0) {
        unsigned* bar = b.bar;
        __builtin_amdgcn_s_waitcnt(0);
        unsigned nloc = b.st[0], nx = b.st[1];
        if (nloc == 0u) { xcd_barrier_complete(bar, b.x, nloc, nx); b.st[0] = nloc; b.st[1] = nx; }
        const unsigned old = xb_add(&bar[XB_XSUB(b.x)], 1u);
        const unsigned gen = old / nloc;
        if (old + 1u == (gen + 1u) * nloc) {
            __builtin_amdgcn_fence(__ATOMIC_RELEASE, "agent");
            asm volatile("s_waitcnt vmcnt(0)" ::: "memory");
            const unsigned og = xb_add(&bar[XB_TOP], 1u);
            const unsigned tg = og / nx;
            if (og + 1u == (tg + 1u) * nx) xb_add(&bar[XB_TOPGEN], 1u);
            else XB_SPIN(xb_ld(&bar[XB_TOPGEN]) == tg, bar);
            __builtin_amdgcn_fence(__ATOMIC_ACQUIRE, "agent");
            xb_add(&bar[XB_XGEN(b.x)], 1u);
            asm volatile("s_waitcnt vmcnt(0)" ::: "memory");
        } else {
            XB_SPIN(xb_ld(&bar[XB_XGEN(b.x)]) == gen, bar);
            __builtin_amdgcn_fence(__ATOMIC_ACQUIRE, "agent");
            asm volatile("s_waitcnt vmcnt(0)" ::: "memory");
        }
    }
    __syncthreads();
}

struct Frame {
    LAS unsigned char* lds; volatile LAS unsigned* MISC; unsigned* ctl;
    int wave, vcu, G;
};
#define F_LANE (lane_id())
#define F_TID (F.wave * 64 + lane_id())
__device__ __forceinline__ float wave_sum(float v) {
#pragma unroll
    for (int o = 1; o < 64; o <<= 1) v += __shfl_xor(v, o);
    return v;
}

__host__ __device__ __forceinline__ int win_row(int sc) { if (sc < NPROJ_SRC) return sc + (sc >= 1184 ? 96 : 0); const int g = sc - NPROJ_SRC, br = g >> 10, oc = g & 1023, p = oc >> 6, j = oc & 63;
    return PROJW + p * 256 + 128 * (br >> 1) + 32 * (j >> 4) + 16 * (br & 1) + (j & 15); }
__device__ __forceinline__ void transpose_item(const float* W, int ldw, bf16* WT, int ldt, int drow0, int k0, int n0, const float* scale, LAS float* scr, int lane, const bool winmap = false) {
#pragma unroll
    for (int i = 0; i < 32; ++i) { const int kk = 2 * i + (lane >> 5); float v = W[(size_t)(k0 + kk) * ldw + n0 + (lane & 31)]; if (scale) v *= scale[k0 + kk]; scr[kk * 33 + (lane & 31)] = v; }
    LDS_WAIT(); asm volatile("" ::: "memory");
    const int c = lane & 7;
#pragma unroll
    for (int j = 0; j < 4; ++j) { const int n = (lane >> 3) + 8 * j; const LAS float* s = scr + (8 * c) * 33 + n;
        v4u o; o.x = pk2(s[0 * 33], s[1 * 33]); o.y = pk2(s[2 * 33], s[3 * 33]); o.z = pk2(s[4 * 33], s[5 * 33]); o.w = pk2(s[6 * 33], s[7 * 33]);
        *(v4u*)(WT + (size_t)(winmap ? win_row(n0 + n) : drow0 + n) * ldt + k0 + 8 * c) = o; }
    LDS_WAIT(); asm volatile("" ::: "memory");
}
__device__ __forceinline__ void convert_job(Frame& F, const float* src, size_t sstride, int K, int N, bf16* dst, size_t dstride, int ldt, int mode, const float* scale, int nmat, int rot, int ncol = 0) {
    LAS float* scr = (LAS float*)(F.lds + RING_OFF + F.wave * 16384);
    const int NGW = F.G * NWAVES, gw = (F.vcu * NWAVES + F.wave + rot) % NGW, lane = F_LANE;
    const int nkb = K / 64, nnb = (ncol ? ncol : N) / 32, per = nkb * nnb, total = per * nmat;
    for (int it = gw; it < total; it += NGW) {
        const int mi = it / per, r = it % per, kb = r / nnb, nb = r % nnb, n0 = nb * 32;
        int drow = n0;
        if (mode == 2) drow = (n0 >> 7) * 256 + (n0 & 127);
        else if (mode == 3) drow = (n0 >> 7) * 256 + 128 + (n0 & 127);
        transpose_item(src + (size_t)mi * sstride, N, dst + (size_t)mi * dstride, ldt, drow, kb * 64, n0, scale, scr, lane, mode == 1);
    }
}

__device__ __forceinline__ float fp8_scale(float amax) { return (amax > 0.f) ? exp2f(fminf(floorf(log2f(448.f / amax)), 100.f)) : 1.f; }
__device__ __forceinline__ unsigned pk4_fp8(float a, float b, float c, float d) { int w = 0; w = __builtin_amdgcn_cvt_pk_fp8_f32(a, b, w, false); w = __builtin_amdgcn_cvt_pk_fp8_f32(c, d, w, true); return (unsigned)w; }
__device__ __forceinline__ void convert_gate8(Frame& F, const float* w_in_l, const unsigned* amax_l, unsigned char* WG8, float* SW, int rot) {
    LAS float* scr = (LAS float*)(F.lds + RING_OFF + F.wave * 16384);
    const int NGW = F.G * NWAVES, gw = (F.vcu * NWAVES + F.wave + rot) % NGW, lane = F_LANE;
    for (int it = gw; it < 16 * 128; it += NGW) {
        const int kb = it / 128, nb = it % 128, k0 = kb * 64, g0 = nb * 32;
#pragma unroll
        for (int i = 0; i < 32; ++i) { const int kk = 2 * i + (lane >> 5); scr[kk * 33 + (lane & 31)] = w_in_l[(size_t)(k0 + kk) * D_IN + NPROJ_SRC + g0 + (lane & 31)]; }
        LDS_WAIT(); asm volatile("" ::: "memory");
#pragma unroll
        for (int j = 0; j < 2; ++j) { const int n = (lane >> 2) + 16 * j, c = lane & 3;
            const float sc = fp8_scale(__uint_as_float(amax_l[g0 + n])); const LAS float* sp = scr + (16 * c) * 33 + n;
            v4u o; o.x = pk4_fp8(sp[0 * 33] * sc, sp[1 * 33] * sc, sp[2 * 33] * sc, sp[3 * 33] * sc); o.y = pk4_fp8(sp[4 * 33] * sc, sp[5 * 33] * sc, sp[6 * 33] * sc, sp[7 * 33] * sc);
            o.z = pk4_fp8(sp[8 * 33] * sc, sp[9 * 33] * sc, sp[10 * 33] * sc, sp[11 * 33] * sc); o.w = pk4_fp8(sp[12 * 33] * sc, sp[13 * 33] * sc, sp[14 * 33] * sc, sp[15 * 33] * sc);
            const int drow = win_row(NPROJ_SRC + g0 + n) - PROJW;
            *(v4u*)(WG8 + (size_t)drow * DM + k0 + 16 * c) = o;
            if (kb == 0 && c == 0) SW[drow] = 1.f / sc; }
        LDS_WAIT(); asm volatile("" ::: "memory");
    }
}

__device__ __forceinline__ void convert_w8_job(Frame& F, const float* src, size_t sstride, int N, unsigned char* dst, size_t dstride, int mode, const unsigned* amax, int astride, float* SW, int swstride, int nmat, int rot, int K = DM) {
    LAS float* scr = (LAS float*)(F.lds + RING_OFF + F.wave * 16384);
    const int NGW = F.G * NWAVES, gw = (F.vcu * NWAVES + F.wave + rot) % NGW, lane = F_LANE;
    const int nnb = N / 32, per = (K / 64) * nnb, total = per * nmat;
    for (int it = gw; it < total; it += NGW) {
        const int mi = it / per, r = it % per, kb = r / nnb, nb = r % nnb, k0 = kb * 64, n0 = nb * 32;
        const float* W = src + (size_t)mi * sstride;
#pragma unroll
        for (int i = 0; i < 32; ++i) { const int kk = 2 * i + (lane >> 5); scr[kk * 33 + (lane & 31)] = W[(size_t)(k0 + kk) * N + n0 + (lane & 31)]; }
        LDS_WAIT(); asm volatile("" ::: "memory");
        const int drow0 = (mode == 0) ? n0 : (n0 >> 7) * 256 + (n0 & 127) + (mode == 3 ? 128 : 0);
#pragma unroll
        for (int j = 0; j < 2; ++j) { const int n = (lane >> 2) + 16 * j, c = lane & 3;
            const float sc = fp8_scale(__uint_as_float(amax[(size_t)mi * astride + n0 + n])); const LAS float* sp = scr + (16 * c) * 33 + n;
            v4u o; o.x = pk4_fp8(sp[0 * 33] * sc, sp[1 * 33] * sc, sp[2 * 33] * sc, sp[3 * 33] * sc); o.y = pk4_fp8(sp[4 * 33] * sc, sp[5 * 33] * sc, sp[6 * 33] * sc, sp[7 * 33] * sc);
            o.z = pk4_fp8(sp[8 * 33] * sc, sp[9 * 33] * sc, sp[10 * 33] * sc, sp[11 * 33] * sc); o.w = pk4_fp8(sp[12 * 33] * sc, sp[13 * 33] * sc, sp[14 * 33] * sc, sp[15 * 33] * sc);
            *(v4u*)(dst + (size_t)mi * dstride + (size_t)(drow0 + n) * K + k0 + 16 * c) = o;
            if (kb == 0 && c == 0) SW[(size_t)mi * swstride + drow0 + n] = 1.f / sc; }
        LDS_WAIT(); asm volatile("" ::: "memory");
    }
}
__device__ __forceinline__ void amax_job(Frame& F, const float* src, size_t sstride, int N, unsigned* amax, int astride, int nmat, int K = DM) {
    const int NGW = F.G * NWAVES, gw = F.vcu * NWAVES + F.wave, lane = F_LANE, ncb = N / 256, per = (K / 64) * ncb;
    for (int it = gw; it < per * nmat; it += NGW) { const int mi = it / per, r = it % per, kb = r / ncb, cb = r % ncb;
        const float* wp = src + (size_t)mi * sstride + (size_t)(kb * 64) * N + cb * 256 + 4 * lane; float4 mx = make_float4(0.f, 0.f, 0.f, 0.f);
#pragma unroll 16
        for (int q = 0; q < 64; ++q) { const float4 v = *(const float4*)(wp + (size_t)q * N); mx.x = fmaxf(mx.x, fabsf(v.x)); mx.y = fmaxf(mx.y, fabsf(v.y)); mx.z = fmaxf(mx.z, fabsf(v.z)); mx.w = fmaxf(mx.w, fabsf(v.w)); }
        unsigned* am = amax + (size_t)mi * astride + cb * 256 + 4 * lane;
        atomicMax(am + 0, __float_as_uint(mx.x)); atomicMax(am + 1, __float_as_uint(mx.y)); atomicMax(am + 2, __float_as_uint(mx.z)); atomicMax(am + 3, __float_as_uint(mx.w)); }
}
enum { IN_X = 0, IN_C, IN_POS, IN_N1G, IN_N2G, IN_ADAW, IN_ADAB, IN_WIN, IN_CONVW, IN_CQG, IN_WUQ, IN_CKVG, IN_WUKV, IN_QNG, IN_KNG, IN_GVG, IN_WS, IN_BS, IN_RETG, IN_WBR, IN_WO,
       IN_F1, IN_F3, IN_F2, IN_RW, IN_RB, IN_M1, IN_M3, IN_M2, N_IN };
enum { PH_PRO = 0, PH_PRO2 = 1, PL_NORM1 = 0, PL_INPROJ, PL_PRE, PL_SCAN, PL_ATTN, PL_GATE, PL_MERGE, PL_WO, PL_NORM2, PL_F0, PL_F1, PL_F2, PL_F3, PL_F4, PL_F5, PL_PER_LAYER = 16, N_PHASES = 2 + 2 * PL_PER_LAYER };
__host__ __device__ constexpr int PHL(int l, int k) { return 2 + l * PL_PER_LAYER + k; }

struct Args { const void* in[N_IN]; float* out; unsigned char* ws; int ph_lo, ph_hi, li, pad; };


typedef const __attribute__((address_space(4))) unsigned long long* karg_t;
__device__ __forceinline__ const void* karg_ptr(int idx) { karg_t k = (karg_t)__builtin_amdgcn_kernarg_segment_ptr(); asm volatile("" : "+s"(k)); return (const void*)(const __attribute__((address_space(1))) char*)k[idx]; }
#define K_IN(i) (karg_ptr(i))
#define K_OUT ((float*)karg_ptr(N_IN))
#define K_WS ((unsigned char*)karg_ptr(N_IN + 1))
__device__ __forceinline__ void norm_phase(Frame& F, const float* X, bf16* H, const float* gain, const float* ada_l, const int off_sh, const int off_sc,
                                           const float* router_w, const float* router_b, nv::Route* route, int* CNT, unsigned char* H8 = nullptr, float* SH = nullptr, const bool x16 = false, const int rbs = 4) {
    int lane_ = F_LANE; asm volatile("" : "+v"(lane_)); const int lane = lane_;
    LAS int* cnt = (LAS int*)(F.lds + RING_OFF);
    for (int blk = F.vcu; blk < NTOK / 128; blk += F.G) {
        if (router_w) { if (F_TID < NEXP) cnt[F_TID] = 0; __syncthreads(); }
        const int b = (blk * 128) / SEQ;
        for (int rb = 0; rb < 16; rb += rbs) {
          float4 gm[4], sh[4];
#pragma unroll
          for (int j = 0; j < 4; ++j) { const int col = 4 * (lane + 64 * j);
            const float4 g = *(const float4*)(gain + col), sc = *(const float4*)(ada_l + (size_t)b * 6 * DM + off_sc + col);
            gm[j] = make_float4(g.x * (1.f + sc.x), g.y * (1.f + sc.y), g.z * (1.f + sc.z), g.w * (1.f + sc.w));
            sh[j] = *(const float4*)(ada_l + (size_t)b * 6 * DM + off_sh + col); }
          {
          pg8::f32x4 v4[4][4];
#pragma unroll
          for (int q = 0; q < 4; ++q) if (q < rbs)
#pragma unroll
              for (int j = 0; j < 4; ++j) { const size_t xo = (size_t)(blk * 128 + F.wave * 16 + rb + q) * DM + 4 * (lane + 64 * j);
                  if (x16) { const pg8::u32x2 r = *(const pg8::u32x2*)((const bf16*)X + xo); v4[q][j] = (pg8::f32x4){pg8::bflo(r.x), pg8::bfhi(r.x), pg8::bflo(r.y), pg8::bfhi(r.y)}; }
                  else v4[q][j] = *(const pg8::f32x4*)(X + xo); }
#pragma unroll
          for (int qp = 0; qp < 4; qp += 2) if (qp < rbs) {
          pg8::f32x4 hall[2][4], lgq[2][2];
#pragma unroll
          for (int q = 0; q < 2; ++q) {
            const int m = blk * 128 + F.wave * 16 + rb + qp + q;
            float4 v[4]; float ss = 0.f;
#pragma unroll
            for (int j = 0; j < 4; ++j) { v[j] = make_float4(v4[qp + q][j][0], v4[qp + q][j][1], v4[qp + q][j][2], v4[qp + q][j][3]); ss += v[j].x * v[j].x + v[j].y * v[j].y + v[j].z * v[j].z + v[j].w * v[j].w; }
            ss = wave_sum(ss);
            const float rstd = rsqrtf(ss * (1.f / DM) + EPS);
            float amax = 0.f;
            lgq[q][0] = (pg8::f32x4){0.f, 0.f, 0.f, 0.f}; lgq[q][1] = lgq[q][0];
#pragma unroll
            for (int j = 0; j < 4; ++j) {
                const int col = 4 * (lane + 64 * j);
                const float h0 = v[j].x * rstd * gm[j].x + sh[j].x, h1 = v[j].y * rstd * gm[j].y + sh[j].y, h2 = v[j].z * rstd * gm[j].z + sh[j].z, h3 = v[j].w * rstd * gm[j].w + sh[j].w;
                if (H) { uint2 o; o.x = pk2(h0, h1); o.y = pk2(h2, h3); *(uint2*)(H + (size_t)m * DM + col) = o; }
                hall[q][j] = (pg8::f32x4){h0, h1, h2, h3};
                if (H8) amax = fmaxf(fmaxf(amax, fmaxf(fabsf(h0), fabsf(h1))), fmaxf(fabsf(h2), fabsf(h3)));
            }
            if (H8) {
#pragma unroll
                for (int o = 1; o < 64; o <<= 1) amax = fmaxf(amax, __shfl_xor(amax, o));
                const float sc = fp8_scale(amax);
#pragma unroll
                for (int j = 0; j < 4; ++j) *(unsigned*)(H8 + (size_t)m * DM + 4 * (lane + 64 * j)) = pk4_fp8(hall[q][j][0] * sc, hall[q][j][1] * sc, hall[q][j][2] * sc, hall[q][j][3] * sc);
                if (lane == 0) SH[m] = 1.f / sc;
            }
          }
          if (router_w) {
#pragma unroll
            for (int j = 0; j < 4; ++j) {
                const float4* rw = (const float4*)(router_w + (size_t)(4 * (lane + 64 * j)) * NEXP);
#pragma unroll
                for (int q2 = 0; q2 < 2; ++q2) { const float4 w0 = rw[q2], w1 = rw[2 + q2], w2 = rw[4 + q2], w3 = rw[6 + q2];
#pragma unroll
                    for (int q = 0; q < 2; ++q) { const float h0 = hall[q][j][0], h1 = hall[q][j][1], h2 = hall[q][j][2], h3 = hall[q][j][3];
                        lgq[q][q2][0] += h0 * w0.x + h1 * w1.x + h2 * w2.x + h3 * w3.x; lgq[q][q2][1] += h0 * w0.y + h1 * w1.y + h2 * w2.y + h3 * w3.y;
                        lgq[q][q2][2] += h0 * w0.z + h1 * w1.z + h2 * w2.z + h3 * w3.z; lgq[q][q2][3] += h0 * w0.w + h1 * w1.w + h2 * w2.w + h3 * w3.w; } }
            }
#pragma unroll
            for (int q = 0; q < 2; ++q) { const int m = blk * 128 + F.wave * 16 + rb + qp + q; float lg[NEXP];
#pragma unroll
                for (int e = 0; e < NEXP; ++e) lg[e] = wave_sum(lgq[q][e >> 2][e & 3]) + router_b[e];
                if (lane == 0) {
                    int e0 = 0; float l0 = lg[0];
#pragma unroll
                    for (int e = 1; e < NEXP; ++e) if (lg[e] > l0) { l0 = lg[e]; e0 = e; }
                    int e1 = -1; float l1 = -INFINITY;
#pragma unroll
                    for (int e = 0; e < NEXP; ++e) if (e != e0 && lg[e] > l1) { l1 = lg[e]; e1 = e; }
                    const float p0 = 1.f / (1.f + __expf(l1 - l0));
                    nv::Route r; r.e0 = e0; r.e1 = e1; r.p0 = p0; r.p1 = 1.f - p0; route[m] = r;
                    atomicAdd((int*)&cnt[e0], 1); atomicAdd((int*)&cnt[e1], 1);
                }
            }
          }
          }
          }
        }
        if (router_w) { __syncthreads(); if (F_TID < NEXP) CNT[blk * NEXP + F_TID] = cnt[F_TID]; __syncthreads(); }
    }
}

__device__ __forceinline__ void moe_assign_phase(Frame& F, const Args& args) {
    unsigned char* ws = K_WS;
    const nv::Route* route = (const nv::Route*)(ws + WS_ROUTE); const int* CNT = (const int*)(ws + WS_CNT); const unsigned char* H8 = ws + WS_H8; unsigned char* XS8 = ws + WS_XS8; const float* SH = (const float*)(ws + WS_SH); float* SXS = (float*)(ws + WS_SXS);
    int* SLOT = (int*)(ws + WS_SLOT); float* PSLOT = (float*)(ws + WS_PSLOT); int* PEXP = (int*)(ws + WS_PEXP); int* TOK = (int*)(ws + WS_TOK);
    LAS int* sm = (LAS int*)(F.lds + RING_OFF);
    LAS int* tot = sm; LAS int* pre = sm + 8; LAS int* base = sm + 16; LAS int* wcnt = sm + 32; LAS int* ss0 = sm + 64; LAS int* ss1 = sm + 192;
    const int tid = F_TID, lane = F_LANE, w = F.wave;
    for (int blk = F.vcu; blk < NTOK / 128; blk += F.G) {
        if (tid < 16) sm[tid] = 0;
        __syncthreads();
        if (tid < 256) { const int4 c0 = *(const int4*)(CNT + tid * NEXP), c1 = *(const int4*)(CNT + tid * NEXP + 4); const int cc[8] = {c0.x, c0.y, c0.z, c0.w, c1.x, c1.y, c1.z, c1.w};
#pragma unroll
            for (int e = 0; e < NEXP; ++e) { int tv = cc[e], pv = (tid < blk) ? cc[e] : 0;
#pragma unroll
                for (int o = 1; o < 64; o <<= 1) { tv += __shfl_xor(tv, o); pv += __shfl_xor(pv, o); }
                if (lane == 0) { (void)__hip_atomic_fetch_add(tot + e, tv, __ATOMIC_RELAXED, __HIP_MEMORY_SCOPE_WORKGROUP); (void)__hip_atomic_fetch_add(pre + e, pv, __ATOMIC_RELAXED, __HIP_MEMORY_SCOPE_WORKGROUP); } } }
        __syncthreads();
        if (tid == 0) { int bsum = 0; for (int e = 0; e < NEXP; ++e) { base[e] = bsum; bsum += (tot[e] + 255) & ~255; } base[NEXP] = bsum; }
        __syncthreads();
        if (blk == 0) { for (int p = tid; p < MAXPANEL + 8; p += NWAVES * 64) { int e = -1;
#pragma unroll
                for (int x = 0; x < NEXP; ++x) if (p * 256 >= base[x] && p * 256 < base[x + 1]) e = x;
                if (p == MAXPANEL) e = base[NEXP] >> 8; PEXP[p] = e; } }
        if (blk < NEXP) { const int e = blk; for (int s = base[e] + tot[e] + tid; s < base[e + 1]; s += NWAVES * 64) { PSLOT[s] = 0.f; TOK[s] = -1; } }
        if (tid < 128) {
            const int t = blk * 128 + tid; const nv::Route r = route[t]; int rank0 = 0, rank1 = 0;
#pragma unroll
            for (int e = 0; e < NEXP; ++e) { const bool in = (r.e0 == e) || (r.e1 == e); const unsigned long long m = __ballot(in); if (lane == 0) wcnt[w * 8 + e] = __popcll(m);
                const int rk = __popcll(m & ((1ull << lane) - 1ull)); if (r.e0 == e) rank0 = rk; if (r.e1 == e) rank1 = rk; }
            ss0[tid] = rank0; ss1[tid] = rank1;
        }
        __syncthreads();
        if (tid < 128) {
            const int t = blk * 128 + tid; const nv::Route r = route[t]; int rank0 = ss0[tid], rank1 = ss1[tid];
            if (w == 1) { rank0 += wcnt[r.e0]; rank1 += wcnt[r.e1]; }
            const int s0 = base[r.e0] + pre[r.e0] + rank0, s1 = base[r.e1] + pre[r.e1] + rank1;
            SLOT[2 * t] = s0; SLOT[2 * t + 1] = s1; PSLOT[s0] = r.p0; PSLOT[s1] = r.p1; TOK[s0] = t; TOK[s1] = t;
        }
        __syncthreads();
        __syncthreads();
    }
}
__device__ __forceinline__ void moe_gather_phase(Frame& F) {
    unsigned char* ws = K_WS; const int* TOK = (const int*)(ws + WS_TOK); const unsigned char* H8 = ws + WS_H8; unsigned char* XS8 = ws + WS_XS8; const float* SH = (const float*)(ws + WS_SH); float* SXS = (float*)(ws + WS_SXS);
    const int total = ((const int*)(ws + WS_PEXP))[MAXPANEL] * 256, per = (total + F.G - 1) / F.G, lane = F_LANE;
    const int s_lo = F.vcu * per, s_hi = (s_lo + per < total) ? s_lo + per : total;
    for (int s0 = s_lo + F.wave * 8; s0 < s_hi; s0 += NWAVES * 8) {
        int tk[8];
#pragma unroll
        for (int i = 0; i < 8; ++i) tk[i] = (s0 + i < s_hi) ? TOK[s0 + i] : -1;
        v4u v[8]; float sc[8];
#pragma unroll
        for (int i = 0; i < 8; ++i) { const int tt = tk[i] < 0 ? 0 : tk[i]; v[i] = *(const v4u*)(H8 + (size_t)tt * DM + lane * 16); sc[i] = SH[tt]; }
#pragma unroll
        for (int i = 0; i < 8; ++i) if (tk[i] >= 0) { *(v4u*)(XS8 + (size_t)(s0 + i) * DM + lane * 16) = v[i]; if (lane == 0) SXS[s0 + i] = sc[i]; }
    }
}

__device__ __forceinline__ float4 moe_yrow(const bf16* Y, const bf16* PART, int slot, int tail0, int c4) {
    if (slot < tail0) { const uint2 a = *(const uint2*)(Y + (size_t)slot * DM + c4); return make_float4(bf2f((bf16)(a.x & 0xffff)), bf2f((bf16)(a.x >> 16)), bf2f((bf16)(a.y & 0xffff)), bf2f((bf16)(a.y >> 16))); }
    float4 r = make_float4(0.f, 0.f, 0.f, 0.f);
#pragma unroll
    for (int kq = 0; kq < 2; ++kq) { const uint2 a = *(const uint2*)(PART + ((size_t)kq * (MAXTAIL * 256) + (slot - tail0)) * DM + c4);
        r.x += bf2f((bf16)(a.x & 0xffff)); r.y += bf2f((bf16)(a.x >> 16)); r.z += bf2f((bf16)(a.y & 0xffff)); r.w += bf2f((bf16)(a.y >> 16)); }
    return r;
}
__device__ __forceinline__ void moe_combine_phase(Frame& F, float* X, const bf16* Y, const bf16* PART, const int tail0, const int* SLOT, const float* g2) {
    const int gw = F.vcu * NWAVES + F.wave, NGW = F.G * NWAVES;
    for (int t0 = gw; t0 < NTOK; t0 += 2 * NGW) {
        const int t1 = t0 + NGW; const bool two = (t1 < NTOK); const int tb = two ? t1 : t0;
        int sl[4] = {SLOT[2 * t0], SLOT[2 * t0 + 1], SLOT[2 * tb], SLOT[2 * tb + 1]};
        const bf16* yp[4];
#pragma unroll
        for (int q = 0; q < 4; ++q) yp[q] = (sl[q] < tail0) ? Y + (size_t)sl[q] * DM : PART + (size_t)(sl[q] - tail0) * DM;
        uint2 yr[4][4]; float4 xa[4], xb[4], ga[4], gb[4];
#pragma unroll
        for (int j = 0; j < 4; ++j) { const int c4 = 4 * (F_LANE + 64 * j);
#pragma unroll
            for (int q = 0; q < 4; ++q) yr[q][j] = *(const uint2*)(yp[q] + c4);
            xa[j] = *(const float4*)(X + (size_t)t0 * DM + c4); xb[j] = *(const float4*)(X + (size_t)tb * DM + c4);
            ga[j] = *(const float4*)(g2 + (size_t)(t0 / SEQ) * 6 * DM + c4); gb[j] = *(const float4*)(g2 + (size_t)(tb / SEQ) * 6 * DM + c4); }
        float4 ys[4][4];
#pragma unroll
        for (int q = 0; q < 4; ++q)
#pragma unroll
            for (int j = 0; j < 4; ++j) { const uint2 a = yr[q][j]; ys[q][j] = make_float4(bf2f((bf16)(a.x & 0xffff)), bf2f((bf16)(a.x >> 16)), bf2f((bf16)(a.y & 0xffff)), bf2f((bf16)(a.y >> 16))); }
#pragma unroll
        for (int q = 0; q < 4; ++q) if (sl[q] >= tail0) {
#pragma unroll
            for (int j = 0; j < 4; ++j) { const int c4 = 4 * (F_LANE + 64 * j); const uint2 a = *(const uint2*)(PART + ((size_t)(MAXTAIL * 256) + (sl[q] - tail0)) * DM + c4);
                ys[q][j].x += bf2f((bf16)(a.x & 0xffff)); ys[q][j].y += bf2f((bf16)(a.x >> 16)); ys[q][j].z += bf2f((bf16)(a.y & 0xffff)); ys[q][j].w += bf2f((bf16)(a.y >> 16)); } }
#pragma unroll
        for (int j = 0; j < 4; ++j) { const int c4 = 4 * (F_LANE + 64 * j);
            { const float4 g = ga[j]; float4 x = xa[j];
              x.x += g.x * (ys[0][j].x + ys[1][j].x); x.y += g.y * (ys[0][j].y + ys[1][j].y); x.z += g.z * (ys[0][j].z + ys[1][j].z); x.w += g.w * (ys[0][j].w + ys[1][j].w); *(float4*)(X + (size_t)t0 * DM + c4) = x; }
            if (two) { const float4 g = gb[j]; float4 x = xb[j];
              x.x += g.x * (ys[2][j].x + ys[3][j].x); x.y += g.y * (ys[2][j].y + ys[3][j].y); x.z += g.z * (ys[2][j].z + ys[3][j].z); x.w += g.w * (ys[2][j].w + ys[3][j].w); *(float4*)(X + (size_t)t1 * DM + c4) = x; } }
    }
}

__device__ __forceinline__ void scan_phase(Frame& F, float* RET) {
    LAS float* T = (LAS float*)(F.lds + RING_OFF);
    const int tid = F_TID, el = tid & 127, seg = tid >> 7;
    for (int blk = F.vcu; blk < NBATCH * NHEAD * 4096 / 128; blk += F.G) {
        const int idx = blk * 128 + el, b = idx / (NHEAD * 4096), h = (idx / 4096) % NHEAD, ed = idx % 4096;
        const float cd = __expf(nv::ret_loggamma(h) * 128.f);
        float* p = RET + ((size_t)(b * NCHUNK + seg * 32) * NHEAD + h) * 4096 + ed; const size_t stp = (size_t)NHEAD * 4096;
        float v[32];
#pragma unroll
        for (int i = 0; i < 32; ++i) v[i] = p[(size_t)i * stp];
        float st = 0.f;
#pragma unroll
        for (int i = 0; i < 32; ++i) { const float kv = v[i]; v[i] = st; st = st * cd + kv; }
        T[seg * 128 + el] = st;
        __syncthreads();
        float cd32 = cd;
#pragma unroll
        for (int i = 0; i < 5; ++i) cd32 *= cd32;
        float carry = 0.f;
        for (int s2 = 0; s2 < seg; ++s2) carry = carry * cd32 + T[s2 * 128 + el];
        float w = carry;
#pragma unroll
        for (int i = 0; i < 32; ++i) { p[(size_t)i * stp] = v[i] + w; w *= cd; }
        __syncthreads();
    }
}
typedef short bf16x8 __attribute__((ext_vector_type(8)));
typedef float f32x4 __attribute__((ext_vector_type(4)));
typedef float f32x16 __attribute__((ext_vector_type(16)));
#define MFMA16(a, b, c) __builtin_amdgcn_mfma_f32_16x16x32_bf16((a), (b), (c), 0, 0, 0)
__device__ __forceinline__ float bflo_(unsigned w) { return __uint_as_float(w << 16); }
__device__ __forceinline__ float bfhi_(unsigned w) { return __uint_as_float(w & 0xffff0000u); }
__device__ __forceinline__ float sumsq8(bf16x8 v) { float s = 0.f;
#pragma unroll
    for (int i = 0; i < 8; ++i) { const float f = bf2f((bf16)v[i]); s += f * f; } return s; }
__device__ __forceinline__ int tofs(int row, int j) { return row * 256 + ((((j >> 3) ^ (row & 15)) << 4) | ((j & 7) << 1)); }
__device__ __forceinline__ float fast_gelu_tanh(float x) { const float u = 0.7978845608028654f * (x + 0.044715f * x * x * x);
    return x * __builtin_amdgcn_rcpf(1.f + __builtin_amdgcn_exp2f(-2.885390081777927f * u)); }

__device__ __forceinline__ void rope_sincos(const float fpos, const float f, float* s, float* c) {
    const float c_hi = 0.15915494f, c_lo = 6.4206e-9f;
    const float x_hi = fpos * f, x_lo = fmaf(fpos, f, -x_hi);
    const float r_hi = x_hi * c_hi, r_lo = fmaf(x_hi, c_hi, -r_hi) + x_hi * c_lo + x_lo * c_hi;
    const float fr = (r_hi - floorf(r_hi)) + r_lo;
    *s = __builtin_amdgcn_sinf(fr); *c = __builtin_amdgcn_cosf(fr);
}

template <int l> __device__ __forceinline__ void pre_conv(Frame& F, const Args& args, const int t0) {
    const bf16* P = (const bf16*)(K_WS + WS_PROJ); bf16* YB = (bf16*)(K_WS + WS_YB); const float* cw = (const float*)K_IN(IN_CONVW) + l * 3 * MIXW;
    int tid_ = F_TID; asm volatile("" : "+v"(tid_)); const int cg = tid_ & 31, tl = tid_ >> 5, c0 = cg * 8, tb = t0 + tl * 8, sb = tb % SEQ;
    float w0[8], w1[8], w2[8], u1[8], u2[8];
#pragma unroll
    for (int i = 0; i < 8; ++i) { w0[i] = cw[c0 + i]; w1[i] = cw[256 + c0 + i]; w2[i] = cw[512 + c0 + i]; u1[i] = 0.f; u2[i] = 0.f; }
    auto ldu = [&](int t, float* u) { const v4u a = *(const v4u*)(P + (size_t)t * PROJW + C_AC + c0), x = *(const v4u*)(P + (size_t)t * PROJW + C_AX + c0);
        u[0] = bflo_(a.x) * bflo_(x.x); u[1] = bfhi_(a.x) * bfhi_(x.x); u[2] = bflo_(a.y) * bflo_(x.y); u[3] = bfhi_(a.y) * bfhi_(x.y);
        u[4] = bflo_(a.z) * bflo_(x.z); u[5] = bfhi_(a.z) * bfhi_(x.z); u[6] = bflo_(a.w) * bflo_(x.w); u[7] = bfhi_(a.w) * bfhi_(x.w); };
    if (sb >= 1) ldu(tb - 1, u1);
    if (sb >= 2) ldu(tb - 2, u2);
    v4u la[8], lx[8], lb[8];
#pragma unroll
    for (int i = 0; i < 8; ++i) { const size_t o = (size_t)(tb + i) * PROJW + c0; la[i] = *(const v4u*)(P + o + C_AC); lx[i] = *(const v4u*)(P + o + C_AX); lb[i] = *(const v4u*)(P + o + C_AB); }
#pragma unroll
    for (int i = 0; i < 8; ++i) { const int t = tb + i; float u0[8];
        { const v4u a = la[i], x = lx[i];
          u0[0] = bflo_(a.x) * bflo_(x.x); u0[1] = bfhi_(a.x) * bfhi_(x.x); u0[2] = bflo_(a.y) * bflo_(x.y); u0[3] = bfhi_(a.y) * bfhi_(x.y);
          u0[4] = bflo_(a.z) * bflo_(x.z); u0[5] = bfhi_(a.z) * bfhi_(x.z); u0[6] = bflo_(a.w) * bflo_(x.w); u0[7] = bfhi_(a.w) * bfhi_(x.w); }
        const v4u ab = lb[i]; const float bb[8] = {bflo_(ab.x), bfhi_(ab.x), bflo_(ab.y), bfhi_(ab.y), bflo_(ab.z), bfhi_(ab.z), bflo_(ab.w), bfhi_(ab.w)};
        float y[8];
#pragma unroll
        for (int c = 0; c < 8; ++c) { y[c] = bb[c] * (w0[c] * u2[c] + w1[c] * u1[c] + w2[c] * u0[c]); u2[c] = u1[c]; u1[c] = u0[c]; }
        v4u o; o.x = pk2(y[0], y[1]); o.y = pk2(y[2], y[3]); o.z = pk2(y[4], y[5]); o.w = pk2(y[6], y[7]);
        *(v4u*)(YB + (size_t)t * DM + c0) = o; }
}

template <int l> __device__ __forceinline__ void pre_mla(Frame& F, const Args& args, const int t0) {
    unsigned char* ws = K_WS;
    const bf16* P = (const bf16*)(ws + WS_PROJ); bf16* Q = (bf16*)(ws + WS_Q); bf16* Kb = (bf16*)(ws + WS_K); bf16* VT = (bf16*)(ws + WS_VT);
    const bf16* WUQ = (const bf16*)(ws + WS_WUQ_T) + (size_t)l * QW * 256; const bf16* WUKV = (const bf16*)(ws + WS_WUKV_T) + (size_t)l * 512 * 128;
    const float* qn_g = (const float*)K_IN(IN_QNG) + l * QKH; const float* kn_g = (const float*)K_IN(IN_KNG) + l * QKH; const int* pos = (const int*)K_IN(IN_POS);
    int lane_ = F_LANE; asm volatile("" : "+v"(lane_)); const int lr = lane_ & 15, lq = lane_ >> 4;
    const int tw = t0 + F.wave * 16 + lr, b = t0 / SEQ, sw = (t0 % SEQ) + F.wave * 16;
    const bf16* prow = P + (size_t)tw * PROJW;
    bf16x8 xq[8], xkv[4]; float ssq = 0.f, sskv = 0.f;
#pragma unroll
    for (int s = 0; s < 8; ++s) { xq[s] = *(const bf16x8*)(prow + C_CQ + 32 * s + 8 * lq); ssq += sumsq8(xq[s]); }
#pragma unroll
    for (int s = 0; s < 4; ++s) { xkv[s] = *(const bf16x8*)(prow + C_CKV + 32 * s + 8 * lq); sskv += sumsq8(xkv[s]); }
    ssq += __shfl_xor(ssq, 16); ssq += __shfl_xor(ssq, 32); sskv += __shfl_xor(sskv, 16); sskv += __shfl_xor(sskv, 32);
    const float rq = rsqrtf(ssq * (1.f / 256) + EPS), rkv = rsqrtf(sskv * (1.f / 128) + EPS);
    float cs[4], sn[4]; { const float fpos = (float)pos[tw];
#pragma unroll
        for (int r = 0; r < 4; ++r) rope_sincos(fpos, powf(10000.f, -(float)(4 * lq + r) / 16.f), &sn[r], &cs[r]); }
    LAS unsigned char* wl = F.lds + RING_OFF; const int tid_w = F_TID;
    v4u wv6[6], wv4[4];
#pragma unroll
    for (int i = 0; i < 6; ++i) { const int p = tid_w + 512 * i; wv6[i] = *(const v4u*)(WUQ + (size_t)(p >> 5) * 256 + (p & 31) * 8); }
#pragma unroll 1
    for (int h = 0; h < NHEAD; ++h) {
        __syncthreads();
#pragma unroll
        for (int i = 0; i < 6; ++i) { const int p = tid_w + 512 * i; *(LAS v4u*)(wl + (p >> 5) * 528 + (p & 31) * 16) = wv6[i]; }
        __syncthreads();
        if (h + 1 < NHEAD) {
#pragma unroll
            for (int i = 0; i < 6; ++i) { const int p = tid_w + 512 * i; wv6[i] = *(const v4u*)(WUQ + (size_t)((h + 1) * 96 + (p >> 5)) * 256 + (p & 31) * 8); }
        } else {
#pragma unroll
            for (int i = 0; i < 4; ++i) { const int p = tid_w + 512 * i; wv4[i] = *(const v4u*)(WUKV + (size_t)(p >> 4) * 128 + (p & 15) * 8); }
        }
        f32x4 acc[6];
#pragma unroll
        for (int nt = 0; nt < 6; ++nt) acc[nt] = (f32x4){0.f, 0.f, 0.f, 0.f};
#pragma unroll
        for (int s = 0; s < 8; ++s)
#pragma unroll
            for (int nt = 0; nt < 6; ++nt) { const bf16x8 wf = *(const LAS bf16x8*)(wl + (nt * 16 + lr) * 528 + (32 * s + 8 * lq) * 2); acc[nt] = MFMA16(wf, xq[s], acc[nt]); }
        float ss = 0.f;
#pragma unroll
        for (int nt = 0; nt < 6; ++nt) { acc[nt] = acc[nt] * rq; ss += acc[nt][0] * acc[nt][0] + acc[nt][1] * acc[nt][1] + acc[nt][2] * acc[nt][2] + acc[nt][3] * acc[nt][3]; }
        ss += __shfl_xor(ss, 16); ss += __shfl_xor(ss, 32);
        const float rh = rsqrtf(ss * (1.f / 96) + EPS);
#pragma unroll
        for (int nt = 0; nt < 6; ++nt) { const f32x4 g = *(const f32x4*)(qn_g + nt * 16 + 4 * lq); acc[nt] = acc[nt] * rh * g; }
#pragma unroll
        for (int r = 0; r < 4; ++r) { const float x1 = acc[4][r], x2 = acc[5][r]; acc[4][r] = x1 * cs[r] - x2 * sn[r]; acc[5][r] = x2 * cs[r] + x1 * sn[r]; }
#pragma unroll
        for (int nt = 0; nt < 6; ++nt) { v2u o; o.x = pk2(acc[nt][0] * ATT_C2, acc[nt][1] * ATT_C2); o.y = pk2(acc[nt][2] * ATT_C2, acc[nt][3] * ATT_C2);
            *(v2u*)(Q + (size_t)tw * QW + h * 96 + nt * 16 + 4 * lq) = o; }
    }
    float kr1[4], kr2[4]; { const v2u a = *(const v2u*)(prow + C_KR + 4 * lq), c = *(const v2u*)(prow + C_KR + 16 + 4 * lq);
        kr1[0] = bflo_(a.x); kr1[1] = bfhi_(a.x); kr1[2] = bflo_(a.y); kr1[3] = bfhi_(a.y); kr2[0] = bflo_(c.x); kr2[1] = bfhi_(c.x); kr2[2] = bflo_(c.y); kr2[3] = bfhi_(c.y); }
    float sskr = 0.f;
#pragma unroll
    for (int r = 0; r < 4; ++r) sskr += kr1[r] * kr1[r] + kr2[r] * kr2[r];
    float rkv_r[4];
#pragma unroll
    for (int r = 0; r < 4; ++r) rkv_r[r] = __shfl(rkv, 4 * lq + r);
#pragma unroll 1
    for (int h = 0; h < NHEAD; ++h) {
        __syncthreads();
#pragma unroll
        for (int i = 0; i < 4; ++i) { const int p = tid_w + 512 * i; *(LAS v4u*)(wl + (p >> 4) * 272 + (p & 15) * 16) = wv4[i]; }
        __syncthreads();
        if (h + 1 < NHEAD) {
#pragma unroll
            for (int i = 0; i < 4; ++i) { const int p = tid_w + 512 * i; wv4[i] = *(const v4u*)(WUKV + (size_t)((h + 1) * 128 + (p >> 4)) * 128 + (p & 15) * 8); }
        }
        f32x4 ak[4], av[4];
#pragma unroll
        for (int nt = 0; nt < 4; ++nt) { ak[nt] = (f32x4){0.f, 0.f, 0.f, 0.f}; av[nt] = (f32x4){0.f, 0.f, 0.f, 0.f}; }
#pragma unroll
        for (int s = 0; s < 4; ++s)
#pragma unroll
            for (int nt = 0; nt < 4; ++nt) {
                const bf16x8 wk = *(const LAS bf16x8*)(wl + (nt * 16 + lr) * 272 + (32 * s + 8 * lq) * 2); ak[nt] = MFMA16(wk, xkv[s], ak[nt]);
                const bf16x8 wv = *(const LAS bf16x8*)(wl + (64 + nt * 16 + lr) * 272 + (32 * s + 8 * lq) * 2); av[nt] = MFMA16(xkv[s], wv, av[nt]);
            }
        float ss = sskr;
#pragma unroll
        for (int nt = 0; nt < 4; ++nt) { ak[nt] = ak[nt] * rkv; ss += ak[nt][0] * ak[nt][0] + ak[nt][1] * ak[nt][1] + ak[nt][2] * ak[nt][2] + ak[nt][3] * ak[nt][3]; }
        ss += __shfl_xor(ss, 16); ss += __shfl_xor(ss, 32);
        const float rk = rsqrtf(ss * (1.f / 96) + EPS);
#pragma unroll
        for (int nt = 0; nt < 4; ++nt) { const f32x4 g = *(const f32x4*)(kn_g + nt * 16 + 4 * lq); const f32x4 v = ak[nt] * rk * g; v2u o; o.x = pk2(v[0], v[1]); o.y = pk2(v[2], v[3]);
            *(v2u*)(Kb + (size_t)tw * QW + h * 96 + nt * 16 + 4 * lq) = o; }
        { const f32x4 g1 = *(const f32x4*)(kn_g + 64 + 4 * lq), g2 = *(const f32x4*)(kn_g + 80 + 4 * lq); float o1[4], o2[4];
#pragma unroll
          for (int r = 0; r < 4; ++r) { const float x1 = kr1[r] * rk * g1[r], x2 = kr2[r] * rk * g2[r]; o1[r] = x1 * cs[r] - x2 * sn[r]; o2[r] = x2 * cs[r] + x1 * sn[r]; }
          v2u a; a.x = pk2(o1[0], o1[1]); a.y = pk2(o1[2], o1[3]); *(v2u*)(Kb + (size_t)tw * QW + h * 96 + 64 + 4 * lq) = a;
          v2u c; c.x = pk2(o2[0], o2[1]); c.y = pk2(o2[2], o2[3]); *(v2u*)(Kb + (size_t)tw * QW + h * 96 + 80 + 4 * lq) = c; }
#pragma unroll
        for (int nt = 0; nt < 4; ++nt) { v2u o; o.x = pk2(av[nt][0] * rkv_r[0], av[nt][1] * rkv_r[1]); o.y = pk2(av[nt][2] * rkv_r[2], av[nt][3] * rkv_r[3]);
            { const int sq = sw + 4 * lq;
              *(v2u*)(VT + (((size_t)(b * NHEAD + h) * (SEQ / 64) + (sq >> 6)) * 64 + nt * 16 + lr) * 64 + (sq & 63)) = o; } }
    }
    __syncthreads();
}

template <int l> __device__ __forceinline__ void pre_sgu(Frame& F, const Args& args, const int t0) {
    unsigned char* ws = K_WS;
    const bf16* P = (const bf16*)(ws + WS_PROJ); bf16* YB = (bf16*)(ws + WS_YB); const bf16* WST = (const bf16*)(ws + WS_WS_T) + (size_t)l * 4 * 128 * 128;
    const float* gv_g = (const float*)K_IN(IN_GVG) + l * 256; const float* b_s = (const float*)K_IN(IN_BS) + l * 4 * 128;
    LAS unsigned char* vT = F.lds + RING_OFF;
    int lane_ = F_LANE; asm volatile("" : "+v"(lane_)); const int lane = lane_, lr = lane & 15, lq = lane >> 4, w = F.wave;
    { const f32x4 gg = *(const f32x4*)(gv_g + 4 * lane);
      v2u a16[16];
#pragma unroll
      for (int j = 0; j < 16; ++j) a16[j] = *(const v2u*)(P + (size_t)(t0 + 16 * w + j) * PROJW + C_SV + 4 * lane);
#pragma unroll
      for (int j = 0; j < 16; ++j) { const int s = 16 * w + j; const v2u a = a16[j];
          float v[4] = {fast_gelu_tanh(bflo_(a.x)), fast_gelu_tanh(bfhi_(a.x)), fast_gelu_tanh(bflo_(a.y)), fast_gelu_tanh(bfhi_(a.y))};
          float ss = v[0] * v[0] + v[1] * v[1] + v[2] * v[2] + v[3] * v[3];
          ss += __shfl_xor(ss, 1); ss += __shfl_xor(ss, 2); ss += __shfl_xor(ss, 4); ss += __shfl_xor(ss, 8);
          const float rs = rsqrtf(ss * (1.f / 64) + EPS);
#pragma unroll
          for (int i = 0; i < 4; ++i) *(LAS bf16*)(vT + tofs(4 * lane + i, s)) = f2bf(v[i] * rs * gg[i]); } }
    __syncthreads();
    const int tw = t0 + 16 * w + lr, nks = (16 * w + 15) / 32 + 1;
#pragma unroll 1
    for (int g = 0; g < 4; ++g) {
        f32x4 acc[4];
#pragma unroll
        for (int ct = 0; ct < 4; ++ct) acc[ct] = (f32x4){0.f, 0.f, 0.f, 0.f};
        bf16x8 wf4[4]; v2u au[4];
#pragma unroll
        for (int ks = 0; ks < 4; ++ks) wf4[ks] = *(const bf16x8*)(WST + ((size_t)g * 128 + 16 * w + lr) * 128 + 32 * ks + 8 * lq);
#pragma unroll
        for (int ct = 0; ct < 4; ++ct) au[ct] = *(const v2u*)(P + (size_t)tw * PROJW + C_SU + g * 64 + ct * 16 + 4 * lq);
        const float bb = b_s[g * 128 + 16 * w + lr];
#pragma unroll
        for (int ks = 0; ks < 4; ++ks) if (ks < nks) { const bf16x8 wf = wf4[ks];
#pragma unroll
            for (int ct = 0; ct < 4; ++ct) { const bf16x8 vf = *(const LAS bf16x8*)(vT + tofs(g * 64 + ct * 16 + lr, 32 * ks + 8 * lq)); acc[ct] = MFMA16(vf, wf, acc[ct]); } }
#pragma unroll
        for (int ct = 0; ct < 4; ++ct) { const v2u a = au[ct];
            v2u o; o.x = pk2(fast_gelu_tanh(bflo_(a.x)) * (acc[ct][0] + bb), fast_gelu_tanh(bfhi_(a.x)) * (acc[ct][1] + bb)); o.y = pk2(fast_gelu_tanh(bflo_(a.y)) * (acc[ct][2] + bb), fast_gelu_tanh(bfhi_(a.y)) * (acc[ct][3] + bb));
            *(v2u*)(YB + (size_t)tw * DM + 512 + g * 64 + ct * 16 + 4 * lq) = o; }
    }
    __syncthreads();
}

__device__ __forceinline__ void pre_retkv(Frame& F, const Args& args, const int t0, const int ch) {
    unsigned char* ws = K_WS;
    bf16* P = (bf16*)(ws + WS_PROJ); float* RET = (float*)(ws + WS_RET); const int* pos = (const int*)K_IN(IN_POS);
    LAS unsigned char* kT = F.lds + RING_OFF; LAS unsigned char* vT = F.lds + RING_OFF + 65536;
    int lane_ = F_LANE; asm volatile("" : "+v"(lane_)); const int lane = lane_, lr = lane & 15, lq = lane >> 4, w = F.wave;
    { const int h = lane >> 4, i0 = (lane & 15) * 2; const float lg = nv::ret_loggamma(h);
      const float f0 = powf(10000.f, -(float)i0 / 32.f), f1 = powf(10000.f, -(float)(i0 + 1) / 32.f);
      for (int jb = 0; jb < 16; jb += 8) {
        unsigned q1a[8], q2a[8], k1a[8], k2a[8]; v2u vva[8]; int posa[8];
#pragma unroll
        for (int jj = 0; jj < 8; ++jj) { const int s = 16 * w + jb + jj; const bf16* r = P + (size_t)(t0 + s) * PROJW; posa[jj] = pos[t0 + s];
            q1a[jj] = *(const unsigned*)(r + C_RQ + h * 64 + i0); q2a[jj] = *(const unsigned*)(r + C_RQ + h * 64 + 32 + i0); k1a[jj] = *(const unsigned*)(r + C_RK + h * 64 + i0); k2a[jj] = *(const unsigned*)(r + C_RK + h * 64 + 32 + i0);
            vva[jj] = *(const v2u*)(r + C_RV + 4 * lane); }
#pragma unroll
        for (int jj = 0; jj < 8; ++jj) { const int j = jb + jj; const int s = 16 * w + j; bf16* r = P + (size_t)(t0 + s) * PROJW; const float fpos = (float)posa[jj];
          const unsigned q1 = q1a[jj], q2 = q2a[jj], k1 = k1a[jj], k2 = k2a[jj];
          const v2u vv = vva[jj];
          float s0, c0, s1, c1; rope_sincos(fpos, f0, &s0, &c0); rope_sincos(fpos, f1, &s1, &c1);
          const float dq = __expf(lg * (float)s), dk = 0.125f * __expf(-lg * (float)s);
          const unsigned qa = pk2((bflo_(q1) * c0 - bflo_(q2) * s0) * dq, (bfhi_(q1) * c1 - bfhi_(q2) * s1) * dq), qb = pk2((bflo_(q2) * c0 + bflo_(q1) * s0) * dq, (bfhi_(q2) * c1 + bfhi_(q1) * s1) * dq);
          const unsigned ka = pk2((bflo_(k1) * c0 - bflo_(k2) * s0) * dk, (bfhi_(k1) * c1 - bfhi_(k2) * s1) * dk), kb = pk2((bflo_(k2) * c0 + bflo_(k1) * s0) * dk, (bfhi_(k2) * c1 + bfhi_(k1) * s1) * dk);
          *(unsigned*)(r + C_RQ + h * 64 + i0) = qa; *(unsigned*)(r + C_RQ + h * 64 + 32 + i0) = qb; *(unsigned*)(r + C_RK + h * 64 + i0) = ka; *(unsigned*)(r + C_RK + h * 64 + 32 + i0) = kb;
          *(LAS bf16*)(kT + tofs(h * 64 + i0, s)) = (bf16)(ka & 0xffff); *(LAS bf16*)(kT + tofs(h * 64 + i0 + 1, s)) = (bf16)(ka >> 16);
          *(LAS bf16*)(kT + tofs(h * 64 + 32 + i0, s)) = (bf16)(kb & 0xffff); *(LAS bf16*)(kT + tofs(h * 64 + 32 + i0 + 1, s)) = (bf16)(kb >> 16);
          *(LAS bf16*)(vT + tofs(4 * lane + 0, s)) = (bf16)(vv.x & 0xffff); *(LAS bf16*)(vT + tofs(4 * lane + 1, s)) = (bf16)(vv.x >> 16);
          *(LAS bf16*)(vT + tofs(4 * lane + 2, s)) = (bf16)(vv.y & 0xffff); *(LAS bf16*)(vT + tofs(4 * lane + 3, s)) = (bf16)(vv.y >> 16); } } }
    __syncthreads();
    { const int h = w >> 1; const float g127 = __expf(nv::ret_loggamma(h) * 127.f);
      f32x4 acc[4][2];
#pragma unroll
      for (int dt = 0; dt < 4; ++dt)
#pragma unroll
          for (int ei = 0; ei < 2; ++ei) acc[dt][ei] = (f32x4){0.f, 0.f, 0.f, 0.f};
#pragma unroll
      for (int ks = 0; ks < 4; ++ks) { bf16x8 vf[2];
#pragma unroll
          for (int ei = 0; ei < 2; ++ei) vf[ei] = *(const LAS bf16x8*)(vT + tofs(h * 64 + ((w & 1) * 2 + ei) * 16 + lr, 32 * ks + 8 * lq));
#pragma unroll
          for (int dt = 0; dt < 4; ++dt) { const bf16x8 kf = *(const LAS bf16x8*)(kT + tofs(h * 64 + dt * 16 + lr, 32 * ks + 8 * lq));
#pragma unroll
              for (int ei = 0; ei < 2; ++ei) acc[dt][ei] = MFMA16(kf, vf[ei], acc[dt][ei]); } }
#pragma unroll
      for (int dt = 0; dt < 4; ++dt)
#pragma unroll
          for (int ei = 0; ei < 2; ++ei) *(f32x4*)(RET + (((size_t)ch * NHEAD + h) * 64 + ((w & 1) * 2 + ei) * 16 + lr) * 64 + dt * 16 + 4 * lq) = acc[dt][ei] * g127; }
    __syncthreads();
}

template <int l> __device__ __forceinline__ void pre_phase(Frame& F, const Args& args) {
    for (int ch = F.vcu; ch < NTOK / CHUNK; ch += F.G) {
        const int t0 = ch * CHUNK;
        pre_conv<l>(F, args, t0);
        pre_mla<l>(F, args, t0);
        pre_sgu<l>(F, args, t0);
        pre_retkv(F, args, t0, ch);
    }
}
#define MFMA32(a, b, c) __builtin_amdgcn_mfma_f32_32x32x16_bf16((a), (b), (c), 0, 0, 0)
typedef short s16x4 __attribute__((ext_vector_type(4)));
constexpr int AT_KROW = 208, AT_VROW = 136, AT_KBYTES = 64 * AT_KROW, AT_STAGE = 22528;
__device__ __forceinline__ int crow32(int r, int hi) { return (r & 3) + 8 * (r >> 2) + 4 * hi; }

__device__ __forceinline__ void attn_unit(Frame& F, const bf16* Q, const bf16* Kb, const bf16* VT, bf16* YB, const float nbnd, const int b, const int h, const int qb) {
    int tid_ = F_TID; asm volatile("" : "+v"(tid_)); const int tid = tid_, lane = tid & 63, r32 = lane & 31, hi = lane >> 5, w = F.wave;
    LAS unsigned char* lds = F.lds + RING_OFF;
    const int bh = b * NHEAD + h, qw0 = qb * 256 + w * 32;
    const size_t tq = (size_t)b * SEQ + qw0 + r32;
    bf16x8 qf[6];
#pragma unroll
    for (int s = 0; s < 6; ++s) qf[s] = *(const bf16x8*)(Q + tq * QW + h * 96 + 16 * s + 8 * hi);
    f32x16 o0, o1, negb; float lsum = 0.f;
#pragma unroll
    for (int r = 0; r < 16; ++r) { o0[r] = 0.f; o1[r] = 0.f; negb[r] = nbnd; }
    asm volatile("" : "+v"(negb));
    const int ntile = 4 * qb + 4;
    const int kr0 = tid / 12, kc0 = tid % 12, kr1 = (tid + 512) / 12, kc1 = (tid + 512) % 12, vd = tid >> 3, vc = tid & 7;
    const bf16* kg0 = Kb + ((size_t)b * SEQ + kr0) * QW + h * 96 + kc0 * 8; const bf16* kg1 = Kb + ((size_t)b * SEQ + kr1) * QW + h * 96 + kc1 * 8;
    const bf16* vg = VT + ((size_t)bh * SEQ + vd) * 64 + vc * 8;
    const int kl0 = kr0 * AT_KROW + kc0 * 16, kl1 = kr1 * AT_KROW + kc1 * 16, vl = AT_KBYTES + vd * AT_VROW + vc * 16;
    v4u rk0, rk1, rv; rk1 = (v4u){0u, 0u, 0u, 0u};
    rk0 = *(const v4u*)kg0; if (tid < 256) rk1 = *(const v4u*)kg1; rv = *(const v4u*)vg;
    *(LAS v4u*)(lds + kl0) = rk0; if (tid < 256) *(LAS v4u*)(lds + kl1) = rk1;
    *(LAS v2u*)(lds + vl) = (v2u){rv.x, rv.y}; *(LAS v2u*)(lds + vl + 8) = (v2u){rv.z, rv.w};
    __syncthreads();
    const int ka = r32 * AT_KROW + hi * 16;
    const int va = AT_KBYTES + r32 * AT_VROW + hi * 8;
    for (int t = 0; t < ntile; ++t) {
        LAS unsigned char* cur = lds + (t & 1) * AT_STAGE; LAS unsigned char* nxt = lds + ((t + 1) & 1) * AT_STAGE;
        const bool more = (t + 1 < ntile);
        if (more) { const size_t ko = (size_t)(t + 1) * 64 * QW; rk0 = *(const v4u*)(kg0 + ko); if (tid < 256) rk1 = *(const v4u*)(kg1 + ko); rv = *(const v4u*)(vg + (size_t)(t + 1) * 4096); }
        if (64 * t <= qw0 + 31) {
            f32x16 p0, p1;
#pragma unroll
            for (int s = 0; s < 6; ++s) { const bf16x8 k0 = *(const LAS bf16x8*)(cur + ka + s * 32), k1 = *(const LAS bf16x8*)(cur + ka + 32 * AT_KROW + s * 32);
                if (s == 0) { p0 = MFMA32(k0, qf[0], negb); p1 = MFMA32(k1, qf[0], negb); } else { p0 = MFMA32(k0, qf[s], p0); p1 = MFMA32(k1, qf[s], p1); } }
#pragma unroll
            for (int r = 0; r < 16; ++r) { p0[r] = __builtin_amdgcn_exp2f(p0[r]); p1[r] = __builtin_amdgcn_exp2f(p1[r]); }
            if (64 * t + 63 > qw0) {
                const int qrel = qw0 + r32 - 64 * t;
#pragma unroll
                for (int r = 0; r < 16; ++r) { const int kk = crow32(r, hi); if (kk > qrel) p0[r] = 0.f; if (kk + 32 > qrel) p1[r] = 0.f; }
            }
            float sacc = 0.f;
#pragma unroll
            for (int r = 0; r < 16; ++r) sacc += p0[r] + p1[r];
            lsum += sacc;
            bf16x8 pb[2][2];
#pragma unroll
            for (int s2 = 0; s2 < 2; ++s2) {
                const v4u a = {pg8::cvt_pk_bf16(p0[8 * s2 + 0], p0[8 * s2 + 1]), pg8::cvt_pk_bf16(p0[8 * s2 + 2], p0[8 * s2 + 3]), pg8::cvt_pk_bf16(p0[8 * s2 + 4], p0[8 * s2 + 5]), pg8::cvt_pk_bf16(p0[8 * s2 + 6], p0[8 * s2 + 7])};
                const v4u c = {pg8::cvt_pk_bf16(p1[8 * s2 + 0], p1[8 * s2 + 1]), pg8::cvt_pk_bf16(p1[8 * s2 + 2], p1[8 * s2 + 3]), pg8::cvt_pk_bf16(p1[8 * s2 + 4], p1[8 * s2 + 5]), pg8::cvt_pk_bf16(p1[8 * s2 + 6], p1[8 * s2 + 7])};
                pb[0][s2] = __builtin_bit_cast(bf16x8, a); pb[1][s2] = __builtin_bit_cast(bf16x8, c); }
#pragma unroll
            for (int kh = 0; kh < 2; ++kh)
#pragma unroll
                for (int s2 = 0; s2 < 2; ++s2) {
                    const int ko = (kh * 32 + 16 * s2) * 2;
                    const s16x4 a0 = *(const LAS s16x4*)(cur + va + ko), a1 = *(const LAS s16x4*)(cur + va + ko + 16);
                    const s16x4 c0 = *(const LAS s16x4*)(cur + va + 32 * AT_VROW + ko), c1 = *(const LAS s16x4*)(cur + va + 32 * AT_VROW + ko + 16);
                    const bf16x8 vf0 = {a0[0], a0[1], a0[2], a0[3], a1[0], a1[1], a1[2], a1[3]}, vf1 = {c0[0], c0[1], c0[2], c0[3], c1[0], c1[1], c1[2], c1[3]};
                    o0 = MFMA32(vf0, pb[kh][s2], o0); o1 = MFMA32(vf1, pb[kh][s2], o1); }
        }
        if (more) { *(LAS v4u*)(nxt + kl0) = rk0; if (tid < 256) *(LAS v4u*)(nxt + kl1) = rk1; *(LAS v2u*)(nxt + vl) = (v2u){rv.x, rv.y}; *(LAS v2u*)(nxt + vl + 8) = (v2u){rv.z, rv.w}; }
        __syncthreads();
    }
    lsum += __shfl_xor(lsum, 32);
    const float il = 1.f / lsum;
    bf16* orow = YB + tq * DM + 256 + h * 64;
#pragma unroll
    for (int g = 0; g < 4; ++g) {
        v2u a; a.x = pg8::cvt_pk_bf16(o0[4 * g] * il, o0[4 * g + 1] * il); a.y = pg8::cvt_pk_bf16(o0[4 * g + 2] * il, o0[4 * g + 3] * il); *(v2u*)(orow + 8 * g + 4 * hi) = a;
        v2u c; c.x = pg8::cvt_pk_bf16(o1[4 * g] * il, o1[4 * g + 1] * il); c.y = pg8::cvt_pk_bf16(o1[4 * g + 2] * il, o1[4 * g + 3] * il); *(v2u*)(orow + 32 + 8 * g + 4 * hi) = c; }
}

template <int l> __device__ __forceinline__ void ret_out_chunk(Frame& F, const Args& args, const int ch) {
    unsigned char* ws = K_WS;
    const bf16* P = (const bf16*)(ws + WS_PROJ); const float* RET = (const float*)(ws + WS_RET); bf16* YB = (bf16*)(ws + WS_YB); const float* ret_g = (const float*)K_IN(IN_RETG) + l * 256;
    LAS unsigned char* vT = F.lds + RING_OFF;
    int lane_ = F_LANE; asm volatile("" : "+v"(lane_)); const int lane = lane_, lr = lane & 15, lq = lane >> 4, w = F.wave;
    const int t0 = ch * CHUNK;
    v2u vv16[16];
#pragma unroll
    for (int j = 0; j < 16; ++j) vv16[j] = *(const v2u*)(P + (size_t)(t0 + 16 * w + j) * PROJW + C_RV + 4 * lane);
#pragma unroll
    for (int j = 0; j < 16; ++j) { const int s = 16 * w + j; const v2u vv = vv16[j];
        *(LAS bf16*)(vT + tofs(4 * lane + 0, s)) = (bf16)(vv.x & 0xffff); *(LAS bf16*)(vT + tofs(4 * lane + 1, s)) = (bf16)(vv.x >> 16);
        *(LAS bf16*)(vT + tofs(4 * lane + 2, s)) = (bf16)(vv.y & 0xffff); *(LAS bf16*)(vT + tofs(4 * lane + 3, s)) = (bf16)(vv.y >> 16); }
    __syncthreads();
    const size_t ti = (size_t)t0 + 16 * w + lr;
#pragma unroll 1
    for (int h = 0; h < NHEAD; ++h) {
        const float gam = __expf(nv::ret_loggamma(h));
        bf16x8 qf[2];
#pragma unroll
        for (int ks = 0; ks < 2; ++ks) qf[ks] = *(const bf16x8*)(P + ti * PROJW + C_RQ + h * 64 + 32 * ks + 8 * lq);
        f32x4 acc[4];
#pragma unroll
        for (int et = 0; et < 4; ++et) acc[et] = (f32x4){0.f, 0.f, 0.f, 0.f};
        bf16x8 kfa[8][2];
#pragma unroll
        for (int jt = 0; jt < 8; ++jt) if (jt <= w) {
#pragma unroll
            for (int ks = 0; ks < 2; ++ks) kfa[jt][ks] = *(const bf16x8*)(P + (size_t)(t0 + jt * 16 + lr) * PROJW + C_RK + h * 64 + 32 * ks + 8 * lq); }
#pragma unroll
        for (int kk = 0; kk < 4; ++kk) if (kk <= (w >> 1)) {
            const int jt0 = 2 * kk, jt1 = 2 * kk + 1;
            f32x4 s0 = {0.f, 0.f, 0.f, 0.f}, s1 = {0.f, 0.f, 0.f, 0.f};
#pragma unroll
            for (int ks = 0; ks < 2; ++ks) s0 = MFMA16(kfa[jt0][ks], qf[ks], s0);
            if (jt1 <= w) {
#pragma unroll
                for (int ks = 0; ks < 2; ++ks) s1 = MFMA16(kfa[jt1][ks], qf[ks], s1); }
            if (jt0 == w) {
#pragma unroll
                for (int r = 0; r < 4; ++r) if (4 * lq + r > lr) s0[r] = 0.f; }
            if (jt1 == w) {
#pragma unroll
                for (int r = 0; r < 4; ++r) if (4 * lq + r > lr) s1[r] = 0.f; }
            const v4u pw = {pk2(s0[0], s0[1]), pk2(s0[2], s0[3]), pk2(s1[0], s1[1]), pk2(s1[2], s1[3])};
            const bf16x8 pb = __builtin_bit_cast(bf16x8, pw);
#pragma unroll
            for (int et = 0; et < 4; ++et) { const int row = h * 64 + et * 16 + lr;
                const s16x4 a0 = *(const LAS s16x4*)(vT + tofs(row, jt0 * 16 + 4 * lq)), a1 = *(const LAS s16x4*)(vT + tofs(row, (jt1 & 7) * 16 + 4 * lq));
                const bf16x8 vf = {a0[0], a0[1], a0[2], a0[3], a1[0], a1[1], a1[2], a1[3]};
                acc[et] = MFMA16(vf, pb, acc[et]); }
        }
#pragma unroll
        for (int ks = 0; ks < 2; ++ks)
#pragma unroll
            for (int et = 0; et < 4; ++et) { const float* pr = RET + (((size_t)ch * NHEAD + h) * 64 + et * 16 + lr) * 64 + 32 * ks + 8 * lq; const f32x4 x0 = *(const f32x4*)pr, x1 = *(const f32x4*)(pr + 4);
                const v4u pw = {pk2(x0[0] * gam, x0[1] * gam), pk2(x0[2] * gam, x0[3] * gam), pk2(x1[0] * gam, x1[1] * gam), pk2(x1[2] * gam, x1[3] * gam)};
                acc[et] = MFMA16(__builtin_bit_cast(bf16x8, pw), qf[ks], acc[et]); }
        float mu = 0.f;
#pragma unroll
        for (int et = 0; et < 4; ++et) mu += acc[et][0] + acc[et][1] + acc[et][2] + acc[et][3];
        mu += __shfl_xor(mu, 16); mu += __shfl_xor(mu, 32); mu *= (1.f / 64);
        float var = 0.f;
#pragma unroll
        for (int et = 0; et < 4; ++et) { acc[et] = acc[et] - mu; var += acc[et][0] * acc[et][0] + acc[et][1] * acc[et][1] + acc[et][2] * acc[et][2] + acc[et][3] * acc[et][3]; }
        var += __shfl_xor(var, 16); var += __shfl_xor(var, 32);
        const float rs = rsqrtf(var * (1.f / 64) + EPS);
        v2u rga[4]; f32x4 ga[4];
#pragma unroll
        for (int et = 0; et < 4; ++et) { const int c = h * 64 + et * 16 + 4 * lq; rga[et] = *(const v2u*)(P + ti * PROJW + C_RG + c); ga[et] = *(const f32x4*)(ret_g + c); }
#pragma unroll
        for (int et = 0; et < 4; ++et) { const int c = h * 64 + et * 16 + 4 * lq; const v2u rg = rga[et]; const f32x4 g = ga[et];
            const float r0 = bflo_(rg.x), r1 = bfhi_(rg.x), r2 = bflo_(rg.y), r3 = bfhi_(rg.y);
            v2u o; o.x = pk2(r0 * pg8::fast_sigmoid(r0) * acc[et][0] * rs * g[0], r1 * pg8::fast_sigmoid(r1) * acc[et][1] * rs * g[1]);
            o.y = pk2(r2 * pg8::fast_sigmoid(r2) * acc[et][2] * rs * g[2], r3 * pg8::fast_sigmoid(r3) * acc[et][3] * rs * g[3]);
            *(v2u*)(YB + ti * DM + 768 + c) = o; }
    }
    __syncthreads();
}

template <int l> __device__ __forceinline__ void attn_phase(Frame& F, const Args& args) {
    for (int p = F.vcu; p < NBATCH * NHEAD * 32; p += F.G) {
        const int bh = p >> 5, s = p & 31; const float nbnd = -((const float*)(K_WS + WS_BND))[l];
        attn_unit(F, (const bf16*)(K_WS + WS_Q), (const bf16*)(K_WS + WS_K), (const bf16*)(K_WS + WS_VT), (bf16*)(K_WS + WS_YB), nbnd, bh / NHEAD, bh % NHEAD, 63 - s);
        attn_unit(F, (const bf16*)(K_WS + WS_Q), (const bf16*)(K_WS + WS_K), (const bf16*)(K_WS + WS_VT), (bf16*)(K_WS + WS_YB), nbnd, bh / NHEAD, bh % NHEAD, s);
    }
    for (int ch = F.vcu; ch < NTOK / CHUNK; ch += F.G) ret_out_chunk<l>(F, args, ch);
}
#ifndef MEGA_THIN
#define MEGA_THIN 0
#endif

#ifndef FFN_FP8
#define FFN_FP8 0
#endif
#ifndef GATE_FP8
#define GATE_FP8 1
#endif
#ifndef REV_GM
#define REV_GM 15
#endif
#ifndef REV_FD
#define REV_FD 15
#endif
#ifndef XB16
#define XB16 1
#endif
#ifndef RPT_MASK
#define RPT_MASK 0
#endif
#define RPT(bit) _Pragma("unroll") for (int rep_ = 0; rep_ < 1 + ((RPT_MASK >> (bit)) & 1); ++rep_)
__device__ __forceinline__ bool in_range(int k, int lo, int hi) { asm volatile("" : "+s"(lo)); return lo <= k && k < hi; }
#define IN(k) (in_range((k), lo, hi))
#ifndef BAR_REP
#define BAR_REP 1
#endif
#define SEAM(k) do { if (IN(k) && IN((k) + 1)) { for (int br_ = 0; br_ < BAR_REP; ++br_) xcd_barrier(bar, F.wave); } } while (0)
#define INF(i) ((const float*)K_IN(i))
template <int l> __device__ __forceinline__ void layer_phases(Frame& F, const Args& args, const XcdBarrier& bar, const int lo, const int hi) {
#define ws (K_WS)
#define ADA ((float*)(K_WS + WS_ADA))
#define bH ((bf16*)(K_WS + WS_H))
#define bYB ((bf16*)(K_WS + WS_YB))
#define bP ((bf16*)(K_WS + WS_PROJ))
#define bG ((bf16*)(K_WS + WS_G))
#define bMG bYB
#define bU bP
#define bX (K_OUT)
#define ring (F.lds + RING_OFF)
#define ada_l (ADA + (size_t)l * 2 * 6 * DM)
#define Xin ((l == 0) ? INF(IN_X) : (const float*)bX)
#define WIN_T ((const bf16*)(K_WS + WS_WIN_T) + (size_t)l * 6912 * DM)

        if (IN(PHL(l, PL_NORM1))) { RPT(8) {
#if MEGA_THIN >= 1
            norm_phase(F, (XB16 && l > 0) ? (const float*)(K_WS + WS_XB) : Xin, bH, INF(IN_N1G) + l * DM, ada_l, A_SH1, A_SC1, nullptr, nullptr, nullptr, nullptr, GATE_FP8 ? (unsigned char*)(K_WS + WS_H8) : nullptr, (float*)(K_WS + WS_SH), XB16 && l > 0);
#endif
        } }
        SEAM(PHL(l, PL_NORM1));
        if (IN(PHL(l, PL_INPROJ))) { RPT(1) {
            pg8::DenseOrder S{(const char*)bH, (const char*)WIN_T, (size_t)256 * DM * 2, (size_t)256 * DM * 2, NTOK / 256, PROJW / 256, F.G, (int)blockIdx.x};
            pg8::EpiBf16<0> E{bP, PROJW, 0};
            pg8::gemm_phase(ring, F.wave, DM, DM, DM, S, E);
        } }
        SEAM(PHL(l, PL_INPROJ));
        if (IN(PHL(l, PL_PRE))) {
#if MEGA_THIN >= 2
            pre_phase<l>(F, args);
#endif
        }
        SEAM(PHL(l, PL_PRE));
        if (IN(PHL(l, PL_SCAN))) {
#if MEGA_THIN >= 1
            scan_phase(F, (float*)(ws + WS_RET));
#endif
        }
        SEAM(PHL(l, PL_SCAN));
        if (IN(PHL(l, PL_ATTN))) { RPT(2) {
#if MEGA_THIN >= 3
            attn_phase<l>(F, args);
#endif
        } }
        SEAM(PHL(l, PL_ATTN));
        if (IN(PHL(l, PL_GATE))) { RPT(3) {
            pg8::MergeOrder S{(const char*)bYB, (const char*)((const bf16*)(K_WS + WS_WBR_T) + (size_t)l * 4 * DM * MIXW), NTOK / 256, DM / 256, F.G, (int)blockIdx.x};
            pg8::EpiZTile E{bG};
            int kz = MIXW; asm volatile("" : "+s"(kz));
            pg8::gemm_phase(ring, F.wave, DM, MIXW, kz, S, E);
        } }
        SEAM(PHL(l, PL_GATE));
        if (IN(PHL(l, PL_MERGE))) { RPT(4) {
#if GATE_FP8
            pg8::DenseOrder S{(const char*)(K_WS + WS_H8), (const char*)(WIN_T + (size_t)PROJW * DM), (size_t)256 * DM, (size_t)256 * DM, NTOK / 256, GATEW / 256, F.G, (int)blockIdx.x, REV_GM};
            pg8::EpiGM8 E{bG, bMG, (const float*)(K_WS + WS_SH), (const float*)(K_WS + WS_SW) + l * GATEW};
            int kg = DM / 2; asm volatile("" : "+s"(kg));
            pg8::gemm_phase<pg8::EpiGM8, pg8::DenseOrder, true>(ring, F.wave, DM / 2, DM / 2, kg, S, E);
#else
            pg8::DenseOrder S{(const char*)bH, (const char*)(WIN_T + (size_t)PROJW * DM), (size_t)256 * DM * 2, (size_t)256 * DM * 2, NTOK / 256, GATEW / 256, F.G, (int)blockIdx.x};
            pg8::EpiGM E{bG, bMG};
            pg8::gemm_phase(ring, F.wave, DM, DM, DM, S, E);
#endif
        } }
        SEAM(PHL(l, PL_MERGE));
        if (IN(PHL(l, PL_WO))) {
            pg8::DenseOrder S{(const char*)bMG, (const char*)((const bf16*)(ws + WS_WO_T) + (size_t)l * DM * DM), (size_t)256 * DM * 2, (size_t)256 * DM * 2, NTOK / 256, DM / 256, F.G, (int)blockIdx.x};
#if XB16
            if constexpr (l == 0) { pg8::EpiResidT<false, true> E{INF(IN_X), (void*)(K_WS + WS_XB), ada_l + A_G1}; pg8::gemm_phase(ring, F.wave, DM, DM, DM, S, E); }
            else { pg8::EpiResidT<true, false> E{(const void*)(K_WS + WS_XB), (void*)bX, ada_l + A_G1}; pg8::gemm_phase(ring, F.wave, DM, DM, DM, S, E); }
#else
            pg8::EpiResid E{Xin, bX, ada_l + A_G1};
            pg8::gemm_phase(ring, F.wave, DM, DM, DM, S, E);
#endif
        }
        SEAM(PHL(l, PL_WO));
        if (IN(PHL(l, PL_NORM2))) {
#if MEGA_THIN >= 1
            if (l == 0) norm_phase(F, XB16 ? (const float*)(K_WS + WS_XB) : (const float*)bX, bH, INF(IN_N2G) + l * DM, ada_l, A_SH2, A_SC2, nullptr, nullptr, nullptr, nullptr, FFN_FP8 ? (unsigned char*)(K_WS + WS_H8) : nullptr, (float*)(K_WS + WS_SH), XB16 != 0);
            else norm_phase(F, bX, nullptr  , INF(IN_N2G) + l * DM, ada_l, A_SH2, A_SC2, INF(IN_RW), INF(IN_RB), (nv::Route*)(ws + WS_ROUTE), (int*)(ws + WS_CNT), (unsigned char*)(K_WS + WS_H8), (float*)(K_WS + WS_SH), false, 2);
#endif
        }
        SEAM(PHL(l, PL_NORM2));
        if constexpr (l == 0) {
            if (IN(PHL(l, PL_F0))) { RPT(5) {
#if FFN_FP8
                pg8::DenseOrder S{(const char*)(K_WS + WS_H8), (const char*)(ws + WS_F13_T), (size_t)256 * DM, (size_t)256 * DM, NTOK / 256, 2 * DFF / 256, F.G, (int)blockIdx.x};
                pg8::EpiSwiglu8 E{bU, DFF, (const float*)(K_WS + WS_SH), (const float*)(K_WS + WS_SWF)};
                int kf = DM / 2; asm volatile("" : "+s"(kf));
                pg8::gemm_phase<pg8::EpiSwiglu8, pg8::DenseOrder, true>(ring, F.wave, DM / 2, DM / 2, kf, S, E);
#else
                pg8::DenseOrder S{(const char*)bH, (const char*)(ws + WS_F13_T), (size_t)256 * DM * 2, (size_t)256 * DM * 2, NTOK / 256, 2 * DFF / 256, F.G, (int)blockIdx.x};
                pg8::EpiSwiglu E{bU, DFF};
                pg8::gemm_phase(ring, F.wave, DM, DM, DM, S, E);
#endif
            } }
            SEAM(PHL(l, PL_F0));
            if (IN(PHL(l, PL_F1))) {
                pg8::DenseOrder S{(const char*)bU, (const char*)(ws + WS_F2_T), (size_t)256 * DFF * 2, (size_t)256 * DFF * 2, NTOK / 256, DM / 256, F.G, (int)blockIdx.x, REV_FD};
#if XB16
                pg8::EpiResidT<true, true> E{(const void*)(K_WS + WS_XB), (void*)(K_WS + WS_XB), ada_l + A_G2};
#else
                pg8::EpiResid E{bX, bX, ada_l + A_G2};
#endif
                pg8::gemm_phase(ring, F.wave, DFF, DFF, DFF, S, E);
            }
            SEAM(PHL(l, PL_F1));
        } else {
#define XS ((bf16*)(K_WS + WS_XS))
#define HID ((bf16*)(K_WS + WS_HID))
#define PEXP ((const int*)(K_WS + WS_PEXP))
#define PSLOT ((const float*)(K_WS + WS_PSLOT))
            if (IN(PHL(l, PL_F0))) {
#if MEGA_THIN >= 1
                moe_assign_phase(F, args);
#endif
                RPT(9) {
                amax_job(F, INF(IN_M1), (size_t)DM * DFFE, DFFE, (unsigned*)(K_WS + WS_AMAXM), DFFE, NEXP);
                amax_job(F, INF(IN_M3), (size_t)DM * DFFE, DFFE, (unsigned*)(K_WS + WS_AMAXM) + NEXP * DFFE, DFFE, NEXP);
                amax_job(F, INF(IN_M2), (size_t)DFFE * DM, DM, (unsigned*)(K_WS + WS_AMAXM) + AMAXM_W2, DM, NEXP, DFFE);
                xcd_barrier(bar, F.wave);
                if (rep_ == 0) moe_gather_phase(F);
                convert_w8_job(F, INF(IN_M1), (size_t)DM * DFFE, DFFE, (unsigned char*)(K_WS + WS_MW13_T), (size_t)2 * DFFE * DM, 2, (const unsigned*)(K_WS + WS_AMAXM), DFFE, (float*)(K_WS + WS_SWM), 2 * DFFE, NEXP, 0);
                convert_w8_job(F, INF(IN_M3), (size_t)DM * DFFE, DFFE, (unsigned char*)(K_WS + WS_MW13_T), (size_t)2 * DFFE * DM, 3, (const unsigned*)(K_WS + WS_AMAXM) + NEXP * DFFE, DFFE, (float*)(K_WS + WS_SWM), 2 * DFFE, NEXP, 977);
                convert_w8_job(F, INF(IN_M2), (size_t)DFFE * DM, DM, (unsigned char*)(K_WS + WS_MW2_T), (size_t)DM * DFFE, 0, (const unsigned*)(K_WS + WS_AMAXM) + AMAXM_W2, DM, (float*)(K_WS + WS_SWM2), DM, NEXP, 1301, DFFE);
                }
            }
            SEAM(PHL(l, PL_F0));
            for (int c = 0; c < NCH; ++c) {
                const int p0 = c * CH0_PANELS; int npan = PEXP[MAXPANEL] - p0; { const int cap = (c == 0) ? CH0_PANELS : CH1_PANELS; npan = npan > cap ? cap : npan; }
                if (IN(PHL(l, PL_F1 + 2 * c))) { RPT(6) {
                    pg8::MoeOrder S{(const char*)(K_WS + WS_XS8 + (size_t)p0 * 256 * DM), (const char*)(ws + WS_MW13_T), (size_t)256 * DM, (size_t)256 * DM, PEXP, p0, npan, 2 * DFFE / 256, F.G, (int)blockIdx.x};
                    pg8::EpiSwiglu8X E{(unsigned char*)(K_WS + WS_HID), (unsigned char*)(K_WS + WS_SCT), (const float*)(K_WS + WS_SXS) + p0 * 256, (const float*)(K_WS + WS_SWM)};
                    int ku = DM / 2; asm volatile("" : "+s"(ku));
                    pg8::gemm_phase<pg8::EpiSwiglu8X, pg8::MoeOrder, 1>(ring, F.wave, DM / 2, DM / 2, ku, S, E);
                } }
                SEAM(PHL(l, PL_F1 + 2 * c));
                if (IN(PHL(l, PL_F2 + 2 * c))) { RPT(7) {
                    const int nreg = (c == 1 && npan > CH0_PANELS) ? CH0_PANELS : npan, ntail = npan - nreg;
                    { pg8::MoeOrderX S{(const char*)(K_WS + WS_HID), (const char*)(ws + WS_MW2_T), (const char*)(K_WS + WS_SCT), (size_t)256 * DFFE, (size_t)256 * DFFE, (size_t)28 * 1024, PEXP, p0, nreg, DM / 256, F.G, (int)blockIdx.x};
                      pg8::EpiMoeDown8 E{XS + (size_t)p0 * 256 * DM, PSLOT + p0 * 256, (const float*)(K_WS + WS_SWM2)};
                      pg8::gemm_phase<pg8::EpiMoeDown8, pg8::MoeOrderX, 2>(ring, F.wave, DFFE / 2, DFFE / 2, DFFE / 2, S, E); }
                    if (c == 1 && ntail > 0) {
                        pg8::MoeTailOrderX S{(const char*)(K_WS + WS_HID) + (size_t)nreg * 256 * DFFE, (const char*)(ws + WS_MW2_T), (const char*)(K_WS + WS_SCT) + (size_t)nreg * 28 * 1024, (size_t)256 * DFFE, (size_t)256 * DFFE, (size_t)28 * 1024, PEXP, p0 + nreg, ntail, F.G, (int)blockIdx.x};
                        pg8::EpiMoePart8 E{(bf16*)(K_WS + WS_PART), PSLOT + (p0 + nreg) * 256, (const float*)(K_WS + WS_SWM2)};
                        int kq = 896; asm volatile("" : "+s"(kq));
                        pg8::gemm_phase<pg8::EpiMoePart8, pg8::MoeTailOrderX, 2>(ring, F.wave, DFFE / 2, DFFE / 2, kq, S, E);
                    }
                } }
                SEAM(PHL(l, PL_F2 + 2 * c));
            }
            if (IN(PHL(l, PL_F5))) {
#if MEGA_THIN >= 1
                { const int ptot = PEXP[MAXPANEL], tail0 = (ptot > 2 * CH0_PANELS) ? 2 * CH0_PANELS * 256 : 0x7fffffff;
                  moe_combine_phase(F, bX, XS, (const bf16*)(K_WS + WS_PART), tail0, (const int*)(ws + WS_SLOT), ada_l + A_G2); }
#endif
            }
        }
#undef XS
#undef HID
#undef PEXP
#undef PSLOT
#undef ws
#undef ADA
#undef bH
#undef bYB
#undef bP
#undef bG
#undef bMG
#undef bU
#undef bX
#undef ring
#undef ada_l
#undef Xin
#undef WIN_T
}

__global__ void __launch_bounds__(NWAVES * 64, 2) mega(Args args) {
    extern __shared__ __attribute__((aligned(16))) unsigned char lds_raw[];
    Frame F;
    F.lds = (LAS unsigned char*)lds_raw;
    F.MISC = (volatile LAS unsigned*)(F.lds + MISC_OFF);
    F.wave = __builtin_amdgcn_readfirstlane((int)threadIdx.x >> 6);
    F.G = gridDim.x; { const int bx = blockIdx.x; F.vcu = (F.G % 8 == 0) ? (bx % 8) * (F.G / 8) + bx / 8 : bx; }
    unsigned char* ws = K_WS;
    F.ctl = (unsigned*)(ws + WS_CTL);
    for (int u = F_TID; u < (LDS_BYTES - LDSCTL_OFF) / 4; u += NWAVES * 64) ((LAS unsigned*)(F.lds + LDSCTL_OFF))[u] = 0u;
    __syncthreads();
    XcdBarrier bar = xcd_barrier_post(F.ctl + CW_BAR + args.li * XCD_BAR_WORDS, F.MISC + 8);
    const int lo = args.ph_lo, hi = args.ph_hi;
    float* ADA = (float*)(ws + WS_ADA); float* BND = (float*)(ws + WS_BND);
    LAS unsigned char* ring = F.lds + RING_OFF;

    if (IN(PH_PRO)) { RPT(0) {
        for (int it = F.vcu; it < DEPTH * 96; it += F.G) {
            const int l = it / 96, j0 = (it % 96) * 64; const float* c = INF(IN_C);
            const float* w = INF(IN_ADAW) + (size_t)l * DM * 6 * DM + j0 + F_LANE;
            float a0 = 0.f, a1 = 0.f;
#pragma unroll 16
            for (int kk = 0; kk < 128; ++kk) { const int k = F.wave * 128 + kk; const float wv = w[(size_t)k * 6 * DM]; const float s0 = silu_f(c[k]), s1 = silu_f(c[DM + k]); a0 += s0 * wv; a1 += s1 * wv; }
            LAS float* red = (LAS float*)ring;
            red[(F.wave * 2 + 0) * 64 + F_LANE] = a0; red[(F.wave * 2 + 1) * 64 + F_LANE] = a1;
            __syncthreads();
            if (F_TID < 128) { const int b = F_TID >> 6, col = F_TID & 63; float s = INF(IN_ADAB)[l * 6 * DM + j0 + col];
#pragma unroll
              for (int w8 = 0; w8 < 8; ++w8) s += red[(w8 * 2 + b) * 64 + col];
              ADA[(size_t)(l * 2 + b) * 6 * DM + j0 + col] = s; }
            __syncthreads();
        }
        if (blockIdx.x == 0 && F_TID < DEPTH) { const int l = F_TID; float a = 0.f, b = 0.f;
            for (int i = 0; i < QKH; ++i) { a = fmaxf(a, fabsf(INF(IN_QNG)[l * QKH + i])); b = fmaxf(b, fabsf(INF(IN_KNG)[l * QKH + i])); }
            BND[l] = 9.797958971132712f * 1.4426950408889634f * a * b * 1.001f; }
        { bf16* WST = (bf16*)(ws + WS_WS_T); const float* wsrc = INF(IN_WS);
          for (int i = (F.vcu * NWAVES * 64 + F_TID); i < DEPTH * 4 * 128 * 128; i += F.G * NWAVES * 64) { const int t = (i >> 7) & 127, s = i & 127; WST[i] = (s <= t) ? f2bf(wsrc[i]) : (bf16)0; } }
        { unsigned* am = (unsigned*)(ws + WS_AMAXM); for (int i = F.vcu * NWAVES * 64 + F_TID; i < 2 * NEXP * DFFE + NEXP * DM; i += F.G * NWAVES * 64) am[i] = 0u; }
        int rot = 0;
        convert_job(F, INF(IN_WIN), (size_t)DM * D_IN, DM, D_IN, (bf16*)(ws + WS_WIN_T), (size_t)6912 * DM, DM, 1, nullptr, DEPTH, rot, GATE_FP8 ? NPROJ_SRC : 0); rot += 331;
        if (GATE_FP8) { const int NGW = F.G * NWAVES, gw = F.vcu * NWAVES + F.wave, lane = F_LANE;
          for (int it = gw; it < DEPTH * 16 * 16; it += NGW) { const int l = it >> 8, kb = (it >> 4) & 15, cb = it & 15; const float* wp = INF(IN_WIN) + (size_t)l * DM * D_IN + (size_t)(kb * 64) * D_IN + NPROJ_SRC + cb * 256 + 4 * lane;
              float4 mx = make_float4(0.f, 0.f, 0.f, 0.f);
#pragma unroll 16
              for (int r = 0; r < 64; ++r) { const float4 v = *(const float4*)(wp + (size_t)r * D_IN); mx.x = fmaxf(mx.x, fabsf(v.x)); mx.y = fmaxf(mx.y, fabsf(v.y)); mx.z = fmaxf(mx.z, fabsf(v.z)); mx.w = fmaxf(mx.w, fabsf(v.w)); }
              unsigned* am = F.ctl + CW_AMAX + l * GATEW + cb * 256 + 4 * lane;
              atomicMax(am + 0, __float_as_uint(mx.x)); atomicMax(am + 1, __float_as_uint(mx.y)); atomicMax(am + 2, __float_as_uint(mx.z)); atomicMax(am + 3, __float_as_uint(mx.w)); } }
        convert_job(F, INF(IN_WBR), (size_t)MIXW * DM, MIXW, DM, (bf16*)(ws + WS_WBR_T), (size_t)DM * MIXW, MIXW, 0, nullptr, DEPTH * 4, rot); rot += 331;
        convert_job(F, INF(IN_WO), (size_t)DM * DM, DM, DM, (bf16*)(ws + WS_WO_T), (size_t)DM * DM, DM, 0, nullptr, DEPTH, rot); rot += 331;
        if (!FFN_FP8) { convert_job(F, INF(IN_F1), 0, DM, DFF, (bf16*)(ws + WS_F13_T), 0, DM, 2, nullptr, 1, rot); rot += 331;
                        convert_job(F, INF(IN_F3), 0, DM, DFF, (bf16*)(ws + WS_F13_T), 0, DM, 3, nullptr, 1, rot); rot += 331; }
        else { amax_job(F, INF(IN_F1), 0, DFF, F.ctl + CW_AMAXF, 0, 1); amax_job(F, INF(IN_F3), 0, DFF, F.ctl + CW_AMAXF + DFF, 0, 1); }
        convert_job(F, INF(IN_F2), 0, DFF, DM, (bf16*)(ws + WS_F2_T), 0, DFF, 0, nullptr, 1, rot); rot += 331;
        for (int l = 0; l < DEPTH; ++l) {
            convert_job(F, INF(IN_WUQ) + (size_t)l * 256 * QW, 0, 256, QW, (bf16*)(ws + WS_WUQ_T) + (size_t)l * QW * 256, 0, 256, 0, INF(IN_CQG) + l * 256, 1, rot); rot += 331;
            convert_job(F, INF(IN_WUKV) + (size_t)l * 128 * 512, 0, 128, 512, (bf16*)(ws + WS_WUKV_T) + (size_t)l * 512 * 128, 0, 128, 0, INF(IN_CKVG) + l * 128, 1, rot); rot += 331;
        }
    } }
    SEAM(PH_PRO);
    if (IN(PH_PRO2) && FFN_FP8) {
        convert_w8_job(F, INF(IN_F1), 0, DFF, (unsigned char*)(K_WS + WS_F13_T), 0, 2, F.ctl + CW_AMAXF, 0, (float*)(K_WS + WS_SWF), 0, 1, 0);
        convert_w8_job(F, INF(IN_F3), 0, DFF, (unsigned char*)(K_WS + WS_F13_T), 0, 3, F.ctl + CW_AMAXF + DFF, 0, (float*)(K_WS + WS_SWF), 0, 1, 555);
    }
    if (IN(PH_PRO2) && GATE_FP8) {
        for (int l = 0; l < DEPTH; ++l)
            convert_gate8(F, INF(IN_WIN) + (size_t)l * DM * D_IN, F.ctl + CW_AMAX + l * GATEW, (unsigned char*)((bf16*)(K_WS + WS_WIN_T) + (size_t)l * 6912 * DM + (size_t)PROJW * DM), (float*)(K_WS + WS_SW) + l * GATEW, l * 977);
    }
    if (GATE_FP8 || FFN_FP8) SEAM(PH_PRO2);

    layer_phases<0>(F, args, bar, lo, hi);
    layer_phases<1>(F, args, bar, lo, hi);
}
#undef IN
#undef SEAM
#undef INF
static int g_grid = 0;
static bool mega_setup() {
    if (g_grid) return g_grid > 0;
    int dev = 0, cus = 0;
    if (hipGetDevice(&dev) != hipSuccess || hipDeviceGetAttribute(&cus, hipDeviceAttributeMultiprocessorCount, dev) != hipSuccess) { g_grid = -1; return false; }
    if (hipFuncSetAttribute((const void*)mega, hipFuncAttributeMaxDynamicSharedMemorySize, LDS_BYTES) != hipSuccess) { fprintf(stderr, "mega: hipFuncSetAttribute failed\n"); g_grid = -1; return false; }
    int per_cu = 0; (void)hipOccupancyMaxActiveBlocksPerMultiprocessor(&per_cu, (const void*)mega, NWAVES * 64, LDS_BYTES); (void)hipGetLastError();
    if (per_cu < 1) { fprintf(stderr, "mega: occupancy query reports %d workgroups per CU\n", per_cu); g_grid = -1; return false; }
    g_grid = cus; return true;
}
extern "C" void kernel_launch(void* const* d_in, const int* in_sizes, int n_in, void* d_out, int out_size, void* d_ws, size_t ws_size, hipStream_t stream) {
    if (n_in != 29 || out_size != NTOK * DM || ws_size < WS_END) { fprintf(stderr, "kernel_launch: unexpected sizes n_in %d out %d ws %zu\n", n_in, out_size, ws_size); return; }
    if (!mega_setup()) return;
    (void)hipMemsetAsync((char*)d_ws + WS_CTL, 0, CTL_ZERO_BYTES, stream);
    Args a{}; for (int i = 0; i < N_IN; ++i) a.in[i] = d_in[i];
    a.out = (float*)d_out; a.ws = (unsigned char*)d_ws; a.ph_lo = 0; a.ph_hi = N_PHASES; a.li = 0; a.pad = 0;
    hipLaunchKernelGGL(mega, dim3(g_grid), dim3(NWAVES * 64), LDS_BYTES, stream, a);
}
```
